# Optimizing an MI355X kernel written in HIP

```python
import jax, jax.numpy as jnp
from jax import lax
import numpy as np

D_MODEL = 2048
BATCH = 4
SEQ = 4096
DEPTH = 1

Q_BLOCK = 128
HEAD_WIDTH = 128
MLA_HEADS = (D_MODEL // 2) // HEAD_WIDTH
MLA_NOPE_DIM = 128
MLA_ROPE_DIM = 64
MLA_V_DIM = 128
MLA_QK_DIM = MLA_NOPE_DIM + MLA_ROPE_DIM
MLA_Q_RANK = 768
MLA_KV_RANK = 512
MLA_WIDTH = MLA_HEADS * MLA_V_DIM
FOX_HEADS = (D_MODEL // 2) // HEAD_WIDTH
FOX_HEAD_DIM = HEAD_WIDTH
FOX_WIDTH = FOX_HEADS * FOX_HEAD_DIM
D_MIX = MLA_WIDTH + FOX_WIDTH
ROPE_THETA = 10000.0
NORM_EPS = 1e-6
IN_SPLITS = (MLA_Q_RANK, MLA_KV_RANK, MLA_ROPE_DIM, MLA_WIDTH,
             FOX_WIDTH, FOX_WIDTH, FOX_WIDTH, FOX_HEADS, FOX_WIDTH)
D_IN = (MLA_Q_RANK + MLA_KV_RANK + MLA_ROPE_DIM + MLA_WIDTH
        + 4 * FOX_WIDTH + FOX_HEADS)

kernel_name = "hybrid_mla_fox_parallel_heads"


def _rms_norm(x, g):
    xf = x.astype(jnp.float32)
    y = xf * lax.rsqrt(jnp.mean(xf * xf, axis=-1, keepdims=True) + NORM_EPS)
    return (y * g.astype(jnp.float32)).astype(x.dtype)


def _rope_angles(positions, dim):
    inv_freq = ROPE_THETA ** (-jnp.arange(0, dim, 2, dtype=jnp.float32) / dim)
    ang = positions.astype(jnp.float32)[..., None] * inv_freq
    return jnp.cos(ang), jnp.sin(ang)


def _apply_rope(x, cos, sin):
    xf = x.astype(jnp.float32)
    half = xf.shape[-1] // 2
    x1, x2 = xf[..., :half], xf[..., half:]
    out = jnp.concatenate([x1 * cos - x2 * sin, x2 * cos + x1 * sin], axis=-1)
    return out.astype(x.dtype)


def _causal_block_sweep(score_fn, v):
    b, seq = v.shape[0], v.shape[1]
    n_blocks = seq // Q_BLOCK
    key_pos = jnp.arange(seq)

    def one_block(i):
        start = i * Q_BLOCK
        logits = score_fn(start)
        q_pos = start + jnp.arange(Q_BLOCK)
        logits = jnp.where(key_pos[None, :] <= q_pos[:, None], logits, -jnp.inf)
        p = jax.nn.softmax(logits, axis=-1).astype(v.dtype)
        return jnp.einsum('bhqs,bshd->bqhd', p, v)

    out = lax.map(one_block, jnp.arange(n_blocks))
    return out.transpose(1, 0, 2, 3, 4).reshape(b, seq, -1)


def _mla_branch(q_lat, kv_lat, k_rope_raw, g_q, w_uq, g_kv, w_ukv, cos, sin):
    b, s, _ = q_lat.shape
    q = (_rms_norm(q_lat, g_q) @ w_uq).reshape(b, s, MLA_HEADS, MLA_QK_DIM)
    q_nope = q[..., :MLA_NOPE_DIM]
    q_rope = _apply_rope(q[..., MLA_NOPE_DIM:], cos[:, :, None, :], sin[:, :, None, :])
    kv = (_rms_norm(kv_lat, g_kv) @ w_ukv).reshape(b, s, MLA_HEADS, MLA_NOPE_DIM + MLA_V_DIM)
    k_nope, v = kv[..., :MLA_NOPE_DIM], kv[..., MLA_NOPE_DIM:]
    k_rope = _apply_rope(k_rope_raw, cos, sin)
    scale = MLA_QK_DIM ** -0.5

    def score(start):
        qn = lax.dynamic_slice_in_dim(q_nope, start, Q_BLOCK, axis=1)
        qr = lax.dynamic_slice_in_dim(q_rope, start, Q_BLOCK, axis=1)
        s_nope = jnp.einsum('bqhd,bshd->bhqs', qn, k_nope, preferred_element_type=jnp.float32)
        s_rope = jnp.einsum('bqhr,bsr->bhqs', qr, k_rope, preferred_element_type=jnp.float32)
        return (s_nope + s_rope) * scale

    return _causal_block_sweep(score, v)


def _fox_branch(q, k, v, f_logit, b_forget):
    b, s, _ = q.shape
    q = q.reshape(b, s, FOX_HEADS, FOX_HEAD_DIM)
    k = k.reshape(b, s, FOX_HEADS, FOX_HEAD_DIM)
    v = v.reshape(b, s, FOX_HEADS, FOX_HEAD_DIM)
    log_f = jax.nn.log_sigmoid(f_logit.astype(jnp.float32) + b_forget.astype(jnp.float32))
    c = jnp.cumsum(log_f, axis=1).transpose(0, 2, 1)
    scale = FOX_HEAD_DIM ** -0.5

    def score(start):
        qb = lax.dynamic_slice_in_dim(q, start, Q_BLOCK, axis=1)
        cq = lax.dynamic_slice_in_dim(c, start, Q_BLOCK, axis=2)
        logits = jnp.einsum('bqhd,bshd->bhqs', qb, k, preferred_element_type=jnp.float32) * scale
        return logits + cq[:, :, :, None] - c[:, :, None, :]

    return _causal_block_sweep(score, v)


def _hybrid_layer(x, cos, sin, g_pre, w_in, g_q, w_uq, g_kv, w_ukv, b_forget, w_out, g_post):
    h = _rms_norm(x, g_pre)
    proj = h @ w_in
    split_points = np.cumsum(IN_SPLITS)[:-1].tolist()
    (q_lat, kv_lat, k_rope_raw, gate_mla,
     fq, fk, fv, f_logit, gate_fox) = jnp.split(proj, split_points, axis=-1)
    o_mla = _mla_branch(q_lat, kv_lat, k_rope_raw, g_q, w_uq, g_kv, w_ukv, cos, sin) * jax.nn.silu(gate_mla)
    o_fox = _fox_branch(fq, fk, fv, f_logit, b_forget) * jax.nn.silu(gate_fox)
    o = jnp.concatenate([o_mla, o_fox], axis=-1) @ w_out
    return x + _rms_norm(o, g_post)


def setup_inputs(seed: int = 0) -> dict:
    key = jax.random.key(seed)
    ks = jax.random.split(key, 12)
    f32 = jnp.float32
    x = jax.random.normal(ks[0], (BATCH, SEQ, D_MODEL), f32)
    offsets = jax.random.randint(ks[1], (BATCH, 1), 0, 1024, dtype=jnp.int32)
    positions = jnp.arange(SEQ, dtype=jnp.int32)[None, :] + offsets
    g_pre = 1.0 + 0.02 * jax.random.normal(ks[2], (DEPTH, D_MODEL), f32)
    w_in = jax.random.normal(ks[3], (DEPTH, D_MODEL, D_IN), f32) * D_MODEL ** -0.5
    g_q_latent = 1.0 + 0.02 * jax.random.normal(ks[4], (DEPTH, MLA_Q_RANK), f32)
    w_uq = jax.random.normal(ks[5], (DEPTH, MLA_Q_RANK, MLA_HEADS * MLA_QK_DIM), f32) * MLA_Q_RANK ** -0.5
    g_kv_latent = 1.0 + 0.02 * jax.random.normal(ks[6], (DEPTH, MLA_KV_RANK), f32)
    w_ukv = jax.random.normal(ks[7], (DEPTH, MLA_KV_RANK, MLA_HEADS * (MLA_NOPE_DIM + MLA_V_DIM)), f32) * MLA_KV_RANK ** -0.5
    b_forget = 3.0 + 0.1 * jax.random.normal(ks[8], (DEPTH, FOX_HEADS), f32)
    w_out = jax.random.normal(ks[9], (DEPTH, D_MIX, D_MODEL), f32) * D_MIX ** -0.5
    g_post = 1.0 + 0.02 * jax.random.normal(ks[10], (DEPTH, D_MODEL), f32)
    return {"x": x, "positions": positions, "g_pre": g_pre, "w_in": w_in,
            "g_q_latent": g_q_latent, "w_uq": w_uq, "g_kv_latent": g_kv_latent,
            "w_ukv": w_ukv, "b_forget": b_forget, "w_out": w_out, "g_post": g_post}


def reference(x, positions, g_pre, w_in, g_q_latent, w_uq, g_kv_latent, w_ukv, b_forget, w_out, g_post):
    cos, sin = _rope_angles(positions, MLA_ROPE_DIM)
    for l in range(DEPTH):
        x = _hybrid_layer(x, cos, sin, g_pre[l], w_in[l], g_q_latent[l], w_uq[l],
                          g_kv_latent[l], w_ukv[l], b_forget[l], w_out[l], g_post[l])
    return x
```

```cpp
#include <hip/hip_runtime.h>
#include <hip/hip_cooperative_groups.h>
#include <cstdio>
#include <cstdint>
namespace cg = cooperative_groups;

#ifndef MK_N_LAUNCHES
#define MK_N_LAUNCHES 1
#endif

namespace pg8 {
#define PG8_LAS __attribute__((address_space(3)))
typedef unsigned short bf16_t;
typedef short bf16x8 __attribute__((ext_vector_type(8)));
typedef float f32x4 __attribute__((ext_vector_type(4)));
typedef unsigned u32x4 __attribute__((ext_vector_type(4)));
constexpr int BM = 256, BK = 64, HALF = 128, HTB = HALF * BK * 2, STAGE_BYTES = 8 * HTB, NXCD = 8, WGM = 8;

__host__ __device__ __forceinline__ int lds_byte(int r, int c) { const int st = (r >> 4) * 2 + (c >> 5), rr = r & 15, cc = c & 31, ob = rr * 64 + cc * 2; return st * 1024 + (ob ^ (((ob >> 9) & 1) << 5)); }
__host__ __device__ __forceinline__ void stage_rc(int b, int& R, int& C) { const int st = b / 1024, sb = b % 1024, swz = sb ^ (((sb >> 9) & 1) << 5); R = (st >> 1) * 16 + swz / 64; C = (st & 1) * 32 + (swz % 64) / 2; }
__host__ __device__ __forceinline__ int perm32(int rho) { const int n = rho >> 4, i = rho & 15; return 8 * (i >> 2) + 4 * n + (i & 3); }

struct Unit { int pm, pn; };
struct Gemm { const bf16_t* A; const bf16_t* Bt; int M, N, K; };

struct StaticOrder {
    int nM, nN, nwg, G, c;
    __host__ __device__ void init(int M, int N, int G_, int c_) { nM = M / BM; nN = N / BM; nwg = nM * nN; G = G_; c = c_; }
    __host__ __device__ bool next(int i, Unit& u) const {
        const long L = (long)i * G + c; if (L >= nwg) return false;
        int wgid = (int)L; { const int q = nwg / NXCD, r = nwg % NXCD, xcd = wgid % NXCD, off = wgid / NXCD; wgid = (xcd < r ? xcd * (q + 1) : r * (q + 1) + (xcd - r) * q) + off; }
        const int nig = WGM * nN, gid = wgid / nig, fm = gid * WGM, gsz = (nM - fm) < WGM ? (nM - fm) : WGM;
        u.pm = fm + ((wgid % nig) % gsz); u.pn = (wgid % nig) / gsz; return true;
    }
    __device__ __forceinline__ void a_ready(const Unit&) const {}
    __device__ __forceinline__ void done(const Unit&) const {}
};

__device__ __forceinline__ unsigned cvt_pk_bf16(float lo, float hi) { unsigned r; asm volatile("v_cvt_pk_bf16_f32 %0, %1, %2" : "=v"(r) : "v"(lo), "v"(hi)); return r; }

template <class Epi, class Sched, bool ALIGN_EPI = false, bool SP2 = false>
__device__ __forceinline__ void gemm_phase(PG8_LAS unsigned char* lds, const Gemm g, const Sched& S, const Epi& E) {
    const int tid = threadIdx.x, wid = __builtin_amdgcn_readfirstlane(tid >> 6), lane = tid & 63, wr = wid >> 2, wc = wid & 3, fr = lane & 15, fq = lane >> 4;
    const int K = g.K, nt = K / BK;
    unsigned voffA[2], voffB[2];
#pragma unroll
    for (int i = 0; i < 2; ++i) { int R, C; stage_rc(tid * 16 + i * 8192, R, C); const int Rb = Epi::PERM ? ((R & ~31) + perm32(R & 31)) : R;
        voffA[i] = (unsigned)(R * K + C) * 2u; voffB[i] = (unsigned)(Rb * K + C) * 2u; }
    const size_t kstep = (size_t)(BK * 2);
    const size_t hstep = (size_t)HALF * K * 2;
    const size_t tstep = 2 * hstep;
    const unsigned ldsw = (unsigned)wid * 1024u;
    const int aoff = lds_byte(wr * 64 + fr, fq * 8), boff = lds_byte(wc * 32 + fr, fq * 8);
#define PG8_SA(b, h) (((b) * 2 + (h)) * HTB)
#define PG8_SB(b, h) ((4 + (b) * 2 + (h)) * HTB)
#define PG8_STAGE(bufoff, gbase, voff) do { _Pragma("unroll") for (int _i = 0; _i < 2; ++_i) \
        __builtin_amdgcn_global_load_lds((const unsigned*)((const char*)(gbase) + (voff)[_i]), (PG8_LAS unsigned*)(lds + (bufoff) + ldsw + _i * 8192), 16, 0, 0); } while (0)
#define PG8_LDA(dst, b, h) do { _Pragma("unroll") for (int m = 0; m < 4; ++m) _Pragma("unroll") for (int k = 0; k < 2; ++k) dst[m][k] = *(const PG8_LAS bf16x8*)(lds + PG8_SA(b, h) + aoff + m * 2048 + k * 1024); } while (0)
#define PG8_LDB(dst, b, h) do { _Pragma("unroll") for (int n = 0; n < 2; ++n) _Pragma("unroll") for (int k = 0; k < 2; ++k) dst[n][k] = *(const PG8_LAS bf16x8*)(lds + PG8_SB(b, h) + boff + n * 2048 + k * 1024); } while (0)
#define PG8_MMA(ai, bj, At, Bt) do { __builtin_amdgcn_s_setprio(1); _Pragma("unroll") for (int m = 0; m < 4; ++m) _Pragma("unroll") for (int n = 0; n < 2; ++n) _Pragma("unroll") for (int k = 0; k < 2; ++k) \
        acc[ai][bj][m][n] = __builtin_amdgcn_mfma_f32_16x16x32_bf16(Bt[n][k], At[m][k], acc[ai][bj][m][n], 0, 0, 0); __builtin_amdgcn_s_setprio(0); } while (0)
#define PG8_WAIT_V(n) asm volatile("s_waitcnt vmcnt(" #n ")" ::: "memory")
#define PG8_WAIT_L(n) asm volatile("s_waitcnt lgkmcnt(" #n ")" ::: "memory")
#define PG8_BAR __builtin_amdgcn_s_barrier()
#define PG8_SCHED __builtin_amdgcn_sched_barrier(0)
    Unit cur, nxt; int ui = 0;
    if (!S.next(0, cur)) return;
    f32x4 acc[2][2][4][2];
#pragma unroll
    for (int a = 0; a < 2; ++a)
#pragma unroll
        for (int b = 0; b < 2; ++b)
#pragma unroll
            for (int m = 0; m < 4; ++m)
#pragma unroll
                for (int n = 0; n < 2; ++n) acc[a][b][m][n] = (f32x4){0.f, 0.f, 0.f, 0.f};
    bf16x8 At[4][2], B0[2][2], B1[2][2];
    const char* cA = (const char*)g.A + (size_t)cur.pm * tstep; const char* cB = (const char*)g.Bt + (size_t)cur.pn * tstep;
    S.a_ready(cur);
    if constexpr (SP2) {
        PG8_STAGE(PG8_SB(0, 0), cB, voffB); PG8_STAGE(PG8_SB(0, 1), cB + hstep, voffB); PG8_STAGE(PG8_SA(0, 0), cA, voffA); PG8_STAGE(PG8_SA(0, 1), cA + hstep, voffA);
        if (wr == 1) PG8_BAR;
        PG8_WAIT_V(2); PG8_BAR;
        PG8_STAGE(PG8_SB(1, 0), cB + kstep, voffB); PG8_STAGE(PG8_SA(1, 0), cA + kstep, voffA); PG8_STAGE(PG8_SB(1, 1), cB + hstep + kstep, voffB);
        PG8_WAIT_V(6); PG8_BAR;
    } else {
        PG8_STAGE(PG8_SB(0, 0), cB, voffB); PG8_STAGE(PG8_SA(0, 0), cA, voffA); PG8_STAGE(PG8_SB(0, 1), cB + hstep, voffB); PG8_STAGE(PG8_SA(0, 1), cA + hstep, voffA);
        if (wr == 1) PG8_BAR;
        PG8_WAIT_V(4); PG8_BAR;
        PG8_STAGE(PG8_SB(1, 0), cB + kstep, voffB); PG8_STAGE(PG8_SA(1, 0), cA + kstep, voffA); PG8_STAGE(PG8_SB(1, 1), cB + hstep + kstep, voffB);
        PG8_WAIT_V(6); PG8_BAR;
    }
    for (;;) {
        const bool has_next = S.next(ui + 1, nxt);
        const char* nA = has_next ? (const char*)g.A + (size_t)nxt.pm * tstep : cA; const char* nB = has_next ? (const char*)g.Bt + (size_t)nxt.pn * tstep : cB;
        for (int t = 0; t < nt; t += 2) {
            const bool last = (t == nt - 2);
            const char* a1 = cA + (size_t)(t + 1) * kstep;
            const char* a2 = last ? nA : cA + (size_t)(t + 2) * kstep; const char* b2 = last ? nB : cB + (size_t)(t + 2) * kstep;
            const char* a3 = a2 + kstep; const char* b3 = b2 + kstep;
            if (last && has_next) S.a_ready(nxt);
            if constexpr (SP2) {
            PG8_LDB(B0, 0, 0); PG8_LDB(B1, 0, 1); PG8_SCHED; PG8_LDA(At, 0, 0); PG8_STAGE(PG8_SA(1, 1), a1 + hstep, voffA);
            PG8_WAIT_V(8); PG8_WAIT_L(0); PG8_BAR; PG8_MMA(0, 0, At, B0); PG8_MMA(0, 1, At, B1); PG8_BAR; PG8_SCHED;
            PG8_LDA(At, 0, 1); PG8_STAGE(PG8_SB(0, 0), b2, voffB); PG8_STAGE(PG8_SB(0, 1), b2 + hstep, voffB); PG8_STAGE(PG8_SA(0, 0), a2, voffA);
            PG8_WAIT_V(8); PG8_WAIT_L(0); PG8_BAR; PG8_MMA(1, 0, At, B0); PG8_MMA(1, 1, At, B1); PG8_BAR; PG8_SCHED;
            PG8_LDB(B0, 1, 0); PG8_LDB(B1, 1, 1); PG8_SCHED; PG8_LDA(At, 1, 0); PG8_STAGE(PG8_SA(0, 1), a2 + hstep, voffA);
            PG8_WAIT_V(8); PG8_WAIT_L(0); PG8_BAR; PG8_MMA(0, 0, At, B0); PG8_MMA(0, 1, At, B1); PG8_BAR; PG8_SCHED;
            PG8_LDA(At, 1, 1); PG8_STAGE(PG8_SB(1, 0), b3, voffB); PG8_STAGE(PG8_SB(1, 1), b3 + hstep, voffB); PG8_STAGE(PG8_SA(1, 0), a3, voffA);
            PG8_WAIT_V(8); PG8_WAIT_L(0); PG8_BAR; PG8_MMA(1, 0, At, B0); PG8_MMA(1, 1, At, B1); PG8_BAR; PG8_SCHED;
            } else {
            PG8_LDB(B0, 0, 0); PG8_SCHED; PG8_LDA(At, 0, 0); PG8_STAGE(PG8_SA(1, 1), a1 + hstep, voffA);
            PG8_WAIT_L(8); PG8_BAR; PG8_WAIT_L(0); PG8_MMA(0, 0, At, B0); PG8_BAR; PG8_SCHED;
            PG8_LDB(B1, 0, 1); PG8_STAGE(PG8_SB(0, 0), b2, voffB);
            PG8_BAR; PG8_WAIT_L(0); PG8_MMA(0, 1, At, B1); PG8_BAR;
            PG8_LDA(At, 0, 1); PG8_STAGE(PG8_SA(0, 0), a2, voffA);
            PG8_BAR; PG8_WAIT_L(0); PG8_MMA(1, 0, At, B0); PG8_BAR; PG8_SCHED;
            PG8_STAGE(PG8_SB(0, 1), b2 + hstep, voffB);
            PG8_WAIT_V(6); PG8_BAR; PG8_MMA(1, 1, At, B1); PG8_BAR;
            PG8_LDB(B0, 1, 0); PG8_SCHED; PG8_LDA(At, 1, 0); PG8_STAGE(PG8_SA(0, 1), a2 + hstep, voffA);
            PG8_WAIT_L(8); PG8_BAR; PG8_WAIT_L(0); PG8_MMA(0, 0, At, B0); PG8_BAR; PG8_SCHED;
            PG8_LDB(B1, 1, 1); PG8_STAGE(PG8_SB(1, 0), b3, voffB);
            PG8_BAR; PG8_WAIT_L(0); PG8_MMA(0, 1, At, B1); PG8_BAR;
            PG8_LDA(At, 1, 1); PG8_STAGE(PG8_SA(1, 0), a3, voffA);
            PG8_BAR; PG8_WAIT_L(0); PG8_MMA(1, 0, At, B0); PG8_BAR; PG8_SCHED;
            PG8_STAGE(PG8_SB(1, 1), b3 + hstep, voffB);
            PG8_WAIT_V(6); PG8_BAR; PG8_MMA(1, 1, At, B1); PG8_BAR;
            }
        }
        if constexpr (ALIGN_EPI) { if (wr == 0) PG8_BAR; }
        if constexpr (!Epi::AFTER_DRAIN) { E(acc, cur, wr, wc, fr, fq); S.done(cur); }
        if (!has_next) break;
#pragma unroll
        for (int a = 0; a < 2; ++a)
#pragma unroll
            for (int b = 0; b < 2; ++b)
#pragma unroll
                for (int m = 0; m < 4; ++m)
#pragma unroll
                    for (int n = 0; n < 2; ++n) acc[a][b][m][n] = (f32x4){0.f, 0.f, 0.f, 0.f};
        cur = nxt; cA = nA; cB = nB; ++ui;
        if constexpr (ALIGN_EPI) { if (wr == 1) PG8_BAR; }
    }
    PG8_WAIT_V(0);
    if constexpr (!ALIGN_EPI) { if (wr == 0) PG8_BAR; }
    PG8_BAR;
#undef PG8_SA
#undef PG8_SB
#undef PG8_STAGE
#undef PG8_LDA
#undef PG8_LDB
#undef PG8_MMA
#undef PG8_WAIT_V
#undef PG8_WAIT_L
#undef PG8_BAR
#undef PG8_SCHED
}
}

typedef unsigned short bf16;
typedef float f32x4 __attribute__((ext_vector_type(4)));
typedef unsigned u32x4 __attribute__((ext_vector_type(4)));
typedef unsigned u32x2 __attribute__((ext_vector_type(2)));
typedef short bf16x8 __attribute__((ext_vector_type(8)));
typedef short s16x4 __attribute__((ext_vector_type(4)));
typedef float f32x16 __attribute__((ext_vector_type(16)));
#define LAS __attribute__((address_space(3)))

constexpr int BATCH = 4, SEQ = 4096, DM = 2048, M = BATCH * SEQ;
constexpr int NH = 8, QKD = 192, QRANK = 768, KVRANK = 512, DIN = 6472;
constexpr int NIN_PAD = 6656;
constexpr float EPS = 1e-6f;
constexpr float LOG2E = 1.4426950408889634f;
constexpr float C2M = 0.07216878364870322f * LOG2E;
constexpr float C2F = 0.08838834764831845f * LOG2E;

constexpr size_t MiB = 1u << 20;
constexpr size_t WS_RSTDX = 0, WS_PARTQ = 1 * MiB, WS_PARTKV = 2 * MiB, WS_PARTY = 3 * MiB, WS_FLOG = 5 * MiB, WS_CF = 6 * MiB, WS_COS = 7 * MiB, WS_SIN = 9 * MiB;
constexpr size_t WS_WIN = 16 * MiB, WS_WUQ = 42 * MiB, WS_WUKV = 45 * MiB, WS_WOUT = 47 * MiB;
constexpr size_t WS_XB = 56 * MiB, WS_O = 56 * MiB;
constexpr size_t WS_QLAT = 120 * MiB, WS_KVLAT = 144 * MiB, WS_G = 160 * MiB;
constexpr size_t WS_QF = 224 * MiB, WS_Y = 224 * MiB, WS_KF = 256 * MiB, WS_VF = 288 * MiB;
constexpr size_t WS_QM = 320 * MiB, WS_KM = 368 * MiB, WS_VM = 416 * MiB, WS_END = 448 * MiB;

constexpr int LDS_BYTES = 147456;

__device__ __forceinline__ unsigned f2bf(float f) { unsigned u = __builtin_bit_cast(unsigned, f); return (u + 0x7fffu + ((u >> 16) & 1u)) >> 16; }
__device__ __forceinline__ unsigned pk2(float lo, float hi) { return pg8::cvt_pk_bf16(lo, hi); }
__device__ __forceinline__ float bflo(unsigned w) { return __builtin_bit_cast(float, w << 16); }
__device__ __forceinline__ float bfhi(unsigned w) { return __builtin_bit_cast(float, w & 0xffff0000u); }
__device__ __forceinline__ float wave_sum(float v) {
#pragma unroll
    for (int o = 1; o < 64; o <<= 1) v += __shfl_xor(v, o);
    return v;
}
__device__ __forceinline__ float silu_f(float v) { return v * __builtin_amdgcn_rcpf(1.f + __builtin_amdgcn_exp2f(-v * LOG2E)); }
__device__ __forceinline__ u32x4 pack8f(f32x4 a, f32x4 b) { u32x4 w; w.x = pk2(a[0], a[1]); w.y = pk2(a[2], a[3]); w.z = pk2(b[0], b[1]); w.w = pk2(b[2], b[3]); return w; }

typedef pg8::f32x4 af4;
struct EpiIn {
    static constexpr bool PERM = true, AFTER_DRAIN = false;
    const float* rstd_x; bf16 *qlat, *kvlat, *G, *Qf, *Kf, *Vf, *Km; float *flog, *partq, *partkv; const float *cosT, *sinT;
    __device__ __forceinline__ void operator()(const af4 (&acc)[2][2][4][2], const pg8::Unit& u, int wr, int wc, int fr, int fq) const {
        const int pn = u.pn; const int row0 = u.pm * 256 + wr * 64 + fr;
        if (pn == 25) {
            if (wc == 0) {
#pragma unroll
                for (int ai = 0; ai < 2; ++ai)
#pragma unroll
                    for (int m = 0; m < 4; ++m) { const int row = row0 + ai * 128 + m * 16; const float rs = rstd_x[row];
                        f32x4 o1[2], o2[2];
#pragma unroll
                        for (int n = 0; n < 2; ++n) { const f32x4 c = *(const f32x4*)(cosT + (size_t)row * 32 + 8 * fq + 4 * n), s = *(const f32x4*)(sinT + (size_t)row * 32 + 8 * fq + 4 * n);
                            const f32x4 x1 = acc[ai][0][m][n] * rs, x2 = acc[ai][1][m][n] * rs; o1[n] = x1 * c - x2 * s; o2[n] = x2 * c + x1 * s; }
                        const u32x4 w1 = pack8f(o1[0], o1[1]), w2 = pack8f(o2[0], o2[1]);
                        bf16* kp = Km + (size_t)row * 1536 + 128 + 8 * fq;
#pragma unroll
                        for (int h = 0; h < 8; ++h) { *(u32x4*)(kp + h * 192) = w1; *(u32x4*)(kp + h * 192 + 32) = w2; } }
            } else if (wc == 1 && fq == 0) {
#pragma unroll
                for (int ai = 0; ai < 2; ++ai)
#pragma unroll
                    for (int m = 0; m < 4; ++m) { const int row = row0 + ai * 128 + m * 16; const float rs = rstd_x[row];
                        *(f32x4*)(flog + (size_t)row * 8) = acc[ai][0][m][0] * rs; *(f32x4*)(flog + (size_t)row * 8 + 4) = acc[ai][0][m][1] * rs; }
            }
            return;
        }
        bf16* base; int ld, colt, mode = 0; float* part = nullptr; int nslot = 0, slot0 = 0;
        if (pn < 3) { base = qlat; ld = 768; colt = pn * 256; part = partq; nslot = 12; slot0 = pn * 4; }
        else if (pn < 5) { base = kvlat; ld = 512; colt = (pn - 3) * 256; part = partkv; nslot = 8; slot0 = (pn - 3) * 4; }
        else if (pn < 9) { base = G; ld = 2048; colt = (pn - 5) * 256; mode = 1; }
        else if (pn < 13) { base = Qf; ld = 1024; colt = (pn - 9) * 256; mode = 2; }
        else if (pn < 17) { base = Kf; ld = 1024; colt = (pn - 13) * 256; }
        else if (pn < 21) { base = Vf; ld = 1024; colt = (pn - 17) * 256; }
        else { base = G; ld = 2048; colt = 1024 + (pn - 21) * 256; mode = 1; }
        const int col0 = colt + wc * 32 + 8 * fq;
#pragma unroll
        for (int ai = 0; ai < 2; ++ai)
#pragma unroll
            for (int m = 0; m < 4; ++m) { const int row = row0 + ai * 128 + m * 16; float rs = rstd_x[row]; if (mode == 2) rs *= C2F;
                bf16* rowp = base + (size_t)row * ld + col0; float ss = 0.f;
#pragma unroll
                for (int bj = 0; bj < 2; ++bj) { f32x4 v0 = acc[ai][bj][m][0] * rs, v1 = acc[ai][bj][m][1] * rs;
                    ss += (v0[0] * v0[0] + v0[1] * v0[1]) + (v0[2] * v0[2] + v0[3] * v0[3]) + (v1[0] * v1[0] + v1[1] * v1[1]) + (v1[2] * v1[2] + v1[3] * v1[3]);
                    if (mode == 1) {
#pragma unroll
                        for (int e = 0; e < 4; ++e) { v0[e] = silu_f(v0[e]); v1[e] = silu_f(v1[e]); } }
                    *(u32x4*)(rowp + bj * 128) = pack8f(v0, v1); }
                if (part) { ss += __shfl_xor(ss, 16); ss += __shfl_xor(ss, 32); if (fq == 0) part[(size_t)row * nslot + slot0 + wc] = ss; } }
    }
};
struct EpiQ {
    static constexpr bool PERM = true, AFTER_DRAIN = false;
    const float* partq; bf16* Qm; const float *cosT, *sinT;
    __device__ __forceinline__ void operator()(const af4 (&acc)[2][2][4][2], const pg8::Unit& u, int wr, int wc, int fr, int fq) const {
        const int pn = u.pn; const int row0 = u.pm * 256 + wr * 64 + fr;
#pragma unroll
        for (int ai = 0; ai < 2; ++ai)
#pragma unroll
            for (int m = 0; m < 4; ++m) { const int row = row0 + ai * 128 + m * 16;
                const f32x4 pa = *(const f32x4*)(partq + (size_t)row * 12), pb = *(const f32x4*)(partq + (size_t)row * 12 + 4), pc = *(const f32x4*)(partq + (size_t)row * 12 + 8);
                const float ssq = ((pa[0] + pa[1]) + (pa[2] + pa[3])) + ((pb[0] + pb[1]) + (pb[2] + pb[3])) + ((pc[0] + pc[1]) + (pc[2] + pc[3]));
                const float rs = C2M / sqrtf(ssq * (1.f / 768.f) + EPS);
                if (pn < 4) {
#pragma unroll
                    for (int bj = 0; bj < 2; ++bj) *(u32x4*)(Qm + (size_t)row * 1536 + (2 * pn + bj) * 192 + wc * 32 + 8 * fq) = pack8f(acc[ai][bj][m][0] * rs, acc[ai][bj][m][1] * rs);
                } else { const int head = 4 * (pn - 4) + wc; f32x4 o1[2], o2[2];
#pragma unroll
                    for (int n = 0; n < 2; ++n) { const f32x4 c = *(const f32x4*)(cosT + (size_t)row * 32 + 8 * fq + 4 * n), s = *(const f32x4*)(sinT + (size_t)row * 32 + 8 * fq + 4 * n);
                        const f32x4 x1 = acc[ai][0][m][n] * rs, x2 = acc[ai][1][m][n] * rs; o1[n] = x1 * c - x2 * s; o2[n] = x2 * c + x1 * s; }
                    bf16* qp = Qm + (size_t)row * 1536 + head * 192 + 128 + 8 * fq;
                    *(u32x4*)qp = pack8f(o1[0], o1[1]); *(u32x4*)(qp + 32) = pack8f(o2[0], o2[1]); } }
    }
};
struct EpiKV {
    static constexpr bool PERM = true, AFTER_DRAIN = false;
    const float* partkv; bf16 *Km, *Vm;
    __device__ __forceinline__ void operator()(const af4 (&acc)[2][2][4][2], const pg8::Unit& u, int wr, int wc, int fr, int fq) const {
        const int pn = u.pn; const int row0 = u.pm * 256 + wr * 64 + fr;
#pragma unroll
        for (int ai = 0; ai < 2; ++ai)
#pragma unroll
            for (int m = 0; m < 4; ++m) { const int row = row0 + ai * 128 + m * 16;
                const f32x4 pa = *(const f32x4*)(partkv + (size_t)row * 8), pb = *(const f32x4*)(partkv + (size_t)row * 8 + 4);
                const float ssq = ((pa[0] + pa[1]) + (pa[2] + pa[3])) + ((pb[0] + pb[1]) + (pb[2] + pb[3]));
                const float rs = 1.f / sqrtf(ssq * (1.f / 512.f) + EPS);
                *(u32x4*)(Km + (size_t)row * 1536 + pn * 192 + wc * 32 + 8 * fq) = pack8f(acc[ai][0][m][0] * rs, acc[ai][0][m][1] * rs);
                *(u32x4*)(Vm + (size_t)row * 1024 + pn * 128 + wc * 32 + 8 * fq) = pack8f(acc[ai][1][m][0] * rs, acc[ai][1][m][1] * rs); }
    }
};
struct EpiOut {
    static constexpr bool PERM = true, AFTER_DRAIN = false;
    bf16* Y; float* party;
    __device__ __forceinline__ void operator()(const af4 (&acc)[2][2][4][2], const pg8::Unit& u, int wr, int wc, int fr, int fq) const {
        const int pn = u.pn; const int row0 = u.pm * 256 + wr * 64 + fr; const int col0 = pn * 256 + wc * 32 + 8 * fq;
#pragma unroll
        for (int ai = 0; ai < 2; ++ai)
#pragma unroll
            for (int m = 0; m < 4; ++m) { const int row = row0 + ai * 128 + m * 16; float ss = 0.f;
#pragma unroll
                for (int bj = 0; bj < 2; ++bj) { const f32x4 v0 = acc[ai][bj][m][0], v1 = acc[ai][bj][m][1];
                    ss += (v0[0] * v0[0] + v0[1] * v0[1]) + (v0[2] * v0[2] + v0[3] * v0[3]) + (v1[0] * v1[0] + v1[1] * v1[1]) + (v1[2] * v1[2] + v1[3] * v1[3]);
                    *(u32x4*)(Y + (size_t)row * 2048 + col0 + bj * 128) = pack8f(v0, v1); }
                ss += __shfl_xor(ss, 16); ss += __shfl_xor(ss, 32); if (fq == 0) party[(size_t)row * 32 + pn * 4 + wc] = ss; }
    }
};

namespace att {
constexpr int KVBLK = 64, QBLK = 32, QB = 256;
constexpr int SHM_K = 24576, SHM_V = 16384;
constexpr int OFF_K = 0, OFF_V = 2 * SHM_K, OFF_CK = OFF_V + 2 * SHM_V, OFF_WS = OFF_CK + 512, OFF_QP = OFF_WS + 2048;
constexpr float THR = 8.f;
#define KSWZ(row, colB) ((row) * 256 + ((colB) ^ (((row) & 7) << 4)))
#define SBAR() __builtin_amdgcn_sched_barrier(0)
__device__ __forceinline__ int v_st(int k, int c) { const int kk = (k & ~0xC) | ((k & 4) << 1) | ((k & 8) >> 1); return ((kk >> 3) * 4 + (c >> 5)) * 512 + ((kk & 7) * 32 + (c & 31)) * 2; }
__device__ __forceinline__ int v_rd_base(int lane) { return ((lane & 3) << 3) | (((lane >> 2) & 3) << 6) | (((lane >> 4) & 1) << 5) | (((lane >> 5) & 1) << 8); }
constexpr int v_rd_off(int d0, int ks, int half) { return d0 * 512 + ks * 4096 + half * 2048; }
__device__ __forceinline__ int crow(int r, int hi) { return (r & 3) + 8 * (r >> 2) + 4 * hi; }
__device__ __forceinline__ unsigned cvtpk(float lo, float hi) { unsigned r; asm volatile("v_cvt_pk_bf16_f32 %0, %1, %2" : "=v"(r) : "v"(lo), "v"(hi)); return r; }

__device__ __forceinline__ void mask_tile(f32x16& p0, f32x16& p1, int dq) {
    const float NEG = -__builtin_inff();
#pragma unroll
    for (int r = 0; r < 16; ++r) { const int c = (r & 3) + 8 * (r >> 2);
        if (dq - c < 0) p0[r] = NEG;
        if (dq - c - 32 < 0) p1[r] = NEG; }
}
__device__ __forceinline__ void softmax_tile(f32x16& p0, f32x16& p1, float& m_reg, float& l_reg, float& alpha, bf16x8& pa0, bf16x8& pa1, bf16x8& pa2, bf16x8& pa3) {
    float pmax = p0[0];
#pragma unroll
    for (int r = 1; r < 16; ++r) pmax = fmaxf(pmax, p0[r]);
#pragma unroll
    for (int r = 0; r < 16; ++r) pmax = fmaxf(pmax, p1[r]);
    { auto rr = __builtin_amdgcn_permlane32_swap(__float_as_uint(pmax), __float_as_uint(pmax), false, false);
      pmax = fmaxf(__uint_as_float(rr[0]), __uint_as_float(rr[1])); }
    float mn;
    if (__builtin_expect(__all(pmax - m_reg <= THR), 1)) { mn = m_reg; alpha = 1.f; }
    else { mn = fmaxf(m_reg, pmax); alpha = __builtin_amdgcn_exp2f(m_reg - mn); m_reg = mn; }
#pragma unroll
    for (int r = 0; r < 16; ++r) { p0[r] = __builtin_amdgcn_exp2f(p0[r] - mn); p1[r] = __builtin_amdgcn_exp2f(p1[r] - mn); }
    float ps = 0.f;
#pragma unroll
    for (int r = 0; r < 16; ++r) ps += p0[r];
#pragma unroll
    for (int r = 0; r < 16; ++r) ps += p1[r];
    { auto rr = __builtin_amdgcn_permlane32_swap(__float_as_uint(ps), __float_as_uint(ps), false, false);
      ps = __uint_as_float(rr[0]) + __uint_as_float(rr[1]); }
    l_reg = l_reg * alpha + ps;
#define PK4(P, B_, OUT) do { unsigned a0 = cvtpk(P[B_+0], P[B_+1]), a1 = cvtpk(P[B_+2], P[B_+3]);                          \
        unsigned b0 = cvtpk(P[B_+4], P[B_+5]), b1 = cvtpk(P[B_+6], P[B_+7]);                                             \
        auto r0 = __builtin_amdgcn_permlane32_swap(a0, b0, false, false); auto r1 = __builtin_amdgcn_permlane32_swap(a1, b1, false, false); \
        u32x4 w = {r0[0], r1[0], r0[1], r1[1]}; OUT = *reinterpret_cast<bf16x8*>(&w); } while (0)
    PK4(p0, 0, pa0); PK4(p0, 8, pa1); PK4(p1, 0, pa2); PK4(p1, 8, pa3);
#undef PK4
}
template <int DQK>
__device__ __forceinline__ void qkt(f32x16& p0, f32x16& p1, const char* Kb, int r32, int hi, const bf16x8* qr, const char* qpk) {
    p0 = f32x16{}; p1 = f32x16{};
    const char* kb[4];
#pragma unroll
    for (int dd = 0; dd < 4; ++dd) kb[dd] = Kb + KSWZ(r32, (dd * 16 + hi * 8) * 2);
#pragma unroll
    for (int d0 = 0; d0 < 8; ++d0) { const char* a = kb[d0 & 3] + (d0 >> 2) * 128;
        bf16x8 b0 = *reinterpret_cast<const bf16x8*>(a);
        bf16x8 b1 = *reinterpret_cast<const bf16x8*>(a + 32 * 256);
        bf16x8 qf; if (DQK == 128 && d0 >= 4) qf = *reinterpret_cast<const bf16x8*>(qpk + (d0 - 4) * 1024); else qf = qr[d0];
        p0 = __builtin_amdgcn_mfma_f32_32x32x16_bf16(b0, qf, p0, 0, 0, 0);
        p1 = __builtin_amdgcn_mfma_f32_32x32x16_bf16(b1, qf, p1, 0, 0, 0); }
    if constexpr (DQK == 192) {
#pragma unroll
        for (int d0 = 0; d0 < 4; ++d0) { const char* a = Kb + 16384 + r32 * 128 + (((d0 * 16 + hi * 8) * 2) ^ ((r32 & 7) << 4));
            bf16x8 b0 = *reinterpret_cast<const bf16x8*>(a);
            bf16x8 b1 = *reinterpret_cast<const bf16x8*>(a + 32 * 128);
            const bf16x8 qf = *reinterpret_cast<const bf16x8*>(qpk + d0 * 1024);
            p0 = __builtin_amdgcn_mfma_f32_32x32x16_bf16(b0, qf, p0, 0, 0, 0);
            p1 = __builtin_amdgcn_mfma_f32_32x32x16_bf16(b1, qf, p1, 0, 0, 0); }
    }
}
template <int VOFF>
__device__ __forceinline__ void pv_tile(f32x16* o, int vb0, bf16x8 pa0, bf16x8 pa1, bf16x8 pa2, bf16x8 pa3) {
#define TRRD(dst, off) asm volatile("ds_read_b64_tr_b16 %0, %1 offset:%2" : "=&v"(dst) : "v"(vb0), "i"(off) : "memory")
#define PV_D0(d0) do { s16x4 l0, l1, l2, l3, h0, h1, h2, h3; constexpr int b_ = VOFF + v_rd_off(d0, 0, 0); \
        TRRD(l0, b_); TRRD(h0, b_ + 2048); TRRD(l1, b_ + 4096); TRRD(h1, b_ + 6144); TRRD(l2, b_ + 8192); TRRD(h2, b_ + 10240); TRRD(l3, b_ + 12288); TRRD(h3, b_ + 14336); \
        asm volatile("s_waitcnt lgkmcnt(0)" ::: "memory"); SBAR(); \
        o[d0] = __builtin_amdgcn_mfma_f32_32x32x16_bf16(pa0, (bf16x8){l0[0], l0[1], l0[2], l0[3], h0[0], h0[1], h0[2], h0[3]}, o[d0], 0, 0, 0);   \
        o[d0] = __builtin_amdgcn_mfma_f32_32x32x16_bf16(pa1, (bf16x8){l1[0], l1[1], l1[2], l1[3], h1[0], h1[1], h1[2], h1[3]}, o[d0], 0, 0, 0);   \
        o[d0] = __builtin_amdgcn_mfma_f32_32x32x16_bf16(pa2, (bf16x8){l2[0], l2[1], l2[2], l2[3], h2[0], h2[1], h2[2], h2[3]}, o[d0], 0, 0, 0);   \
        o[d0] = __builtin_amdgcn_mfma_f32_32x32x16_bf16(pa3, (bf16x8){l3[0], l3[1], l3[2], l3[3], h3[0], h3[1], h3[2], h3[3]}, o[d0], 0, 0, 0); } while (0)
    PV_D0(0); PV_D0(1); PV_D0(2); PV_D0(3);
#undef PV_D0
#undef TRRD
}

template <int DQK, bool FOX>
__device__ __forceinline__ void attn_unit(char* lds, const bf16* Q, int ldq, const bf16* K, int ldk, const bf16* V, int ldv, const float* cfs, const bf16* Gp, bf16* Op, int qb) {
    const int tid = threadIdx.x, wid = __builtin_amdgcn_readfirstlane(tid >> 6), lane = tid & 63, r32 = lane & 31, hi = lane >> 5;
    const int q0 = qb * QB, NT = 4 * (qb + 1);
    char* K_lds = lds + OFF_K; char* V_lds = lds + OFF_V; float* ck_l = (float*)(lds + OFF_CK);
    float* wsf = (float*)(lds + OFF_WS) + wid * 64; float* li_l = wsf; float* al_l = wsf + 32;
    constexpr int NQR = DQK / 16 - 4;
    bf16x8 qr[NQR];
    char* qpk = lds + OFF_QP + wid * 4096 + (hi * 32 + r32) * 16;
    { const bf16* qp = Q + (size_t)(q0 + wid * QBLK + r32) * ldq + hi * 8;
#pragma unroll
      for (int d0 = 0; d0 < NQR; ++d0) qr[d0] = *(const bf16x8*)(qp + d0 * 16);
#pragma unroll
      for (int d0 = 0; d0 < 4; ++d0) *(bf16x8*)(qpk + d0 * 1024) = *(const bf16x8*)(qp + (NQR + d0) * 16); }
    float cq = 0.f; if constexpr (FOX) cq = cfs[q0 + wid * QBLK + r32];
    unsigned koff[2], voff[2], kroff = 0;
#pragma unroll
    for (int j = 0; j < 2; ++j) { const int p = wid + 8 * j;
        { const int row = 4 * p + (lane >> 4), c = (lane & 15) ^ (row & 7); koff[j] = (unsigned)(row * ldk + c * 8) * 2u; }
        { const int st = 2 * p + (lane >> 5), kk = 8 * (st >> 2) + ((lane & 31) >> 2), k = (kk & ~0xC) | ((kk & 4) << 1) | ((kk & 8) >> 1); voff[j] = (unsigned)(k * ldv + 32 * (st & 3) + 8 * (lane & 3)) * 2u; } }
    if constexpr (DQK == 192) { const int row = 8 * wid + (lane >> 3), c = (lane & 7) ^ (row & 7); kroff = (unsigned)(row * ldk + 128 + c * 8) * 2u; }
    const int vb0 = (int)(uintptr_t)V_lds + v_rd_base(lane);
    LAS unsigned char* ldsl = (LAS unsigned char*)(uintptr_t)(unsigned)(uintptr_t)lds;
#define A_DMA(t, bf) do { const char* kt_ = (const char*)K + (size_t)(t) * KVBLK * ldk * 2; const char* vt_ = (const char*)V + (size_t)(t) * KVBLK * ldv * 2; \
        _Pragma("unroll") for (int j_ = 0; j_ < 2; ++j_) { \
            __builtin_amdgcn_global_load_lds((const unsigned*)(kt_ + koff[j_]), (LAS unsigned*)(ldsl + OFF_K + (bf) * SHM_K + (wid + 8 * j_) * 1024), 16, 0, 0); \
            __builtin_amdgcn_global_load_lds((const unsigned*)(vt_ + voff[j_]), (LAS unsigned*)(ldsl + OFF_V + (bf) * SHM_V + (wid + 8 * j_) * 1024), 16, 0, 0); } \
        if constexpr (DQK == 192) __builtin_amdgcn_global_load_lds((const unsigned*)(kt_ + kroff), (LAS unsigned*)(ldsl + OFF_K + (bf) * SHM_K + 16384 + wid * 1024), 16, 0, 0); \
        if constexpr (FOX) { if (wid == 0) __builtin_amdgcn_global_load_lds((const unsigned*)(cfs + (t) * KVBLK + lane), (LAS unsigned*)(ldsl + OFF_CK + (bf) * 256), 4, 0, 0); } } while (0)
#define A_SYNC() do { asm volatile("s_waitcnt vmcnt(0)" ::: "memory"); __syncthreads(); } while (0)
    A_DMA(0, 0);
    A_SYNC();
    float m_reg = -1e30f, l_reg = 0.f; f32x16 o[4] = {};
#define A_STEP(KB, t) do { \
        if ((t) + 1 < NT) A_DMA((t) + 1, (KB) ^ 1); \
        const int jb_ = (t) - (NT - 4); \
        if (jb_ < 0 || 64 * jb_ <= 32 * wid + 31) { \
            f32x16 p0, p1; float alpha; bf16x8 pa0, pa1, pa2, pa3; \
            qkt<DQK>(p0, p1, K_lds + (KB) * SHM_K, r32, hi, qr, qpk); \
            if constexpr (FOX) { const float* ckp = ck_l + (KB) * 64 + 4 * hi; \
                _Pragma("unroll") for (int g_ = 0; g_ < 4; ++g_) { const f32x4 c0 = *(const f32x4*)(ckp + 8 * g_), c1 = *(const f32x4*)(ckp + 32 + 8 * g_); \
                    _Pragma("unroll") for (int e_ = 0; e_ < 4; ++e_) { p0[4 * g_ + e_] += cq - c0[e_]; p1[4 * g_ + e_] += cq - c1[e_]; } } } \
            if (jb_ >= 0 && 64 * jb_ + 63 > 32 * wid) mask_tile(p0, p1, 32 * wid + r32 - 64 * jb_ - 4 * hi); \
            softmax_tile(p0, p1, m_reg, l_reg, alpha, pa0, pa1, pa2, pa3); \
            if (__any(alpha < 1.f)) { if (hi == 0) al_l[r32] = alpha; asm volatile("s_waitcnt lgkmcnt(0)" ::: "memory"); \
                _Pragma("unroll") for (int d_ = 0; d_ < 4; ++d_) _Pragma("unroll") for (int r = 0; r < 16; ++r) o[d_][r] *= al_l[crow(r, hi)]; } \
            SBAR(); pv_tile<(KB) * SHM_V>(o, vb0, pa0, pa1, pa2, pa3); \
        } \
        A_SYNC(); } while (0)
    for (int t = 0; t < NT; t += 2) { A_STEP(0, t); A_STEP(1, t + 1); }
#undef A_STEP
#undef A_DMA
#undef A_SYNC
    if (hi == 0) li_l[r32] = l_reg; asm volatile("s_waitcnt lgkmcnt(0)" ::: "memory");
    bf16* stg = (bf16*)(lds + wid * 8192);
#pragma unroll
    for (int r = 0; r < 16; ++r) { const int orow = crow(r, hi); const float rl = __builtin_amdgcn_rcpf(li_l[orow]);
#pragma unroll
        for (int d0 = 0; d0 < 4; ++d0) stg[orow * 128 + d0 * 32 + r32] = (bf16)f2bf(o[d0][r] * rl); }
    asm volatile("s_waitcnt lgkmcnt(0)" ::: "memory");
#pragma unroll
    for (int i = 0; i < 8; ++i) { const int row = i * 4 + (lane >> 4), ch = lane & 15;
        const u32x4 v = *(const u32x4*)(stg + row * 128 + ch * 8);
        const size_t go = (size_t)(q0 + wid * QBLK + row) * 2048 + ch * 8;
        const u32x4 g = *(const u32x4*)(Gp + go); u32x4 w;
        w.x = cvtpk(bflo(v.x) * bflo(g.x), bfhi(v.x) * bfhi(g.x)); w.y = cvtpk(bflo(v.y) * bflo(g.y), bfhi(v.y) * bfhi(g.y));
        w.z = cvtpk(bflo(v.z) * bflo(g.z), bfhi(v.z) * bfhi(g.z)); w.w = cvtpk(bflo(v.w) * bflo(g.w), bfhi(v.w) * bfhi(g.w));
        *(u32x4*)(Op + go) = w; }
    __syncthreads();
}
#undef KSWZ
#undef SBAR
}

__device__ __forceinline__ void transpose_item(const float* W, int ldw, int K, const float* g, bf16* WT, int dst_row0, int src_col0, int nvalid, int k0, LAS float* scr, int lane) {
    const int n = lane & 31; const bool ok = (src_col0 >= 0) && (n < nvalid);
#pragma unroll 8
    for (int i = 0; i < 32; ++i) { const int kk = 2 * i + (lane >> 5); float v = 0.f; if (ok) { v = W[(size_t)(k0 + kk) * ldw + src_col0 + n]; if (g) v *= g[k0 + kk]; } scr[kk * 33 + n] = v; }
    asm volatile("s_waitcnt lgkmcnt(0)" ::: "memory");
    const int c = lane & 7;
#pragma unroll
    for (int j = 0; j < 4; ++j) { const int nn = (lane >> 3) + 8 * j; const LAS float* s = scr + (8 * c) * 33 + nn;
        u32x4 o; o.x = pk2(s[0 * 33], s[1 * 33]); o.y = pk2(s[2 * 33], s[3 * 33]); o.z = pk2(s[4 * 33], s[5 * 33]); o.w = pk2(s[6 * 33], s[7 * 33]);
        *(u32x4*)(WT + (size_t)(dst_row0 + nn) * K + k0 + 8 * c) = o; }
    asm volatile("s_waitcnt lgkmcnt(0)" ::: "memory");
}
__device__ __forceinline__ void win_src(int r0, int& src, int& nv) {
    nv = 32;
    if (r0 < 1280) src = r0;
    else if (r0 < 2304) src = 1344 + (r0 - 1280);
    else if (r0 < 3328) src = 2368 + (r0 - 2304);
    else if (r0 < 4352) src = 3392 + (r0 - 3328);
    else if (r0 < 5376) src = 4416 + (r0 - 4352);
    else if (r0 < 6400) src = 5448 + (r0 - 5376);
    else if (r0 == 6400) src = 1280;
    else if (r0 == 6432) { src = 5440; nv = 8; }
    else if (r0 == 6528) src = 1312;
    else src = -1;
}
__device__ __forceinline__ int wuq_src(int r0) {
    if (r0 < 1024) return (r0 >> 7) * 192 + (r0 & 127);
    const int q = r0 - 1024, t = q >> 8, bj = (q >> 7) & 1, wc = (q >> 5) & 3;
    return (4 * t + wc) * 192 + 128 + 32 * bj;
}

struct Args { const float* x; const int* pos; const float* g_pre; const float* w_in; const float* g_q; const float* w_uq; const float* g_kv; const float* w_ukv;
              const float* b_forget; const float* w_out; const float* g_post; float* out; unsigned char* ws; int ph_lo, ph_hi; };

__global__ void __launch_bounds__(512, 2) hybrid_fwd(Args a) {
    extern __shared__ __attribute__((aligned(16))) unsigned char lds[];
    cg::grid_group grid = cg::this_grid();
    const int tid = threadIdx.x, lane = tid & 63, wave = __builtin_amdgcn_readfirstlane(tid >> 6);
    const int G = gridDim.x, bx = blockIdx.x; const int vcu = (G % 8 == 0) ? (bx % 8) * (G / 8) + bx / 8 : bx;
    unsigned char* ws = a.ws;
    float* rstd_x = (float*)(ws + WS_RSTDX); float* partq = (float*)(ws + WS_PARTQ); float* partkv = (float*)(ws + WS_PARTKV); float* party = (float*)(ws + WS_PARTY);
    float* flog = (float*)(ws + WS_FLOG); float* cf = (float*)(ws + WS_CF); float* cosT = (float*)(ws + WS_COS); float* sinT = (float*)(ws + WS_SIN);
    bf16* Win_t = (bf16*)(ws + WS_WIN); bf16* Wuq_t = (bf16*)(ws + WS_WUQ); bf16* Wukv_t = (bf16*)(ws + WS_WUKV); bf16* Wout_t = (bf16*)(ws + WS_WOUT);
    bf16* Xb = (bf16*)(ws + WS_XB); bf16* Ob = (bf16*)(ws + WS_O); bf16* qlat = (bf16*)(ws + WS_QLAT); bf16* kvlat = (bf16*)(ws + WS_KVLAT); bf16* Gb = (bf16*)(ws + WS_G);
    bf16* Qf = (bf16*)(ws + WS_QF); bf16* Kf = (bf16*)(ws + WS_KF); bf16* Vf = (bf16*)(ws + WS_VF); bf16* Yb = (bf16*)(ws + WS_Y);
    bf16* Qm = (bf16*)(ws + WS_QM); bf16* Km = (bf16*)(ws + WS_KM); bf16* Vm = (bf16*)(ws + WS_VM);
    const int lo = a.ph_lo, hi = a.ph_hi;
#ifndef PH_MASK
#define PH_MASK 63
#endif
#define IN(k) (((PH_MASK >> (k)) & 1) && lo <= (k) && (k) < hi)
#define BOTH(k) (IN(k) && IN((k) + 1))
    LAS unsigned char* ldsl = (LAS unsigned char*)lds;

    if (IN(0)) {
        LAS float* scr = (LAS float*)(ldsl + wave * 16384);
        const int gw = vcu * 8 + wave, NGW = G * 8;
        constexpr int I_IN = 32 * 208, I_UQ = 12 * 48, I_UKV = 8 * 64, I_OUT = 32 * 64, NITEMS = I_IN + I_UQ + I_UKV + I_OUT;
        for (int it = gw; it < NITEMS; it += NGW) {
            int r = it;
            if (r < I_IN) { const int kb = r / 208, nb = r % 208; int src, nv; win_src(nb * 32, src, nv); transpose_item(a.w_in, DIN, 2048, a.g_pre, Win_t, nb * 32, src, nv, kb * 64, scr, lane); continue; } r -= I_IN;
            if (r < I_UQ) { const int kb = r / 48, nb = r % 48; transpose_item(a.w_uq, 1536, 768, a.g_q, Wuq_t, nb * 32, wuq_src(nb * 32), 32, kb * 64, scr, lane); continue; } r -= I_UQ;
            if (r < I_UKV) { const int kb = r / 64, nb = r % 64; transpose_item(a.w_ukv, 2048, 512, a.g_kv, Wukv_t, nb * 32, nb * 32, 32, kb * 64, scr, lane); continue; } r -= I_UKV;
            { const int kb = r / 64, nb = r % 64; transpose_item(a.w_out, 2048, 2048, nullptr, Wout_t, nb * 32, nb * 32, 32, kb * 64, scr, lane); }
        }
        for (int m = gw; m < M; m += NGW) {
            const f32x4* xr = (const f32x4*)(a.x + (size_t)m * DM) + lane; f32x4 v[8]; float s = 0.f;
#pragma unroll
            for (int j = 0; j < 8; ++j) { v[j] = xr[64 * j]; s += (v[j][0] * v[j][0] + v[j][1] * v[j][1]) + (v[j][2] * v[j][2] + v[j][3] * v[j][3]); }
            s = wave_sum(s); if (lane == 0) rstd_x[m] = 1.f / sqrtf(s * (1.f / DM) + EPS);
            u32x2* o8 = (u32x2*)(Xb + (size_t)m * DM) + lane;
#pragma unroll
            for (int j = 0; j < 8; ++j) { u32x2 w; w.x = pk2(v[j][0], v[j][1]); w.y = pk2(v[j][2], v[j][3]); o8[64 * j] = w; }
        }
        for (int e = (vcu * 512 + tid); e < M * 32; e += G * 512) { const int row = e >> 5, i = e & 31;
            const float inv = exp2f(-(float)i * (13.287712379549449f / 32.f)); const float ang = (float)a.pos[row] * inv;
            const float n = rintf(ang * 0.15915494309189535f); float r = fmaf(-n, 6.28318548202514648f, ang); r = fmaf(-n, -1.7484555e-7f, r);
            cosT[e] = __cosf(r); sinT[e] = __sinf(r); }
    }
    if (BOTH(0)) grid.sync();

    if (IN(1)) {
        pg8::Gemm g{Xb, Win_t, M, NIN_PAD, 2048}; pg8::StaticOrder S; S.init(M, NIN_PAD, G, bx);
        EpiIn E{rstd_x, qlat, kvlat, Gb, Qf, Kf, Vf, Km, flog, partq, partkv, cosT, sinT};
        pg8::gemm_phase<EpiIn, pg8::StaticOrder, true, true>(ldsl, g, S, E);
    }
    if (BOTH(1)) grid.sync();

    if (IN(2)) {
        const int gw = bx * 8 + wave;
        if (gw < BATCH * NH) { const int b = gw >> 3, h = gw & 7; const float bf = a.b_forget[h];
            const float* fl = flog + ((size_t)b * SEQ + 64 * lane) * 8 + h; float run = 0.f;
            for (int j = 0; j < 64; ++j) { const float z = fl[j * 8] + bf; run += fminf(z, 0.f) - log1pf(expf(-fabsf(z))); }
            float incl = run;
#pragma unroll
            for (int o = 1; o < 64; o <<= 1) { const float t = __shfl_up(incl, o); if (lane >= o) incl += t; }
            float acc = incl - run; float* cp = cf + (size_t)gw * SEQ + 64 * lane;
            for (int j = 0; j < 64; ++j) { const float z = fl[j * 8] + bf; acc += fminf(z, 0.f) - log1pf(expf(-fabsf(z))); cp[j] = acc * LOG2E; }
        }
        { pg8::Gemm g{qlat, Wuq_t, M, 1536, QRANK}; pg8::StaticOrder S; S.init(M, 1536, G, bx);
          EpiQ E{partq, Qm, cosT, sinT};
          pg8::gemm_phase<EpiQ, pg8::StaticOrder, true, true>(ldsl, g, S, E); }
        { pg8::Gemm g{kvlat, Wukv_t, M, 2048, KVRANK}; pg8::StaticOrder S; S.init(M, 2048, G, bx);
          EpiKV E{partkv, Km, Vm};
          pg8::gemm_phase<EpiKV, pg8::StaticOrder, true, true>(ldsl, g, S, E); }
    }
    if (BOTH(2)) grid.sync();

    if (IN(3)) {
        for (int v = vcu; v < 256; v += G) {
            const int s = v & 3, w = v >> 2, b = w >> 4, hh = w & 15, hd = hh & 7, swp = hh >> 3;
            const size_t rb = (size_t)b * SEQ;
#pragma unroll 1
            for (int i = 0; i < 2; ++i) {
                const int qb = __builtin_amdgcn_readfirstlane(swp ? (i == 0 ? 8 + s : 7 - s) : (i == 0 ? 15 - s : s));
                att::attn_unit<192, false>((char*)lds, Qm + rb * 1536 + hd * 192, 1536, Km + rb * 1536 + hd * 192, 1536, Vm + rb * 1024 + hd * 128, 1024, nullptr,
                                           Gb + rb * 2048 + hd * 128, Ob + rb * 2048 + hd * 128, qb);
            }
#pragma unroll 1
            for (int i = 0; i < 2; ++i) {
                const int qb = __builtin_amdgcn_readfirstlane(swp ? (i == 0 ? 15 - s : s) : (i == 0 ? 8 + s : 7 - s));
                att::attn_unit<128, true>((char*)lds, Qf + rb * 1024 + hd * 128, 1024, Kf + rb * 1024 + hd * 128, 1024, Vf + rb * 1024 + hd * 128, 1024, cf + (size_t)(b * 8 + hd) * SEQ,
                                          Gb + rb * 2048 + 1024 + hd * 128, Ob + rb * 2048 + 1024 + hd * 128, qb);
            }
        }
    }
    if (BOTH(3)) grid.sync();

    if (IN(4)) {
        pg8::Gemm g{Ob, Wout_t, M, 2048, 2048}; pg8::StaticOrder S; S.init(M, 2048, G, bx);
        EpiOut E{Yb, party};
        pg8::gemm_phase<EpiOut, pg8::StaticOrder, true, true>(ldsl, g, S, E);
    }
    if (BOTH(4)) grid.sync();

    if (IN(5)) {
        const int gw = vcu * 8 + wave, NGW = G * 8;
        for (int m = gw; m < M; m += NGW) {
            float s = (lane < 32) ? party[(size_t)m * 32 + lane] : 0.f; s = wave_sum(s);
            const float rs = 1.f / sqrtf(s * (1.f / DM) + EPS);
            const f32x4* xr = (const f32x4*)(a.x + (size_t)m * DM) + lane; const f32x4* gp = (const f32x4*)a.g_post + lane;
            const u32x2* yr = (const u32x2*)(Yb + (size_t)m * DM) + lane; f32x4* orow = (f32x4*)(a.out + (size_t)m * DM) + lane;
#pragma unroll
            for (int j = 0; j < 8; ++j) { const f32x4 xv = xr[64 * j], gv = gp[64 * j]; const u32x2 y = yr[64 * j];
                f32x4 o; o[0] = xv[0] + bflo(y.x) * rs * gv[0]; o[1] = xv[1] + bfhi(y.x) * rs * gv[1]; o[2] = xv[2] + bflo(y.y) * rs * gv[2]; o[3] = xv[3] + bfhi(y.y) * rs * gv[3];
                orow[64 * j] = o; }
        }
    }
#undef IN
#undef BOTH
}

extern "C" void kernel_launch(void* const* d_in, const int* in_sizes, int n_in, void* d_out, int out_size, void* d_ws, size_t ws_size, hipStream_t stream) {
    static int grid = 0;
    if (grid == 0) {
        if (n_in != 11 || in_sizes[0] != M * DM || out_size != M * DM || ws_size < WS_END) { fprintf(stderr, "kernel_launch: shape mismatch n_in %d in0 %d out %d ws %zu\n", n_in, n_in > 0 ? in_sizes[0] : -1, out_size, ws_size); grid = -1; return; }
        int dev = 0, cus = 0, per_cu = 0;
        if (hipGetDevice(&dev) != hipSuccess || hipDeviceGetAttribute(&cus, hipDeviceAttributeMultiprocessorCount, dev) != hipSuccess) { grid = -1; return; }
        if (hipFuncSetAttribute((const void*)hybrid_fwd, hipFuncAttributeMaxDynamicSharedMemorySize, LDS_BYTES) != hipSuccess) { fprintf(stderr, "kernel_launch: hipFuncSetAttribute failed\n"); grid = -1; return; }
        if (hipOccupancyMaxActiveBlocksPerMultiprocessor(&per_cu, (const void*)hybrid_fwd, 512, LDS_BYTES) != hipSuccess || per_cu < 1) { fprintf(stderr, "kernel_launch: occupancy query says %d\n", per_cu); per_cu = 1; }
        (void)hipGetLastError();
        grid = cus;
    }
    if (grid < 0) return;
    Args a{};
    a.x = (const float*)d_in[0]; a.pos = (const int*)d_in[1]; a.g_pre = (const float*)d_in[2]; a.w_in = (const float*)d_in[3]; a.g_q = (const float*)d_in[4]; a.w_uq = (const float*)d_in[5];
    a.g_kv = (const float*)d_in[6]; a.w_ukv = (const float*)d_in[7]; a.b_forget = (const float*)d_in[8]; a.w_out = (const float*)d_in[9]; a.g_post = (const float*)d_in[10];
    a.out = (float*)d_out; a.ws = (unsigned char*)d_ws;
#if MK_N_LAUNCHES == 1
    a.ph_lo = 0; a.ph_hi = 6;
    void* args[] = {&a};
    hipError_t e = hipLaunchCooperativeKernel((const void*)hybrid_fwd, dim3(grid), dim3(512), args, LDS_BYTES, stream);
    if (e != hipSuccess) fprintf(stderr, "cooperative launch failed: %s (grid %d)\n", hipGetErrorString(e), grid);
#else
    for (int p = 0; p < 6; ++p) { a.ph_lo = p; a.ph_hi = p + 1; hipLaunchKernelGGL(hybrid_fwd, dim3(grid), dim3(512), LDS_BYTES, stream, a); }
#endif
}
```

```cpp
#include <hip/hip_runtime.h>
#include <hip/hip_cooperative_groups.h>
#include <cstdio>
#include <cstdint>
namespace cg = cooperative_groups;

#ifndef MK_N_LAUNCHES
#define MK_N_LAUNCHES 1
#endif

namespace pg8 {
#define PG8_LAS __attribute__((address_space(3)))
typedef unsigned short bf16_t;
typedef short bf16x8 __attribute__((ext_vector_type(8)));
typedef float f32x4 __attribute__((ext_vector_type(4)));
typedef unsigned u32x4 __attribute__((ext_vector_type(4)));
constexpr int BM = 256, BK = 64, HALF = 128, HTB = HALF * BK * 2, STAGE_BYTES = 8 * HTB, NXCD = 8, WGM = 8;

__host__ __device__ __forceinline__ int lds_byte(int r, int c) { const int st = (r >> 4) * 2 + (c >> 5), rr = r & 15, cc = c & 31, ob = rr * 64 + cc * 2; return st * 1024 + (ob ^ (((ob >> 9) & 1) << 5)); }
__host__ __device__ __forceinline__ void stage_rc(int b, int& R, int& C) { const int st = b / 1024, sb = b % 1024, swz = sb ^ (((sb >> 9) & 1) << 5); R = (st >> 1) * 16 + swz / 64; C = (st & 1) * 32 + (swz % 64) / 2; }
__host__ __device__ __forceinline__ int perm32(int rho) { const int n = rho >> 4, i = rho & 15; return 8 * (i >> 2) + 4 * n + (i & 3); }

struct Unit { int pm, pn; };
struct Gemm { const bf16_t* A; const bf16_t* Bt; int M, N, K; };

struct StaticOrder {
    int nM, nN, nwg, G, c;
    __host__ __device__ void init(int M, int N, int G_, int c_) { nM = M / BM; nN = N / BM; nwg = nM * nN; G = G_; c = c_; }
    __host__ __device__ bool next(int i, Unit& u) const {
        const long L = (long)i * G + c; if (L >= nwg) return false;
        int wgid = (int)L; { const int q = nwg / NXCD, r = nwg % NXCD, xcd = wgid % NXCD, off = wgid / NXCD; wgid = (xcd < r ? xcd * (q + 1) : r * (q + 1) + (xcd - r) * q) + off; }
        const int nig = WGM * nN, gid = wgid / nig, fm = gid * WGM, gsz = (nM - fm) < WGM ? (nM - fm) : WGM;
        u.pm = fm + ((wgid % nig) % gsz); u.pn = (wgid % nig) / gsz; return true;
    }
    __device__ __forceinline__ void a_ready(const Unit&) const {}
    __device__ __forceinline__ void done(const Unit&) const {}
};

__device__ __forceinline__ unsigned cvt_pk_bf16(float lo, float hi) { unsigned r; asm volatile("v_cvt_pk_bf16_f32 %0, %1, %2" : "=v"(r) : "v"(lo), "v"(hi)); return r; }

template <class Epi, class Sched, bool ALIGN_EPI = false, bool SP2 = false>
__device__ __forceinline__ void gemm_phase(PG8_LAS unsigned char* lds, const Gemm g, const Sched& S, const Epi& E) {
    const int tid = threadIdx.x, wid = __builtin_amdgcn_readfirstlane(tid >> 6), lane = tid & 63, wr = wid >> 2, wc = wid & 3, fr = lane & 15, fq = lane >> 4;
    const int K = g.K, nt = K / BK;
    unsigned voffA[2], voffB[2];
#pragma unroll
    for (int i = 0; i < 2; ++i) { int R, C; stage_rc(tid * 16 + i * 8192, R, C); const int Rb = Epi::PERM ? ((R & ~31) + perm32(R & 31)) : R;
        voffA[i] = (unsigned)(R * K + C) * 2u; voffB[i] = (unsigned)(Rb * K + C) * 2u; }
    const size_t kstep = (size_t)(BK * 2);
    const size_t hstep = (size_t)HALF * K * 2;
    const size_t tstep = 2 * hstep;
    const unsigned ldsw = (unsigned)wid * 1024u;
    const int aoff = lds_byte(wr * 64 + fr, fq * 8), boff = lds_byte(wc * 32 + fr, fq * 8);
#define PG8_SA(b, h) (((b) * 2 + (h)) * HTB)
#define PG8_SB(b, h) ((4 + (b) * 2 + (h)) * HTB)
#define PG8_STAGE(bufoff, gbase, voff) do { _Pragma("unroll") for (int _i = 0; _i < 2; ++_i) \
        __builtin_amdgcn_global_load_lds((const unsigned*)((const char*)(gbase) + (voff)[_i]), (PG8_LAS unsigned*)(lds + (bufoff) + ldsw + _i * 8192), 16, 0, 0); } while (0)
#define PG8_LDA(dst, b, h) do { _Pragma("unroll") for (int m = 0; m < 4; ++m) _Pragma("unroll") for (int k = 0; k < 2; ++k) dst[m][k] = *(const PG8_LAS bf16x8*)(lds + PG8_SA(b, h) + aoff + m * 2048 + k * 1024); } while (0)
#define PG8_LDB(dst, b, h) do { _Pragma("unroll") for (int n = 0; n < 2; ++n) _Pragma("unroll") for (int k = 0; k < 2; ++k) dst[n][k] = *(const PG8_LAS bf16x8*)(lds + PG8_SB(b, h) + boff + n * 2048 + k * 1024); } while (0)
#define PG8_MMA(ai, bj, At, Bt) do { __builtin_amdgcn_s_setprio(1); _Pragma("unroll") for (int m = 0; m < 4; ++m) _Pragma("unroll") for (int n = 0; n < 2; ++n) _Pragma("unroll") for (int k = 0; k < 2; ++k) \
        acc[ai][bj][m][n] = __builtin_amdgcn_mfma_f32_16x16x32_bf16(Bt[n][k], At[m][k], acc[ai][bj][m][n], 0, 0, 0); __builtin_amdgcn_s_setprio(0); } while (0)
#define PG8_WAIT_V(n) asm volatile("s_waitcnt vmcnt(" #n ")" ::: "memory")
#define PG8_WAIT_L(n) asm volatile("s_waitcnt lgkmcnt(" #n ")" ::: "memory")
#define PG8_BAR __builtin_amdgcn_s_barrier()
#define PG8_SCHED __builtin_amdgcn_sched_barrier(0)
    Unit cur, nxt; int ui = 0;
    if (!S.next(0, cur)) return;
    f32x4 acc[2][2][4][2];
#pragma unroll
    for (int a = 0; a < 2; ++a)
#pragma unroll
        for (int b = 0; b < 2; ++b)
#pragma unroll
            for (int m = 0; m < 4; ++m)
#pragma unroll
                for (int n = 0; n < 2; ++n) acc[a][b][m][n] = (f32x4){0.f, 0.f, 0.f, 0.f};
    bf16x8 At[4][2], B0[2][2], B1[2][2];
    const char* cA = (const char*)g.A + (size_t)cur.pm * tstep; const char* cB = (const char*)g.Bt + (size_t)cur.pn * tstep;
    S.a_ready(cur);
    if constexpr (SP2) {
        PG8_STAGE(PG8_SB(0, 0), cB, voffB); PG8_STAGE(PG8_SB(0, 1), cB + hstep, voffB); PG8_STAGE(PG8_SA(0, 0), cA, voffA); PG8_STAGE(PG8_SA(0, 1), cA + hstep, voffA);
        if (wr == 1) PG8_BAR;
        PG8_WAIT_V(2); PG8_BAR;
        PG8_STAGE(PG8_SB(1, 0), cB + kstep, voffB); PG8_STAGE(PG8_SA(1, 0), cA + kstep, voffA); PG8_STAGE(PG8_SB(1, 1), cB + hstep + kstep, voffB);
        PG8_WAIT_V(6); PG8_BAR;
    } else {
        PG8_STAGE(PG8_SB(0, 0), cB, voffB); PG8_STAGE(PG8_SA(0, 0), cA, voffA); PG8_STAGE(PG8_SB(0, 1), cB + hstep, voffB); PG8_STAGE(PG8_SA(0, 1), cA + hstep, voffA);
        if (wr == 1) PG8_BAR;
        PG8_WAIT_V(4); PG8_BAR;
        PG8_STAGE(PG8_SB(1, 0), cB + kstep, voffB); PG8_STAGE(PG8_SA(1, 0), cA + kstep, voffA); PG8_STAGE(PG8_SB(1, 1), cB + hstep + kstep, voffB);
        PG8_WAIT_V(6); PG8_BAR;
    }
    for (;;) {
        const bool has_next = S.next(ui + 1, nxt);
        const char* nA = has_next ? (const char*)g.A + (size_t)nxt.pm * tstep : cA; const char* nB = has_next ? (const char*)g.Bt + (size_t)nxt.pn * tstep : cB;
        for (int t = 0; t < nt; t += 2) {
            const bool last = (t == nt - 2);
            const char* a1 = cA + (size_t)(t + 1) * kstep;
            const char* a2 = last ? nA : cA + (size_t)(t + 2) * kstep; const char* b2 = last ? nB : cB + (size_t)(t + 2) * kstep;
            const char* a3 = a2 + kstep; const char* b3 = b2 + kstep;
            if (last && has_next) S.a_ready(nxt);
            if constexpr (SP2) {
            PG8_LDB(B0, 0, 0); PG8_LDB(B1, 0, 1); PG8_SCHED; PG8_LDA(At, 0, 0); PG8_STAGE(PG8_SA(1, 1), a1 + hstep, voffA);
            PG8_WAIT_V(8); PG8_WAIT_L(0); PG8_BAR; PG8_MMA(0, 0, At, B0); PG8_MMA(0, 1, At, B1); PG8_BAR; PG8_SCHED;
            PG8_LDA(At, 0, 1); PG8_STAGE(PG8_SB(0, 0), b2, voffB); PG8_STAGE(PG8_SB(0, 1), b2 + hstep, voffB); PG8_STAGE(PG8_SA(0, 0), a2, voffA);
            PG8_WAIT_V(8); PG8_WAIT_L(0); PG8_BAR; PG8_MMA(1, 0, At, B0); PG8_MMA(1, 1, At, B1); PG8_BAR; PG8_SCHED;
            PG8_LDB(B0, 1, 0); PG8_LDB(B1, 1, 1); PG8_SCHED; PG8_LDA(At, 1, 0); PG8_STAGE(PG8_SA(0, 1), a2 + hstep, voffA);
            PG8_WAIT_V(8); PG8_WAIT_L(0); PG8_BAR; PG8_MMA(0, 0, At, B0); PG8_MMA(0, 1, At, B1); PG8_BAR; PG8_SCHED;
            PG8_LDA(At, 1, 1); PG8_STAGE(PG8_SB(1, 0), b3, voffB); PG8_STAGE(PG8_SB(1, 1), b3 + hstep, voffB); PG8_STAGE(PG8_SA(1, 0), a3, voffA);
            PG8_WAIT_V(8); PG8_WAIT_L(0); PG8_BAR; PG8_MMA(1, 0, At, B0); PG8_MMA(1, 1, At, B1); PG8_BAR; PG8_SCHED;
            } else {
            PG8_LDB(B0, 0, 0); PG8_SCHED; PG8_LDA(At, 0, 0); PG8_STAGE(PG8_SA(1, 1), a1 + hstep, voffA);
            PG8_WAIT_L(8); PG8_BAR; PG8_WAIT_L(0); PG8_MMA(0, 0, At, B0); PG8_BAR; PG8_SCHED;
            PG8_LDB(B1, 0, 1); PG8_STAGE(PG8_SB(0, 0), b2, voffB);
            PG8_BAR; PG8_WAIT_L(0); PG8_MMA(0, 1, At, B1); PG8_BAR;
            PG8_LDA(At, 0, 1); PG8_STAGE(PG8_SA(0, 0), a2, voffA);
            PG8_BAR; PG8_WAIT_L(0); PG8_MMA(1, 0, At, B0); PG8_BAR; PG8_SCHED;
            PG8_STAGE(PG8_SB(0, 1), b2 + hstep, voffB);
            PG8_WAIT_V(6); PG8_BAR; PG8_MMA(1, 1, At, B1); PG8_BAR;
            PG8_LDB(B0, 1, 0); PG8_SCHED; PG8_LDA(At, 1, 0); PG8_STAGE(PG8_SA(0, 1), a2 + hstep, voffA);
            PG8_WAIT_L(8); PG8_BAR; PG8_WAIT_L(0); PG8_MMA(0, 0, At, B0); PG8_BAR; PG8_SCHED;
            PG8_LDB(B1, 1, 1); PG8_STAGE(PG8_SB(1, 0), b3, voffB);
            PG8_BAR; PG8_WAIT_L(0); PG8_MMA(0, 1, At, B1); PG8_BAR;
            PG8_LDA(At, 1, 1); PG8_STAGE(PG8_SA(1, 0), a3, voffA);
            PG8_BAR; PG8_WAIT_L(0); PG8_MMA(1, 0, At, B0); PG8_BAR; PG8_SCHED;
            PG8_STAGE(PG8_SB(1, 1), b3 + hstep, voffB);
            PG8_WAIT_V(6); PG8_BAR; PG8_MMA(1, 1, At, B1); PG8_BAR;
            }
        }
        if constexpr (ALIGN_EPI) { if (wr == 0) PG8_BAR; }
        if constexpr (!Epi::AFTER_DRAIN) { E(acc, cur, wr, wc, fr, fq); S.done(cur); }
        if (!has_next) break;
#pragma unroll
        for (int a = 0; a < 2; ++a)
#pragma unroll
            for (int b = 0; b < 2; ++b)
#pragma unroll
                for (int m = 0; m < 4; ++m)
#pragma unroll
                    for (int n = 0; n < 2; ++n) acc[a][b][m][n] = (f32x4){0.f, 0.f, 0.f, 0.f};
        cur = nxt; cA = nA; cB = nB; ++ui;
        if constexpr (ALIGN_EPI) { if (wr == 1) PG8_BAR; }
    }
    PG8_WAIT_V(0);
    if constexpr (!ALIGN_EPI) { if (wr == 0) PG8_BAR; }
    PG8_BAR;
#undef PG8_SA
#undef PG8_SB
#undef PG8_STAGE
#undef PG8_LDA
#undef PG8_LDB
#undef PG8_MMA
#undef PG8_WAIT_V
#undef PG8_WAIT_L
#undef PG8_BAR
#undef PG8_SCHED
}
}

typedef unsigned short bf16;
typedef float f32x4 __attribute__((ext_vector_type(4)));
typedef unsigned u32x4 __attribute__((ext_vector_type(4)));
typedef unsigned u32x2 __attribute__((ext_vector_type(2)));
typedef short bf16x8 __attribute__((ext_vector_type(8)));
typedef short s16x4 __attribute__((ext_vector_type(4)));
typedef float f32x16 __attribute__((ext_vector_type(16)));
#define LAS __attribute__((address_space(3)))

constexpr int BATCH = 4, SEQ = 4096, DM = 2048, M = BATCH * SEQ;
constexpr int NH = 8, QKD = 192, QRANK = 768, KVRANK = 512, DIN = 6472;
constexpr int NIN_PAD = 6656;
constexpr float EPS = 1e-6f;
constexpr float LOG2E = 1.4426950408889634f;
constexpr float C2M = 0.07216878364870322f * LOG2E;
constexpr float C2F = 0.08838834764831845f * LOG2E;

constexpr size_t MiB = 1u << 20;
constexpr size_t WS_RSTDX = 0, WS_PARTQ = 1 * MiB, WS_PARTKV = 2 * MiB, WS_PARTY = 3 * MiB, WS_FLOG = 5 * MiB, WS_CF = 6 * MiB, WS_COS = 7 * MiB, WS_SIN = 9 * MiB;
constexpr size_t WS_CTL = 11 * MiB, CTL_BYTES = 16384;
constexpr size_t WS_WIN = 16 * MiB, WS_WUQ = 42 * MiB, WS_WUKV = 45 * MiB, WS_WOUT = 47 * MiB;
constexpr size_t WS_XB = 56 * MiB, WS_O = 56 * MiB;
constexpr size_t WS_QLAT = 120 * MiB, WS_KVLAT = 144 * MiB, WS_G = 160 * MiB;
constexpr size_t WS_QF = 224 * MiB, WS_Y = 224 * MiB, WS_KF = 256 * MiB, WS_VF = 288 * MiB;
constexpr size_t WS_QM = 320 * MiB, WS_KM = 368 * MiB, WS_VM = 416 * MiB, WS_END = 448 * MiB;

constexpr int LDS_BYTES = 147456;

__device__ __forceinline__ unsigned f2bf(float f) { unsigned u = __builtin_bit_cast(unsigned, f); return (u + 0x7fffu + ((u >> 16) & 1u)) >> 16; }
__device__ __forceinline__ unsigned pk2(float lo, float hi) { return pg8::cvt_pk_bf16(lo, hi); }
__device__ __forceinline__ float bflo(unsigned w) { return __builtin_bit_cast(float, w << 16); }
__device__ __forceinline__ float bfhi(unsigned w) { return __builtin_bit_cast(float, w & 0xffff0000u); }
__device__ __forceinline__ float wave_sum(float v) {
#pragma unroll
    for (int o = 1; o < 64; o <<= 1) v += __shfl_xor(v, o);
    return v;
}
__device__ __forceinline__ float silu_f(float v) { return v * __builtin_amdgcn_rcpf(1.f + __builtin_amdgcn_exp2f(-v * LOG2E)); }
__device__ __forceinline__ u32x4 pack8f(f32x4 a, f32x4 b) { u32x4 w; w.x = pk2(a[0], a[1]); w.y = pk2(a[2], a[3]); w.z = pk2(b[0], b[1]); w.w = pk2(b[2], b[3]); return w; }

typedef pg8::f32x4 af4;
struct EpiIn {
    static constexpr bool PERM = true, AFTER_DRAIN = false;
    const float* rstd_x; bf16 *qlat, *kvlat, *G, *Qf, *Kf, *Vf, *Km; float *flog, *partq, *partkv; const float *cosT, *sinT;
    __device__ __forceinline__ void operator()(const af4 (&acc)[2][2][4][2], const pg8::Unit& u, int wr, int wc, int fr, int fq) const {
        const int pn = u.pn; const int row0 = u.pm * 256 + wr * 64 + fr;
        if (pn == 25) {
            if (wc == 0) {
#pragma unroll
                for (int ai = 0; ai < 2; ++ai)
#pragma unroll
                    for (int m = 0; m < 4; ++m) { const int row = row0 + ai * 128 + m * 16; const float rs = rstd_x[row];
                        f32x4 o1[2], o2[2];
#pragma unroll
                        for (int n = 0; n < 2; ++n) { const f32x4 c = *(const f32x4*)(cosT + (size_t)row * 32 + 8 * fq + 4 * n), s = *(const f32x4*)(sinT + (size_t)row * 32 + 8 * fq + 4 * n);
                            const f32x4 x1 = acc[ai][0][m][n] * rs, x2 = acc[ai][1][m][n] * rs; o1[n] = x1 * c - x2 * s; o2[n] = x2 * c + x1 * s; }
                        const u32x4 w1 = pack8f(o1[0], o1[1]), w2 = pack8f(o2[0], o2[1]);
                        bf16* kp = Km + (size_t)row * 1536 + 128 + 8 * fq;
#pragma unroll
                        for (int h = 0; h < 8; ++h) { *(u32x4*)(kp + h * 192) = w1; *(u32x4*)(kp + h * 192 + 32) = w2; } }
            } else if (wc == 1 && fq == 0) {
#pragma unroll
                for (int ai = 0; ai < 2; ++ai)
#pragma unroll
                    for (int m = 0; m < 4; ++m) { const int row = row0 + ai * 128 + m * 16; const float rs = rstd_x[row];
                        *(f32x4*)(flog + (size_t)row * 8) = acc[ai][0][m][0] * rs; *(f32x4*)(flog + (size_t)row * 8 + 4) = acc[ai][0][m][1] * rs; }
            }
            return;
        }
        bf16* base; int ld, colt, mode = 0; float* part = nullptr; int nslot = 0, slot0 = 0;
        if (pn < 3) { base = qlat; ld = 768; colt = pn * 256; part = partq; nslot = 12; slot0 = pn * 4; }
        else if (pn < 5) { base = kvlat; ld = 512; colt = (pn - 3) * 256; part = partkv; nslot = 8; slot0 = (pn - 3) * 4; }
        else if (pn < 9) { base = G; ld = 2048; colt = (pn - 5) * 256; mode = 1; }
        else if (pn < 13) { base = Qf; ld = 1024; colt = (pn - 9) * 256; mode = 2; }
        else if (pn < 17) { base = Kf; ld = 1024; colt = (pn - 13) * 256; }
        else if (pn < 21) { base = Vf; ld = 1024; colt = (pn - 17) * 256; }
        else { base = G; ld = 2048; colt = 1024 + (pn - 21) * 256; mode = 1; }
        const int col0 = colt + wc * 32 + 8 * fq;
#pragma unroll
        for (int ai = 0; ai < 2; ++ai)
#pragma unroll
            for (int m = 0; m < 4; ++m) { const int row = row0 + ai * 128 + m * 16; float rs = rstd_x[row]; if (mode == 2) rs *= C2F;
                bf16* rowp = base + (size_t)row * ld + col0; float ss = 0.f;
#pragma unroll
                for (int bj = 0; bj < 2; ++bj) { f32x4 v0 = acc[ai][bj][m][0] * rs, v1 = acc[ai][bj][m][1] * rs;
                    ss += (v0[0] * v0[0] + v0[1] * v0[1]) + (v0[2] * v0[2] + v0[3] * v0[3]) + (v1[0] * v1[0] + v1[1] * v1[1]) + (v1[2] * v1[2] + v1[3] * v1[3]);
                    if (mode == 1) {
#pragma unroll
                        for (int e = 0; e < 4; ++e) { v0[e] = silu_f(v0[e]); v1[e] = silu_f(v1[e]); } }
                    *(u32x4*)(rowp + bj * 128) = pack8f(v0, v1); }
                if (part) { ss += __shfl_xor(ss, 16); ss += __shfl_xor(ss, 32); if (fq == 0) part[(size_t)row * nslot + slot0 + wc] = ss; } }
    }
};
struct EpiQ {
    static constexpr bool PERM = true, AFTER_DRAIN = false;
    const float* partq; bf16* Qm; const float *cosT, *sinT;
    __device__ __forceinline__ void operator()(const af4 (&acc)[2][2][4][2], const pg8::Unit& u, int wr, int wc, int fr, int fq) const {
        const int pn = u.pn; const int row0 = u.pm * 256 + wr * 64 + fr;
#pragma unroll
        for (int ai = 0; ai < 2; ++ai)
#pragma unroll
            for (int m = 0; m < 4; ++m) { const int row = row0 + ai * 128 + m * 16;
                const f32x4 pa = *(const f32x4*)(partq + (size_t)row * 12), pb = *(const f32x4*)(partq + (size_t)row * 12 + 4), pc = *(const f32x4*)(partq + (size_t)row * 12 + 8);
                const float ssq = ((pa[0] + pa[1]) + (pa[2] + pa[3])) + ((pb[0] + pb[1]) + (pb[2] + pb[3])) + ((pc[0] + pc[1]) + (pc[2] + pc[3]));
                const float rs = C2M / sqrtf(ssq * (1.f / 768.f) + EPS);
                if (pn < 4) {
#pragma unroll
                    for (int bj = 0; bj < 2; ++bj) *(u32x4*)(Qm + (size_t)row * 1536 + (2 * pn + bj) * 192 + wc * 32 + 8 * fq) = pack8f(acc[ai][bj][m][0] * rs, acc[ai][bj][m][1] * rs);
                } else { const int head = 4 * (pn - 4) + wc; f32x4 o1[2], o2[2];
#pragma unroll
                    for (int n = 0; n < 2; ++n) { const f32x4 c = *(const f32x4*)(cosT + (size_t)row * 32 + 8 * fq + 4 * n), s = *(const f32x4*)(sinT + (size_t)row * 32 + 8 * fq + 4 * n);
                        const f32x4 x1 = acc[ai][0][m][n] * rs, x2 = acc[ai][1][m][n] * rs; o1[n] = x1 * c - x2 * s; o2[n] = x2 * c + x1 * s; }
                    bf16* qp = Qm + (size_t)row * 1536 + head * 192 + 128 + 8 * fq;
                    *(u32x4*)qp = pack8f(o1[0], o1[1]); *(u32x4*)(qp + 32) = pack8f(o2[0], o2[1]); } }
    }
};
struct EpiKV {
    static constexpr bool PERM = true, AFTER_DRAIN = false;
    const float* partkv; bf16 *Km, *Vm;
    __device__ __forceinline__ void operator()(const af4 (&acc)[2][2][4][2], const pg8::Unit& u, int wr, int wc, int fr, int fq) const {
        const int pn = u.pn; const int row0 = u.pm * 256 + wr * 64 + fr;
#pragma unroll
        for (int ai = 0; ai < 2; ++ai)
#pragma unroll
            for (int m = 0; m < 4; ++m) { const int row = row0 + ai * 128 + m * 16;
                const f32x4 pa = *(const f32x4*)(partkv + (size_t)row * 8), pb = *(const f32x4*)(partkv + (size_t)row * 8 + 4);
                const float ssq = ((pa[0] + pa[1]) + (pa[2] + pa[3])) + ((pb[0] + pb[1]) + (pb[2] + pb[3]));
                const float rs = 1.f / sqrtf(ssq * (1.f / 512.f) + EPS);
                *(u32x4*)(Km + (size_t)row * 1536 + pn * 192 + wc * 32 + 8 * fq) = pack8f(acc[ai][0][m][0] * rs, acc[ai][0][m][1] * rs);
                *(u32x4*)(Vm + (size_t)row * 1024 + pn * 128 + wc * 32 + 8 * fq) = pack8f(acc[ai][1][m][0] * rs, acc[ai][1][m][1] * rs); }
    }
};
struct EpiOut {
    static constexpr bool PERM = true, AFTER_DRAIN = false;
    bf16* Y; float* party;
    __device__ __forceinline__ void operator()(const af4 (&acc)[2][2][4][2], const pg8::Unit& u, int wr, int wc, int fr, int fq) const {
        const int pn = u.pn; const int row0 = u.pm * 256 + wr * 64 + fr; const int col0 = pn * 256 + wc * 32 + 8 * fq;
#pragma unroll
        for (int ai = 0; ai < 2; ++ai)
#pragma unroll
            for (int m = 0; m < 4; ++m) { const int row = row0 + ai * 128 + m * 16; float ss = 0.f;
#pragma unroll
                for (int bj = 0; bj < 2; ++bj) { const f32x4 v0 = acc[ai][bj][m][0], v1 = acc[ai][bj][m][1];
                    ss += (v0[0] * v0[0] + v0[1] * v0[1]) + (v0[2] * v0[2] + v0[3] * v0[3]) + (v1[0] * v1[0] + v1[1] * v1[1]) + (v1[2] * v1[2] + v1[3] * v1[3]);
                    *(u32x4*)(Y + (size_t)row * 2048 + col0 + bj * 128) = pack8f(v0, v1); }
                ss += __shfl_xor(ss, 16); ss += __shfl_xor(ss, 32); if (fq == 0) party[(size_t)row * 32 + pn * 4 + wc] = ss; }
    }
};

namespace att {
constexpr int KVBLK = 64, QBLK = 32, QB = 256;
constexpr int SHM_K = 24576, SHM_V = 16384;
constexpr int OFF_K = 0, OFF_V = 2 * SHM_K, OFF_CK = OFF_V + 2 * SHM_V, OFF_WS = OFF_CK + 512, OFF_QP = OFF_WS + 2048;
constexpr float THR = 8.f;
#define KSWZ(row, colB) ((row) * 256 + ((colB) ^ (((row) & 7) << 4)))
#define SBAR() __builtin_amdgcn_sched_barrier(0)
__device__ __forceinline__ int v_st(int k, int c) { const int kk = (k & ~0xC) | ((k & 4) << 1) | ((k & 8) >> 1); return ((kk >> 3) * 4 + (c >> 5)) * 512 + ((kk & 7) * 32 + (c & 31)) * 2; }
__device__ __forceinline__ int v_rd_base(int lane) { return ((lane & 3) << 3) | (((lane >> 2) & 3) << 6) | (((lane >> 4) & 1) << 5) | (((lane >> 5) & 1) << 8); }
constexpr int v_rd_off(int d0, int ks, int half) { return d0 * 512 + ks * 4096 + half * 2048; }
__device__ __forceinline__ int crow(int r, int hi) { return (r & 3) + 8 * (r >> 2) + 4 * hi; }
__device__ __forceinline__ unsigned cvtpk(float lo, float hi) { unsigned r; asm volatile("v_cvt_pk_bf16_f32 %0, %1, %2" : "=v"(r) : "v"(lo), "v"(hi)); return r; }

__device__ __forceinline__ void mask_tile(f32x16& p0, f32x16& p1, int dq) {
    const float NEG = -__builtin_inff();
#pragma unroll
    for (int r = 0; r < 16; ++r) { const int c = (r & 3) + 8 * (r >> 2);
        if (dq - c < 0) p0[r] = NEG;
        if (dq - c - 32 < 0) p1[r] = NEG; }
}
__device__ __forceinline__ void softmax_tile(f32x16& p0, f32x16& p1, float& m_reg, float& l_reg, float& alpha, bf16x8& pa0, bf16x8& pa1, bf16x8& pa2, bf16x8& pa3) {
    float pmax = p0[0];
#pragma unroll
    for (int r = 1; r < 16; ++r) pmax = fmaxf(pmax, p0[r]);
#pragma unroll
    for (int r = 0; r < 16; ++r) pmax = fmaxf(pmax, p1[r]);
    { auto rr = __builtin_amdgcn_permlane32_swap(__float_as_uint(pmax), __float_as_uint(pmax), false, false);
      pmax = fmaxf(__uint_as_float(rr[0]), __uint_as_float(rr[1])); }
    float mn;
    if (__builtin_expect(__all(pmax - m_reg <= THR), 1)) { mn = m_reg; alpha = 1.f; }
    else { mn = fmaxf(m_reg, pmax); alpha = __builtin_amdgcn_exp2f(m_reg - mn); m_reg = mn; }
#pragma unroll
    for (int r = 0; r < 16; ++r) { p0[r] = __builtin_amdgcn_exp2f(p0[r] - mn); p1[r] = __builtin_amdgcn_exp2f(p1[r] - mn); }
    float ps = 0.f;
#pragma unroll
    for (int r = 0; r < 16; ++r) ps += p0[r];
#pragma unroll
    for (int r = 0; r < 16; ++r) ps += p1[r];
    { auto rr = __builtin_amdgcn_permlane32_swap(__float_as_uint(ps), __float_as_uint(ps), false, false);
      ps = __uint_as_float(rr[0]) + __uint_as_float(rr[1]); }
    l_reg = l_reg * alpha + ps;
#define PK4(P, B_, OUT) do { unsigned a0 = cvtpk(P[B_+0], P[B_+1]), a1 = cvtpk(P[B_+2], P[B_+3]);                          \
        unsigned b0 = cvtpk(P[B_+4], P[B_+5]), b1 = cvtpk(P[B_+6], P[B_+7]);                                             \
        auto r0 = __builtin_amdgcn_permlane32_swap(a0, b0, false, false); auto r1 = __builtin_amdgcn_permlane32_swap(a1, b1, false, false); \
        u32x4 w = {r0[0], r1[0], r0[1], r1[1]}; OUT = *reinterpret_cast<bf16x8*>(&w); } while (0)
    PK4(p0, 0, pa0); PK4(p0, 8, pa1); PK4(p1, 0, pa2); PK4(p1, 8, pa3);
#undef PK4
}
template <int DQK>
__device__ __forceinline__ void qkt(f32x16& p0, f32x16& p1, const char* Kb, int r32, int hi, const bf16x8* qr, const char* qpk) {
    p0 = f32x16{}; p1 = f32x16{};
    const char* kb[4];
#pragma unroll
    for (int dd = 0; dd < 4; ++dd) kb[dd] = Kb + KSWZ(r32, (dd * 16 + hi * 8) * 2);
#pragma unroll
    for (int d0 = 0; d0 < 8; ++d0) { const char* a = kb[d0 & 3] + (d0 >> 2) * 128;
        bf16x8 b0 = *reinterpret_cast<const bf16x8*>(a);
        bf16x8 b1 = *reinterpret_cast<const bf16x8*>(a + 32 * 256);
        bf16x8 qf; if (DQK == 128 && d0 >= 4) qf = *reinterpret_cast<const bf16x8*>(qpk + (d0 - 4) * 1024); else qf = qr[d0];
        p0 = __builtin_amdgcn_mfma_f32_32x32x16_bf16(b0, qf, p0, 0, 0, 0);
        p1 = __builtin_amdgcn_mfma_f32_32x32x16_bf16(b1, qf, p1, 0, 0, 0); }
    if constexpr (DQK == 192) {
#pragma unroll
        for (int d0 = 0; d0 < 4; ++d0) { const char* a = Kb + 16384 + r32 * 128 + (((d0 * 16 + hi * 8) * 2) ^ ((r32 & 7) << 4));
            bf16x8 b0 = *reinterpret_cast<const bf16x8*>(a);
            bf16x8 b1 = *reinterpret_cast<const bf16x8*>(a + 32 * 128);
            const bf16x8 qf = *reinterpret_cast<const bf16x8*>(qpk + d0 * 1024);
            p0 = __builtin_amdgcn_mfma_f32_32x32x16_bf16(b0, qf, p0, 0, 0, 0);
            p1 = __builtin_amdgcn_mfma_f32_32x32x16_bf16(b1, qf, p1, 0, 0, 0); }
    }
}
template <int VOFF>
__device__ __forceinline__ void pv_tile(f32x16* o, int vb0, bf16x8 pa0, bf16x8 pa1, bf16x8 pa2, bf16x8 pa3) {
#define TRRD(dst, off) asm volatile("ds_read_b64_tr_b16 %0, %1 offset:%2" : "=&v"(dst) : "v"(vb0), "i"(off) : "memory")
#define PV_D0(d0) do { s16x4 l0, l1, l2, l3, h0, h1, h2, h3; constexpr int b_ = VOFF + v_rd_off(d0, 0, 0); \
        TRRD(l0, b_); TRRD(h0, b_ + 2048); TRRD(l1, b_ + 4096); TRRD(h1, b_ + 6144); TRRD(l2, b_ + 8192); TRRD(h2, b_ + 10240); TRRD(l3, b_ + 12288); TRRD(h3, b_ + 14336); \
        asm volatile("s_waitcnt lgkmcnt(0)" ::: "memory"); SBAR(); \
        o[d0] = __builtin_amdgcn_mfma_f32_32x32x16_bf16(pa0, (bf16x8){l0[0], l0[1], l0[2], l0[3], h0[0], h0[1], h0[2], h0[3]}, o[d0], 0, 0, 0);   \
        o[d0] = __builtin_amdgcn_mfma_f32_32x32x16_bf16(pa1, (bf16x8){l1[0], l1[1], l1[2], l1[3], h1[0], h1[1], h1[2], h1[3]}, o[d0], 0, 0, 0);   \
        o[d0] = __builtin_amdgcn_mfma_f32_32x32x16_bf16(pa2, (bf16x8){l2[0], l2[1], l2[2], l2[3], h2[0], h2[1], h2[2], h2[3]}, o[d0], 0, 0, 0);   \
        o[d0] = __builtin_amdgcn_mfma_f32_32x32x16_bf16(pa3, (bf16x8){l3[0], l3[1], l3[2], l3[3], h3[0], h3[1], h3[2], h3[3]}, o[d0], 0, 0, 0); } while (0)
    PV_D0(0); PV_D0(1); PV_D0(2); PV_D0(3);
#undef PV_D0
#undef TRRD
}

template <int DQK, bool FOX>
__device__ __forceinline__ void attn_unit(char* lds, const bf16* Q, int ldq, const bf16* K, int ldk, const bf16* V, int ldv, const float* cfs, const bf16* Gp, bf16* Op, int qb) {
    const int tid = threadIdx.x, wid = __builtin_amdgcn_readfirstlane(tid >> 6), lane = tid & 63, r32 = lane & 31, hi = lane >> 5;
    const int q0 = qb * QB, NT = 4 * (qb + 1);
    char* K_lds = lds + OFF_K; char* V_lds = lds + OFF_V; float* ck_l = (float*)(lds + OFF_CK);
    float* wsf = (float*)(lds + OFF_WS) + wid * 64; float* li_l = wsf; float* al_l = wsf + 32;
    constexpr int NQR = DQK / 16 - 4;
    bf16x8 qr[NQR];
    char* qpk = lds + OFF_QP + wid * 4096 + (hi * 32 + r32) * 16;
    { const bf16* qp = Q + (size_t)(q0 + wid * QBLK + r32) * ldq + hi * 8;
#pragma unroll
      for (int d0 = 0; d0 < NQR; ++d0) qr[d0] = *(const bf16x8*)(qp + d0 * 16);
#pragma unroll
      for (int d0 = 0; d0 < 4; ++d0) *(bf16x8*)(qpk + d0 * 1024) = *(const bf16x8*)(qp + (NQR + d0) * 16); }
    float cq = 0.f; if constexpr (FOX) cq = cfs[q0 + wid * QBLK + r32];
    unsigned koff[2], voff[2], kroff = 0;
#pragma unroll
    for (int j = 0; j < 2; ++j) { const int p = wid + 8 * j;
        { const int row = 4 * p + (lane >> 4), c = (lane & 15) ^ (row & 7); koff[j] = (unsigned)(row * ldk + c * 8) * 2u; }
        { const int st = 2 * p + (lane >> 5), kk = 8 * (st >> 2) + ((lane & 31) >> 2), k = (kk & ~0xC) | ((kk & 4) << 1) | ((kk & 8) >> 1); voff[j] = (unsigned)(k * ldv + 32 * (st & 3) + 8 * (lane & 3)) * 2u; } }
    if constexpr (DQK == 192) { const int row = 8 * wid + (lane >> 3), c = (lane & 7) ^ (row & 7); kroff = (unsigned)(row * ldk + 128 + c * 8) * 2u; }
    const int vb0 = (int)(uintptr_t)V_lds + v_rd_base(lane);
    LAS unsigned char* ldsl = (LAS unsigned char*)(uintptr_t)(unsigned)(uintptr_t)lds;
#define A_DMA(t, bf) do { const char* kt_ = (const char*)K + (size_t)(t) * KVBLK * ldk * 2; const char* vt_ = (const char*)V + (size_t)(t) * KVBLK * ldv * 2; \
        _Pragma("unroll") for (int j_ = 0; j_ < 2; ++j_) { \
            __builtin_amdgcn_global_load_lds((const unsigned*)(kt_ + koff[j_]), (LAS unsigned*)(ldsl + OFF_K + (bf) * SHM_K + (wid + 8 * j_) * 1024), 16, 0, 0); \
            __builtin_amdgcn_global_load_lds((const unsigned*)(vt_ + voff[j_]), (LAS unsigned*)(ldsl + OFF_V + (bf) * SHM_V + (wid + 8 * j_) * 1024), 16, 0, 0); } \
        if constexpr (DQK == 192) __builtin_amdgcn_global_load_lds((const unsigned*)(kt_ + kroff), (LAS unsigned*)(ldsl + OFF_K + (bf) * SHM_K + 16384 + wid * 1024), 16, 0, 0); \
        if constexpr (FOX) { if (wid == 0) __builtin_amdgcn_global_load_lds((const unsigned*)(cfs + (t) * KVBLK + lane), (LAS unsigned*)(ldsl + OFF_CK + (bf) * 256), 4, 0, 0); } } while (0)
#define A_SYNC() do { asm volatile("s_waitcnt vmcnt(0)" ::: "memory"); __syncthreads(); } while (0)
    A_DMA(0, 0);
    A_SYNC();
    float m_reg = -1e30f, l_reg = 0.f; f32x16 o[4] = {};
#define A_STEP(KB, t) do { \
        if ((t) + 1 < NT) A_DMA((t) + 1, (KB) ^ 1); \
        const int jb_ = (t) - (NT - 4); \
        if (jb_ < 0 || 64 * jb_ <= 32 * wid + 31) { \
            f32x16 p0, p1; float alpha; bf16x8 pa0, pa1, pa2, pa3; \
            qkt<DQK>(p0, p1, K_lds + (KB) * SHM_K, r32, hi, qr, qpk); \
            if constexpr (FOX) { const float* ckp = ck_l + (KB) * 64 + 4 * hi; \
                _Pragma("unroll") for (int g_ = 0; g_ < 4; ++g_) { const f32x4 c0 = *(const f32x4*)(ckp + 8 * g_), c1 = *(const f32x4*)(ckp + 32 + 8 * g_); \
                    _Pragma("unroll") for (int e_ = 0; e_ < 4; ++e_) { p0[4 * g_ + e_] += cq - c0[e_]; p1[4 * g_ + e_] += cq - c1[e_]; } } } \
            if (jb_ >= 0 && 64 * jb_ + 63 > 32 * wid) mask_tile(p0, p1, 32 * wid + r32 - 64 * jb_ - 4 * hi); \
            softmax_tile(p0, p1, m_reg, l_reg, alpha, pa0, pa1, pa2, pa3); \
            if (__any(alpha < 1.f)) { if (hi == 0) al_l[r32] = alpha; asm volatile("s_waitcnt lgkmcnt(0)" ::: "memory"); \
                _Pragma("unroll") for (int d_ = 0; d_ < 4; ++d_) _Pragma("unroll") for (int r = 0; r < 16; ++r) o[d_][r] *= al_l[crow(r, hi)]; } \
            SBAR(); pv_tile<(KB) * SHM_V>(o, vb0, pa0, pa1, pa2, pa3); \
        } \
        A_SYNC(); } while (0)
    for (int t = 0; t < NT; t += 2) { A_STEP(0, t); A_STEP(1, t + 1); }
#undef A_STEP
#undef A_DMA
#undef A_SYNC
    if (hi == 0) li_l[r32] = l_reg; asm volatile("s_waitcnt lgkmcnt(0)" ::: "memory");
    bf16* stg = (bf16*)(lds + wid * 8192);
#pragma unroll
    for (int r = 0; r < 16; ++r) { const int orow = crow(r, hi); const float rl = __builtin_amdgcn_rcpf(li_l[orow]);
#pragma unroll
        for (int d0 = 0; d0 < 4; ++d0) stg[orow * 128 + d0 * 32 + r32] = (bf16)f2bf(o[d0][r] * rl); }
    asm volatile("s_waitcnt lgkmcnt(0)" ::: "memory");
#pragma unroll
    for (int i = 0; i < 8; ++i) { const int row = i * 4 + (lane >> 4), ch = lane & 15;
        const u32x4 v = *(const u32x4*)(stg + row * 128 + ch * 8);
        const size_t go = (size_t)(q0 + wid * QBLK + row) * 2048 + ch * 8;
        const u32x4 g = *(const u32x4*)(Gp + go); u32x4 w;
        w.x = cvtpk(bflo(v.x) * bflo(g.x), bfhi(v.x) * bfhi(g.x)); w.y = cvtpk(bflo(v.y) * bflo(g.y), bfhi(v.y) * bfhi(g.y));
        w.z = cvtpk(bflo(v.z) * bflo(g.z), bfhi(v.z) * bfhi(g.z)); w.w = cvtpk(bflo(v.w) * bflo(g.w), bfhi(v.w) * bfhi(g.w));
        *(u32x4*)(Op + go) = w; }
    __syncthreads();
}
#undef KSWZ
#undef SBAR
}

__device__ __forceinline__ void transpose_item(const float* W, int ldw, int K, const float* g, bf16* WT, int dst_row0, int src_col0, int nvalid, int k0, LAS float* scr, int lane) {
    const int n = lane & 31; const bool ok = (src_col0 >= 0) && (n < nvalid);
#pragma unroll 8
    for (int i = 0; i < 32; ++i) { const int kk = 2 * i + (lane >> 5); float v = 0.f; if (ok) { v = W[(size_t)(k0 + kk) * ldw + src_col0 + n]; if (g) v *= g[k0 + kk]; } scr[kk * 33 + n] = v; }
    asm volatile("s_waitcnt lgkmcnt(0)" ::: "memory");
    const int c = lane & 7;
#pragma unroll
    for (int j = 0; j < 4; ++j) { const int nn = (lane >> 3) + 8 * j; const LAS float* s = scr + (8 * c) * 33 + nn;
        u32x4 o; o.x = pk2(s[0 * 33], s[1 * 33]); o.y = pk2(s[2 * 33], s[3 * 33]); o.z = pk2(s[4 * 33], s[5 * 33]); o.w = pk2(s[6 * 33], s[7 * 33]);
        *(u32x4*)(WT + (size_t)(dst_row0 + nn) * K + k0 + 8 * c) = o; }
    asm volatile("s_waitcnt lgkmcnt(0)" ::: "memory");
}
__device__ __forceinline__ void win_src(int r0, int& src, int& nv) {
    nv = 32;
    if (r0 < 1280) src = r0;
    else if (r0 < 2304) src = 1344 + (r0 - 1280);
    else if (r0 < 3328) src = 2368 + (r0 - 2304);
    else if (r0 < 4352) src = 3392 + (r0 - 3328);
    else if (r0 < 5376) src = 4416 + (r0 - 4352);
    else if (r0 < 6400) src = 5448 + (r0 - 5376);
    else if (r0 == 6400) src = 1280;
    else if (r0 == 6432) { src = 5440; nv = 8; }
    else if (r0 == 6528) src = 1312;
    else src = -1;
}
__device__ __forceinline__ int wuq_src(int r0) {
    if (r0 < 1024) return (r0 >> 7) * 192 + (r0 & 127);
    const int q = r0 - 1024, t = q >> 8, bj = (q >> 7) & 1, wc = (q >> 5) & 3;
    return (4 * t + wc) * 192 + 128 + 32 * bj;
}


#define XB_TMO      128
#define XB_XCNT(j)  (256  + 64 * (j))
#define XB_XSUB(j)  (1280 + 64 * (j))
#define XB_XGEN(j)  (2304 + 64 * (j))
#define XB_TOP      3328
#define XB_TOPGEN   3392
#define XCD_BAR_WORDS 3456
#define XB_SPIN_CAP (1u << 18)
__device__ __forceinline__ unsigned xb_ld(unsigned* p)              { return __hip_atomic_load(p, __ATOMIC_RELAXED, __HIP_MEMORY_SCOPE_AGENT); }
__device__ __forceinline__ unsigned xb_add(unsigned* p, unsigned v) { return __hip_atomic_fetch_add(p, v, __ATOMIC_RELAXED, __HIP_MEMORY_SCOPE_AGENT); }
__device__ __forceinline__ unsigned xb_xcc_id() { return (unsigned)__builtin_amdgcn_s_getreg((3 << 11) | 20) & 0xFu; }
#define XB_SPIN(cond, bar) do { unsigned _sp = 0; while (cond) { __builtin_amdgcn_s_sleep(1); \
    if ((++_sp & 255u) == 0u) { if (xb_ld(&(bar)[XB_TMO])) break; if (_sp > XB_SPIN_CAP) { atomicAdd(&(bar)[XB_TMO], 1u); break; } } } } while (0)
struct XcdBarrier { unsigned* bar; unsigned x; volatile LAS unsigned* st; };
__device__ __forceinline__ XcdBarrier xcd_barrier_post(unsigned* bar, volatile LAS unsigned* st) {
    XcdBarrier b; b.bar = bar; b.x = xb_xcc_id(); b.st = st;
    if (threadIdx.x == 0) (void)xb_add(&bar[XB_XCNT(b.x)], 1u);
    return b;
}
__device__ __forceinline__ void xcd_barrier_complete(unsigned* bar, unsigned x, unsigned& nloc, unsigned& nx) {
    const unsigned G = gridDim.x * gridDim.y * gridDim.z;
    unsigned sum, cnt, mine, sp = 0u;
    for (;;) {
        sum = 0u; cnt = 0u; mine = 0u;
#pragma unroll
        for (unsigned j = 0; j < 16; ++j) { const unsigned c = xb_ld(&bar[XB_XCNT(j)]); sum += c; cnt += (c > 0u) ? 1u : 0u; mine = (j == x) ? c : mine; }
        if (sum == G) break;
        __builtin_amdgcn_s_sleep(1);
        if ((++sp & 255u) == 0u) { if (xb_ld(&bar[XB_TMO])) break; if (sp > XB_SPIN_CAP) { atomicAdd(&bar[XB_TMO], 1u); break; } }
    }
    nloc = mine > 0u ? mine : 1u; nx = cnt > 0u ? cnt : 1u;
}
__device__ __forceinline__ void xcd_barrier(const XcdBarrier& b) {
    asm volatile("s_waitcnt vmcnt(0)" ::: "memory");
    __syncthreads();
    if (threadIdx.x == 0) {
        unsigned* bar = b.bar;
        __builtin_amdgcn_s_waitcnt(0);
        unsigned nloc = b.st[0], nx = b.st[1];
        if (nloc == 0u) { xcd_barrier_complete(bar, b.x, nloc, nx); b.st[0] = nloc; b.st[1] = nx; }
        const unsigned old = xb_add(&bar[XB_XSUB(b.x)], 1u);
        const unsigned gen = old / nloc;
        if (old + 1u == (gen + 1u) * nloc) {
            __builtin_amdgcn_fence(__ATOMIC_RELEASE, "agent");
            asm volatile("s_waitcnt vmcnt(0)" ::: "memory");
            const unsigned og = xb_add(&bar[XB_TOP], 1u);
            const unsigned tg = og / nx;
            if (og + 1u == (tg + 1u) * nx) xb_add(&bar[XB_TOPGEN], 1u);
            else XB_SPIN(xb_ld(&bar[XB_TOPGEN]) == tg, bar);
            __builtin_amdgcn_fence(__ATOMIC_ACQUIRE, "agent");
            xb_add(&bar[XB_XGEN(b.x)], 1u);
            asm volatile("s_waitcnt vmcnt(0)" ::: "memory");
        } else {
            XB_SPIN(xb_ld(&bar[XB_XGEN(b.x)]) == gen, bar);
            __builtin_amdgcn_fence(__ATOMIC_ACQUIRE, "agent");
            asm volatile("s_waitcnt vmcnt(0)" ::: "memory");
        }
    }
    __syncthreads();
}

struct Args { const float* x; const int* pos; const float* g_pre; const float* w_in; const float* g_q; const float* w_uq; const float* g_kv; const float* w_ukv;
              const float* b_forget; const float* w_out; const float* g_post; float* out; unsigned char* ws; int ph_lo, ph_hi; };

__global__ void __launch_bounds__(512, 2) hybrid_fwd(Args a) {
    extern __shared__ __attribute__((aligned(16))) unsigned char lds[];
    cg::grid_group grid = cg::this_grid();
    const int tid = threadIdx.x, lane = tid & 63, wave = __builtin_amdgcn_readfirstlane(tid >> 6);
    const int G = gridDim.x, bx = blockIdx.x; const int vcu = (G % 8 == 0) ? (bx % 8) * (G / 8) + bx / 8 : bx;
    unsigned char* ws = a.ws;
    float* rstd_x = (float*)(ws + WS_RSTDX); float* partq = (float*)(ws + WS_PARTQ); float* partkv = (float*)(ws + WS_PARTKV); float* party = (float*)(ws + WS_PARTY);
    float* flog = (float*)(ws + WS_FLOG); float* cf = (float*)(ws + WS_CF); float* cosT = (float*)(ws + WS_COS); float* sinT = (float*)(ws + WS_SIN);
    bf16* Win_t = (bf16*)(ws + WS_WIN); bf16* Wuq_t = (bf16*)(ws + WS_WUQ); bf16* Wukv_t = (bf16*)(ws + WS_WUKV); bf16* Wout_t = (bf16*)(ws + WS_WOUT);
    bf16* Xb = (bf16*)(ws + WS_XB); bf16* Ob = (bf16*)(ws + WS_O); bf16* qlat = (bf16*)(ws + WS_QLAT); bf16* kvlat = (bf16*)(ws + WS_KVLAT); bf16* Gb = (bf16*)(ws + WS_G);
    bf16* Qf = (bf16*)(ws + WS_QF); bf16* Kf = (bf16*)(ws + WS_KF); bf16* Vf = (bf16*)(ws + WS_VF); bf16* Yb = (bf16*)(ws + WS_Y);
    bf16* Qm = (bf16*)(ws + WS_QM); bf16* Km = (bf16*)(ws + WS_KM); bf16* Vm = (bf16*)(ws + WS_VM);
    const int lo = a.ph_lo, hi = a.ph_hi;
#ifndef PH_MASK
#define PH_MASK 63
#endif
#define IN(k) (((PH_MASK >> (k)) & 1) && lo <= (k) && (k) < hi)
#define BOTH(k) (IN(k) && IN((k) + 1))
    LAS unsigned char* ldsl = (LAS unsigned char*)lds;
    volatile LAS unsigned* bst = (volatile LAS unsigned*)(ldsl + LDS_BYTES - 64);
    if (tid < 2) bst[tid] = 0u;
    __syncthreads();
    XcdBarrier xbar = xcd_barrier_post((unsigned*)(ws + WS_CTL), bst);

    if (IN(0)) {
        LAS float* scr = (LAS float*)(ldsl + wave * 16384);
        const int gw = vcu * 8 + wave, NGW = G * 8;
        constexpr int I_IN = 32 * 208, I_UQ = 12 * 48, I_UKV = 8 * 64, I_OUT = 32 * 64, NITEMS = I_IN + I_UQ + I_UKV + I_OUT;
        for (int it = gw; it < NITEMS; it += NGW) {
            int r = it;
            if (r < I_IN) { const int kb = r / 208, nb = r % 208; int src, nv; win_src(nb * 32, src, nv); transpose_item(a.w_in, DIN, 2048, a.g_pre, Win_t, nb * 32, src, nv, kb * 64, scr, lane); continue; } r -= I_IN;
            if (r < I_UQ) { const int kb = r / 48, nb = r % 48; transpose_item(a.w_uq, 1536, 768, a.g_q, Wuq_t, nb * 32, wuq_src(nb * 32), 32, kb * 64, scr, lane); continue; } r -= I_UQ;
            if (r < I_UKV) { const int kb = r / 64, nb = r % 64; transpose_item(a.w_ukv, 2048, 512, a.g_kv, Wukv_t, nb * 32, nb * 32, 32, kb * 64, scr, lane); continue; } r -= I_UKV;
            { const int kb = r / 64, nb = r % 64; transpose_item(a.w_out, 2048, 2048, nullptr, Wout_t, nb * 32, nb * 32, 32, kb * 64, scr, lane); }
        }
        for (int m = gw; m < M; m += NGW) {
            const f32x4* xr = (const f32x4*)(a.x + (size_t)m * DM) + lane; f32x4 v[8]; float s = 0.f;
#pragma unroll
            for (int j = 0; j < 8; ++j) { v[j] = xr[64 * j]; s += (v[j][0] * v[j][0] + v[j][1] * v[j][1]) + (v[j][2] * v[j][2] + v[j][3] * v[j][3]); }
            s = wave_sum(s); if (lane == 0) rstd_x[m] = 1.f / sqrtf(s * (1.f / DM) + EPS);
            u32x2* o8 = (u32x2*)(Xb + (size_t)m * DM) + lane;
#pragma unroll
            for (int j = 0; j < 8; ++j) { u32x2 w; w.x = pk2(v[j][0], v[j][1]); w.y = pk2(v[j][2], v[j][3]); o8[64 * j] = w; }
        }
        for (int e = (vcu * 512 + tid); e < M * 32; e += G * 512) { const int row = e >> 5, i = e & 31;
            const float inv = exp2f(-(float)i * (13.287712379549449f / 32.f)); const float ang = (float)a.pos[row] * inv;
            const float n = rintf(ang * 0.15915494309189535f); float r = fmaf(-n, 6.28318548202514648f, ang); r = fmaf(-n, -1.7484555e-7f, r);
            cosT[e] = __cosf(r); sinT[e] = __sinf(r); }
    }
    if (BOTH(0)) grid.sync();

    if (IN(1)) {
        pg8::Gemm g{Xb, Win_t, M, NIN_PAD, 2048}; pg8::StaticOrder S; S.init(M, NIN_PAD, G, bx);
        EpiIn E{rstd_x, qlat, kvlat, Gb, Qf, Kf, Vf, Km, flog, partq, partkv, cosT, sinT};
        pg8::gemm_phase<EpiIn, pg8::StaticOrder, true, true>(ldsl, g, S, E);
    }
    if (BOTH(1)) xcd_barrier(xbar);

    if (IN(2)) {
        const int gw = bx * 8 + wave;
        if (gw < BATCH * NH) { const int b = gw >> 3, h = gw & 7; const float bf = a.b_forget[h];
            const float* fl = flog + ((size_t)b * SEQ + 64 * lane) * 8 + h; float run = 0.f;
            for (int j = 0; j < 64; ++j) { const float z = fl[j * 8] + bf; run += fminf(z, 0.f) - log1pf(expf(-fabsf(z))); }
            float incl = run;
#pragma unroll
            for (int o = 1; o < 64; o <<= 1) { const float t = __shfl_up(incl, o); if (lane >= o) incl += t; }
            float acc = incl - run; float* cp = cf + (size_t)gw * SEQ + 64 * lane;
            for (int j = 0; j < 64; ++j) { const float z = fl[j * 8] + bf; acc += fminf(z, 0.f) - log1pf(expf(-fabsf(z))); cp[j] = acc * LOG2E; }
        }
        { pg8::Gemm g{qlat, Wuq_t, M, 1536, QRANK}; pg8::StaticOrder S; S.init(M, 1536, G, bx);
          EpiQ E{partq, Qm, cosT, sinT};
          pg8::gemm_phase<EpiQ, pg8::StaticOrder, true, true>(ldsl, g, S, E); }
        { pg8::Gemm g{kvlat, Wukv_t, M, 2048, KVRANK}; pg8::StaticOrder S; S.init(M, 2048, G, bx);
          EpiKV E{partkv, Km, Vm};
          pg8::gemm_phase<EpiKV, pg8::StaticOrder, true, true>(ldsl, g, S, E); }
    }
    if (BOTH(2)) xcd_barrier(xbar);

    if (IN(3)) {
        for (int v = vcu; v < 256; v += G) {
            const int s = v & 3, w = v >> 2, b = w >> 4, hh = w & 15, hd = hh & 7, swp = hh >> 3;
            const size_t rb = (size_t)b * SEQ;
#pragma unroll 1
            for (int i = 0; i < 2; ++i) {
                const int qb = __builtin_amdgcn_readfirstlane(swp ? (i == 0 ? 8 + s : 7 - s) : (i == 0 ? 15 - s : s));
                att::attn_unit<192, false>((char*)lds, Qm + rb * 1536 + hd * 192, 1536, Km + rb * 1536 + hd * 192, 1536, Vm + rb * 1024 + hd * 128, 1024, nullptr,
                                           Gb + rb * 2048 + hd * 128, Ob + rb * 2048 + hd * 128, qb);
            }
#pragma unroll 1
            for (int i = 0; i < 2; ++i) {
                const int qb = __builtin_amdgcn_readfirstlane(swp ? (i == 0 ? 15 - s : s) : (i == 0 ? 8 + s : 7 - s));
                att::attn_unit<128, true>((char*)lds, Qf + rb * 1024 + hd * 128, 1024, Kf + rb * 1024 + hd * 128, 1024, Vf + rb * 1024 + hd * 128, 1024, cf + (size_t)(b * 8 + hd) * SEQ,
                                          Gb + rb * 2048 + 1024 + hd * 128, Ob + rb * 2048 + 1024 + hd * 128, qb);
            }
        }
    }
    if (BOTH(3)) xcd_barrier(xbar);

    if (IN(4)) {
        pg8::Gemm g{Ob, Wout_t, M, 2048, 2048}; pg8::StaticOrder S; S.init(M, 2048, G, bx);
        EpiOut E{Yb, party};
        pg8::gemm_phase<EpiOut, pg8::StaticOrder, true, true>(ldsl, g, S, E);
    }
    if (BOTH(4)) xcd_barrier(xbar);

    if (IN(5)) {
        const int gw = vcu * 8 + wave, NGW = G * 8;
        for (int m = gw; m < M; m += NGW) {
            float s = (lane < 32) ? party[(size_t)m * 32 + lane] : 0.f; s = wave_sum(s);
            const float rs = 1.f / sqrtf(s * (1.f / DM) + EPS);
            const f32x4* xr = (const f32x4*)(a.x + (size_t)m * DM) + lane; const f32x4* gp = (const f32x4*)a.g_post + lane;
            const u32x2* yr = (const u32x2*)(Yb + (size_t)m * DM) + lane; f32x4* orow = (f32x4*)(a.out + (size_t)m * DM) + lane;
#pragma unroll
            for (int j = 0; j < 8; ++j) { const f32x4 xv = xr[64 * j], gv = gp[64 * j]; const u32x2 y = yr[64 * j];
                f32x4 o; o[0] = xv[0] + bflo(y.x) * rs * gv[0]; o[1] = xv[1] + bfhi(y.x) * rs * gv[1]; o[2] = xv[2] + bflo(y.y) * rs * gv[2]; o[3] = xv[3] + bfhi(y.y) * rs * gv[3];
                orow[64 * j] = o; }
        }
    }
#undef IN
#undef BOTH
}

extern "C" void kernel_launch(void* const* d_in, const int* in_sizes, int n_in, void* d_out, int out_size, void* d_ws, size_t ws_size, hipStream_t stream) {
    static int grid = 0;
    if (grid == 0) {
        if (n_in != 11 || in_sizes[0] != M * DM || out_size != M * DM || ws_size < WS_END) { fprintf(stderr, "kernel_launch: shape mismatch n_in %d in0 %d out %d ws %zu\n", n_in, n_in > 0 ? in_sizes[0] : -1, out_size, ws_size); grid = -1; return; }
        int dev = 0, cus = 0, per_cu = 0;
        if (hipGetDevice(&dev) != hipSuccess || hipDeviceGetAttribute(&cus, hipDeviceAttributeMultiprocessorCount, dev) != hipSuccess) { grid = -1; return; }
        if (hipFuncSetAttribute((const void*)hybrid_fwd, hipFuncAttributeMaxDynamicSharedMemorySize, LDS_BYTES) != hipSuccess) { fprintf(stderr, "kernel_launch: hipFuncSetAttribute failed\n"); grid = -1; return; }
        if (hipOccupancyMaxActiveBlocksPerMultiprocessor(&per_cu, (const void*)hybrid_fwd, 512, LDS_BYTES) != hipSuccess || per_cu < 1) { fprintf(stderr, "kernel_launch: occupancy query says %d\n", per_cu); per_cu = 1; }
        (void)hipGetLastError();
        grid = cus;
    }
    if (grid < 0) return;
    if (hipMemsetAsync((char*)d_ws + WS_CTL, 0, CTL_BYTES, stream) != hipSuccess) { fprintf(stderr, "kernel_launch: memset failed\n"); return; }
    Args a{};
    a.x = (const float*)d_in[0]; a.pos = (const int*)d_in[1]; a.g_pre = (const float*)d_in[2]; a.w_in = (const float*)d_in[3]; a.g_q = (const float*)d_in[4]; a.w_uq = (const float*)d_in[5];
    a.g_kv = (const float*)d_in[6]; a.w_ukv = (const float*)d_in[7]; a.b_forget = (const float*)d_in[8]; a.w_out = (const float*)d_in[9]; a.g_post = (const float*)d_in[10];
    a.out = (float*)d_out; a.ws = (unsigned char*)d_ws;
#if MK_N_LAUNCHES == 1
    a.ph_lo = 0; a.ph_hi = 6;
    void* args[] = {&a};
    hipError_t e = hipLaunchCooperativeKernel((const void*)hybrid_fwd, dim3(grid), dim3(512), args, LDS_BYTES, stream);
    if (e != hipSuccess) fprintf(stderr, "cooperative launch failed: %s (grid %d)\n", hipGetErrorString(e), grid);
#else
    for (int p = 0; p < 6; ++p) { a.ph_lo = p; a.ph_hi = p + 1; hipLaunchKernelGGL(hybrid_fwd, dim3(grid), dim3(512), LDS_BYTES, stream, a); }
#endif
}
```

```cpp
#include <hip/hip_runtime.h>
#include <hip/hip_cooperative_groups.h>
#include <cstdio>
#include <cstdint>
namespace cg = cooperative_groups;

#ifndef PROBE_REP0
#define PROBE_REP0 1
#endif
#ifndef PROBE_REP1
#define PROBE_REP1 1
#endif
#ifndef PROBE_REP2
#define PROBE_REP2 1
#endif
#ifndef PROBE_REP3
#define PROBE_REP3 1
#endif
#ifndef PROBE_REP4
#define PROBE_REP4 1
#endif
#ifndef PROBE_REP5
#define PROBE_REP5 1
#endif
#ifndef PROBE_DUP
#define PROBE_DUP -1
#endif
#ifndef MK_N_LAUNCHES
#define MK_N_LAUNCHES 1
#endif

namespace pg8 {
#define PG8_LAS __attribute__((address_space(3)))
typedef unsigned short bf16_t;
typedef short bf16x8 __attribute__((ext_vector_type(8)));
typedef float f32x4 __attribute__((ext_vector_type(4)));
typedef unsigned u32x4 __attribute__((ext_vector_type(4)));
constexpr int BM = 256, BK = 64, HALF = 128, HTB = HALF * BK * 2, STAGE_BYTES = 8 * HTB, NXCD = 8, WGM = 8;

__host__ __device__ __forceinline__ int lds_byte(int r, int c) { const int st = (r >> 4) * 2 + (c >> 5), rr = r & 15, cc = c & 31, ob = rr * 64 + cc * 2; return st * 1024 + (ob ^ (((ob >> 9) & 1) << 5)); }
__host__ __device__ __forceinline__ void stage_rc(int b, int& R, int& C) { const int st = b / 1024, sb = b % 1024, swz = sb ^ (((sb >> 9) & 1) << 5); R = (st >> 1) * 16 + swz / 64; C = (st & 1) * 32 + (swz % 64) / 2; }
__host__ __device__ __forceinline__ int perm32(int rho) { const int n = rho >> 4, i = rho & 15; return 8 * (i >> 2) + 4 * n + (i & 3); }

struct Unit { int pm, pn; };
struct Gemm { const bf16_t* A; const bf16_t* Bt; int M, N, K; };

struct StaticOrder {
    int nM, nN, nwg, G, c;
    __host__ __device__ void init(int M, int N, int G_, int c_) { nM = M / BM; nN = N / BM; nwg = nM * nN; G = G_; c = c_; }
    __host__ __device__ bool next(int i, Unit& u) const {
        const long L = (long)i * G + c; if (L >= nwg) return false;
        int wgid = (int)L; { const int q = nwg / NXCD, r = nwg % NXCD, xcd = wgid % NXCD, off = wgid / NXCD; wgid = (xcd < r ? xcd * (q + 1) : r * (q + 1) + (xcd - r) * q) + off; }
        const int nig = WGM * nN, gid = wgid / nig, fm = gid * WGM, gsz = (nM - fm) < WGM ? (nM - fm) : WGM;
        u.pm = fm + ((wgid % nig) % gsz); u.pn = (wgid % nig) / gsz; return true;
    }
    __device__ __forceinline__ void a_ready(const Unit&) const {}
    __device__ __forceinline__ void done(const Unit&) const {}
};

__device__ __forceinline__ unsigned cvt_pk_bf16(float lo, float hi) { unsigned r; asm volatile("v_cvt_pk_bf16_f32 %0, %1, %2" : "=v"(r) : "v"(lo), "v"(hi)); return r; }

template <class Epi, class Sched, bool ALIGN_EPI = false, bool SP2 = false>
__device__ __forceinline__ void gemm_phase(PG8_LAS unsigned char* lds, const Gemm g, const Sched& S, const Epi& E) {
    const int tid = threadIdx.x, wid = __builtin_amdgcn_readfirstlane(tid >> 6), lane = tid & 63, wr = wid >> 2, wc = wid & 3, fr = lane & 15, fq = lane >> 4;
    const int K = g.K, nt = K / BK;
    unsigned voffA[2], voffB[2];
#pragma unroll
    for (int i = 0; i < 2; ++i) { int R, C; stage_rc(tid * 16 + i * 8192, R, C); const int Rb = Epi::PERM ? ((R & ~31) + perm32(R & 31)) : R;
        voffA[i] = (unsigned)(R * K + C) * 2u; voffB[i] = (unsigned)(Rb * K + C) * 2u; }
    const size_t kstep = (size_t)(BK * 2);
    const size_t hstep = (size_t)HALF * K * 2;
    const size_t tstep = 2 * hstep;
    const unsigned ldsw = (unsigned)wid * 1024u;
    const int aoff = lds_byte(wr * 64 + fr, fq * 8), boff = lds_byte(wc * 32 + fr, fq * 8);
#define PG8_SA(b, h) (((b) * 2 + (h)) * HTB)
#define PG8_SB(b, h) ((4 + (b) * 2 + (h)) * HTB)
#define PG8_STAGE(bufoff, gbase, voff) do { _Pragma("unroll") for (int _i = 0; _i < 2; ++_i) \
        __builtin_amdgcn_global_load_lds((const unsigned*)((const char*)(gbase) + (voff)[_i]), (PG8_LAS unsigned*)(lds + (bufoff) + ldsw + _i * 8192), 16, 0, 0); } while (0)
#define PG8_LDA(dst, b, h) do { _Pragma("unroll") for (int m = 0; m < 4; ++m) _Pragma("unroll") for (int k = 0; k < 2; ++k) dst[m][k] = *(const PG8_LAS bf16x8*)(lds + PG8_SA(b, h) + aoff + m * 2048 + k * 1024); } while (0)
#define PG8_LDB(dst, b, h) do { _Pragma("unroll") for (int n = 0; n < 2; ++n) _Pragma("unroll") for (int k = 0; k < 2; ++k) dst[n][k] = *(const PG8_LAS bf16x8*)(lds + PG8_SB(b, h) + boff + n * 2048 + k * 1024); } while (0)
#define PG8_MMA(ai, bj, At, Bt) do { __builtin_amdgcn_s_setprio(1); _Pragma("unroll") for (int m = 0; m < 4; ++m) _Pragma("unroll") for (int n = 0; n < 2; ++n) _Pragma("unroll") for (int k = 0; k < 2; ++k) \
        acc[ai][bj][m][n] = __builtin_amdgcn_mfma_f32_16x16x32_bf16(Bt[n][k], At[m][k], acc[ai][bj][m][n], 0, 0, 0); __builtin_amdgcn_s_setprio(0); } while (0)
#define PG8_WAIT_V(n) asm volatile("s_waitcnt vmcnt(" #n ")" ::: "memory")
#define PG8_WAIT_L(n) asm volatile("s_waitcnt lgkmcnt(" #n ")" ::: "memory")
#define PG8_BAR __builtin_amdgcn_s_barrier()
#define PG8_SCHED __builtin_amdgcn_sched_barrier(0)
    Unit cur, nxt; int ui = 0;
    if (!S.next(0, cur)) return;
    f32x4 acc[2][2][4][2];
#pragma unroll
    for (int a = 0; a < 2; ++a)
#pragma unroll
        for (int b = 0; b < 2; ++b)
#pragma unroll
            for (int m = 0; m < 4; ++m)
#pragma unroll
                for (int n = 0; n < 2; ++n) acc[a][b][m][n] = (f32x4){0.f, 0.f, 0.f, 0.f};
    bf16x8 At[4][2], B0[2][2], B1[2][2];
    const char* cA = (const char*)g.A + (size_t)cur.pm * tstep; const char* cB = (const char*)g.Bt + (size_t)cur.pn * tstep;
    S.a_ready(cur);
    if constexpr (SP2) {
        PG8_STAGE(PG8_SB(0, 0), cB, voffB); PG8_STAGE(PG8_SB(0, 1), cB + hstep, voffB); PG8_STAGE(PG8_SA(0, 0), cA, voffA); PG8_STAGE(PG8_SA(0, 1), cA + hstep, voffA);
        if (wr == 1) PG8_BAR;
        PG8_WAIT_V(2); PG8_BAR;
        PG8_STAGE(PG8_SB(1, 0), cB + kstep, voffB); PG8_STAGE(PG8_SA(1, 0), cA + kstep, voffA); PG8_STAGE(PG8_SB(1, 1), cB + hstep + kstep, voffB);
        PG8_WAIT_V(6); PG8_BAR;
    } else {
        PG8_STAGE(PG8_SB(0, 0), cB, voffB); PG8_STAGE(PG8_SA(0, 0), cA, voffA); PG8_STAGE(PG8_SB(0, 1), cB + hstep, voffB); PG8_STAGE(PG8_SA(0, 1), cA + hstep, voffA);
        if (wr == 1) PG8_BAR;
        PG8_WAIT_V(4); PG8_BAR;
        PG8_STAGE(PG8_SB(1, 0), cB + kstep, voffB); PG8_STAGE(PG8_SA(1, 0), cA + kstep, voffA); PG8_STAGE(PG8_SB(1, 1), cB + hstep + kstep, voffB);
        PG8_WAIT_V(6); PG8_BAR;
    }
    for (;;) {
        const bool has_next = S.next(ui + 1, nxt);
        const char* nA = has_next ? (const char*)g.A + (size_t)nxt.pm * tstep : cA; const char* nB = has_next ? (const char*)g.Bt + (size_t)nxt.pn * tstep : cB;
        for (int t = 0; t < nt; t += 2) {
            const bool last = (t == nt - 2);
            const char* a1 = cA + (size_t)(t + 1) * kstep;
            const char* a2 = last ? nA : cA + (size_t)(t + 2) * kstep; const char* b2 = last ? nB : cB + (size_t)(t + 2) * kstep;
            const char* a3 = a2 + kstep; const char* b3 = b2 + kstep;
            if (last && has_next) S.a_ready(nxt);
            if constexpr (SP2) {
            PG8_LDB(B0, 0, 0); PG8_LDB(B1, 0, 1); PG8_SCHED; PG8_LDA(At, 0, 0); PG8_STAGE(PG8_SA(1, 1), a1 + hstep, voffA);
            PG8_WAIT_V(8); PG8_WAIT_L(0); PG8_BAR; PG8_MMA(0, 0, At, B0); PG8_MMA(0, 1, At, B1); PG8_BAR; PG8_SCHED;
            PG8_LDA(At, 0, 1); PG8_STAGE(PG8_SB(0, 0), b2, voffB); PG8_STAGE(PG8_SB(0, 1), b2 + hstep, voffB); PG8_STAGE(PG8_SA(0, 0), a2, voffA);
            PG8_WAIT_V(8); PG8_WAIT_L(0); PG8_BAR; PG8_MMA(1, 0, At, B0); PG8_MMA(1, 1, At, B1); PG8_BAR; PG8_SCHED;
            PG8_LDB(B0, 1, 0); PG8_LDB(B1, 1, 1); PG8_SCHED; PG8_LDA(At, 1, 0); PG8_STAGE(PG8_SA(0, 1), a2 + hstep, voffA);
            PG8_WAIT_V(8); PG8_WAIT_L(0); PG8_BAR; PG8_MMA(0, 0, At, B0); PG8_MMA(0, 1, At, B1); PG8_BAR; PG8_SCHED;
            PG8_LDA(At, 1, 1); PG8_STAGE(PG8_SB(1, 0), b3, voffB); PG8_STAGE(PG8_SB(1, 1), b3 + hstep, voffB); PG8_STAGE(PG8_SA(1, 0), a3, voffA);
            PG8_WAIT_V(8); PG8_WAIT_L(0); PG8_BAR; PG8_MMA(1, 0, At, B0); PG8_MMA(1, 1, At, B1); PG8_BAR; PG8_SCHED;
            } else {
            PG8_LDB(B0, 0, 0); PG8_SCHED; PG8_LDA(At, 0, 0); PG8_STAGE(PG8_SA(1, 1), a1 + hstep, voffA);
            PG8_WAIT_L(8); PG8_BAR; PG8_WAIT_L(0); PG8_MMA(0, 0, At, B0); PG8_BAR; PG8_SCHED;
            PG8_LDB(B1, 0, 1); PG8_STAGE(PG8_SB(0, 0), b2, voffB);
            PG8_BAR; PG8_WAIT_L(0); PG8_MMA(0, 1, At, B1); PG8_BAR;
            PG8_LDA(At, 0, 1); PG8_STAGE(PG8_SA(0, 0), a2, voffA);
            PG8_BAR; PG8_WAIT_L(0); PG8_MMA(1, 0, At, B0); PG8_BAR; PG8_SCHED;
            PG8_STAGE(PG8_SB(0, 1), b2 + hstep, voffB);
            PG8_WAIT_V(6); PG8_BAR; PG8_MMA(1, 1, At, B1); PG8_BAR;
            PG8_LDB(B0, 1, 0); PG8_SCHED; PG8_LDA(At, 1, 0); PG8_STAGE(PG8_SA(0, 1), a2 + hstep, voffA);
            PG8_WAIT_L(8); PG8_BAR; PG8_WAIT_L(0); PG8_MMA(0, 0, At, B0); PG8_BAR; PG8_SCHED;
            PG8_LDB(B1, 1, 1); PG8_STAGE(PG8_SB(1, 0), b3, voffB);
            PG8_BAR; PG8_WAIT_L(0); PG8_MMA(0, 1, At, B1); PG8_BAR;
            PG8_LDA(At, 1, 1); PG8_STAGE(PG8_SA(1, 0), a3, voffA);
            PG8_BAR; PG8_WAIT_L(0); PG8_MMA(1, 0, At, B0); PG8_BAR; PG8_SCHED;
            PG8_STAGE(PG8_SB(1, 1), b3 + hstep, voffB);
            PG8_WAIT_V(6); PG8_BAR; PG8_MMA(1, 1, At, B1); PG8_BAR;
            }
        }
        if constexpr (ALIGN_EPI) { if (wr == 0) PG8_BAR; }
        if constexpr (!Epi::AFTER_DRAIN) { E(acc, cur, wr, wc, fr, fq); S.done(cur); }
        if (!has_next) break;
#pragma unroll
        for (int a = 0; a < 2; ++a)
#pragma unroll
            for (int b = 0; b < 2; ++b)
#pragma unroll
                for (int m = 0; m < 4; ++m)
#pragma unroll
                    for (int n = 0; n < 2; ++n) acc[a][b][m][n] = (f32x4){0.f, 0.f, 0.f, 0.f};
        cur = nxt; cA = nA; cB = nB; ++ui;
        if constexpr (ALIGN_EPI) { if (wr == 1) PG8_BAR; }
    }
    PG8_WAIT_V(0);
    if constexpr (!ALIGN_EPI) { if (wr == 0) PG8_BAR; }
    PG8_BAR;
#undef PG8_SA
#undef PG8_SB
#undef PG8_STAGE
#undef PG8_LDA
#undef PG8_LDB
#undef PG8_MMA
#undef PG8_WAIT_V
#undef PG8_WAIT_L
#undef PG8_BAR
#undef PG8_SCHED
}
}

typedef unsigned short bf16;
typedef float f32x4 __attribute__((ext_vector_type(4)));
typedef unsigned u32x4 __attribute__((ext_vector_type(4)));
typedef unsigned u32x2 __attribute__((ext_vector_type(2)));
typedef short bf16x8 __attribute__((ext_vector_type(8)));
typedef short s16x4 __attribute__((ext_vector_type(4)));
typedef float f32x16 __attribute__((ext_vector_type(16)));
#define LAS __attribute__((address_space(3)))

constexpr int BATCH = 4, SEQ = 4096, DM = 2048, M = BATCH * SEQ;
constexpr int NH = 8, QKD = 192, QRANK = 768, KVRANK = 512, DIN = 6472;
constexpr int NIN_PAD = 6656;
constexpr float EPS = 1e-6f;
constexpr float LOG2E = 1.4426950408889634f;
constexpr float C2M = 0.07216878364870322f * LOG2E;
constexpr float C2F = 0.08838834764831845f * LOG2E;

constexpr size_t MiB = 1u << 20;
constexpr size_t WS_RSTDX = 0, WS_PARTQ = 1 * MiB, WS_PARTKV = 2 * MiB, WS_PARTY = 3 * MiB, WS_FLOG = 5 * MiB, WS_CF = 6 * MiB, WS_COS = 7 * MiB, WS_SIN = 9 * MiB;
constexpr size_t WS_CTL = 11 * MiB, CTL_BYTES = 16384;
constexpr size_t WS_WIN = 16 * MiB, WS_WUQ = 42 * MiB, WS_WUKV = 45 * MiB, WS_WOUT = 47 * MiB;
constexpr size_t WS_XB = 56 * MiB, WS_O = 56 * MiB;
constexpr size_t WS_QLAT = 120 * MiB, WS_KVLAT = 144 * MiB, WS_G = 160 * MiB;
constexpr size_t WS_QF = 224 * MiB, WS_Y = 224 * MiB, WS_KF = 256 * MiB, WS_VF = 288 * MiB;
constexpr size_t WS_QM = 320 * MiB, WS_KM = 368 * MiB, WS_VM = 416 * MiB, WS_END = 448 * MiB;

constexpr int LDS_BYTES = 147456;

__device__ __forceinline__ unsigned f2bf(float f) { unsigned u = __builtin_bit_cast(unsigned, f); return (u + 0x7fffu + ((u >> 16) & 1u)) >> 16; }
__device__ __forceinline__ unsigned pk2(float lo, float hi) { return pg8::cvt_pk_bf16(lo, hi); }
__device__ __forceinline__ float bflo(unsigned w) { return __builtin_bit_cast(float, w << 16); }
__device__ __forceinline__ float bfhi(unsigned w) { return __builtin_bit_cast(float, w & 0xffff0000u); }
__device__ __forceinline__ float wave_sum(float v) {
#pragma unroll
    for (int o = 1; o < 64; o <<= 1) v += __shfl_xor(v, o);
    return v;
}
__device__ __forceinline__ float silu_f(float v) { return v * __builtin_amdgcn_rcpf(1.f + __builtin_amdgcn_exp2f(-v * LOG2E)); }
__device__ __forceinline__ u32x4 pack8f(f32x4 a, f32x4 b) { u32x4 w; w.x = pk2(a[0], a[1]); w.y = pk2(a[2], a[3]); w.z = pk2(b[0], b[1]); w.w = pk2(b[2], b[3]); return w; }

typedef pg8::f32x4 af4;
struct EpiIn {
    static constexpr bool PERM = true, AFTER_DRAIN = false;
    const float* rstd_x; bf16 *qlat, *kvlat, *G, *Qf, *Kf, *Vf, *Km; float *flog, *partq, *partkv; const float *cosT, *sinT;
    __device__ __forceinline__ void operator()(const af4 (&acc)[2][2][4][2], const pg8::Unit& u, int wr, int wc, int fr, int fq) const {
        const int pn = u.pn; const int row0 = u.pm * 256 + wr * 64 + fr;
        if (pn == 25) {
            if (wc == 0) {
#pragma unroll
                for (int ai = 0; ai < 2; ++ai)
#pragma unroll
                    for (int m = 0; m < 4; ++m) { const int row = row0 + ai * 128 + m * 16; const float rs = rstd_x[row];
                        f32x4 o1[2], o2[2];
#pragma unroll
                        for (int n = 0; n < 2; ++n) { const f32x4 c = *(const f32x4*)(cosT + (size_t)row * 32 + 8 * fq + 4 * n), s = *(const f32x4*)(sinT + (size_t)row * 32 + 8 * fq + 4 * n);
                            const f32x4 x1 = acc[ai][0][m][n] * rs, x2 = acc[ai][1][m][n] * rs; o1[n] = x1 * c - x2 * s; o2[n] = x2 * c + x1 * s; }
                        const u32x4 w1 = pack8f(o1[0], o1[1]), w2 = pack8f(o2[0], o2[1]);
                        bf16* kp = Km + (size_t)row * 1536 + 128 + 8 * fq;
#pragma unroll
                        for (int h = 0; h < 8; ++h) { *(u32x4*)(kp + h * 192) = w1; *(u32x4*)(kp + h * 192 + 32) = w2; } }
            } else if (wc == 1 && fq == 0) {
#pragma unroll
                for (int ai = 0; ai < 2; ++ai)
#pragma unroll
                    for (int m = 0; m < 4; ++m) { const int row = row0 + ai * 128 + m * 16; const float rs = rstd_x[row];
                        *(f32x4*)(flog + (size_t)row * 8) = acc[ai][0][m][0] * rs; *(f32x4*)(flog + (size_t)row * 8 + 4) = acc[ai][0][m][1] * rs; }
            }
            return;
        }
        bf16* base; int ld, colt, mode = 0; float* part = nullptr; int nslot = 0, slot0 = 0;
        if (pn < 3) { base = qlat; ld = 768; colt = pn * 256; part = partq; nslot = 12; slot0 = pn * 4; }
        else if (pn < 5) { base = kvlat; ld = 512; colt = (pn - 3) * 256; part = partkv; nslot = 8; slot0 = (pn - 3) * 4; }
        else if (pn < 9) { base = G; ld = 2048; colt = (pn - 5) * 256; mode = 1; }
        else if (pn < 13) { base = Qf; ld = 1024; colt = (pn - 9) * 256; mode = 2; }
        else if (pn < 17) { base = Kf; ld = 1024; colt = (pn - 13) * 256; }
        else if (pn < 21) { base = Vf; ld = 1024; colt = (pn - 17) * 256; }
        else { base = G; ld = 2048; colt = 1024 + (pn - 21) * 256; mode = 1; }
        const int col0 = colt + wc * 32 + 8 * fq;
#pragma unroll
        for (int ai = 0; ai < 2; ++ai)
#pragma unroll
            for (int m = 0; m < 4; ++m) { const int row = row0 + ai * 128 + m * 16; float rs = rstd_x[row]; if (mode == 2) rs *= C2F;
                bf16* rowp = base + (size_t)row * ld + col0; float ss = 0.f;
#pragma unroll
                for (int bj = 0; bj < 2; ++bj) { f32x4 v0 = acc[ai][bj][m][0] * rs, v1 = acc[ai][bj][m][1] * rs;
                    ss += (v0[0] * v0[0] + v0[1] * v0[1]) + (v0[2] * v0[2] + v0[3] * v0[3]) + (v1[0] * v1[0] + v1[1] * v1[1]) + (v1[2] * v1[2] + v1[3] * v1[3]);
                    if (mode == 1) {
#pragma unroll
                        for (int e = 0; e < 4; ++e) { v0[e] = silu_f(v0[e]); v1[e] = silu_f(v1[e]); } }
                    *(u32x4*)(rowp + bj * 128) = pack8f(v0, v1); }
                if (part) { ss += __shfl_xor(ss, 16); ss += __shfl_xor(ss, 32); if (fq == 0) part[(size_t)row * nslot + slot0 + wc] = ss; } }
    }
};
struct EpiQ {
    static constexpr bool PERM = true, AFTER_DRAIN = false;
    const float* partq; bf16* Qm; const float *cosT, *sinT;
    __device__ __forceinline__ void operator()(const af4 (&acc)[2][2][4][2], const pg8::Unit& u, int wr, int wc, int fr, int fq) const {
        const int pn = u.pn; const int row0 = u.pm * 256 + wr * 64 + fr;
#pragma unroll
        for (int ai = 0; ai < 2; ++ai)
#pragma unroll
            for (int m = 0; m < 4; ++m) { const int row = row0 + ai * 128 + m * 16;
                const f32x4 pa = *(const f32x4*)(partq + (size_t)row * 12), pb = *(const f32x4*)(partq + (size_t)row * 12 + 4), pc = *(const f32x4*)(partq + (size_t)row * 12 + 8);
                const float ssq = ((pa[0] + pa[1]) + (pa[2] + pa[3])) + ((pb[0] + pb[1]) + (pb[2] + pb[3])) + ((pc[0] + pc[1]) + (pc[2] + pc[3]));
                const float rs = C2M / sqrtf(ssq * (1.f / 768.f) + EPS);
                if (pn < 4) {
#pragma unroll
                    for (int bj = 0; bj < 2; ++bj) *(u32x4*)(Qm + (size_t)row * 1536 + (2 * pn + bj) * 192 + wc * 32 + 8 * fq) = pack8f(acc[ai][bj][m][0] * rs, acc[ai][bj][m][1] * rs);
                } else { const int head = 4 * (pn - 4) + wc; f32x4 o1[2], o2[2];
#pragma unroll
                    for (int n = 0; n < 2; ++n) { const f32x4 c = *(const f32x4*)(cosT + (size_t)row * 32 + 8 * fq + 4 * n), s = *(const f32x4*)(sinT + (size_t)row * 32 + 8 * fq + 4 * n);
                        const f32x4 x1 = acc[ai][0][m][n] * rs, x2 = acc[ai][1][m][n] * rs; o1[n] = x1 * c - x2 * s; o2[n] = x2 * c + x1 * s; }
                    bf16* qp = Qm + (size_t)row * 1536 + head * 192 + 128 + 8 * fq;
                    *(u32x4*)qp = pack8f(o1[0], o1[1]); *(u32x4*)(qp + 32) = pack8f(o2[0], o2[1]); } }
    }
};
struct EpiKV {
    static constexpr bool PERM = true, AFTER_DRAIN = false;
    const float* partkv; bf16 *Km, *Vm;
    __device__ __forceinline__ void operator()(const af4 (&acc)[2][2][4][2], const pg8::Unit& u, int wr, int wc, int fr, int fq) const {
        const int pn = u.pn; const int row0 = u.pm * 256 + wr * 64 + fr;
#pragma unroll
        for (int ai = 0; ai < 2; ++ai)
#pragma unroll
            for (int m = 0; m < 4; ++m) { const int row = row0 + ai * 128 + m * 16;
                const f32x4 pa = *(const f32x4*)(partkv + (size_t)row * 8), pb = *(const f32x4*)(partkv + (size_t)row * 8 + 4);
                const float ssq = ((pa[0] + pa[1]) + (pa[2] + pa[3])) + ((pb[0] + pb[1]) + (pb[2] + pb[3]));
                const float rs = 1.f / sqrtf(ssq * (1.f / 512.f) + EPS);
                *(u32x4*)(Km + (size_t)row * 1536 + pn * 192 + wc * 32 + 8 * fq) = pack8f(acc[ai][0][m][0] * rs, acc[ai][0][m][1] * rs);
                *(u32x4*)(Vm + (size_t)row * 1024 + pn * 128 + wc * 32 + 8 * fq) = pack8f(acc[ai][1][m][0] * rs, acc[ai][1][m][1] * rs); }
    }
};
struct EpiOut {
    static constexpr bool PERM = true, AFTER_DRAIN = false;
    bf16* Y; float* party;
    __device__ __forceinline__ void operator()(const af4 (&acc)[2][2][4][2], const pg8::Unit& u, int wr, int wc, int fr, int fq) const {
        const int pn = u.pn; const int row0 = u.pm * 256 + wr * 64 + fr; const int col0 = pn * 256 + wc * 32 + 8 * fq;
#pragma unroll
        for (int ai = 0; ai < 2; ++ai)
#pragma unroll
            for (int m = 0; m < 4; ++m) { const int row = row0 + ai * 128 + m * 16; float ss = 0.f;
#pragma unroll
                for (int bj = 0; bj < 2; ++bj) { const f32x4 v0 = acc[ai][bj][m][0], v1 = acc[ai][bj][m][1];
                    ss += (v0[0] * v0[0] + v0[1] * v0[1]) + (v0[2] * v0[2] + v0[3] * v0[3]) + (v1[0] * v1[0] + v1[1] * v1[1]) + (v1[2] * v1[2] + v1[3] * v1[3]);
                    *(u32x4*)(Y + (size_t)row * 2048 + col0 + bj * 128) = pack8f(v0, v1); }
                ss += __shfl_xor(ss, 16); ss += __shfl_xor(ss, 32); if (fq == 0) party[(size_t)row * 32 + pn * 4 + wc] = ss; }
    }
};

namespace att {
constexpr int KVBLK = 64, QBLK = 32, QB = 256;
constexpr int SHM_K = 24576, SHM_V = 16384;
constexpr int OFF_K = 0, OFF_V = 2 * SHM_K, OFF_CK = OFF_V + 2 * SHM_V, OFF_WS = OFF_CK + 512, OFF_QP = OFF_WS + 2048;
constexpr float THR = 8.f;
#define KSWZ(row, colB) ((row) * 256 + ((colB) ^ (((row) & 7) << 4)))
#define SBAR() __builtin_amdgcn_sched_barrier(0)
__device__ __forceinline__ int v_st(int k, int c) { const int kk = (k & ~0xC) | ((k & 4) << 1) | ((k & 8) >> 1); return ((kk >> 3) * 4 + (c >> 5)) * 512 + ((kk & 7) * 32 + (c & 31)) * 2; }
__device__ __forceinline__ int v_rd_base(int lane) { return ((lane & 3) << 3) | (((lane >> 2) & 3) << 6) | (((lane >> 4) & 1) << 5) | (((lane >> 5) & 1) << 8); }
constexpr int v_rd_off(int d0, int ks, int half) { return d0 * 512 + ks * 4096 + half * 2048; }
__device__ __forceinline__ int crow(int r, int hi) { return (r & 3) + 8 * (r >> 2) + 4 * hi; }
__device__ __forceinline__ unsigned cvtpk(float lo, float hi) { unsigned r; asm volatile("v_cvt_pk_bf16_f32 %0, %1, %2" : "=v"(r) : "v"(lo), "v"(hi)); return r; }

__device__ __forceinline__ void mask_tile(f32x16& p0, f32x16& p1, int dq) {
    const float NEG = -__builtin_inff();
#pragma unroll
    for (int r = 0; r < 16; ++r) { const int c = (r & 3) + 8 * (r >> 2);
        if (dq - c < 0) p0[r] = NEG;
        if (dq - c - 32 < 0) p1[r] = NEG; }
}
__device__ __forceinline__ void softmax_tile(f32x16& p0, f32x16& p1, float& m_reg, float& l_reg, float& alpha, bf16x8& pa0, bf16x8& pa1, bf16x8& pa2, bf16x8& pa3) {
    float pmax = p0[0];
#pragma unroll
    for (int r = 1; r < 16; ++r) pmax = fmaxf(pmax, p0[r]);
#pragma unroll
    for (int r = 0; r < 16; ++r) pmax = fmaxf(pmax, p1[r]);
    { auto rr = __builtin_amdgcn_permlane32_swap(__float_as_uint(pmax), __float_as_uint(pmax), false, false);
      pmax = fmaxf(__uint_as_float(rr[0]), __uint_as_float(rr[1])); }
    float mn;
    if (__builtin_expect(__all(pmax - m_reg <= THR), 1)) { mn = m_reg; alpha = 1.f; }
    else { mn = fmaxf(m_reg, pmax); alpha = __builtin_amdgcn_exp2f(m_reg - mn); m_reg = mn; }
#pragma unroll
    for (int r = 0; r < 16; ++r) { p0[r] = __builtin_amdgcn_exp2f(p0[r] - mn); p1[r] = __builtin_amdgcn_exp2f(p1[r] - mn); }
    float ps = 0.f;
#pragma unroll
    for (int r = 0; r < 16; ++r) ps += p0[r];
#pragma unroll
    for (int r = 0; r < 16; ++r) ps += p1[r];
    { auto rr = __builtin_amdgcn_permlane32_swap(__float_as_uint(ps), __float_as_uint(ps), false, false);
      ps = __uint_as_float(rr[0]) + __uint_as_float(rr[1]); }
    l_reg = l_reg * alpha + ps;
#define PK4(P, B_, OUT) do { unsigned a0 = cvtpk(P[B_+0], P[B_+1]), a1 = cvtpk(P[B_+2], P[B_+3]);                          \
        unsigned b0 = cvtpk(P[B_+4], P[B_+5]), b1 = cvtpk(P[B_+6], P[B_+7]);                                             \
        auto r0 = __builtin_amdgcn_permlane32_swap(a0, b0, false, false); auto r1 = __builtin_amdgcn_permlane32_swap(a1, b1, false, false); \
        u32x4 w = {r0[0], r1[0], r0[1], r1[1]}; OUT = *reinterpret_cast<bf16x8*>(&w); } while (0)
    PK4(p0, 0, pa0); PK4(p0, 8, pa1); PK4(p1, 0, pa2); PK4(p1, 8, pa3);
#undef PK4
}
template <int DQK>
__device__ __forceinline__ void qkt(f32x16& p0, f32x16& p1, const char* Kb, int r32, int hi, const bf16x8* qr, const char* qpk) {
    p0 = f32x16{}; p1 = f32x16{};
    const char* kb[4];
#pragma unroll
    for (int dd = 0; dd < 4; ++dd) kb[dd] = Kb + KSWZ(r32, (dd * 16 + hi * 8) * 2);
#pragma unroll
    for (int d0 = 0; d0 < 8; ++d0) { const char* a = kb[d0 & 3] + (d0 >> 2) * 128;
        bf16x8 b0 = *reinterpret_cast<const bf16x8*>(a);
        bf16x8 b1 = *reinterpret_cast<const bf16x8*>(a + 32 * 256);
        bf16x8 qf; if (DQK == 128 && d0 >= 4) qf = *reinterpret_cast<const bf16x8*>(qpk + (d0 - 4) * 1024); else qf = qr[d0];
        p0 = __builtin_amdgcn_mfma_f32_32x32x16_bf16(b0, qf, p0, 0, 0, 0);
        p1 = __builtin_amdgcn_mfma_f32_32x32x16_bf16(b1, qf, p1, 0, 0, 0); }
    if constexpr (DQK == 192) {
#pragma unroll
        for (int d0 = 0; d0 < 4; ++d0) { const char* a = Kb + 16384 + r32 * 128 + (((d0 * 16 + hi * 8) * 2) ^ ((r32 & 7) << 4));
            bf16x8 b0 = *reinterpret_cast<const bf16x8*>(a);
            bf16x8 b1 = *reinterpret_cast<const bf16x8*>(a + 32 * 128);
            const bf16x8 qf = *reinterpret_cast<const bf16x8*>(qpk + d0 * 1024);
            p0 = __builtin_amdgcn_mfma_f32_32x32x16_bf16(b0, qf, p0, 0, 0, 0);
            p1 = __builtin_amdgcn_mfma_f32_32x32x16_bf16(b1, qf, p1, 0, 0, 0); }
    }
}
template <int VOFF>
__device__ __forceinline__ void pv_tile(f32x16* o, int vb0, bf16x8 pa0, bf16x8 pa1, bf16x8 pa2, bf16x8 pa3) {
#define TRRD(dst, off) asm volatile("ds_read_b64_tr_b16 %0, %1 offset:%2" : "=&v"(dst) : "v"(vb0), "i"(off) : "memory")
#define PV_D0(d0) do { s16x4 l0, l1, l2, l3, h0, h1, h2, h3; constexpr int b_ = VOFF + v_rd_off(d0, 0, 0); \
        TRRD(l0, b_); TRRD(h0, b_ + 2048); TRRD(l1, b_ + 4096); TRRD(h1, b_ + 6144); TRRD(l2, b_ + 8192); TRRD(h2, b_ + 10240); TRRD(l3, b_ + 12288); TRRD(h3, b_ + 14336); \
        asm volatile("s_waitcnt lgkmcnt(0)" ::: "memory"); SBAR(); \
        o[d0] = __builtin_amdgcn_mfma_f32_32x32x16_bf16(pa0, (bf16x8){l0[0], l0[1], l0[2], l0[3], h0[0], h0[1], h0[2], h0[3]}, o[d0], 0, 0, 0);   \
        o[d0] = __builtin_amdgcn_mfma_f32_32x32x16_bf16(pa1, (bf16x8){l1[0], l1[1], l1[2], l1[3], h1[0], h1[1], h1[2], h1[3]}, o[d0], 0, 0, 0);   \
        o[d0] = __builtin_amdgcn_mfma_f32_32x32x16_bf16(pa2, (bf16x8){l2[0], l2[1], l2[2], l2[3], h2[0], h2[1], h2[2], h2[3]}, o[d0], 0, 0, 0);   \
        o[d0] = __builtin_amdgcn_mfma_f32_32x32x16_bf16(pa3, (bf16x8){l3[0], l3[1], l3[2], l3[3], h3[0], h3[1], h3[2], h3[3]}, o[d0], 0, 0, 0); } while (0)
    PV_D0(0); PV_D0(1); PV_D0(2); PV_D0(3);
#undef PV_D0
#undef TRRD
}

template <int DQK, bool FOX>
__device__ __forceinline__ void attn_unit(char* lds, const bf16* Q, int ldq, const bf16* K, int ldk, const bf16* V, int ldv, const float* cfs, const bf16* Gp, bf16* Op, int qb) {
    const int tid = threadIdx.x, wid = __builtin_amdgcn_readfirstlane(tid >> 6), lane = tid & 63, r32 = lane & 31, hi = lane >> 5;
    const int q0 = qb * QB, NT = 4 * (qb + 1);
    char* K_lds = lds + OFF_K; char* V_lds = lds + OFF_V; float* ck_l = (float*)(lds + OFF_CK);
    float* wsf = (float*)(lds + OFF_WS) + wid * 64; float* li_l = wsf; float* al_l = wsf + 32;
    constexpr int NQR = DQK / 16 - 4;
    bf16x8 qr[NQR];
    char* qpk = lds + OFF_QP + wid * 4096 + (hi * 32 + r32) * 16;
    { const bf16* qp = Q + (size_t)(q0 + wid * QBLK + r32) * ldq + hi * 8;
#pragma unroll
      for (int d0 = 0; d0 < NQR; ++d0) qr[d0] = *(const bf16x8*)(qp + d0 * 16);
#pragma unroll
      for (int d0 = 0; d0 < 4; ++d0) *(bf16x8*)(qpk + d0 * 1024) = *(const bf16x8*)(qp + (NQR + d0) * 16); }
    float cq = 0.f; if constexpr (FOX) cq = cfs[q0 + wid * QBLK + r32];
    unsigned koff[2], voff[2], kroff = 0;
#pragma unroll
    for (int j = 0; j < 2; ++j) { const int p = wid + 8 * j;
        { const int row = 4 * p + (lane >> 4), c = (lane & 15) ^ (row & 7); koff[j] = (unsigned)(row * ldk + c * 8) * 2u; }
        { const int st = 2 * p + (lane >> 5), kk = 8 * (st >> 2) + ((lane & 31) >> 2), k = (kk & ~0xC) | ((kk & 4) << 1) | ((kk & 8) >> 1); voff[j] = (unsigned)(k * ldv + 32 * (st & 3) + 8 * (lane & 3)) * 2u; } }
    if constexpr (DQK == 192) { const int row = 8 * wid + (lane >> 3), c = (lane & 7) ^ (row & 7); kroff = (unsigned)(row * ldk + 128 + c * 8) * 2u; }
    const int vb0 = (int)(uintptr_t)V_lds + v_rd_base(lane);
    LAS unsigned char* ldsl = (LAS unsigned char*)(uintptr_t)(unsigned)(uintptr_t)lds;
#define A_DMA(t, bf) do { const char* kt_ = (const char*)K + (size_t)(t) * KVBLK * ldk * 2; const char* vt_ = (const char*)V + (size_t)(t) * KVBLK * ldv * 2; \
        _Pragma("unroll") for (int j_ = 0; j_ < 2; ++j_) { \
            __builtin_amdgcn_global_load_lds((const unsigned*)(kt_ + koff[j_]), (LAS unsigned*)(ldsl + OFF_K + (bf) * SHM_K + (wid + 8 * j_) * 1024), 16, 0, 0); \
            __builtin_amdgcn_global_load_lds((const unsigned*)(vt_ + voff[j_]), (LAS unsigned*)(ldsl + OFF_V + (bf) * SHM_V + (wid + 8 * j_) * 1024), 16, 0, 0); } \
        if constexpr (DQK == 192) __builtin_amdgcn_global_load_lds((const unsigned*)(kt_ + kroff), (LAS unsigned*)(ldsl + OFF_K + (bf) * SHM_K + 16384 + wid * 1024), 16, 0, 0); \
        if constexpr (FOX) { if (wid == 0) __builtin_amdgcn_global_load_lds((const unsigned*)(cfs + (t) * KVBLK + lane), (LAS unsigned*)(ldsl + OFF_CK + (bf) * 256), 4, 0, 0); } } while (0)
#define A_SYNC() do { asm volatile("s_waitcnt vmcnt(0)" ::: "memory"); __syncthreads(); } while (0)
    A_DMA(0, 0);
    A_SYNC();
    float m_reg = -1e30f, l_reg = 0.f; f32x16 o[4] = {};
#define A_STEP(KB, t) do { \
        if ((t) + 1 < NT) A_DMA((t) + 1, (KB) ^ 1); \
        const int jb_ = (t) - (NT - 4); \
        if (jb_ < 0 || 64 * jb_ <= 32 * wid + 31) { \
            f32x16 p0, p1; float alpha; bf16x8 pa0, pa1, pa2, pa3; \
            qkt<DQK>(p0, p1, K_lds + (KB) * SHM_K, r32, hi, qr, qpk); \
            if constexpr (FOX) { const float* ckp = ck_l + (KB) * 64 + 4 * hi; \
                _Pragma("unroll") for (int g_ = 0; g_ < 4; ++g_) { const f32x4 c0 = *(const f32x4*)(ckp + 8 * g_), c1 = *(const f32x4*)(ckp + 32 + 8 * g_); \
                    _Pragma("unroll") for (int e_ = 0; e_ < 4; ++e_) { p0[4 * g_ + e_] += cq - c0[e_]; p1[4 * g_ + e_] += cq - c1[e_]; } } } \
            if (jb_ >= 0 && 64 * jb_ + 63 > 32 * wid) mask_tile(p0, p1, 32 * wid + r32 - 64 * jb_ - 4 * hi); \
            softmax_tile(p0, p1, m_reg, l_reg, alpha, pa0, pa1, pa2, pa3); \
            if (__any(alpha < 1.f)) { if (hi == 0) al_l[r32] = alpha; asm volatile("s_waitcnt lgkmcnt(0)" ::: "memory"); \
                _Pragma("unroll") for (int d_ = 0; d_ < 4; ++d_) _Pragma("unroll") for (int r = 0; r < 16; ++r) o[d_][r] *= al_l[crow(r, hi)]; } \
            SBAR(); pv_tile<(KB) * SHM_V>(o, vb0, pa0, pa1, pa2, pa3); \
        } \
        A_SYNC(); } while (0)
    for (int t = 0; t < NT; t += 2) { A_STEP(0, t); A_STEP(1, t + 1); }
#undef A_STEP
#undef A_DMA
#undef A_SYNC
    if (hi == 0) li_l[r32] = l_reg; asm volatile("s_waitcnt lgkmcnt(0)" ::: "memory");
    bf16* stg = (bf16*)(lds + wid * 8192);
#pragma unroll
    for (int r = 0; r < 16; ++r) { const int orow = crow(r, hi); const float rl = __builtin_amdgcn_rcpf(li_l[orow]);
#pragma unroll
        for (int d0 = 0; d0 < 4; ++d0) stg[orow * 128 + d0 * 32 + r32] = (bf16)f2bf(o[d0][r] * rl); }
    asm volatile("s_waitcnt lgkmcnt(0)" ::: "memory");
#pragma unroll
    for (int i = 0; i < 8; ++i) { const int row = i * 4 + (lane >> 4), ch = lane & 15;
        const u32x4 v = *(const u32x4*)(stg + row * 128 + ch * 8);
        const size_t go = (size_t)(q0 + wid * QBLK + row) * 2048 + ch * 8;
        const u32x4 g = *(const u32x4*)(Gp + go); u32x4 w;
        w.x = cvtpk(bflo(v.x) * bflo(g.x), bfhi(v.x) * bfhi(g.x)); w.y = cvtpk(bflo(v.y) * bflo(g.y), bfhi(v.y) * bfhi(g.y));
        w.z = cvtpk(bflo(v.z) * bflo(g.z), bfhi(v.z) * bfhi(g.z)); w.w = cvtpk(bflo(v.w) * bflo(g.w), bfhi(v.w) * bfhi(g.w));
        *(u32x4*)(Op + go) = w; }
    __syncthreads();
}
#undef KSWZ
#undef SBAR
}

__device__ __forceinline__ void transpose_item(const float* W, int ldw, int K, const float* g, bf16* WT, int dst_row0, int src_col0, int nvalid, int k0, LAS float* scr, int lane) {
    const int n = lane & 31; const bool ok = (src_col0 >= 0) && (n < nvalid);
    float tv[32];
#pragma unroll
    for (int i = 0; i < 32; ++i) { const int kk = 2 * i + (lane >> 5); tv[i] = ok ? W[(size_t)(k0 + kk) * ldw + src_col0 + n] : 0.f; }
    if (g) {
#pragma unroll
        for (int i = 0; i < 32; ++i) tv[i] *= g[k0 + 2 * i + (lane >> 5)]; }
#pragma unroll
    for (int i = 0; i < 32; ++i) scr[(2 * i + (lane >> 5)) * 33 + n] = tv[i];
    asm volatile("s_waitcnt lgkmcnt(0)" ::: "memory");
    const int c = lane & 7;
#pragma unroll
    for (int j = 0; j < 4; ++j) { const int nn = (lane >> 3) + 8 * j; const LAS float* s = scr + (8 * c) * 33 + nn;
        u32x4 o; o.x = pk2(s[0 * 33], s[1 * 33]); o.y = pk2(s[2 * 33], s[3 * 33]); o.z = pk2(s[4 * 33], s[5 * 33]); o.w = pk2(s[6 * 33], s[7 * 33]);
        *(u32x4*)(WT + (size_t)(dst_row0 + nn) * K + k0 + 8 * c) = o; }
    asm volatile("s_waitcnt lgkmcnt(0)" ::: "memory");
}
__device__ __forceinline__ void win_src(int r0, int& src, int& nv) {
    nv = 32;
    if (r0 < 1280) src = r0;
    else if (r0 < 2304) src = 1344 + (r0 - 1280);
    else if (r0 < 3328) src = 2368 + (r0 - 2304);
    else if (r0 < 4352) src = 3392 + (r0 - 3328);
    else if (r0 < 5376) src = 4416 + (r0 - 4352);
    else if (r0 < 6400) src = 5448 + (r0 - 5376);
    else if (r0 == 6400) src = 1280;
    else if (r0 == 6432) { src = 5440; nv = 8; }
    else if (r0 == 6528) src = 1312;
    else src = -1;
}
__device__ __forceinline__ int wuq_src(int r0) {
    if (r0 < 1024) return (r0 >> 7) * 192 + (r0 & 127);
    const int q = r0 - 1024, t = q >> 8, bj = (q >> 7) & 1, wc = (q >> 5) & 3;
    return (4 * t + wc) * 192 + 128 + 32 * bj;
}


#define XB_TMO      128
#define XB_XCNT(j)  (256  + 64 * (j))
#define XB_XSUB(j)  (1280 + 64 * (j))
#define XB_XGEN(j)  (2304 + 64 * (j))
#define XB_TOP      3328
#define XB_TOPGEN   3392
#define XCD_BAR_WORDS 3456
#define XB_SPIN_CAP (1u << 18)
__device__ __forceinline__ unsigned xb_ld(unsigned* p)              { return __hip_atomic_load(p, __ATOMIC_RELAXED, __HIP_MEMORY_SCOPE_AGENT); }
__device__ __forceinline__ unsigned xb_add(unsigned* p, unsigned v) { return __hip_atomic_fetch_add(p, v, __ATOMIC_RELAXED, __HIP_MEMORY_SCOPE_AGENT); }
__device__ __forceinline__ unsigned xb_xcc_id() { return (unsigned)__builtin_amdgcn_s_getreg((3 << 11) | 20) & 0xFu; }
#define XB_SPIN(cond, bar) do { unsigned _sp = 0; while (cond) { __builtin_amdgcn_s_sleep(1); \
    if ((++_sp & 255u) == 0u) { if (xb_ld(&(bar)[XB_TMO])) break; if (_sp > XB_SPIN_CAP) { atomicAdd(&(bar)[XB_TMO], 1u); break; } } } } while (0)
struct XcdBarrier { unsigned* bar; unsigned x; volatile LAS unsigned* st; };
__device__ __forceinline__ XcdBarrier xcd_barrier_post(unsigned* bar, volatile LAS unsigned* st) {
    XcdBarrier b; b.bar = bar; b.x = xb_xcc_id(); b.st = st;
    if (threadIdx.x == 0) (void)xb_add(&bar[XB_XCNT(b.x)], 1u);
    return b;
}
__device__ __forceinline__ void xcd_barrier_complete(unsigned* bar, unsigned x, unsigned& nloc, unsigned& nx) {
    const unsigned G = gridDim.x * gridDim.y * gridDim.z;
    unsigned sum, cnt, mine, sp = 0u;
    for (;;) {
        sum = 0u; cnt = 0u; mine = 0u;
#pragma unroll
        for (unsigned j = 0; j < 16; ++j) { const unsigned c = xb_ld(&bar[XB_XCNT(j)]); sum += c; cnt += (c > 0u) ? 1u : 0u; mine = (j == x) ? c : mine; }
        if (sum == G) break;
        __builtin_amdgcn_s_sleep(1);
        if ((++sp & 255u) == 0u) { if (xb_ld(&bar[XB_TMO])) break; if (sp > XB_SPIN_CAP) { atomicAdd(&bar[XB_TMO], 1u); break; } }
    }
    nloc = mine > 0u ? mine : 1u; nx = cnt > 0u ? cnt : 1u;
}
__device__ __forceinline__ void xcd_barrier(const XcdBarrier& b) {
    asm volatile("s_waitcnt vmcnt(0)" ::: "memory");
    __syncthreads();
    if (threadIdx.x == 0) {
        unsigned* bar = b.bar;
        __builtin_amdgcn_s_waitcnt(0);
        unsigned nloc = b.st[0], nx = b.st[1];
        if (nloc == 0u) { xcd_barrier_complete(bar, b.x, nloc, nx); b.st[0] = nloc; b.st[1] = nx; }
        const unsigned old = xb_add(&bar[XB_XSUB(b.x)], 1u);
        const unsigned gen = old / nloc;
        if (old + 1u == (gen + 1u) * nloc) {
            __builtin_amdgcn_fence(__ATOMIC_RELEASE, "agent");
            asm volatile("s_waitcnt vmcnt(0)" ::: "memory");
            const unsigned og = xb_add(&bar[XB_TOP], 1u);
            const unsigned tg = og / nx;
            if (og + 1u == (tg + 1u) * nx) xb_add(&bar[XB_TOPGEN], 1u);
            else XB_SPIN(xb_ld(&bar[XB_TOPGEN]) == tg, bar);
            __builtin_amdgcn_fence(__ATOMIC_ACQUIRE, "agent");
            xb_add(&bar[XB_XGEN(b.x)], 1u);
            asm volatile("s_waitcnt vmcnt(0)" ::: "memory");
        } else {
            XB_SPIN(xb_ld(&bar[XB_XGEN(b.x)]) == gen, bar);
            __builtin_amdgcn_fence(__ATOMIC_ACQUIRE, "agent");
            asm volatile("s_waitcnt vmcnt(0)" ::: "memory");
        }
    }
    __syncthreads();
}

struct Args { const float* x; const int* pos; const float* g_pre; const float* w_in; const float* g_q; const float* w_uq; const float* g_kv; const float* w_ukv;
              const float* b_forget; const float* w_out; const float* g_post; float* out; unsigned char* ws; int ph_lo, ph_hi; };

__global__ void __launch_bounds__(512, 2) hybrid_fwd(Args a) {
    extern __shared__ __attribute__((aligned(16))) unsigned char lds[];
    cg::grid_group grid = cg::this_grid();
    const int tid = threadIdx.x, lane = tid & 63, wave = __builtin_amdgcn_readfirstlane(tid >> 6);
    const int G = gridDim.x, bx = blockIdx.x; const int vcu = (G % 8 == 0) ? (bx % 8) * (G / 8) + bx / 8 : bx;
    unsigned char* ws = a.ws;
    float* rstd_x = (float*)(ws + WS_RSTDX); float* partq = (float*)(ws + WS_PARTQ); float* partkv = (float*)(ws + WS_PARTKV); float* party = (float*)(ws + WS_PARTY);
    float* flog = (float*)(ws + WS_FLOG); float* cf = (float*)(ws + WS_CF); float* cosT = (float*)(ws + WS_COS); float* sinT = (float*)(ws + WS_SIN);
    bf16* Win_t = (bf16*)(ws + WS_WIN); bf16* Wuq_t = (bf16*)(ws + WS_WUQ); bf16* Wukv_t = (bf16*)(ws + WS_WUKV); bf16* Wout_t = (bf16*)(ws + WS_WOUT);
    bf16* Xb = (bf16*)(ws + WS_XB); bf16* Ob = (bf16*)(ws + WS_O); bf16* qlat = (bf16*)(ws + WS_QLAT); bf16* kvlat = (bf16*)(ws + WS_KVLAT); bf16* Gb = (bf16*)(ws + WS_G);
    bf16* Qf = (bf16*)(ws + WS_QF); bf16* Kf = (bf16*)(ws + WS_KF); bf16* Vf = (bf16*)(ws + WS_VF); bf16* Yb = (bf16*)(ws + WS_Y);
    bf16* Qm = (bf16*)(ws + WS_QM); bf16* Km = (bf16*)(ws + WS_KM); bf16* Vm = (bf16*)(ws + WS_VM);
    const int lo = a.ph_lo, hi = a.ph_hi;
#ifndef PH_MASK
#define PH_MASK 63
#endif
#define IN(k) (((PH_MASK >> (k)) & 1) && lo <= (k) && (k) < hi)
#define BOTH(k) (IN(k) && IN((k) + 1))
    LAS unsigned char* ldsl = (LAS unsigned char*)lds;
    volatile LAS unsigned* bst = (volatile LAS unsigned*)(ldsl + LDS_BYTES - 64);
    if (tid < 2) bst[tid] = 0u;
    __syncthreads();
    XcdBarrier xbar = xcd_barrier_post((unsigned*)(ws + WS_CTL), bst);

    if (IN(0)) for (int rep_ = 0; rep_ < PROBE_REP0; ++rep_) {
        LAS float* scr = (LAS float*)(ldsl + wave * 16384);
        const int gw = vcu * 8 + wave, NGW = G * 8;
        constexpr int I_IN = 32 * 208, I_UQ = 12 * 48, I_UKV = 8 * 64, I_OUT = 32 * 64, NITEMS = I_IN + I_UQ + I_UKV + I_OUT;
        for (int it = gw; it < NITEMS; it += NGW) {
            int r = it;
            if (r < I_IN) { const int kb = r / 208, nb = r % 208; int src, nv; win_src(nb * 32, src, nv); transpose_item(a.w_in, DIN, 2048, a.g_pre, Win_t, nb * 32, src, nv, kb * 64, scr, lane); continue; } r -= I_IN;
            if (r < I_UQ) { const int kb = r / 48, nb = r % 48; transpose_item(a.w_uq, 1536, 768, a.g_q, Wuq_t, nb * 32, wuq_src(nb * 32), 32, kb * 64, scr, lane); continue; } r -= I_UQ;
            if (r < I_UKV) { const int kb = r / 64, nb = r % 64; transpose_item(a.w_ukv, 2048, 512, a.g_kv, Wukv_t, nb * 32, nb * 32, 32, kb * 64, scr, lane); continue; } r -= I_UKV;
            { const int kb = r / 64, nb = r % 64; transpose_item(a.w_out, 2048, 2048, nullptr, Wout_t, nb * 32, nb * 32, 32, kb * 64, scr, lane); }
        }
        for (int m = gw; m < M; m += 2 * NGW) {
            const int m2 = m + NGW;
            const f32x4* xr = (const f32x4*)(a.x + (size_t)m * DM) + lane; const f32x4* xr2 = (const f32x4*)(a.x + (size_t)m2 * DM) + lane; f32x4 v[8], v2[8]; float s = 0.f, s2 = 0.f;
#pragma unroll
            for (int j = 0; j < 8; ++j) { v[j] = __builtin_nontemporal_load(xr + 64 * j); v2[j] = __builtin_nontemporal_load(xr2 + 64 * j); }
#pragma unroll
            for (int j = 0; j < 8; ++j) { s += (v[j][0] * v[j][0] + v[j][1] * v[j][1]) + (v[j][2] * v[j][2] + v[j][3] * v[j][3]); s2 += (v2[j][0] * v2[j][0] + v2[j][1] * v2[j][1]) + (v2[j][2] * v2[j][2] + v2[j][3] * v2[j][3]); }
            s = wave_sum(s); s2 = wave_sum(s2);
            if (lane == 0) { rstd_x[m] = 1.f / sqrtf(s * (1.f / DM) + EPS); rstd_x[m2] = 1.f / sqrtf(s2 * (1.f / DM) + EPS); }
            u32x2* o8 = (u32x2*)(Xb + (size_t)m * DM) + lane; u32x2* o82 = (u32x2*)(Xb + (size_t)m2 * DM) + lane;
#pragma unroll
            for (int j = 0; j < 8; ++j) { u32x2 w; w.x = pk2(v[j][0], v[j][1]); w.y = pk2(v[j][2], v[j][3]); o8[64 * j] = w; u32x2 w2; w2.x = pk2(v2[j][0], v2[j][1]); w2.y = pk2(v2[j][2], v2[j][3]); o82[64 * j] = w2; }
        }
        for (int e = (vcu * 512 + tid); e < M * 32; e += G * 512) { const int row = e >> 5, i = e & 31;
            const float inv = exp2f(-(float)i * (13.287712379549449f / 32.f)); const float ang = (float)a.pos[row] * inv;
            const float n = rintf(ang * 0.15915494309189535f); float r = fmaf(-n, 6.28318548202514648f, ang); r = fmaf(-n, -1.7484555e-7f, r);
            cosT[e] = __cosf(r); sinT[e] = __sinf(r); }
    }
    if (BOTH(0)) grid.sync();

    if (IN(1)) for (int rep_ = 0; rep_ < PROBE_REP1; ++rep_) {
        pg8::Gemm g{Xb, Win_t, M, NIN_PAD, 2048}; pg8::StaticOrder S; S.init(M, NIN_PAD, G, bx);
        EpiIn E{rstd_x, qlat, kvlat, Gb, Qf, Kf, Vf, Km, flog, partq, partkv, cosT, sinT};
        pg8::gemm_phase<EpiIn, pg8::StaticOrder, true, true>(ldsl, g, S, E);
    }
    if (BOTH(1)) xcd_barrier(xbar);

    if (IN(2)) for (int rep_ = 0; rep_ < PROBE_REP2; ++rep_) {
        if (bx < BATCH * NH) {
            const int b = bx >> 3, h = bx & 7; const float bf = a.b_forget[h];
            const float* fl = flog + ((size_t)b * SEQ + 8 * tid) * 8 + h; float lf[8];
#pragma unroll
            for (int j = 0; j < 8; ++j) lf[j] = fl[j * 8] + bf;
#pragma unroll
            for (int j = 0; j < 8; ++j) { const float z = lf[j]; lf[j] = fminf(z, 0.f) - log1pf(expf(-fabsf(z))); }
#pragma unroll
            for (int j = 1; j < 8; ++j) lf[j] += lf[j - 1];
            float incl = lf[7];
#pragma unroll
            for (int o = 1; o < 64; o <<= 1) { const float t = __shfl_up(incl, o); if (lane >= o) incl += t; }
            volatile LAS float* wtot = (volatile LAS float*)(ldsl + LDS_BYTES - 128);
            if (lane == 63) wtot[wave] = incl;
            __syncthreads();
            float off = incl - lf[7];
            for (int w2 = 0; w2 < wave; ++w2) off += wtot[w2];
            float* cp = cf + (size_t)bx * SEQ + 8 * tid;
            f32x4 o0, o1;
#pragma unroll
            for (int j = 0; j < 4; ++j) { o0[j] = (off + lf[j]) * LOG2E; o1[j] = (off + lf[4 + j]) * LOG2E; }
            *(f32x4*)cp = o0; *(f32x4*)(cp + 4) = o1;
            __syncthreads();
        }
        { pg8::Gemm g{qlat, Wuq_t, M, 1536, QRANK}; pg8::StaticOrder S; S.init(M, 1536, G, bx);
          EpiQ E{partq, Qm, cosT, sinT};
          pg8::gemm_phase<EpiQ, pg8::StaticOrder, true, true>(ldsl, g, S, E); }
        { pg8::Gemm g{kvlat, Wukv_t, M, 2048, KVRANK}; pg8::StaticOrder S; S.init(M, 2048, G, bx);
          EpiKV E{partkv, Km, Vm};
          pg8::gemm_phase<EpiKV, pg8::StaticOrder, true, true>(ldsl, g, S, E); }
    }
    if (BOTH(2)) xcd_barrier(xbar);

    if (IN(3)) for (int rep_ = 0; rep_ < PROBE_REP3; ++rep_) {
        for (int v = vcu; v < 256; v += G) {
            const int s = v & 3, w = v >> 2, b = w >> 4, hh = w & 15, hd = hh & 7, swp = hh >> 3;
            const size_t rb = (size_t)b * SEQ;
#pragma unroll 1
            for (int i = 0; i < 2; ++i) {
                const int qb = __builtin_amdgcn_readfirstlane(swp ? (i == 0 ? 8 + s : 7 - s) : (i == 0 ? 15 - s : s));
                att::attn_unit<192, false>((char*)lds, Qm + rb * 1536 + hd * 192, 1536, Km + rb * 1536 + hd * 192, 1536, Vm + rb * 1024 + hd * 128, 1024, nullptr,
                                           Gb + rb * 2048 + hd * 128, Ob + rb * 2048 + hd * 128, qb);
            }
#pragma unroll 1
            for (int i = 0; i < 2; ++i) {
                const int qb = __builtin_amdgcn_readfirstlane(swp ? (i == 0 ? 15 - s : s) : (i == 0 ? 8 + s : 7 - s));
                att::attn_unit<128, true>((char*)lds, Qf + rb * 1024 + hd * 128, 1024, Kf + rb * 1024 + hd * 128, 1024, Vf + rb * 1024 + hd * 128, 1024, cf + (size_t)(b * 8 + hd) * SEQ,
                                          Gb + rb * 2048 + 1024 + hd * 128, Ob + rb * 2048 + 1024 + hd * 128, qb);
            }
        }
    }
    if (BOTH(3)) xcd_barrier(xbar);

    if (IN(4)) for (int rep_ = 0; rep_ < PROBE_REP4; ++rep_) {
        pg8::Gemm g{Ob, Wout_t, M, 2048, 2048}; pg8::StaticOrder S; S.init(M, 2048, G, bx);
        EpiOut E{Yb, party};
        pg8::gemm_phase<EpiOut, pg8::StaticOrder, true, true>(ldsl, g, S, E);
    }
    if (BOTH(4)) xcd_barrier(xbar);

    if (IN(5)) for (int rep_ = 0; rep_ < PROBE_REP5; ++rep_) {
        const int gw = vcu * 8 + wave, NGW = G * 8;
        const f32x4* gp = (const f32x4*)a.g_post + lane; f32x4 gv[8];
#pragma unroll
        for (int j = 0; j < 8; ++j) gv[j] = gp[64 * j];
        for (int m = gw; m < M; m += 2 * NGW) {
            const int m2 = m + NGW;
            float s = (lane < 32) ? party[(size_t)m * 32 + lane] : 0.f, s2 = (lane < 32) ? party[(size_t)m2 * 32 + lane] : 0.f;
            const f32x4* xr = (const f32x4*)(a.x + (size_t)m * DM) + lane; const f32x4* xr2 = (const f32x4*)(a.x + (size_t)m2 * DM) + lane;
            const u32x2* yr = (const u32x2*)(Yb + (size_t)m * DM) + lane; const u32x2* yr2 = (const u32x2*)(Yb + (size_t)m2 * DM) + lane;
            f32x4 xv[8], xv2[8]; u32x2 y[8], y2[8];
#pragma unroll
            for (int j = 0; j < 8; ++j) { xv[j] = __builtin_nontemporal_load(xr + 64 * j); xv2[j] = __builtin_nontemporal_load(xr2 + 64 * j); y[j] = __builtin_nontemporal_load(yr + 64 * j); y2[j] = __builtin_nontemporal_load(yr2 + 64 * j); }
            s = wave_sum(s); s2 = wave_sum(s2);
            const float rs = 1.f / sqrtf(s * (1.f / DM) + EPS), rs2 = 1.f / sqrtf(s2 * (1.f / DM) + EPS);
            f32x4* orow = (f32x4*)(a.out + (size_t)m * DM) + lane; f32x4* orow2 = (f32x4*)(a.out + (size_t)m2 * DM) + lane;
#pragma unroll
            for (int j = 0; j < 8; ++j) {
                f32x4 o; o[0] = xv[j][0] + bflo(y[j].x) * rs * gv[j][0]; o[1] = xv[j][1] + bfhi(y[j].x) * rs * gv[j][1]; o[2] = xv[j][2] + bflo(y[j].y) * rs * gv[j][2]; o[3] = xv[j][3] + bfhi(y[j].y) * rs * gv[j][3];
                __builtin_nontemporal_store(o, orow + 64 * j);
                f32x4 o2; o2[0] = xv2[j][0] + bflo(y2[j].x) * rs2 * gv[j][0]; o2[1] = xv2[j][1] + bfhi(y2[j].x) * rs2 * gv[j][1]; o2[2] = xv2[j][2] + bflo(y2[j].y) * rs2 * gv[j][2]; o2[3] = xv2[j][3] + bfhi(y2[j].y) * rs2 * gv[j][3];
                __builtin_nontemporal_store(o2, orow2 + 64 * j); }
        }
    }
#undef IN
#undef BOTH
}

extern "C" void kernel_launch(void* const* d_in, const int* in_sizes, int n_in, void* d_out, int out_size, void* d_ws, size_t ws_size, hipStream_t stream) {
    static int grid = 0;
    if (grid == 0) {
        if (n_in != 11 || in_sizes[0] != M * DM || out_size != M * DM || ws_size < WS_END) { fprintf(stderr, "kernel_launch: shape mismatch n_in %d in0 %d out %d ws %zu\n", n_in, n_in > 0 ? in_sizes[0] : -1, out_size, ws_size); grid = -1; return; }
        int dev = 0, cus = 0, per_cu = 0;
        if (hipGetDevice(&dev) != hipSuccess || hipDeviceGetAttribute(&cus, hipDeviceAttributeMultiprocessorCount, dev) != hipSuccess) { grid = -1; return; }
        if (hipFuncSetAttribute((const void*)hybrid_fwd, hipFuncAttributeMaxDynamicSharedMemorySize, LDS_BYTES) != hipSuccess) { fprintf(stderr, "kernel_launch: hipFuncSetAttribute failed\n"); grid = -1; return; }
        if (hipOccupancyMaxActiveBlocksPerMultiprocessor(&per_cu, (const void*)hybrid_fwd, 512, LDS_BYTES) != hipSuccess || per_cu < 1) { fprintf(stderr, "kernel_launch: occupancy query says %d\n", per_cu); per_cu = 1; }
        (void)hipGetLastError();
        grid = cus;
    }
    if (grid < 0) return;
    if (hipMemsetAsync((char*)d_ws + WS_CTL, 0, CTL_BYTES, stream) != hipSuccess) { fprintf(stderr, "kernel_launch: memset failed\n"); return; }
    Args a{};
    a.x = (const float*)d_in[0]; a.pos = (const int*)d_in[1]; a.g_pre = (const float*)d_in[2]; a.w_in = (const float*)d_in[3]; a.g_q = (const float*)d_in[4]; a.w_uq = (const float*)d_in[5];
    a.g_kv = (const float*)d_in[6]; a.w_ukv = (const float*)d_in[7]; a.b_forget = (const float*)d_in[8]; a.w_out = (const float*)d_in[9]; a.g_post = (const float*)d_in[10];
    a.out = (float*)d_out; a.ws = (unsigned char*)d_ws;
#if MK_N_LAUNCHES == 1
    a.ph_lo = 0; a.ph_hi = 6;
    void* args[] = {&a};
    hipError_t e = hipLaunchCooperativeKernel((const void*)hybrid_fwd, dim3(grid), dim3(512), args, LDS_BYTES, stream);
    if (e != hipSuccess) fprintf(stderr, "cooperative launch failed: %s (grid %d)\n", hipGetErrorString(e), grid);
#else
    for (int p = 0; p < 6; ++p) { a.ph_lo = p; a.ph_hi = p + 1; for (int r = 0; r < (p == PROBE_DUP ? 2 : 1); ++r) hipLaunchKernelGGL(hybrid_fwd, dim3(grid), dim3(512), LDS_BYTES, stream, a); }
#endif
}
```

```cpp
#include <hip/hip_runtime.h>
#include <hip/hip_cooperative_groups.h>
#include <cstdio>
#include <cstdint>
namespace cg = cooperative_groups;

#ifndef PROBE_REP0
#define PROBE_REP0 1
#endif
#ifndef PROBE_REP1
#define PROBE_REP1 1
#endif
#ifndef PROBE_REP2
#define PROBE_REP2 1
#endif
#ifndef PROBE_REP3
#define PROBE_REP3 1
#endif
#ifndef PROBE_REP4
#define PROBE_REP4 1
#endif
#ifndef PROBE_REP5
#define PROBE_REP5 1
#endif
#ifndef PROBE_DUP
#define PROBE_DUP -1
#endif
#ifndef MK_N_LAUNCHES
#define MK_N_LAUNCHES 1
#endif

namespace pg8 {
#define PG8_LAS __attribute__((address_space(3)))
typedef unsigned short bf16_t;
typedef short bf16x8 __attribute__((ext_vector_type(8)));
typedef float f32x4 __attribute__((ext_vector_type(4)));
typedef unsigned u32x4 __attribute__((ext_vector_type(4)));
constexpr int BM = 256, BK = 64, HALF = 128, HTB = HALF * BK * 2, STAGE_BYTES = 8 * HTB, NXCD = 8, WGM = 8;

__host__ __device__ __forceinline__ int lds_byte(int r, int c) { const int st = (r >> 4) * 2 + (c >> 5), rr = r & 15, cc = c & 31, ob = rr * 64 + cc * 2; return st * 1024 + (ob ^ (((ob >> 9) & 1) << 5)); }
__host__ __device__ __forceinline__ void stage_rc(int b, int& R, int& C) { const int st = b / 1024, sb = b % 1024, swz = sb ^ (((sb >> 9) & 1) << 5); R = (st >> 1) * 16 + swz / 64; C = (st & 1) * 32 + (swz % 64) / 2; }
__host__ __device__ __forceinline__ int perm32(int rho) { const int n = rho >> 4, i = rho & 15; return 8 * (i >> 2) + 4 * n + (i & 3); }

struct Unit { int pm, pn; };
struct Gemm { const bf16_t* A; const bf16_t* Bt; int M, N, K; };

struct StaticOrder {
    int nM, nN, nwg, G, c;
    __host__ __device__ void init(int M, int N, int G_, int c_) { nM = M / BM; nN = N / BM; nwg = nM * nN; G = G_; c = c_; }
    __host__ __device__ bool next(int i, Unit& u) const {
        const long L = (long)i * G + c; if (L >= nwg) return false;
        int wgid = (int)L; { const int q = nwg / NXCD, r = nwg % NXCD, xcd = wgid % NXCD, off = wgid / NXCD; wgid = (xcd < r ? xcd * (q + 1) : r * (q + 1) + (xcd - r) * q) + off; }
        const int nig = WGM * nN, gid = wgid / nig, fm = gid * WGM, gsz = (nM - fm) < WGM ? (nM - fm) : WGM;
        u.pm = fm + ((wgid % nig) % gsz); u.pn = (wgid % nig) / gsz; return true;
    }
    __device__ __forceinline__ void a_ready(const Unit&) const {}
    __device__ __forceinline__ void done(const Unit&) const {}
};

__device__ __forceinline__ unsigned cvt_pk_bf16(float lo, float hi) { unsigned r; asm volatile("v_cvt_pk_bf16_f32 %0, %1, %2" : "=v"(r) : "v"(lo), "v"(hi)); return r; }

template <class Epi, class Sched, bool ALIGN_EPI = false, bool SP2 = false>
__device__ __forceinline__ void gemm_phase(PG8_LAS unsigned char* lds, const Gemm g, const Sched& S, const Epi& E) {
    const int tid = threadIdx.x, wid = __builtin_amdgcn_readfirstlane(tid >> 6), lane = tid & 63, wr = wid >> 2, wc = wid & 3, fr = lane & 15, fq = lane >> 4;
    const int K = g.K, nt = K / BK;
    unsigned voffA[2], voffB[2];
#pragma unroll
    for (int i = 0; i < 2; ++i) { int R, C; stage_rc(tid * 16 + i * 8192, R, C); const int Rb = Epi::PERM ? ((R & ~31) + perm32(R & 31)) : R;
        voffA[i] = (unsigned)(R * K + C) * 2u; voffB[i] = (unsigned)(Rb * K + C) * 2u; }
    const size_t kstep = (size_t)(BK * 2);
    const size_t hstep = (size_t)HALF * K * 2;
    const size_t tstep = 2 * hstep;
    const unsigned ldsw = (unsigned)wid * 1024u;
    const int aoff = lds_byte(wr * 64 + fr, fq * 8), boff = lds_byte(wc * 32 + fr, fq * 8);
#define PG8_SA(b, h) (((b) * 2 + (h)) * HTB)
#define PG8_SB(b, h) ((4 + (b) * 2 + (h)) * HTB)
#define PG8_STAGE(bufoff, gbase, voff) do { _Pragma("unroll") for (int _i = 0; _i < 2; ++_i) \
        __builtin_amdgcn_global_load_lds((const unsigned*)((const char*)(gbase) + (voff)[_i]), (PG8_LAS unsigned*)(lds + (bufoff) + ldsw + _i * 8192), 16, 0, 0); } while (0)
#define PG8_LDA(dst, b, h) do { _Pragma("unroll") for (int m = 0; m < 4; ++m) _Pragma("unroll") for (int k = 0; k < 2; ++k) dst[m][k] = *(const PG8_LAS bf16x8*)(lds + PG8_SA(b, h) + aoff + m * 2048 + k * 1024); } while (0)
#define PG8_LDB(dst, b, h) do { _Pragma("unroll") for (int n = 0; n < 2; ++n) _Pragma("unroll") for (int k = 0; k < 2; ++k) dst[n][k] = *(const PG8_LAS bf16x8*)(lds + PG8_SB(b, h) + boff + n * 2048 + k * 1024); } while (0)
#define PG8_MMA(ai, bj, At, Bt) do { __builtin_amdgcn_s_setprio(1); _Pragma("unroll") for (int m = 0; m < 4; ++m) _Pragma("unroll") for (int n = 0; n < 2; ++n) _Pragma("unroll") for (int k = 0; k < 2; ++k) \
        acc[ai][bj][m][n] = __builtin_amdgcn_mfma_f32_16x16x32_bf16(Bt[n][k], At[m][k], acc[ai][bj][m][n], 0, 0, 0); __builtin_amdgcn_s_setprio(0); } while (0)
#define PG8_WAIT_V(n) asm volatile("s_waitcnt vmcnt(" #n ")" ::: "memory")
#define PG8_WAIT_L(n) asm volatile("s_waitcnt lgkmcnt(" #n ")" ::: "memory")
#define PG8_BAR __builtin_amdgcn_s_barrier()
#define PG8_SCHED __builtin_amdgcn_sched_barrier(0)
    Unit cur, nxt; int ui = 0;
    if (!S.next(0, cur)) return;
    f32x4 acc[2][2][4][2];
#pragma unroll
    for (int a = 0; a < 2; ++a)
#pragma unroll
        for (int b = 0; b < 2; ++b)
#pragma unroll
            for (int m = 0; m < 4; ++m)
#pragma unroll
                for (int n = 0; n < 2; ++n) acc[a][b][m][n] = (f32x4){0.f, 0.f, 0.f, 0.f};
    bf16x8 At[4][2], B0[2][2], B1[2][2];
    const char* cA = (const char*)g.A + (size_t)cur.pm * tstep; const char* cB = (const char*)g.Bt + (size_t)cur.pn * tstep;
    S.a_ready(cur);
    if constexpr (SP2) {
        PG8_STAGE(PG8_SB(0, 0), cB, voffB); PG8_STAGE(PG8_SB(0, 1), cB + hstep, voffB); PG8_STAGE(PG8_SA(0, 0), cA, voffA); PG8_STAGE(PG8_SA(0, 1), cA + hstep, voffA);
        if (wr == 1) PG8_BAR;
        PG8_WAIT_V(2); PG8_BAR;
        PG8_STAGE(PG8_SB(1, 0), cB + kstep, voffB); PG8_STAGE(PG8_SA(1, 0), cA + kstep, voffA); PG8_STAGE(PG8_SB(1, 1), cB + hstep + kstep, voffB);
        PG8_WAIT_V(6); PG8_BAR;
    } else {
        PG8_STAGE(PG8_SB(0, 0), cB, voffB); PG8_STAGE(PG8_SA(0, 0), cA, voffA); PG8_STAGE(PG8_SB(0, 1), cB + hstep, voffB); PG8_STAGE(PG8_SA(0, 1), cA + hstep, voffA);
        if (wr == 1) PG8_BAR;
        PG8_WAIT_V(4); PG8_BAR;
        PG8_STAGE(PG8_SB(1, 0), cB + kstep, voffB); PG8_STAGE(PG8_SA(1, 0), cA + kstep, voffA); PG8_STAGE(PG8_SB(1, 1), cB + hstep + kstep, voffB);
        PG8_WAIT_V(6); PG8_BAR;
    }
    for (;;) {
        const bool has_next = S.next(ui + 1, nxt);
        const char* nA = has_next ? (const char*)g.A + (size_t)nxt.pm * tstep : cA; const char* nB = has_next ? (const char*)g.Bt + (size_t)nxt.pn * tstep : cB;
        for (int t = 0; t < nt; t += 2) {
            const bool last = (t == nt - 2);
            const char* a1 = cA + (size_t)(t + 1) * kstep;
            const char* a2 = last ? nA : cA + (size_t)(t + 2) * kstep; const char* b2 = last ? nB : cB + (size_t)(t + 2) * kstep;
            const char* a3 = a2 + kstep; const char* b3 = b2 + kstep;
            if (last && has_next) S.a_ready(nxt);
            if constexpr (SP2) {
            PG8_LDB(B0, 0, 0); PG8_LDB(B1, 0, 1); PG8_SCHED; PG8_LDA(At, 0, 0); PG8_STAGE(PG8_SA(1, 1), a1 + hstep, voffA);
            PG8_WAIT_V(8); PG8_WAIT_L(0); PG8_BAR; PG8_MMA(0, 0, At, B0); PG8_MMA(0, 1, At, B1); PG8_BAR; PG8_SCHED;
            PG8_LDA(At, 0, 1); PG8_STAGE(PG8_SB(0, 0), b2, voffB); PG8_STAGE(PG8_SB(0, 1), b2 + hstep, voffB); PG8_STAGE(PG8_SA(0, 0), a2, voffA);
            PG8_WAIT_V(8); PG8_WAIT_L(0); PG8_BAR; PG8_MMA(1, 0, At, B0); PG8_MMA(1, 1, At, B1); PG8_BAR; PG8_SCHED;
            PG8_LDB(B0, 1, 0); PG8_LDB(B1, 1, 1); PG8_SCHED; PG8_LDA(At, 1, 0); PG8_STAGE(PG8_SA(0, 1), a2 + hstep, voffA);
            PG8_WAIT_V(8); PG8_WAIT_L(0); PG8_BAR; PG8_MMA(0, 0, At, B0); PG8_MMA(0, 1, At, B1); PG8_BAR; PG8_SCHED;
            PG8_LDA(At, 1, 1); PG8_STAGE(PG8_SB(1, 0), b3, voffB); PG8_STAGE(PG8_SB(1, 1), b3 + hstep, voffB); PG8_STAGE(PG8_SA(1, 0), a3, voffA);
            PG8_WAIT_V(8); PG8_WAIT_L(0); PG8_BAR; PG8_MMA(1, 0, At, B0); PG8_MMA(1, 1, At, B1); PG8_BAR; PG8_SCHED;
            } else {
            PG8_LDB(B0, 0, 0); PG8_SCHED; PG8_LDA(At, 0, 0); PG8_STAGE(PG8_SA(1, 1), a1 + hstep, voffA);
            PG8_WAIT_L(8); PG8_BAR; PG8_WAIT_L(0); PG8_MMA(0, 0, At, B0); PG8_BAR; PG8_SCHED;
            PG8_LDB(B1, 0, 1); PG8_STAGE(PG8_SB(0, 0), b2, voffB);
            PG8_BAR; PG8_WAIT_L(0); PG8_MMA(0, 1, At, B1); PG8_BAR;
            PG8_LDA(At, 0, 1); PG8_STAGE(PG8_SA(0, 0), a2, voffA);
            PG8_BAR; PG8_WAIT_L(0); PG8_MMA(1, 0, At, B0); PG8_BAR; PG8_SCHED;
            PG8_STAGE(PG8_SB(0, 1), b2 + hstep, voffB);
            PG8_WAIT_V(6); PG8_BAR; PG8_MMA(1, 1, At, B1); PG8_BAR;
            PG8_LDB(B0, 1, 0); PG8_SCHED; PG8_LDA(At, 1, 0); PG8_STAGE(PG8_SA(0, 1), a2 + hstep, voffA);
            PG8_WAIT_L(8); PG8_BAR; PG8_WAIT_L(0); PG8_MMA(0, 0, At, B0); PG8_BAR; PG8_SCHED;
            PG8_LDB(B1, 1, 1); PG8_STAGE(PG8_SB(1, 0), b3, voffB);
            PG8_BAR; PG8_WAIT_L(0); PG8_MMA(0, 1, At, B1); PG8_BAR;
            PG8_LDA(At, 1, 1); PG8_STAGE(PG8_SA(1, 0), a3, voffA);
            PG8_BAR; PG8_WAIT_L(0); PG8_MMA(1, 0, At, B0); PG8_BAR; PG8_SCHED;
            PG8_STAGE(PG8_SB(1, 1), b3 + hstep, voffB);
            PG8_WAIT_V(6); PG8_BAR; PG8_MMA(1, 1, At, B1); PG8_BAR;
            }
        }
        if constexpr (ALIGN_EPI) { if (wr == 0) PG8_BAR; }
        if constexpr (!Epi::AFTER_DRAIN) { E(acc, cur, wr, wc, fr, fq); S.done(cur); }
        if (!has_next) break;
#pragma unroll
        for (int a = 0; a < 2; ++a)
#pragma unroll
            for (int b = 0; b < 2; ++b)
#pragma unroll
                for (int m = 0; m < 4; ++m)
#pragma unroll
                    for (int n = 0; n < 2; ++n) acc[a][b][m][n] = (f32x4){0.f, 0.f, 0.f, 0.f};
        cur = nxt; cA = nA; cB = nB; ++ui;
        if constexpr (ALIGN_EPI) { if (wr == 1) PG8_BAR; }
    }
    PG8_WAIT_V(0);
    if constexpr (!ALIGN_EPI) { if (wr == 0) PG8_BAR; }
    PG8_BAR;
#undef PG8_SA
#undef PG8_SB
#undef PG8_STAGE
#undef PG8_LDA
#undef PG8_LDB
#undef PG8_MMA
#undef PG8_WAIT_V
#undef PG8_WAIT_L
#undef PG8_BAR
#undef PG8_SCHED
}
}

typedef unsigned short bf16;
typedef float f32x4 __attribute__((ext_vector_type(4)));
typedef unsigned u32x4 __attribute__((ext_vector_type(4)));
typedef unsigned u32x2 __attribute__((ext_vector_type(2)));
typedef short bf16x8 __attribute__((ext_vector_type(8)));
typedef short s16x4 __attribute__((ext_vector_type(4)));
typedef float f32x16 __attribute__((ext_vector_type(16)));
#define LAS __attribute__((address_space(3)))

constexpr int BATCH = 4, SEQ = 4096, DM = 2048, M = BATCH * SEQ;
constexpr int NH = 8, QKD = 192, QRANK = 768, KVRANK = 512, DIN = 6472;
constexpr int NIN_PAD = 6656;
constexpr float EPS = 1e-6f;
constexpr float LOG2E = 1.4426950408889634f;
constexpr float C2M = 0.07216878364870322f * LOG2E;
constexpr float C2F = 0.08838834764831845f * LOG2E;

constexpr size_t MiB = 1u << 20;
constexpr size_t WS_RSTDX = 0, WS_PARTQ = 1 * MiB, WS_PARTKV = 2 * MiB, WS_PARTY = 3 * MiB, WS_FLOG = 5 * MiB, WS_CF = 6 * MiB, WS_COS = 7 * MiB, WS_SIN = 9 * MiB;
constexpr size_t WS_CTL = 11 * MiB, CTL_BYTES = 16384;
constexpr size_t WS_WIN = 16 * MiB, WS_WUQ = 42 * MiB, WS_WUKV = 45 * MiB, WS_WOUT = 47 * MiB;
constexpr size_t WS_XB = 56 * MiB, WS_O = 56 * MiB;
constexpr size_t WS_QLAT = 120 * MiB, WS_KVLAT = 144 * MiB, WS_G = 160 * MiB;
constexpr size_t WS_QF = 224 * MiB, WS_Y = 224 * MiB, WS_KF = 256 * MiB, WS_VF = 288 * MiB;
constexpr size_t WS_QM = 320 * MiB, WS_KM = 368 * MiB, WS_VM = 416 * MiB, WS_END = 448 * MiB;

constexpr int LDS_BYTES = 163840;

__device__ __forceinline__ unsigned f2bf(float f) { unsigned u = __builtin_bit_cast(unsigned, f); return (u + 0x7fffu + ((u >> 16) & 1u)) >> 16; }
__device__ __forceinline__ unsigned pk2(float lo, float hi) { return pg8::cvt_pk_bf16(lo, hi); }
__device__ __forceinline__ float bflo(unsigned w) { return __builtin_bit_cast(float, w << 16); }
__device__ __forceinline__ float bfhi(unsigned w) { return __builtin_bit_cast(float, w & 0xffff0000u); }
__device__ __forceinline__ int launder(int v) { asm volatile("" : "+v"(v)); return v; }
__device__ __forceinline__ float wave_sum(float v) {
#pragma unroll
    for (int o = 1; o < 64; o <<= 1) v += __shfl_xor(v, o);
    return v;
}
__device__ __forceinline__ float silu_f(float v) { return v * __builtin_amdgcn_rcpf(1.f + __builtin_amdgcn_exp2f(-v * LOG2E)); }
__device__ __forceinline__ u32x4 pack8f(f32x4 a, f32x4 b) { u32x4 w; w.x = pk2(a[0], a[1]); w.y = pk2(a[2], a[3]); w.z = pk2(b[0], b[1]); w.w = pk2(b[2], b[3]); return w; }

typedef pg8::f32x4 af4;
struct EpiIn {
    static constexpr bool PERM = true, AFTER_DRAIN = false;
    const float* rstd_x; bf16 *qlat, *kvlat, *G, *Qf, *Kf, *Vf, *Km; float *flog, *partq, *partkv; const float *cosT, *sinT;
    __device__ __forceinline__ void operator()(const af4 (&acc)[2][2][4][2], const pg8::Unit& u, int wr, int wc, int fr, int fq) const {
        const int pn = u.pn; const int row0 = u.pm * 256 + wr * 64 + fr;
        if (pn == 25) {
            if (wc == 0) {
#pragma unroll
                for (int ai = 0; ai < 2; ++ai)
#pragma unroll
                    for (int m = 0; m < 4; ++m) { const int row = row0 + ai * 128 + m * 16; const float rs = rstd_x[row];
                        f32x4 o1[2], o2[2];
#pragma unroll
                        for (int n = 0; n < 2; ++n) { const f32x4 c = *(const f32x4*)(cosT + (size_t)row * 32 + 8 * fq + 4 * n), s = *(const f32x4*)(sinT + (size_t)row * 32 + 8 * fq + 4 * n);
                            const f32x4 x1 = acc[ai][0][m][n] * rs, x2 = acc[ai][1][m][n] * rs; o1[n] = x1 * c - x2 * s; o2[n] = x2 * c + x1 * s; }
                        const u32x4 w1 = pack8f(o1[0], o1[1]), w2 = pack8f(o2[0], o2[1]);
                        bf16* kp = Km + (size_t)row * 1536 + 128 + 8 * fq;
#pragma unroll
                        for (int h = 0; h < 8; ++h) { *(u32x4*)(kp + h * 192) = w1; *(u32x4*)(kp + h * 192 + 32) = w2; } }
            } else if (wc == 1 && fq == 0) {
#pragma unroll
                for (int ai = 0; ai < 2; ++ai)
#pragma unroll
                    for (int m = 0; m < 4; ++m) { const int row = row0 + ai * 128 + m * 16; const float rs = rstd_x[row];
                        *(f32x4*)(flog + (size_t)row * 8) = acc[ai][0][m][0] * rs; *(f32x4*)(flog + (size_t)row * 8 + 4) = acc[ai][0][m][1] * rs; }
            }
            return;
        }
        bf16* base; int ld, colt, mode = 0; float* part = nullptr; int nslot = 0, slot0 = 0;
        if (pn < 3) { base = qlat; ld = 768; colt = pn * 256; part = partq; nslot = 12; slot0 = pn * 4; }
        else if (pn < 5) { base = kvlat; ld = 512; colt = (pn - 3) * 256; part = partkv; nslot = 8; slot0 = (pn - 3) * 4; }
        else if (pn < 9) { base = G; ld = 2048; colt = (pn - 5) * 256; mode = 1; }
        else if (pn < 13) { base = Qf; ld = 1024; colt = (pn - 9) * 256; mode = 2; }
        else if (pn < 17) { base = Kf; ld = 1024; colt = (pn - 13) * 256; }
        else if (pn < 21) { base = Vf; ld = 1024; colt = (pn - 17) * 256; }
        else { base = G; ld = 2048; colt = 1024 + (pn - 21) * 256; mode = 1; }
        const int col0 = colt + wc * 32 + 8 * fq;
#pragma unroll
        for (int ai = 0; ai < 2; ++ai)
#pragma unroll
            for (int m = 0; m < 4; ++m) { const int row = row0 + ai * 128 + m * 16; float rs = rstd_x[row]; if (mode == 2) rs *= C2F;
                bf16* rowp = base + (size_t)row * ld + col0; float ss = 0.f;
#pragma unroll
                for (int bj = 0; bj < 2; ++bj) { f32x4 v0 = acc[ai][bj][m][0] * rs, v1 = acc[ai][bj][m][1] * rs;
                    ss += (v0[0] * v0[0] + v0[1] * v0[1]) + (v0[2] * v0[2] + v0[3] * v0[3]) + (v1[0] * v1[0] + v1[1] * v1[1]) + (v1[2] * v1[2] + v1[3] * v1[3]);
                    if (mode == 1) {
#pragma unroll
                        for (int e = 0; e < 4; ++e) { v0[e] = silu_f(v0[e]); v1[e] = silu_f(v1[e]); } }
                    *(u32x4*)(rowp + bj * 128) = pack8f(v0, v1); }
                if (part) { ss += __shfl_xor(ss, 16); ss += __shfl_xor(ss, 32); if (fq == 0) part[(size_t)row * nslot + slot0 + wc] = ss; } }
    }
};
struct EpiQ {
    static constexpr bool PERM = true, AFTER_DRAIN = false;
    const float* partq; bf16* Qm; const float *cosT, *sinT;
    __device__ __forceinline__ void operator()(const af4 (&acc)[2][2][4][2], const pg8::Unit& u, int wr, int wc, int fr, int fq) const {
        const int pn = u.pn; const int row0 = u.pm * 256 + wr * 64 + fr;
#pragma unroll
        for (int ai = 0; ai < 2; ++ai)
#pragma unroll
            for (int m = 0; m < 4; ++m) { const int row = row0 + ai * 128 + m * 16;
                const f32x4 pa = *(const f32x4*)(partq + (size_t)row * 12), pb = *(const f32x4*)(partq + (size_t)row * 12 + 4), pc = *(const f32x4*)(partq + (size_t)row * 12 + 8);
                const float ssq = ((pa[0] + pa[1]) + (pa[2] + pa[3])) + ((pb[0] + pb[1]) + (pb[2] + pb[3])) + ((pc[0] + pc[1]) + (pc[2] + pc[3]));
                const float rs = C2M / sqrtf(ssq * (1.f / 768.f) + EPS);
                if (pn < 4) {
#pragma unroll
                    for (int bj = 0; bj < 2; ++bj) *(u32x4*)(Qm + (size_t)row * 1536 + (2 * pn + bj) * 192 + wc * 32 + 8 * fq) = pack8f(acc[ai][bj][m][0] * rs, acc[ai][bj][m][1] * rs);
                } else { const int head = 4 * (pn - 4) + wc; f32x4 o1[2], o2[2];
#pragma unroll
                    for (int n = 0; n < 2; ++n) { const f32x4 c = *(const f32x4*)(cosT + (size_t)row * 32 + 8 * fq + 4 * n), s = *(const f32x4*)(sinT + (size_t)row * 32 + 8 * fq + 4 * n);
                        const f32x4 x1 = acc[ai][0][m][n] * rs, x2 = acc[ai][1][m][n] * rs; o1[n] = x1 * c - x2 * s; o2[n] = x2 * c + x1 * s; }
                    bf16* qp = Qm + (size_t)row * 1536 + head * 192 + 128 + 8 * fq;
                    *(u32x4*)qp = pack8f(o1[0], o1[1]); *(u32x4*)(qp + 32) = pack8f(o2[0], o2[1]); } }
    }
};
struct EpiKV {
    static constexpr bool PERM = true, AFTER_DRAIN = false;
    const float* partkv; bf16 *Km, *Vm;
    __device__ __forceinline__ void operator()(const af4 (&acc)[2][2][4][2], const pg8::Unit& u, int wr, int wc, int fr, int fq) const {
        const int pn = u.pn; const int row0 = u.pm * 256 + wr * 64 + fr;
#pragma unroll
        for (int ai = 0; ai < 2; ++ai)
#pragma unroll
            for (int m = 0; m < 4; ++m) { const int row = row0 + ai * 128 + m * 16;
                const f32x4 pa = *(const f32x4*)(partkv + (size_t)row * 8), pb = *(const f32x4*)(partkv + (size_t)row * 8 + 4);
                const float ssq = ((pa[0] + pa[1]) + (pa[2] + pa[3])) + ((pb[0] + pb[1]) + (pb[2] + pb[3]));
                const float rs = 1.f / sqrtf(ssq * (1.f / 512.f) + EPS);
                *(u32x4*)(Km + (size_t)row * 1536 + pn * 192 + wc * 32 + 8 * fq) = pack8f(acc[ai][0][m][0] * rs, acc[ai][0][m][1] * rs);
                *(u32x4*)(Vm + (size_t)row * 1024 + pn * 128 + wc * 32 + 8 * fq) = pack8f(acc[ai][1][m][0] * rs, acc[ai][1][m][1] * rs); }
    }
};
struct EpiOut {
    static constexpr bool PERM = true, AFTER_DRAIN = false;
    bf16* Y; float* party;
    __device__ __forceinline__ void operator()(const af4 (&acc)[2][2][4][2], const pg8::Unit& u, int wr, int wc, int fr, int fq) const {
        const int pn = u.pn; const int row0 = u.pm * 256 + wr * 64 + fr; const int col0 = pn * 256 + wc * 32 + 8 * fq;
#pragma unroll
        for (int ai = 0; ai < 2; ++ai)
#pragma unroll
            for (int m = 0; m < 4; ++m) { const int row = row0 + ai * 128 + m * 16; float ss = 0.f;
#pragma unroll
                for (int bj = 0; bj < 2; ++bj) { const f32x4 v0 = acc[ai][bj][m][0], v1 = acc[ai][bj][m][1];
                    ss += (v0[0] * v0[0] + v0[1] * v0[1]) + (v0[2] * v0[2] + v0[3] * v0[3]) + (v1[0] * v1[0] + v1[1] * v1[1]) + (v1[2] * v1[2] + v1[3] * v1[3]);
                    *(u32x4*)(Y + (size_t)row * 2048 + col0 + bj * 128) = pack8f(v0, v1); }
                ss += __shfl_xor(ss, 16); ss += __shfl_xor(ss, 32); if (fq == 0) party[(size_t)row * 32 + pn * 4 + wc] = ss; }
    }
};

namespace att {
constexpr int KVBLK = 64, QBLK = 32, QB = 256;
constexpr int SHM_K = 24576, SHM_V = 16384;
constexpr int NRING = 3;
constexpr int OFF_K = 0, OFF_V = NRING * SHM_K, OFF_CK = OFF_V + NRING * SHM_V, OFF_WS = OFF_CK + 1024, OFF_QP = OFF_WS + 2048;
constexpr float THR = 8.f;
#define KSWZ(row, colB) ((row) * 256 + ((colB) ^ (((row) & 7) << 4)))
#define SBAR() __builtin_amdgcn_sched_barrier(0)
__device__ __forceinline__ int v_st(int k, int c) { const int kk = (k & ~0xC) | ((k & 4) << 1) | ((k & 8) >> 1); return ((kk >> 3) * 4 + (c >> 5)) * 512 + ((kk & 7) * 32 + (c & 31)) * 2; }
__device__ __forceinline__ int v_rd_base(int lane) { return ((lane & 3) << 3) | (((lane >> 2) & 3) << 6) | (((lane >> 4) & 1) << 5) | (((lane >> 5) & 1) << 8); }
constexpr int v_rd_off(int d0, int ks, int half) { return d0 * 512 + ks * 4096 + half * 2048; }
__device__ __forceinline__ int crow(int r, int hi) { return (r & 3) + 8 * (r >> 2) + 4 * hi; }
__device__ __forceinline__ unsigned cvtpk(float lo, float hi) { unsigned r; asm volatile("v_cvt_pk_bf16_f32 %0, %1, %2" : "=v"(r) : "v"(lo), "v"(hi)); return r; }

__device__ __forceinline__ void mask_tile(f32x16& p0, f32x16& p1, int dq) {
    const float NEG = -__builtin_inff();
#pragma unroll
    for (int r = 0; r < 16; ++r) { const int c = (r & 3) + 8 * (r >> 2);
        if (dq - c < 0) p0[r] = NEG;
        if (dq - c - 32 < 0) p1[r] = NEG; }
}
__device__ __forceinline__ void softmax_tile(f32x16& p0, f32x16& p1, float& m_reg, float& l_reg, float& alpha, bf16x8& pa0, bf16x8& pa1, bf16x8& pa2, bf16x8& pa3) {
    float pmax = p0[0];
#pragma unroll
    for (int r = 1; r < 16; ++r) pmax = fmaxf(pmax, p0[r]);
#pragma unroll
    for (int r = 0; r < 16; ++r) pmax = fmaxf(pmax, p1[r]);
    { auto rr = __builtin_amdgcn_permlane32_swap(__float_as_uint(pmax), __float_as_uint(pmax), false, false);
      pmax = fmaxf(__uint_as_float(rr[0]), __uint_as_float(rr[1])); }
    float mn;
    if (__builtin_expect(__all(pmax - m_reg <= THR), 1)) { mn = m_reg; alpha = 1.f; }
    else { mn = fmaxf(m_reg, pmax); alpha = __builtin_amdgcn_exp2f(m_reg - mn); m_reg = mn; }
#pragma unroll
    for (int r = 0; r < 16; ++r) { p0[r] = __builtin_amdgcn_exp2f(p0[r] - mn); p1[r] = __builtin_amdgcn_exp2f(p1[r] - mn); }
    float ps = 0.f;
#pragma unroll
    for (int r = 0; r < 16; ++r) ps += p0[r];
#pragma unroll
    for (int r = 0; r < 16; ++r) ps += p1[r];
    { auto rr = __builtin_amdgcn_permlane32_swap(__float_as_uint(ps), __float_as_uint(ps), false, false);
      ps = __uint_as_float(rr[0]) + __uint_as_float(rr[1]); }
    l_reg = l_reg * alpha + ps;
#define PK4(P, B_, OUT) do { unsigned a0 = cvtpk(P[B_+0], P[B_+1]), a1 = cvtpk(P[B_+2], P[B_+3]);                          \
        unsigned b0 = cvtpk(P[B_+4], P[B_+5]), b1 = cvtpk(P[B_+6], P[B_+7]);                                             \
        auto r0 = __builtin_amdgcn_permlane32_swap(a0, b0, false, false); auto r1 = __builtin_amdgcn_permlane32_swap(a1, b1, false, false); \
        u32x4 w = {r0[0], r1[0], r0[1], r1[1]}; OUT = *reinterpret_cast<bf16x8*>(&w); } while (0)
    PK4(p0, 0, pa0); PK4(p0, 8, pa1); PK4(p1, 0, pa2); PK4(p1, 8, pa3);
#undef PK4
}
template <int DQK, int NPARK>
__device__ __forceinline__ void qkt(f32x16& p0, f32x16& p1, const char* Kb, int r32, int hi, const bf16x8* qr, const char* qpk) {
    constexpr int ND = DQK / 16, NQR = ND - NPARK;
    p0 = f32x16{}; p1 = f32x16{};
    const char* kb[4];
#pragma unroll
    for (int dd = 0; dd < 4; ++dd) kb[dd] = Kb + KSWZ(r32, (dd * 16 + hi * 8) * 2);
    const char* kr = Kb + 16384 + r32 * 128;
    const int rx = (r32 & 7) << 4;
    bf16x8 kf[3][2], qf[3];
#define QK_LD(set, d_) do { \
            if ((d_) < 8) { const char* a_ = kb[(d_) & 3] + ((d_) >> 2) * 128; kf[set][0] = *reinterpret_cast<const bf16x8*>(a_); kf[set][1] = *reinterpret_cast<const bf16x8*>(a_ + 32 * 256); } \
            else { const char* a_ = kr + (((((d_) - 8) * 16 + hi * 8) * 2) ^ rx); kf[set][0] = *reinterpret_cast<const bf16x8*>(a_); kf[set][1] = *reinterpret_cast<const bf16x8*>(a_ + 32 * 128); } \
            if ((d_) >= NQR) qf[set] = *reinterpret_cast<const bf16x8*>(qpk + ((d_) - NQR) * 1024); } while (0)
    QK_LD(0, 0); QK_LD(1, 1); SBAR();
#pragma unroll
    for (int d = 0; d < ND; ++d) {
        const int cs = d % 3;
        if (d + 2 < ND) { const int ns = (d + 2) % 3; if (ns == 0) QK_LD(0, d + 2); else if (ns == 1) QK_LD(1, d + 2); else QK_LD(2, d + 2); SBAR(); }
        const bf16x8 q = (d < NQR) ? qr[d < NQR ? d : 0] : qf[cs];
        p0 = __builtin_amdgcn_mfma_f32_32x32x16_bf16(kf[cs][0], q, p0, 0, 0, 0);
        p1 = __builtin_amdgcn_mfma_f32_32x32x16_bf16(kf[cs][1], q, p1, 0, 0, 0);
        SBAR();
    }
#undef QK_LD
}
template <int VOFF>
__device__ __forceinline__ void pv_tile(f32x16* o, int vb0, bf16x8 pa0, bf16x8 pa1, bf16x8 pa2, bf16x8 pa3) {
#define TRRD(dst, off) asm volatile("ds_read_b64_tr_b16 %0, %1 offset:%2" : "=&v"(dst) : "v"(vb0), "i"(off) : "memory")
#define PV_D0(d0) do { s16x4 l0, l1, l2, l3, h0, h1, h2, h3; constexpr int b_ = VOFF + v_rd_off(d0, 0, 0); \
        TRRD(l0, b_); TRRD(h0, b_ + 2048); TRRD(l1, b_ + 4096); TRRD(h1, b_ + 6144); TRRD(l2, b_ + 8192); TRRD(h2, b_ + 10240); TRRD(l3, b_ + 12288); TRRD(h3, b_ + 14336); \
        asm volatile("s_waitcnt lgkmcnt(0)" ::: "memory"); SBAR(); \
        o[d0] = __builtin_amdgcn_mfma_f32_32x32x16_bf16(pa0, (bf16x8){l0[0], l0[1], l0[2], l0[3], h0[0], h0[1], h0[2], h0[3]}, o[d0], 0, 0, 0);   \
        o[d0] = __builtin_amdgcn_mfma_f32_32x32x16_bf16(pa1, (bf16x8){l1[0], l1[1], l1[2], l1[3], h1[0], h1[1], h1[2], h1[3]}, o[d0], 0, 0, 0);   \
        o[d0] = __builtin_amdgcn_mfma_f32_32x32x16_bf16(pa2, (bf16x8){l2[0], l2[1], l2[2], l2[3], h2[0], h2[1], h2[2], h2[3]}, o[d0], 0, 0, 0);   \
        o[d0] = __builtin_amdgcn_mfma_f32_32x32x16_bf16(pa3, (bf16x8){l3[0], l3[1], l3[2], l3[3], h3[0], h3[1], h3[2], h3[3]}, o[d0], 0, 0, 0); } while (0)
    PV_D0(0); PV_D0(1); PV_D0(2); PV_D0(3);
#undef PV_D0
#undef TRRD
}

template <int DQK, bool FOX>
__device__ __forceinline__ void attn_unit(char* lds, const bf16* Q, int ldq, const bf16* K, int ldk, const bf16* V, int ldv, const float* cfs, const bf16* Gp, bf16* Op, int qb) {
    const int tid = threadIdx.x, wid = __builtin_amdgcn_readfirstlane(tid >> 6), lane = tid & 63, r32 = lane & 31, hi = lane >> 5;
    const bool grpA = wid < 4; const int w4 = wid & 3;
    const int q0 = qb * QB, NT = 4 * (qb + 1);
    char* K_lds = lds + OFF_K; char* V_lds = lds + OFF_V; float* ck_l = (float*)(lds + OFF_CK);
    float* wsf = (float*)(lds + OFF_WS) + wid * 64; float* li_l = wsf; float* al_l = wsf + 32;
    constexpr int NPARK = 4, NQR = DQK / 16 - NPARK;
    bf16x8 qr[NQR];
    char* qpk = lds + OFF_QP + wid * 4096 + (hi * 32 + r32) * 16;
    unsigned koff, kroff = 0, voff;
    { const int row = 4 * w4 + (lane >> 4), c = (lane & 15) ^ (row & 7); koff = (unsigned)(row * ldk + c * 8) * 2u; }
    { const int s0 = 2 * w4 + (lane >> 5), kk = 8 * (s0 >> 2) + ((lane & 31) >> 2), k = (kk & ~0xC) | ((kk & 4) << 1) | ((kk & 8) >> 1); voff = (unsigned)(k * ldv + 32 * (s0 & 3) + 8 * (lane & 3)) * 2u; }
    if constexpr (DQK == 192) { const int row = 8 * w4 + (lane >> 3), c = (lane & 7) ^ (row & 7); kroff = (unsigned)(row * ldk + 128 + c * 8) * 2u; }
    const int vb0 = (int)(uintptr_t)V_lds + v_rd_base(lane);
    LAS unsigned char* ldsl = (LAS unsigned char*)(uintptr_t)(unsigned)(uintptr_t)lds;
#define DMA_K(t, bf) do { const char* kt_ = (const char*)K + (size_t)(t) * KVBLK * ldk * 2; \
        _Pragma("unroll") for (int j_ = 0; j_ < 4; ++j_) \
            __builtin_amdgcn_global_load_lds((const unsigned*)(kt_ + koff + (size_t)j_ * 16 * ldk * 2), (LAS unsigned*)(ldsl + OFF_K + (bf) * SHM_K + (w4 + 4 * j_) * 1024), 16, 0, 0); \
        if constexpr (DQK == 192) { _Pragma("unroll") for (int j_ = 0; j_ < 2; ++j_) \
            __builtin_amdgcn_global_load_lds((const unsigned*)(kt_ + kroff + (size_t)j_ * 32 * ldk * 2), (LAS unsigned*)(ldsl + OFF_K + (bf) * SHM_K + 16384 + (w4 + 4 * j_) * 1024), 16, 0, 0); } \
        if constexpr (FOX) { __builtin_amdgcn_global_load_lds((const unsigned*)(cfs + (t) * KVBLK + lane), (LAS unsigned*)(ldsl + OFF_CK + ((t) & 3) * 256), 4, 0, 0); } } while (0)
#define DMA_V(t, bf) do { const char* vt_ = (const char*)V + (size_t)(t) * KVBLK * ldv * 2; \
        _Pragma("unroll") for (int j_ = 0; j_ < 4; ++j_) \
            __builtin_amdgcn_global_load_lds((const unsigned*)(vt_ + voff + (size_t)j_ * 16 * ldv * 2), (LAS unsigned*)(ldsl + OFF_V + (bf) * SHM_V + (w4 + 4 * j_) * 1024), 16, 0, 0); } while (0)
#define BAR_L() asm volatile("s_waitcnt lgkmcnt(0)\n\ts_barrier" ::: "memory")
#define BAR_VL() asm volatile("s_waitcnt vmcnt(0) lgkmcnt(0)\n\ts_barrier" ::: "memory")
    constexpr int NDK = 4 + (DQK == 192 ? 2 : 0) + (FOX ? 1 : 0), NDV = 4;
#define BAR_VN(n) asm volatile("s_waitcnt vmcnt(%0) lgkmcnt(0)\n\ts_barrier" :: "n"(n) : "memory")
    if (grpA) { DMA_K(0, 0); DMA_K(1, 1); DMA_V(0, 0); }
    { const bf16* qp = Q + (size_t)(q0 + wid * QBLK + r32) * ldq + hi * 8;
#pragma unroll
      for (int d0 = 0; d0 < NQR; ++d0) qr[d0] = *(const bf16x8*)(qp + d0 * 16);
#pragma unroll
      for (int d0 = 0; d0 < NPARK; ++d0) *(bf16x8*)(qpk + d0 * 1024) = *(const bf16x8*)(qp + (NQR + d0) * 16); }
    float cq = 0.f; if constexpr (FOX) cq = cfs[q0 + wid * QBLK + r32];
    BAR_VL();
    if (!grpA) BAR_L();
    float m_reg = -1e30f, l_reg = 0.f; f32x16 o[4] = {}; f32x16 p0, p1; bf16x8 pa0 = {}, pa1 = {}, pa2 = {}, pa3 = {};
#define ACTW(tt) ((tt) - (NT - 4) < 0 || 64 * ((tt) - (NT - 4)) <= 32 * wid + 31)
    int rc = 0, rp = 2, rn = 1;
#pragma unroll 1
    for (int t = 0; t < NT; ++t) {
        if (grpA) { if (t + 2 < NT) DMA_K(t + 2, rp); if (t + 1 < NT) DMA_V(t + 1, rn); }
        const int jb_ = t - (NT - 4); const bool act_ = ACTW(t);
        if (act_) qkt<DQK, NPARK>(p0, p1, K_lds + rc * SHM_K, r32, hi, qr, qpk);
        if (t > 0 && ACTW(t - 1)) { SBAR(); pv_tile<0>(o, vb0 + rp * SHM_V, pa0, pa1, pa2, pa3); }
        BAR_L();
        if (act_) { float alpha;
            if constexpr (FOX) { const float* ckp = ck_l + (t & 3) * 64 + 4 * hi;
#pragma unroll
                for (int g_ = 0; g_ < 4; ++g_) { const f32x4 c0 = *(const f32x4*)(ckp + 8 * g_), c1 = *(const f32x4*)(ckp + 32 + 8 * g_);
#pragma unroll
                    for (int e_ = 0; e_ < 4; ++e_) { p0[4 * g_ + e_] += cq - c0[e_]; p1[4 * g_ + e_] += cq - c1[e_]; } } }
            if (jb_ >= 0 && 64 * jb_ + 63 > 32 * wid) mask_tile(p0, p1, 32 * wid + r32 - 64 * jb_ - 4 * hi);
            softmax_tile(p0, p1, m_reg, l_reg, alpha, pa0, pa1, pa2, pa3);
            if (__any(alpha < 1.f)) { if (hi == 0) al_l[r32] = alpha; asm volatile("s_waitcnt lgkmcnt(0)" ::: "memory");
#pragma unroll
                for (int d_ = 0; d_ < 4; ++d_)
#pragma unroll
                    for (int r = 0; r < 16; ++r) o[d_][r] *= al_l[crow(r, hi)]; }
        }
        if (t + 2 < NT) BAR_VN(NDK + NDV); else if (t + 1 < NT) BAR_VN(NDV); else BAR_VN(0);
        rp = rc; rc = rn; rn = (rn == NRING - 1) ? 0 : rn + 1;
    }
    if (ACTW(NT - 1)) { SBAR(); pv_tile<0>(o, vb0 + rp * SHM_V, pa0, pa1, pa2, pa3); }
    if (grpA) BAR_L();
#undef BAR_VN
#undef ACTW
#undef DMA_K
#undef DMA_V
    if (hi == 0) li_l[r32] = l_reg; asm volatile("s_waitcnt lgkmcnt(0)" ::: "memory");
    bf16* stg = (bf16*)(lds + wid * 8192);
    const int lane_e = launder(lane);
#pragma unroll
    for (int r = 0; r < 16; ++r) { const int orow = crow(r, hi); const float rl = __builtin_amdgcn_rcpf(li_l[orow]);
#pragma unroll
        for (int d0 = 0; d0 < 4; ++d0) stg[orow * 128 + d0 * 32 + r32] = (bf16)f2bf(o[d0][r] * rl); }
    asm volatile("s_waitcnt lgkmcnt(0)" ::: "memory");
#pragma unroll
    for (int i = 0; i < 8; ++i) { const int row = i * 4 + (lane_e >> 4), ch = lane_e & 15;
        const u32x4 v = *(const u32x4*)(stg + row * 128 + ch * 8);
        const size_t go = (size_t)(q0 + wid * QBLK + row) * 2048 + ch * 8;
        const u32x4 g = *(const u32x4*)(Gp + go); u32x4 w;
        w.x = cvtpk(bflo(v.x) * bflo(g.x), bfhi(v.x) * bfhi(g.x)); w.y = cvtpk(bflo(v.y) * bflo(g.y), bfhi(v.y) * bfhi(g.y));
        w.z = cvtpk(bflo(v.z) * bflo(g.z), bfhi(v.z) * bfhi(g.z)); w.w = cvtpk(bflo(v.w) * bflo(g.w), bfhi(v.w) * bfhi(g.w));
        *(u32x4*)(Op + go) = w; }
    BAR_VL();
#undef BAR_L
#undef BAR_VL
}
#undef KSWZ
#undef SBAR
}

__device__ __forceinline__ void transpose_item(const float* W, int ldw, int K, const float* g, bf16* WT, int dst_row0, int src_col0, int nvalid, int k0, LAS float* scr, int lane) {
    const int n = lane & 31; const bool ok = (src_col0 >= 0) && (n < nvalid);
    float tv[32];
#pragma unroll
    for (int i = 0; i < 32; ++i) { const int kk = 2 * i + (lane >> 5); tv[i] = ok ? W[(size_t)(k0 + kk) * ldw + src_col0 + n] : 0.f; }
    if (g) {
#pragma unroll
        for (int i = 0; i < 32; ++i) tv[i] *= g[k0 + 2 * i + (lane >> 5)]; }
#pragma unroll
    for (int i = 0; i < 32; ++i) scr[(2 * i + (lane >> 5)) * 33 + n] = tv[i];
    asm volatile("s_waitcnt lgkmcnt(0)" ::: "memory");
    const int c = lane & 7;
#pragma unroll
    for (int j = 0; j < 4; ++j) { const int nn = (lane >> 3) + 8 * j; const LAS float* s = scr + (8 * c) * 33 + nn;
        u32x4 o; o.x = pk2(s[0 * 33], s[1 * 33]); o.y = pk2(s[2 * 33], s[3 * 33]); o.z = pk2(s[4 * 33], s[5 * 33]); o.w = pk2(s[6 * 33], s[7 * 33]);
        *(u32x4*)(WT + (size_t)(dst_row0 + nn) * K + k0 + 8 * c) = o; }
    asm volatile("s_waitcnt lgkmcnt(0)" ::: "memory");
}
__device__ __forceinline__ void win_src(int r0, int& src, int& nv) {
    nv = 32;
    if (r0 < 1280) src = r0;
    else if (r0 < 2304) src = 1344 + (r0 - 1280);
    else if (r0 < 3328) src = 2368 + (r0 - 2304);
    else if (r0 < 4352) src = 3392 + (r0 - 3328);
    else if (r0 < 5376) src = 4416 + (r0 - 4352);
    else if (r0 < 6400) src = 5448 + (r0 - 5376);
    else if (r0 == 6400) src = 1280;
    else if (r0 == 6432) { src = 5440; nv = 8; }
    else if (r0 == 6528) src = 1312;
    else src = -1;
}
__device__ __forceinline__ int wuq_src(int r0) {
    if (r0 < 1024) return (r0 >> 7) * 192 + (r0 & 127);
    const int q = r0 - 1024, t = q >> 8, bj = (q >> 7) & 1, wc = (q >> 5) & 3;
    return (4 * t + wc) * 192 + 128 + 32 * bj;
}


#define XB_TMO      128
#define XB_XCNT(j)  (256  + 64 * (j))
#define XB_XSUB(j)  (1280 + 64 * (j))
#define XB_XGEN(j)  (2304 + 64 * (j))
#define XB_TOP      3328
#define XB_TOPGEN   3392
#define XCD_BAR_WORDS 3456
#define XB_SPIN_CAP (1u << 18)
__device__ __forceinline__ unsigned xb_ld(unsigned* p)              { return __hip_atomic_load(p, __ATOMIC_RELAXED, __HIP_MEMORY_SCOPE_AGENT); }
__device__ __forceinline__ unsigned xb_add(unsigned* p, unsigned v) { return __hip_atomic_fetch_add(p, v, __ATOMIC_RELAXED, __HIP_MEMORY_SCOPE_AGENT); }
__device__ __forceinline__ unsigned xb_xcc_id() { return (unsigned)__builtin_amdgcn_s_getreg((3 << 11) | 20) & 0xFu; }
#define XB_SPIN(cond, bar) do { unsigned _sp = 0; while (cond) { __builtin_amdgcn_s_sleep(1); \
    if ((++_sp & 255u) == 0u) { if (xb_ld(&(bar)[XB_TMO])) break; if (_sp > XB_SPIN_CAP) { atomicAdd(&(bar)[XB_TMO], 1u); break; } } } } while (0)
struct XcdBarrier { unsigned* bar; unsigned x; volatile LAS unsigned* st; };
__device__ __forceinline__ XcdBarrier xcd_barrier_post(unsigned* bar, volatile LAS unsigned* st) {
    XcdBarrier b; b.bar = bar; b.x = xb_xcc_id(); b.st = st;
    if (threadIdx.x == 0) (void)xb_add(&bar[XB_XCNT(b.x)], 1u);
    return b;
}
__device__ __forceinline__ void xcd_barrier_complete(unsigned* bar, unsigned x, unsigned& nloc, unsigned& nx) {
    const unsigned G = gridDim.x * gridDim.y * gridDim.z;
    unsigned sum, cnt, mine, sp = 0u;
    for (;;) {
        sum = 0u; cnt = 0u; mine = 0u;
#pragma unroll
        for (unsigned j = 0; j < 16; ++j) { const unsigned c = xb_ld(&bar[XB_XCNT(j)]); sum += c; cnt += (c > 0u) ? 1u : 0u; mine = (j == x) ? c : mine; }
        if (sum == G) break;
        __builtin_amdgcn_s_sleep(1);
        if ((++sp & 255u) == 0u) { if (xb_ld(&bar[XB_TMO])) break; if (sp > XB_SPIN_CAP) { atomicAdd(&bar[XB_TMO], 1u); break; } }
    }
    nloc = mine > 0u ? mine : 1u; nx = cnt > 0u ? cnt : 1u;
}
__device__ __forceinline__ void xcd_barrier(const XcdBarrier& b) {
    asm volatile("s_waitcnt vmcnt(0)" ::: "memory");
    __syncthreads();
    if (threadIdx.x == 0) {
        unsigned* bar = b.bar;
        __builtin_amdgcn_s_waitcnt(0);
        unsigned nloc = b.st[0], nx = b.st[1];
        if (nloc == 0u) { xcd_barrier_complete(bar, b.x, nloc, nx); b.st[0] = nloc; b.st[1] = nx; }
        const unsigned old = xb_add(&bar[XB_XSUB(b.x)], 1u);
        const unsigned gen = old / nloc;
        if (old + 1u == (gen + 1u) * nloc) {
            __builtin_amdgcn_fence(__ATOMIC_RELEASE, "agent");
            asm volatile("s_waitcnt vmcnt(0)" ::: "memory");
            const unsigned og = xb_add(&bar[XB_TOP], 1u);
            const unsigned tg = og / nx;
            if (og + 1u == (tg + 1u) * nx) xb_add(&bar[XB_TOPGEN], 1u);
            else XB_SPIN(xb_ld(&bar[XB_TOPGEN]) == tg, bar);
            __builtin_amdgcn_fence(__ATOMIC_ACQUIRE, "agent");
            xb_add(&bar[XB_XGEN(b.x)], 1u);
            asm volatile("s_waitcnt vmcnt(0)" ::: "memory");
        } else {
            XB_SPIN(xb_ld(&bar[XB_XGEN(b.x)]) == gen, bar);
            __builtin_amdgcn_fence(__ATOMIC_ACQUIRE, "agent");
            asm volatile("s_waitcnt vmcnt(0)" ::: "memory");
        }
    }
    __syncthreads();
}

struct Args { const float* x; const int* pos; const float* g_pre; const float* w_in; const float* g_q; const float* w_uq; const float* g_kv; const float* w_ukv;
              const float* b_forget; const float* w_out; const float* g_post; float* out; unsigned char* ws; int ph_lo, ph_hi; };

__global__ void __launch_bounds__(512, 2) hybrid_fwd(Args a) {
    extern __shared__ __attribute__((aligned(16))) unsigned char lds[];
    cg::grid_group grid = cg::this_grid();
    const int tid_k = threadIdx.x, lane_k = tid_k & 63, wave = __builtin_amdgcn_readfirstlane(tid_k >> 6);
    const int G = gridDim.x, bx = blockIdx.x; const int vcu = (G % 8 == 0) ? (bx % 8) * (G / 8) + bx / 8 : bx;
    unsigned char* ws = a.ws;
    float* rstd_x = (float*)(ws + WS_RSTDX); float* partq = (float*)(ws + WS_PARTQ); float* partkv = (float*)(ws + WS_PARTKV); float* party = (float*)(ws + WS_PARTY);
    float* flog = (float*)(ws + WS_FLOG); float* cf = (float*)(ws + WS_CF); float* cosT = (float*)(ws + WS_COS); float* sinT = (float*)(ws + WS_SIN);
    bf16* Win_t = (bf16*)(ws + WS_WIN); bf16* Wuq_t = (bf16*)(ws + WS_WUQ); bf16* Wukv_t = (bf16*)(ws + WS_WUKV); bf16* Wout_t = (bf16*)(ws + WS_WOUT);
    bf16* Xb = (bf16*)(ws + WS_XB); bf16* Ob = (bf16*)(ws + WS_O); bf16* qlat = (bf16*)(ws + WS_QLAT); bf16* kvlat = (bf16*)(ws + WS_KVLAT); bf16* Gb = (bf16*)(ws + WS_G);
    bf16* Qf = (bf16*)(ws + WS_QF); bf16* Kf = (bf16*)(ws + WS_KF); bf16* Vf = (bf16*)(ws + WS_VF); bf16* Yb = (bf16*)(ws + WS_Y);
    bf16* Qm = (bf16*)(ws + WS_QM); bf16* Km = (bf16*)(ws + WS_KM); bf16* Vm = (bf16*)(ws + WS_VM);
    const int lo = a.ph_lo, hi = a.ph_hi;
#ifndef PH_MASK
#define PH_MASK 63
#endif
#define IN(k) (((PH_MASK >> (k)) & 1) && lo <= (k) && (k) < hi)
#define BOTH(k) (IN(k) && IN((k) + 1))
    LAS unsigned char* ldsl = (LAS unsigned char*)lds;
    volatile LAS unsigned* bst = (volatile LAS unsigned*)(ldsl + LDS_BYTES - 64);
    if (tid_k < 2) bst[tid_k] = 0u;
    __syncthreads();
    XcdBarrier xbar = xcd_barrier_post((unsigned*)(ws + WS_CTL), bst);

    if (IN(0)) for (int rep_ = 0; rep_ < PROBE_REP0; ++rep_) {
        const int lane = launder(lane_k), tid = launder(tid_k);
        LAS float* scr = (LAS float*)(ldsl + wave * 16384);
        const int gw = vcu * 8 + wave, NGW = G * 8;
        constexpr int I_IN = 32 * 208, I_UQ = 12 * 48, I_UKV = 8 * 64, I_OUT = 32 * 64, NITEMS = I_IN + I_UQ + I_UKV + I_OUT;
        for (int it = gw; it < NITEMS; it += NGW) {
            int r = it;
            if (r < I_IN) { const int kb = r / 208, nb = r % 208; int src, nv; win_src(nb * 32, src, nv); transpose_item(a.w_in, DIN, 2048, a.g_pre, Win_t, nb * 32, src, nv, kb * 64, scr, lane); continue; } r -= I_IN;
            if (r < I_UQ) { const int kb = r / 48, nb = r % 48; transpose_item(a.w_uq, 1536, 768, a.g_q, Wuq_t, nb * 32, wuq_src(nb * 32), 32, kb * 64, scr, lane); continue; } r -= I_UQ;
            if (r < I_UKV) { const int kb = r / 64, nb = r % 64; transpose_item(a.w_ukv, 2048, 512, a.g_kv, Wukv_t, nb * 32, nb * 32, 32, kb * 64, scr, lane); continue; } r -= I_UKV;
            { const int kb = r / 64, nb = r % 64; transpose_item(a.w_out, 2048, 2048, nullptr, Wout_t, nb * 32, nb * 32, 32, kb * 64, scr, lane); }
        }
        for (int m = gw; m < M; m += 2 * NGW) {
            const int m2 = m + NGW;
            const f32x4* xr = (const f32x4*)(a.x + (size_t)m * DM) + lane; const f32x4* xr2 = (const f32x4*)(a.x + (size_t)m2 * DM) + lane; f32x4 v[8], v2[8]; float s = 0.f, s2 = 0.f;
#pragma unroll
            for (int j = 0; j < 8; ++j) { v[j] = __builtin_nontemporal_load(xr + 64 * j); v2[j] = __builtin_nontemporal_load(xr2 + 64 * j); }
#pragma unroll
            for (int j = 0; j < 8; ++j) { s += (v[j][0] * v[j][0] + v[j][1] * v[j][1]) + (v[j][2] * v[j][2] + v[j][3] * v[j][3]); s2 += (v2[j][0] * v2[j][0] + v2[j][1] * v2[j][1]) + (v2[j][2] * v2[j][2] + v2[j][3] * v2[j][3]); }
            s = wave_sum(s); s2 = wave_sum(s2);
            if (lane == 0) { rstd_x[m] = 1.f / sqrtf(s * (1.f / DM) + EPS); rstd_x[m2] = 1.f / sqrtf(s2 * (1.f / DM) + EPS); }
            u32x2* o8 = (u32x2*)(Xb + (size_t)m * DM) + lane; u32x2* o82 = (u32x2*)(Xb + (size_t)m2 * DM) + lane;
#pragma unroll
            for (int j = 0; j < 8; ++j) { u32x2 w; w.x = pk2(v[j][0], v[j][1]); w.y = pk2(v[j][2], v[j][3]); o8[64 * j] = w; u32x2 w2; w2.x = pk2(v2[j][0], v2[j][1]); w2.y = pk2(v2[j][2], v2[j][3]); o82[64 * j] = w2; }
        }
        for (int e = (vcu * 512 + tid); e < M * 32; e += G * 512) { const int row = e >> 5, i = e & 31;
            const float inv = exp2f(-(float)i * (13.287712379549449f / 32.f)); const float ang = (float)a.pos[row] * inv;
            const float n = rintf(ang * 0.15915494309189535f); float r = fmaf(-n, 6.28318548202514648f, ang); r = fmaf(-n, -1.7484555e-7f, r);
            cosT[e] = __cosf(r); sinT[e] = __sinf(r); }
    }
    if (BOTH(0)) grid.sync();

    if (IN(1)) for (int rep_ = 0; rep_ < PROBE_REP1; ++rep_) {
        pg8::Gemm g{Xb, Win_t, M, NIN_PAD, 2048}; pg8::StaticOrder S; S.init(M, NIN_PAD, G, bx);
        EpiIn E{rstd_x, qlat, kvlat, Gb, Qf, Kf, Vf, Km, flog, partq, partkv, cosT, sinT};
        pg8::gemm_phase<EpiIn, pg8::StaticOrder, true, true>(ldsl, g, S, E);
    }
    if (BOTH(1)) xcd_barrier(xbar);

    if (IN(2)) for (int rep_ = 0; rep_ < PROBE_REP2; ++rep_) {
        const int lane = launder(lane_k), tid = launder(tid_k);
        if (bx < BATCH * NH) {
            const int b = bx >> 3, h = bx & 7; const float bf = a.b_forget[h];
            const float* fl = flog + ((size_t)b * SEQ + 8 * tid) * 8 + h; float lf[8];
#pragma unroll
            for (int j = 0; j < 8; ++j) lf[j] = fl[j * 8] + bf;
#pragma unroll
            for (int j = 0; j < 8; ++j) { const float z = lf[j]; lf[j] = fminf(z, 0.f) - log1pf(expf(-fabsf(z))); }
#pragma unroll
            for (int j = 1; j < 8; ++j) lf[j] += lf[j - 1];
            float incl = lf[7];
#pragma unroll
            for (int o = 1; o < 64; o <<= 1) { const float t = __shfl_up(incl, o); if (lane >= o) incl += t; }
            volatile LAS float* wtot = (volatile LAS float*)(ldsl + LDS_BYTES - 128);
            if (lane == 63) wtot[wave] = incl;
            __syncthreads();
            float off = incl - lf[7];
            for (int w2 = 0; w2 < wave; ++w2) off += wtot[w2];
            float* cp = cf + (size_t)bx * SEQ + 8 * tid;
            f32x4 o0, o1;
#pragma unroll
            for (int j = 0; j < 4; ++j) { o0[j] = (off + lf[j]) * LOG2E; o1[j] = (off + lf[4 + j]) * LOG2E; }
            *(f32x4*)cp = o0; *(f32x4*)(cp + 4) = o1;
            __syncthreads();
        }
        { pg8::Gemm g{qlat, Wuq_t, M, 1536, QRANK}; pg8::StaticOrder S; S.init(M, 1536, G, bx);
          EpiQ E{partq, Qm, cosT, sinT};
          pg8::gemm_phase<EpiQ, pg8::StaticOrder, true, true>(ldsl, g, S, E); }
        { pg8::Gemm g{kvlat, Wukv_t, M, 2048, KVRANK}; pg8::StaticOrder S; S.init(M, 2048, G, bx);
          EpiKV E{partkv, Km, Vm};
          pg8::gemm_phase<EpiKV, pg8::StaticOrder, true, true>(ldsl, g, S, E); }
    }
    if (BOTH(2)) xcd_barrier(xbar);

    if (IN(3)) for (int rep_ = 0; rep_ < PROBE_REP3; ++rep_) {
        for (int v = vcu; v < 256; v += G) {
            const int s = v & 3, w = v >> 2, b = w >> 4, hh = w & 15, hd = hh & 7, swp = hh >> 3;
            const size_t rb = (size_t)b * SEQ;
#pragma unroll 1
            for (int i = 0; i < 2; ++i) {
                const int qb = __builtin_amdgcn_readfirstlane(swp ? (i == 0 ? 8 + s : 7 - s) : (i == 0 ? 15 - s : s));
                att::attn_unit<192, false>((char*)lds, Qm + rb * 1536 + hd * 192, 1536, Km + rb * 1536 + hd * 192, 1536, Vm + rb * 1024 + hd * 128, 1024, nullptr,
                                           Gb + rb * 2048 + hd * 128, Ob + rb * 2048 + hd * 128, qb);
            }
#pragma unroll 1
            for (int i = 0; i < 2; ++i) {
                const int qb = __builtin_amdgcn_readfirstlane(swp ? (i == 0 ? 15 - s : s) : (i == 0 ? 8 + s : 7 - s));
                att::attn_unit<128, true>((char*)lds, Qf + rb * 1024 + hd * 128, 1024, Kf + rb * 1024 + hd * 128, 1024, Vf + rb * 1024 + hd * 128, 1024, cf + (size_t)(b * 8 + hd) * SEQ,
                                          Gb + rb * 2048 + 1024 + hd * 128, Ob + rb * 2048 + 1024 + hd * 128, qb);
            }
        }
    }
    if (BOTH(3)) xcd_barrier(xbar);

    if (IN(4)) for (int rep_ = 0; rep_ < PROBE_REP4; ++rep_) {
        pg8::Gemm g{Ob, Wout_t, M, 2048, 2048}; pg8::StaticOrder S; S.init(M, 2048, G, bx);
        EpiOut E{Yb, party};
        pg8::gemm_phase<EpiOut, pg8::StaticOrder, true, true>(ldsl, g, S, E);
    }
    if (BOTH(4)) xcd_barrier(xbar);

    if (IN(5)) for (int rep_ = 0; rep_ < PROBE_REP5; ++rep_) {
        const int lane = launder(lane_k);
        const int gw = vcu * 8 + wave, NGW = G * 8;
        const f32x4* gp = (const f32x4*)a.g_post + lane; f32x4 gv[8];
#pragma unroll
        for (int j = 0; j < 8; ++j) gv[j] = gp[64 * j];
        for (int m = gw; m < M; m += 2 * NGW) {
            const int m2 = m + NGW;
            float s = (lane < 32) ? party[(size_t)m * 32 + lane] : 0.f, s2 = (lane < 32) ? party[(size_t)m2 * 32 + lane] : 0.f;
            const f32x4* xr = (const f32x4*)(a.x + (size_t)m * DM) + lane; const f32x4* xr2 = (const f32x4*)(a.x + (size_t)m2 * DM) + lane;
            const u32x2* yr = (const u32x2*)(Yb + (size_t)m * DM) + lane; const u32x2* yr2 = (const u32x2*)(Yb + (size_t)m2 * DM) + lane;
            f32x4 xv[8], xv2[8]; u32x2 y[8], y2[8];
#pragma unroll
            for (int j = 0; j < 8; ++j) { xv[j] = __builtin_nontemporal_load(xr + 64 * j); xv2[j] = __builtin_nontemporal_load(xr2 + 64 * j); y[j] = __builtin_nontemporal_load(yr + 64 * j); y2[j] = __builtin_nontemporal_load(yr2 + 64 * j); }
            s = wave_sum(s); s2 = wave_sum(s2);
            const float rs = 1.f / sqrtf(s * (1.f / DM) + EPS), rs2 = 1.f / sqrtf(s2 * (1.f / DM) + EPS);
            f32x4* orow = (f32x4*)(a.out + (size_t)m * DM) + lane; f32x4* orow2 = (f32x4*)(a.out + (size_t)m2 * DM) + lane;
#pragma unroll
            for (int j = 0; j < 8; ++j) {
                f32x4 o; o[0] = xv[j][0] + bflo(y[j].x) * rs * gv[j][0]; o[1] = xv[j][1] + bfhi(y[j].x) * rs * gv[j][1]; o[2] = xv[j][2] + bflo(y[j].y) * rs * gv[j][2]; o[3] = xv[j][3] + bfhi(y[j].y) * rs * gv[j][3];
                __builtin_nontemporal_store(o, orow + 64 * j);
                f32x4 o2; o2[0] = xv2[j][0] + bflo(y2[j].x) * rs2 * gv[j][0]; o2[1] = xv2[j][1] + bfhi(y2[j].x) * rs2 * gv[j][1]; o2[2] = xv2[j][2] + bflo(y2[j].y) * rs2 * gv[j][2]; o2[3] = xv2[j][3] + bfhi(y2[j].y) * rs2 * gv[j][3];
                __builtin_nontemporal_store(o2, orow2 + 64 * j); }
        }
    }
#undef IN
#undef BOTH
}

extern "C" void kernel_launch(void* const* d_in, const int* in_sizes, int n_in, void* d_out, int out_size, void* d_ws, size_t ws_size, hipStream_t stream) {
    static int grid = 0;
    if (grid == 0) {
        if (n_in != 11 || in_sizes[0] != M * DM || out_size != M * DM || ws_size < WS_END) { fprintf(stderr, "kernel_launch: shape mismatch n_in %d in0 %d out %d ws %zu\n", n_in, n_in > 0 ? in_sizes[0] : -1, out_size, ws_size); grid = -1; return; }
        int dev = 0, cus = 0, per_cu = 0;
        if (hipGetDevice(&dev) != hipSuccess || hipDeviceGetAttribute(&cus, hipDeviceAttributeMultiprocessorCount, dev) != hipSuccess) { grid = -1; return; }
        if (hipFuncSetAttribute((const void*)hybrid_fwd, hipFuncAttributeMaxDynamicSharedMemorySize, LDS_BYTES) != hipSuccess) { fprintf(stderr, "kernel_launch: hipFuncSetAttribute failed\n"); grid = -1; return; }
        if (hipOccupancyMaxActiveBlocksPerMultiprocessor(&per_cu, (const void*)hybrid_fwd, 512, LDS_BYTES) != hipSuccess || per_cu < 1) { fprintf(stderr, "kernel_launch: occupancy query says %d\n", per_cu); per_cu = 1; }
        (void)hipGetLastError();
        grid = cus;
    }
    if (grid < 0) return;
    if (hipMemsetAsync((char*)d_ws + WS_CTL, 0, CTL_BYTES, stream) != hipSuccess) { fprintf(stderr, "kernel_launch: memset failed\n"); return; }
    Args a{};
    a.x = (const float*)d_in[0]; a.pos = (const int*)d_in[1]; a.g_pre = (const float*)d_in[2]; a.w_in = (const float*)d_in[3]; a.g_q = (const float*)d_in[4]; a.w_uq = (const float*)d_in[5];
    a.g_kv = (const float*)d_in[6]; a.w_ukv = (const float*)d_in[7]; a.b_forget = (const float*)d_in[8]; a.w_out = (const float*)d_in[9]; a.g_post = (const float*)d_in[10];
    a.out = (float*)d_out; a.ws = (unsigned char*)d_ws;
#if MK_N_LAUNCHES == 1
    a.ph_lo = 0; a.ph_hi = 6;
    void* args[] = {&a};
    hipError_t e = hipLaunchCooperativeKernel((const void*)hybrid_fwd, dim3(grid), dim3(512), args, LDS_BYTES, stream);
    if (e != hipSuccess) fprintf(stderr, "cooperative launch failed: %s (grid %d)\n", hipGetErrorString(e), grid);
#else
    for (int p = 0; p < 6; ++p) { a.ph_lo = p; a.ph_hi = p + 1; for (int r = 0; r < (p == PROBE_DUP ? 2 : 1); ++r) hipLaunchKernelGGL(hybrid_fwd, dim3(grid), dim3(512), LDS_BYTES, stream, a); }
#endif
}
```

```cpp
#include <hip/hip_runtime.h>
#include <hip/hip_cooperative_groups.h>
#include <cstdio>
#include <cstdint>
namespace cg = cooperative_groups;

#ifndef PROBE_REP0
#define PROBE_REP0 1
#endif
#ifndef PROBE_REP1
#define PROBE_REP1 1
#endif
#ifndef PROBE_REP2
#define PROBE_REP2 1
#endif
#ifndef PROBE_REP3
#define PROBE_REP3 1
#endif
#ifndef PROBE_REP4
#define PROBE_REP4 1
#endif
#ifndef PROBE_REP5
#define PROBE_REP5 1
#endif
#ifndef PROBE_ABL
#define PROBE_ABL -1
#endif
#ifndef PROBE_DUP
#define PROBE_DUP -1
#endif
#ifndef MK_N_LAUNCHES
#define MK_N_LAUNCHES 1
#endif

namespace pg8 {
#define PG8_LAS __attribute__((address_space(3)))
typedef unsigned short bf16_t;
typedef short bf16x8 __attribute__((ext_vector_type(8)));
typedef float f32x4 __attribute__((ext_vector_type(4)));
typedef unsigned u32x4 __attribute__((ext_vector_type(4)));
constexpr int BM = 256, BK = 64, HALF = 128, HTB = HALF * BK * 2, STAGE_BYTES = 8 * HTB, NXCD = 8, WGM = 8;

__host__ __device__ __forceinline__ int lds_byte(int r, int c) { const int st = (r >> 4) * 2 + (c >> 5), rr = r & 15, cc = c & 31, ob = rr * 64 + cc * 2; return st * 1024 + (ob ^ (((ob >> 9) & 1) << 5)); }
__host__ __device__ __forceinline__ void stage_rc(int b, int& R, int& C) { const int st = b / 1024, sb = b % 1024, swz = sb ^ (((sb >> 9) & 1) << 5); R = (st >> 1) * 16 + swz / 64; C = (st & 1) * 32 + (swz % 64) / 2; }
__host__ __device__ __forceinline__ int perm32(int rho) { const int n = rho >> 4, i = rho & 15; return 8 * (i >> 2) + 4 * n + (i & 3); }

struct Unit { int pm, pn; };
struct Gemm { const bf16_t* A; const bf16_t* Bt; int M, N, K; };

struct StaticOrder {
    int nM, nN, nwg, G, c;
    __host__ __device__ void init(int M, int N, int G_, int c_) { nM = M / BM; nN = N / BM; nwg = nM * nN; G = G_; c = c_; }
    __host__ __device__ bool next(int i, Unit& u) const {
        const long L = (long)i * G + c; if (L >= nwg) return false;
        int wgid = (int)L; { const int q = nwg / NXCD, r = nwg % NXCD, xcd = wgid % NXCD, off = wgid / NXCD; wgid = (xcd < r ? xcd * (q + 1) : r * (q + 1) + (xcd - r) * q) + off; }
        const int nig = WGM * nN, gid = wgid / nig, fm = gid * WGM, gsz = (nM - fm) < WGM ? (nM - fm) : WGM;
        u.pm = fm + ((wgid % nig) % gsz); u.pn = (wgid % nig) / gsz; return true;
    }
    __device__ __forceinline__ void a_ready(const Unit&) const {}
    __device__ __forceinline__ void done(const Unit&) const {}
};

__device__ __forceinline__ unsigned cvt_pk_bf16(float lo, float hi) { unsigned r; asm volatile("v_cvt_pk_bf16_f32 %0, %1, %2" : "=v"(r) : "v"(lo), "v"(hi)); return r; }

template <class Epi, class Sched, bool ALIGN_EPI = false, bool SP2 = false>
__device__ __forceinline__ void gemm_phase(PG8_LAS unsigned char* lds, const Gemm g, const Sched& S, const Epi& E) {
    const int tid = threadIdx.x, wid = __builtin_amdgcn_readfirstlane(tid >> 6), lane = tid & 63, wr = wid >> 2, wc = wid & 3, fr = lane & 15, fq = lane >> 4;
    const int K = g.K, nt = K / BK;
    unsigned voffA[2], voffB[2];
#pragma unroll
    for (int i = 0; i < 2; ++i) { int R, C; stage_rc(tid * 16 + i * 8192, R, C); const int Rb = Epi::PERM ? ((R & ~31) + perm32(R & 31)) : R;
        voffA[i] = (unsigned)(R * K + C) * 2u; voffB[i] = (unsigned)(Rb * K + C) * 2u; }
    const size_t kstep = (size_t)(BK * 2);
    const size_t hstep = (size_t)HALF * K * 2;
    const size_t tstep = 2 * hstep;
    const unsigned ldsw = (unsigned)wid * 1024u;
    const int aoff = lds_byte(wr * 64 + fr, fq * 8), boff = lds_byte(wc * 32 + fr, fq * 8);
#define PG8_SA(b, h) (((b) * 2 + (h)) * HTB)
#define PG8_SB(b, h) ((4 + (b) * 2 + (h)) * HTB)
#define PG8_STAGE(bufoff, gbase, voff) do { _Pragma("unroll") for (int _i = 0; _i < 2; ++_i) \
        __builtin_amdgcn_global_load_lds((const unsigned*)((const char*)(gbase) + (voff)[_i]), (PG8_LAS unsigned*)(lds + (bufoff) + ldsw + _i * 8192), 16, 0, 0); } while (0)
#define PG8_LDA(dst, b, h) do { _Pragma("unroll") for (int m = 0; m < 4; ++m) _Pragma("unroll") for (int k = 0; k < 2; ++k) dst[m][k] = *(const PG8_LAS bf16x8*)(lds + PG8_SA(b, h) + aoff + m * 2048 + k * 1024); } while (0)
#define PG8_LDB(dst, b, h) do { _Pragma("unroll") for (int n = 0; n < 2; ++n) _Pragma("unroll") for (int k = 0; k < 2; ++k) dst[n][k] = *(const PG8_LAS bf16x8*)(lds + PG8_SB(b, h) + boff + n * 2048 + k * 1024); } while (0)
#define PG8_MMA(ai, bj, At, Bt) do { __builtin_amdgcn_s_setprio(1); _Pragma("unroll") for (int m = 0; m < 4; ++m) _Pragma("unroll") for (int n = 0; n < 2; ++n) _Pragma("unroll") for (int k = 0; k < 2; ++k) \
        acc[ai][bj][m][n] = __builtin_amdgcn_mfma_f32_16x16x32_bf16(Bt[n][k], At[m][k], acc[ai][bj][m][n], 0, 0, 0); __builtin_amdgcn_s_setprio(0); } while (0)
#define PG8_WAIT_V(n) asm volatile("s_waitcnt vmcnt(" #n ")" ::: "memory")
#define PG8_WAIT_L(n) asm volatile("s_waitcnt lgkmcnt(" #n ")" ::: "memory")
#define PG8_BAR __builtin_amdgcn_s_barrier()
#define PG8_SCHED __builtin_amdgcn_sched_barrier(0)
    Unit cur, nxt; int ui = 0;
    if (!S.next(0, cur)) return;
    f32x4 acc[2][2][4][2];
#pragma unroll
    for (int a = 0; a < 2; ++a)
#pragma unroll
        for (int b = 0; b < 2; ++b)
#pragma unroll
            for (int m = 0; m < 4; ++m)
#pragma unroll
                for (int n = 0; n < 2; ++n) acc[a][b][m][n] = (f32x4){0.f, 0.f, 0.f, 0.f};
    bf16x8 At[4][2], B0[2][2], B1[2][2];
    const char* cA = (const char*)g.A + (size_t)cur.pm * tstep; const char* cB = (const char*)g.Bt + (size_t)cur.pn * tstep;
    S.a_ready(cur);
    if constexpr (SP2) {
        PG8_STAGE(PG8_SB(0, 0), cB, voffB); PG8_STAGE(PG8_SB(0, 1), cB + hstep, voffB); PG8_STAGE(PG8_SA(0, 0), cA, voffA); PG8_STAGE(PG8_SA(0, 1), cA + hstep, voffA);
        if (wr == 1) PG8_BAR;
        PG8_WAIT_V(2); PG8_BAR;
        PG8_STAGE(PG8_SB(1, 0), cB + kstep, voffB); PG8_STAGE(PG8_SA(1, 0), cA + kstep, voffA); PG8_STAGE(PG8_SB(1, 1), cB + hstep + kstep, voffB);
        PG8_WAIT_V(6); PG8_BAR;
    } else {
        PG8_STAGE(PG8_SB(0, 0), cB, voffB); PG8_STAGE(PG8_SA(0, 0), cA, voffA); PG8_STAGE(PG8_SB(0, 1), cB + hstep, voffB); PG8_STAGE(PG8_SA(0, 1), cA + hstep, voffA);
        if (wr == 1) PG8_BAR;
        PG8_WAIT_V(4); PG8_BAR;
        PG8_STAGE(PG8_SB(1, 0), cB + kstep, voffB); PG8_STAGE(PG8_SA(1, 0), cA + kstep, voffA); PG8_STAGE(PG8_SB(1, 1), cB + hstep + kstep, voffB);
        PG8_WAIT_V(6); PG8_BAR;
    }
    for (;;) {
        const bool has_next = S.next(ui + 1, nxt);
        const char* nA = has_next ? (const char*)g.A + (size_t)nxt.pm * tstep : cA; const char* nB = has_next ? (const char*)g.Bt + (size_t)nxt.pn * tstep : cB;
        for (int t = 0; t < nt; t += 2) {
            const bool last = (t == nt - 2);
            const char* a1 = cA + (size_t)(t + 1) * kstep;
            const char* a2 = last ? nA : cA + (size_t)(t + 2) * kstep; const char* b2 = last ? nB : cB + (size_t)(t + 2) * kstep;
            const char* a3 = a2 + kstep; const char* b3 = b2 + kstep;
            if (last && has_next) S.a_ready(nxt);
            if constexpr (SP2) {
            PG8_LDB(B0, 0, 0); PG8_LDB(B1, 0, 1); PG8_SCHED; PG8_LDA(At, 0, 0); PG8_STAGE(PG8_SA(1, 1), a1 + hstep, voffA);
            PG8_WAIT_V(8); PG8_WAIT_L(0); PG8_BAR; PG8_MMA(0, 0, At, B0); PG8_MMA(0, 1, At, B1); PG8_BAR; PG8_SCHED;
            PG8_LDA(At, 0, 1); PG8_STAGE(PG8_SB(0, 0), b2, voffB); PG8_STAGE(PG8_SB(0, 1), b2 + hstep, voffB); PG8_STAGE(PG8_SA(0, 0), a2, voffA);
            PG8_WAIT_V(8); PG8_WAIT_L(0); PG8_BAR; PG8_MMA(1, 0, At, B0); PG8_MMA(1, 1, At, B1); PG8_BAR; PG8_SCHED;
            PG8_LDB(B0, 1, 0); PG8_LDB(B1, 1, 1); PG8_SCHED; PG8_LDA(At, 1, 0); PG8_STAGE(PG8_SA(0, 1), a2 + hstep, voffA);
            PG8_WAIT_V(8); PG8_WAIT_L(0); PG8_BAR; PG8_MMA(0, 0, At, B0); PG8_MMA(0, 1, At, B1); PG8_BAR; PG8_SCHED;
            PG8_LDA(At, 1, 1); PG8_STAGE(PG8_SB(1, 0), b3, voffB); PG8_STAGE(PG8_SB(1, 1), b3 + hstep, voffB); PG8_STAGE(PG8_SA(1, 0), a3, voffA);
            PG8_WAIT_V(8); PG8_WAIT_L(0); PG8_BAR; PG8_MMA(1, 0, At, B0); PG8_MMA(1, 1, At, B1); PG8_BAR; PG8_SCHED;
            } else {
            PG8_LDB(B0, 0, 0); PG8_SCHED; PG8_LDA(At, 0, 0); PG8_STAGE(PG8_SA(1, 1), a1 + hstep, voffA);
            PG8_WAIT_L(8); PG8_BAR; PG8_WAIT_L(0); PG8_MMA(0, 0, At, B0); PG8_BAR; PG8_SCHED;
            PG8_LDB(B1, 0, 1); PG8_STAGE(PG8_SB(0, 0), b2, voffB);
            PG8_BAR; PG8_WAIT_L(0); PG8_MMA(0, 1, At, B1); PG8_BAR;
            PG8_LDA(At, 0, 1); PG8_STAGE(PG8_SA(0, 0), a2, voffA);
            PG8_BAR; PG8_WAIT_L(0); PG8_MMA(1, 0, At, B0); PG8_BAR; PG8_SCHED;
            PG8_STAGE(PG8_SB(0, 1), b2 + hstep, voffB);
            PG8_WAIT_V(6); PG8_BAR; PG8_MMA(1, 1, At, B1); PG8_BAR;
            PG8_LDB(B0, 1, 0); PG8_SCHED; PG8_LDA(At, 1, 0); PG8_STAGE(PG8_SA(0, 1), a2 + hstep, voffA);
            PG8_WAIT_L(8); PG8_BAR; PG8_WAIT_L(0); PG8_MMA(0, 0, At, B0); PG8_BAR; PG8_SCHED;
            PG8_LDB(B1, 1, 1); PG8_STAGE(PG8_SB(1, 0), b3, voffB);
            PG8_BAR; PG8_WAIT_L(0); PG8_MMA(0, 1, At, B1); PG8_BAR;
            PG8_LDA(At, 1, 1); PG8_STAGE(PG8_SA(1, 0), a3, voffA);
            PG8_BAR; PG8_WAIT_L(0); PG8_MMA(1, 0, At, B0); PG8_BAR; PG8_SCHED;
            PG8_STAGE(PG8_SB(1, 1), b3 + hstep, voffB);
            PG8_WAIT_V(6); PG8_BAR; PG8_MMA(1, 1, At, B1); PG8_BAR;
            }
        }
        if constexpr (ALIGN_EPI) { if (wr == 0) PG8_BAR; }
        if constexpr (!Epi::AFTER_DRAIN) { E(acc, cur, wr, wc, fr, fq); S.done(cur); }
        if (!has_next) break;
#pragma unroll
        for (int a = 0; a < 2; ++a)
#pragma unroll
            for (int b = 0; b < 2; ++b)
#pragma unroll
                for (int m = 0; m < 4; ++m)
#pragma unroll
                    for (int n = 0; n < 2; ++n) acc[a][b][m][n] = (f32x4){0.f, 0.f, 0.f, 0.f};
        cur = nxt; cA = nA; cB = nB; ++ui;
        if constexpr (ALIGN_EPI) { if (wr == 1) PG8_BAR; }
    }
    PG8_WAIT_V(0);
    if constexpr (!ALIGN_EPI) { if (wr == 0) PG8_BAR; }
    PG8_BAR;
#undef PG8_SA
#undef PG8_SB
#undef PG8_STAGE
#undef PG8_LDA
#undef PG8_LDB
#undef PG8_MMA
#undef PG8_WAIT_V
#undef PG8_WAIT_L
#undef PG8_BAR
#undef PG8_SCHED
}
}

typedef unsigned short bf16;
typedef float f32x4 __attribute__((ext_vector_type(4)));
typedef unsigned u32x4 __attribute__((ext_vector_type(4)));
typedef unsigned u32x2 __attribute__((ext_vector_type(2)));
typedef short bf16x8 __attribute__((ext_vector_type(8)));
typedef short s16x4 __attribute__((ext_vector_type(4)));
typedef float f32x16 __attribute__((ext_vector_type(16)));
#define LAS __attribute__((address_space(3)))

constexpr int BATCH = 4, SEQ = 4096, DM = 2048, M = BATCH * SEQ;
constexpr int NH = 8, QKD = 192, QRANK = 768, KVRANK = 512, DIN = 6472;
constexpr int NIN_PAD = 6656;
constexpr float EPS = 1e-6f;
constexpr float LOG2E = 1.4426950408889634f;
constexpr float C2M = 0.07216878364870322f * LOG2E;
constexpr float C2F = 0.08838834764831845f * LOG2E;

constexpr size_t MiB = 1u << 20;
constexpr size_t WS_RSTDX = 0, WS_PARTQ = 1 * MiB, WS_PARTKV = 2 * MiB, WS_PARTY = 3 * MiB, WS_FLOG = 5 * MiB, WS_CF = 6 * MiB, WS_COS = 7 * MiB, WS_SIN = 9 * MiB;
constexpr size_t WS_CTL = 11 * MiB, CTL_BYTES = 16384;
constexpr size_t WS_WIN = 16 * MiB, WS_WUQ = 42 * MiB, WS_WUKV = 45 * MiB, WS_WOUT = 47 * MiB;
constexpr size_t WS_XB = 56 * MiB, WS_O = 56 * MiB;
constexpr size_t WS_QLAT = 120 * MiB, WS_KVLAT = 144 * MiB, WS_G = 160 * MiB;
constexpr size_t WS_QF = 224 * MiB, WS_Y = 224 * MiB, WS_KF = 256 * MiB, WS_VF = 288 * MiB;
constexpr size_t WS_QM = 320 * MiB, WS_KM = 368 * MiB, WS_VM = 416 * MiB, WS_END = 448 * MiB;

constexpr int LDS_BYTES = 163840;

__device__ __forceinline__ unsigned f2bf(float f) { unsigned u = __builtin_bit_cast(unsigned, f); return (u + 0x7fffu + ((u >> 16) & 1u)) >> 16; }
__device__ __forceinline__ unsigned pk2(float lo, float hi) { return pg8::cvt_pk_bf16(lo, hi); }
__device__ __forceinline__ float bflo(unsigned w) { return __builtin_bit_cast(float, w << 16); }
__device__ __forceinline__ float bfhi(unsigned w) { return __builtin_bit_cast(float, w & 0xffff0000u); }
__device__ __forceinline__ int launder(int v) { asm volatile("" : "+v"(v)); return v; }
__device__ __forceinline__ float wave_sum(float v) {
#pragma unroll
    for (int o = 1; o < 64; o <<= 1) v += __shfl_xor(v, o);
    return v;
}
__device__ __forceinline__ float silu_f(float v) { return v * __builtin_amdgcn_rcpf(1.f + __builtin_amdgcn_exp2f(-v * LOG2E)); }
__device__ __forceinline__ u32x4 pack8f(f32x4 a, f32x4 b) { u32x4 w; w.x = pk2(a[0], a[1]); w.y = pk2(a[2], a[3]); w.z = pk2(b[0], b[1]); w.w = pk2(b[2], b[3]); return w; }

typedef pg8::f32x4 af4;
struct EpiIn {
    static constexpr bool PERM = true, AFTER_DRAIN = false;
    const float* rstd_x; bf16 *qlat, *kvlat, *G, *Qf, *Kf, *Vf, *Km; float *flog, *partq, *partkv; const float *cosT, *sinT;
    __device__ __forceinline__ void operator()(const af4 (&acc)[2][2][4][2], const pg8::Unit& u, int wr, int wc, int fr, int fq) const {
        const int pn = u.pn; const int row0 = u.pm * 256 + wr * 64 + fr;
        if (pn == 25) {
            if (wc == 0) {
#pragma unroll
                for (int ai = 0; ai < 2; ++ai)
#pragma unroll
                    for (int m = 0; m < 4; ++m) { const int row = row0 + ai * 128 + m * 16; const float rs = rstd_x[row];
                        f32x4 o1[2], o2[2];
#pragma unroll
                        for (int n = 0; n < 2; ++n) { const f32x4 c = *(const f32x4*)(cosT + (size_t)row * 32 + 8 * fq + 4 * n), s = *(const f32x4*)(sinT + (size_t)row * 32 + 8 * fq + 4 * n);
                            const f32x4 x1 = acc[ai][0][m][n] * rs, x2 = acc[ai][1][m][n] * rs; o1[n] = x1 * c - x2 * s; o2[n] = x2 * c + x1 * s; }
                        const u32x4 w1 = pack8f(o1[0], o1[1]), w2 = pack8f(o2[0], o2[1]);
                        bf16* kp = Km + (size_t)row * 1536 + 128 + 8 * fq;
#pragma unroll
                        for (int h = 0; h < 8; ++h) { *(u32x4*)(kp + h * 192) = w1; *(u32x4*)(kp + h * 192 + 32) = w2; } }
            } else if (wc == 1 && fq == 0) {
#pragma unroll
                for (int ai = 0; ai < 2; ++ai)
#pragma unroll
                    for (int m = 0; m < 4; ++m) { const int row = row0 + ai * 128 + m * 16; const float rs = rstd_x[row];
                        *(f32x4*)(flog + (size_t)row * 8) = acc[ai][0][m][0] * rs; *(f32x4*)(flog + (size_t)row * 8 + 4) = acc[ai][0][m][1] * rs; }
            }
            return;
        }
        bf16* base; int ld, colt, mode = 0; float* part = nullptr; int nslot = 0, slot0 = 0;
        if (pn < 3) { base = qlat; ld = 768; colt = pn * 256; part = partq; nslot = 12; slot0 = pn * 4; }
        else if (pn < 5) { base = kvlat; ld = 512; colt = (pn - 3) * 256; part = partkv; nslot = 8; slot0 = (pn - 3) * 4; }
        else if (pn < 9) { base = G; ld = 2048; colt = (pn - 5) * 256; mode = 1; }
        else if (pn < 13) { base = Qf; ld = 1024; colt = (pn - 9) * 256; mode = 2; }
        else if (pn < 17) { base = Kf; ld = 1024; colt = (pn - 13) * 256; }
        else if (pn < 21) { base = Vf; ld = 1024; colt = (pn - 17) * 256; }
        else { base = G; ld = 2048; colt = 1024 + (pn - 21) * 256; mode = 1; }
        const int col0 = colt + wc * 32 + 8 * fq;
#pragma unroll
        for (int ai = 0; ai < 2; ++ai)
#pragma unroll
            for (int m = 0; m < 4; ++m) { const int row = row0 + ai * 128 + m * 16; float rs = rstd_x[row]; if (mode == 2) rs *= C2F;
                bf16* rowp = base + (size_t)row * ld + col0; float ss = 0.f;
#pragma unroll
                for (int bj = 0; bj < 2; ++bj) { f32x4 v0 = acc[ai][bj][m][0] * rs, v1 = acc[ai][bj][m][1] * rs;
                    ss += (v0[0] * v0[0] + v0[1] * v0[1]) + (v0[2] * v0[2] + v0[3] * v0[3]) + (v1[0] * v1[0] + v1[1] * v1[1]) + (v1[2] * v1[2] + v1[3] * v1[3]);
                    if (mode == 1) {
#pragma unroll
                        for (int e = 0; e < 4; ++e) { v0[e] = silu_f(v0[e]); v1[e] = silu_f(v1[e]); } }
                    *(u32x4*)(rowp + bj * 128) = pack8f(v0, v1); }
                if (part) { ss += __shfl_xor(ss, 16); ss += __shfl_xor(ss, 32); if (fq == 0) part[(size_t)row * nslot + slot0 + wc] = ss; } }
    }
};
struct EpiQ {
    static constexpr bool PERM = true, AFTER_DRAIN = false;
    const float* partq; bf16* Qm; const float *cosT, *sinT;
    __device__ __forceinline__ void operator()(const af4 (&acc)[2][2][4][2], const pg8::Unit& u, int wr, int wc, int fr, int fq) const {
        const int pn = u.pn; const int row0 = u.pm * 256 + wr * 64 + fr;
#pragma unroll
        for (int ai = 0; ai < 2; ++ai)
#pragma unroll
            for (int m = 0; m < 4; ++m) { const int row = row0 + ai * 128 + m * 16;
                const f32x4 pa = *(const f32x4*)(partq + (size_t)row * 12), pb = *(const f32x4*)(partq + (size_t)row * 12 + 4), pc = *(const f32x4*)(partq + (size_t)row * 12 + 8);
                const float ssq = ((pa[0] + pa[1]) + (pa[2] + pa[3])) + ((pb[0] + pb[1]) + (pb[2] + pb[3])) + ((pc[0] + pc[1]) + (pc[2] + pc[3]));
                const float rs = C2M / sqrtf(ssq * (1.f / 768.f) + EPS);
                if (pn < 4) {
#pragma unroll
                    for (int bj = 0; bj < 2; ++bj) *(u32x4*)(Qm + (size_t)row * 1536 + (2 * pn + bj) * 192 + wc * 32 + 8 * fq) = pack8f(acc[ai][bj][m][0] * rs, acc[ai][bj][m][1] * rs);
                } else { const int head = 4 * (pn - 4) + wc; f32x4 o1[2], o2[2];
#pragma unroll
                    for (int n = 0; n < 2; ++n) { const f32x4 c = *(const f32x4*)(cosT + (size_t)row * 32 + 8 * fq + 4 * n), s = *(const f32x4*)(sinT + (size_t)row * 32 + 8 * fq + 4 * n);
                        const f32x4 x1 = acc[ai][0][m][n] * rs, x2 = acc[ai][1][m][n] * rs; o1[n] = x1 * c - x2 * s; o2[n] = x2 * c + x1 * s; }
                    bf16* qp = Qm + (size_t)row * 1536 + head * 192 + 128 + 8 * fq;
                    *(u32x4*)qp = pack8f(o1[0], o1[1]); *(u32x4*)(qp + 32) = pack8f(o2[0], o2[1]); } }
    }
};
struct EpiKV {
    static constexpr bool PERM = true, AFTER_DRAIN = false;
    const float* partkv; bf16 *Km, *Vm;
    __device__ __forceinline__ void operator()(const af4 (&acc)[2][2][4][2], const pg8::Unit& u, int wr, int wc, int fr, int fq) const {
        const int pn = u.pn; const int row0 = u.pm * 256 + wr * 64 + fr;
#pragma unroll
        for (int ai = 0; ai < 2; ++ai)
#pragma unroll
            for (int m = 0; m < 4; ++m) { const int row = row0 + ai * 128 + m * 16;
                const f32x4 pa = *(const f32x4*)(partkv + (size_t)row * 8), pb = *(const f32x4*)(partkv + (size_t)row * 8 + 4);
                const float ssq = ((pa[0] + pa[1]) + (pa[2] + pa[3])) + ((pb[0] + pb[1]) + (pb[2] + pb[3]));
                const float rs = 1.f / sqrtf(ssq * (1.f / 512.f) + EPS);
                *(u32x4*)(Km + (size_t)row * 1536 + pn * 192 + wc * 32 + 8 * fq) = pack8f(acc[ai][0][m][0] * rs, acc[ai][0][m][1] * rs);
                *(u32x4*)(Vm + (size_t)row * 1024 + pn * 128 + wc * 32 + 8 * fq) = pack8f(acc[ai][1][m][0] * rs, acc[ai][1][m][1] * rs); }
    }
};
struct EpiOut {
    static constexpr bool PERM = true, AFTER_DRAIN = false;
    bf16* Y; float* party;
    __device__ __forceinline__ void operator()(const af4 (&acc)[2][2][4][2], const pg8::Unit& u, int wr, int wc, int fr, int fq) const {
        const int pn = u.pn; const int row0 = u.pm * 256 + wr * 64 + fr; const int col0 = pn * 256 + wc * 32 + 8 * fq;
#pragma unroll
        for (int ai = 0; ai < 2; ++ai)
#pragma unroll
            for (int m = 0; m < 4; ++m) { const int row = row0 + ai * 128 + m * 16; float ss = 0.f;
#pragma unroll
                for (int bj = 0; bj < 2; ++bj) { const f32x4 v0 = acc[ai][bj][m][0], v1 = acc[ai][bj][m][1];
                    ss += (v0[0] * v0[0] + v0[1] * v0[1]) + (v0[2] * v0[2] + v0[3] * v0[3]) + (v1[0] * v1[0] + v1[1] * v1[1]) + (v1[2] * v1[2] + v1[3] * v1[3]);
                    *(u32x4*)(Y + (size_t)row * 2048 + col0 + bj * 128) = pack8f(v0, v1); }
                ss += __shfl_xor(ss, 16); ss += __shfl_xor(ss, 32); if (fq == 0) party[(size_t)row * 32 + pn * 4 + wc] = ss; }
    }
};

namespace att {
constexpr int KVBLK = 64, QBLK = 32, QB = 256;
constexpr int SHM_K = 24576, SHM_V = 16384;
constexpr int NRING = 3;
constexpr int OFF_K = 0, OFF_V = NRING * SHM_K, OFF_CK = OFF_V + NRING * SHM_V, OFF_WS = OFF_CK + 1024, OFF_QP = OFF_WS + 2048;
constexpr float THR = 8.f;
#define KSWZ(row, colB) ((row) * 256 + ((colB) ^ (((row) & 7) << 4)))
#define SBAR() __builtin_amdgcn_sched_barrier(0)
__device__ __forceinline__ int v_st(int k, int c) { const int kk = (k & ~0xC) | ((k & 4) << 1) | ((k & 8) >> 1); return ((kk >> 3) * 4 + (c >> 5)) * 512 + ((kk & 7) * 32 + (c & 31)) * 2; }
__device__ __forceinline__ int v_rd_base(int lane) { return ((lane & 3) << 3) | (((lane >> 2) & 3) << 6) | (((lane >> 4) & 1) << 5) | (((lane >> 5) & 1) << 8); }
constexpr int v_rd_off(int d0, int ks, int half) { return d0 * 512 + ks * 4096 + half * 2048; }
__device__ __forceinline__ int crow(int r, int hi) { return (r & 3) + 8 * (r >> 2) + 4 * hi; }
__device__ __forceinline__ unsigned cvtpk(float lo, float hi) { unsigned r; asm volatile("v_cvt_pk_bf16_f32 %0, %1, %2" : "=v"(r) : "v"(lo), "v"(hi)); return r; }

__device__ __forceinline__ void mask_tile(f32x16& p0, f32x16& p1, int dq) {
    const float NEG = -__builtin_inff();
#pragma unroll
    for (int r = 0; r < 16; ++r) { const int c = (r & 3) + 8 * (r >> 2);
        if (dq - c < 0) p0[r] = NEG;
        if (dq - c - 32 < 0) p1[r] = NEG; }
}
__device__ __forceinline__ void softmax_tile(f32x16& p0, f32x16& p1, float& m_reg, float& l_reg, float& alpha, bf16x8& pa0, bf16x8& pa1, bf16x8& pa2, bf16x8& pa3) {
    float pmax = p0[0];
#pragma unroll
    for (int r = 1; r < 16; ++r) pmax = fmaxf(pmax, p0[r]);
#pragma unroll
    for (int r = 0; r < 16; ++r) pmax = fmaxf(pmax, p1[r]);
    { auto rr = __builtin_amdgcn_permlane32_swap(__float_as_uint(pmax), __float_as_uint(pmax), false, false);
      pmax = fmaxf(__uint_as_float(rr[0]), __uint_as_float(rr[1])); }
    float mn;
    if (__builtin_expect(__all(pmax - m_reg <= THR), 1)) { mn = m_reg; alpha = 1.f; }
    else { mn = fmaxf(m_reg, pmax); alpha = __builtin_amdgcn_exp2f(m_reg - mn); m_reg = mn; }
#pragma unroll
    for (int r = 0; r < 16; ++r) { p0[r] = __builtin_amdgcn_exp2f(p0[r] - mn); p1[r] = __builtin_amdgcn_exp2f(p1[r] - mn); }
    float ps = 0.f;
#pragma unroll
    for (int r = 0; r < 16; ++r) ps += p0[r];
#pragma unroll
    for (int r = 0; r < 16; ++r) ps += p1[r];
    { auto rr = __builtin_amdgcn_permlane32_swap(__float_as_uint(ps), __float_as_uint(ps), false, false);
      ps = __uint_as_float(rr[0]) + __uint_as_float(rr[1]); }
    l_reg = l_reg * alpha + ps;
#define PK4(P, B_, OUT) do { unsigned a0 = cvtpk(P[B_+0], P[B_+1]), a1 = cvtpk(P[B_+2], P[B_+3]);                          \
        unsigned b0 = cvtpk(P[B_+4], P[B_+5]), b1 = cvtpk(P[B_+6], P[B_+7]);                                             \
        auto r0 = __builtin_amdgcn_permlane32_swap(a0, b0, false, false); auto r1 = __builtin_amdgcn_permlane32_swap(a1, b1, false, false); \
        u32x4 w = {r0[0], r1[0], r0[1], r1[1]}; OUT = *reinterpret_cast<bf16x8*>(&w); } while (0)
    PK4(p0, 0, pa0); PK4(p0, 8, pa1); PK4(p1, 0, pa2); PK4(p1, 8, pa3);
#undef PK4
}
template <int DQK, int NPARK>
__device__ __forceinline__ void qkt(f32x16& p0, f32x16& p1, const char* Kb, int r32, int hi, const bf16x8* qr, const char* qpk) {
    constexpr int ND = DQK / 16, NQR = ND - NPARK;
    p0 = f32x16{}; p1 = f32x16{};
    const char* kb[4];
#pragma unroll
    for (int dd = 0; dd < 4; ++dd) kb[dd] = Kb + KSWZ(r32, (dd * 16 + hi * 8) * 2);
    const char* kr = Kb + 16384 + r32 * 128;
    const int rx = (r32 & 7) << 4;
    bf16x8 kf[3][2], qf[3];
#define QK_LD(set, d_) do { \
            if ((d_) < 8) { const char* a_ = kb[(d_) & 3] + ((d_) >> 2) * 128; kf[set][0] = *reinterpret_cast<const bf16x8*>(a_); kf[set][1] = *reinterpret_cast<const bf16x8*>(a_ + 32 * 256); } \
            else { const char* a_ = kr + (((((d_) - 8) * 16 + hi * 8) * 2) ^ rx); kf[set][0] = *reinterpret_cast<const bf16x8*>(a_); kf[set][1] = *reinterpret_cast<const bf16x8*>(a_ + 32 * 128); } \
            if ((d_) >= NQR) qf[set] = *reinterpret_cast<const bf16x8*>(qpk + ((d_) - NQR) * 1024); } while (0)
    QK_LD(0, 0); QK_LD(1, 1); SBAR();
#pragma unroll
    for (int d = 0; d < ND; ++d) {
        const int cs = d % 3;
        if (d + 2 < ND) { const int ns = (d + 2) % 3; if (ns == 0) QK_LD(0, d + 2); else if (ns == 1) QK_LD(1, d + 2); else QK_LD(2, d + 2); SBAR(); }
        const bf16x8 q = (d < NQR) ? qr[d < NQR ? d : 0] : qf[cs];
        p0 = __builtin_amdgcn_mfma_f32_32x32x16_bf16(kf[cs][0], q, p0, 0, 0, 0);
        p1 = __builtin_amdgcn_mfma_f32_32x32x16_bf16(kf[cs][1], q, p1, 0, 0, 0);
        SBAR();
    }
#undef QK_LD
}
template <int VOFF>
__device__ __forceinline__ void pv_tile(f32x16* o, int vb0, bf16x8 pa0, bf16x8 pa1, bf16x8 pa2, bf16x8 pa3) {
#define TRRD(dst, off) asm volatile("ds_read_b64_tr_b16 %0, %1 offset:%2" : "=&v"(dst) : "v"(vb0), "i"(off) : "memory")
#define PV_D0(d0) do { s16x4 l0, l1, l2, l3, h0, h1, h2, h3; constexpr int b_ = VOFF + v_rd_off(d0, 0, 0); \
        TRRD(l0, b_); TRRD(h0, b_ + 2048); TRRD(l1, b_ + 4096); TRRD(h1, b_ + 6144); TRRD(l2, b_ + 8192); TRRD(h2, b_ + 10240); TRRD(l3, b_ + 12288); TRRD(h3, b_ + 14336); \
        asm volatile("s_waitcnt lgkmcnt(0)" ::: "memory"); SBAR(); \
        o[d0] = __builtin_amdgcn_mfma_f32_32x32x16_bf16(pa0, (bf16x8){l0[0], l0[1], l0[2], l0[3], h0[0], h0[1], h0[2], h0[3]}, o[d0], 0, 0, 0);   \
        o[d0] = __builtin_amdgcn_mfma_f32_32x32x16_bf16(pa1, (bf16x8){l1[0], l1[1], l1[2], l1[3], h1[0], h1[1], h1[2], h1[3]}, o[d0], 0, 0, 0);   \
        o[d0] = __builtin_amdgcn_mfma_f32_32x32x16_bf16(pa2, (bf16x8){l2[0], l2[1], l2[2], l2[3], h2[0], h2[1], h2[2], h2[3]}, o[d0], 0, 0, 0);   \
        o[d0] = __builtin_amdgcn_mfma_f32_32x32x16_bf16(pa3, (bf16x8){l3[0], l3[1], l3[2], l3[3], h3[0], h3[1], h3[2], h3[3]}, o[d0], 0, 0, 0); } while (0)
    PV_D0(0); PV_D0(1); PV_D0(2); PV_D0(3);
#undef PV_D0
#undef TRRD
}

#define RD128(dst, addr, off) asm volatile("ds_read_b128 %0, %1 offset:%2" : "=&v"(dst) : "v"(addr), "i"(off) : "memory")
#define RDTR(dst, addr, off) asm volatile("ds_read_b64_tr_b16 %0, %1 offset:%2" : "=&v"(dst) : "v"(addr), "i"(off) : "memory")
#define WAITK(n, x) asm volatile("s_waitcnt lgkmcnt(%1)" : "+v"(x) : "n"(n) : "memory")
#define WAITKQ(n, x, q) asm volatile("s_waitcnt lgkmcnt(%2)" : "+v"(x), "+v"(q) : "n"(n) : "memory")
#define WAITV(n, x, y) asm volatile("s_waitcnt lgkmcnt(%2)" : "+v"(x), "+v"(y) : "n"(n) : "memory")

__device__ __forceinline__ void mblock_mla_q(f32x16& p0, f32x16& p1, f32x16* o, const bf16x8* qr, bf16x8 pa0, bf16x8 pa1, bf16x8 pa2, bf16x8 pa3, const unsigned* kbv, const unsigned* krv, unsigned qpkv, unsigned vbv) {
    bf16x8 ksl[5], qsl[3]; s16x4 vlo[5], vhi[5];
    p0 = f32x16{}; p1 = f32x16{};
    RD128(ksl[0], kbv[0], 0);
    RD128(ksl[1], kbv[0], 8192);
    RD128(ksl[2], kbv[1], 0);
    RD128(ksl[3], kbv[1], 8192);
    RD128(ksl[4], kbv[2], 0);
    WAITK(4, ksl[0]); p0 = __builtin_amdgcn_mfma_f32_32x32x16_bf16(ksl[0], qr[0], p0, 0, 0, 0);
    RD128(ksl[0], kbv[2], 8192);
    WAITK(4, ksl[1]); p1 = __builtin_amdgcn_mfma_f32_32x32x16_bf16(ksl[1], qr[0], p1, 0, 0, 0);
    RD128(ksl[1], kbv[3], 0);
    WAITK(4, ksl[2]); p0 = __builtin_amdgcn_mfma_f32_32x32x16_bf16(ksl[2], qr[1], p0, 0, 0, 0);
    RD128(ksl[2], kbv[3], 8192);
    WAITK(4, ksl[3]); p1 = __builtin_amdgcn_mfma_f32_32x32x16_bf16(ksl[3], qr[1], p1, 0, 0, 0);
    RD128(ksl[3], kbv[0], 128);
    WAITK(4, ksl[4]); p0 = __builtin_amdgcn_mfma_f32_32x32x16_bf16(ksl[4], qr[2], p0, 0, 0, 0);
    RD128(ksl[4], kbv[0], 8320);
    WAITK(4, ksl[0]); p1 = __builtin_amdgcn_mfma_f32_32x32x16_bf16(ksl[0], qr[2], p1, 0, 0, 0);
    RD128(ksl[0], kbv[1], 128);
    WAITK(4, ksl[1]); p0 = __builtin_amdgcn_mfma_f32_32x32x16_bf16(ksl[1], qr[3], p0, 0, 0, 0);
    RD128(ksl[1], kbv[1], 8320);
    WAITK(4, ksl[2]); p1 = __builtin_amdgcn_mfma_f32_32x32x16_bf16(ksl[2], qr[3], p1, 0, 0, 0);
    RD128(ksl[2], kbv[2], 128);
    WAITK(4, ksl[3]); p0 = __builtin_amdgcn_mfma_f32_32x32x16_bf16(ksl[3], qr[4], p0, 0, 0, 0);
    RD128(ksl[3], kbv[2], 8320);
    WAITK(4, ksl[4]); p1 = __builtin_amdgcn_mfma_f32_32x32x16_bf16(ksl[4], qr[4], p1, 0, 0, 0);
    RD128(ksl[4], kbv[3], 128);
    WAITK(4, ksl[0]); p0 = __builtin_amdgcn_mfma_f32_32x32x16_bf16(ksl[0], qr[5], p0, 0, 0, 0);
    RD128(ksl[0], kbv[3], 8320);
    WAITK(4, ksl[1]); p1 = __builtin_amdgcn_mfma_f32_32x32x16_bf16(ksl[1], qr[5], p1, 0, 0, 0);
    RD128(ksl[1], krv[0], 0); RD128(qsl[2], qpkv, 0);
    WAITK(5, ksl[2]); p0 = __builtin_amdgcn_mfma_f32_32x32x16_bf16(ksl[2], qr[6], p0, 0, 0, 0);
    RD128(ksl[2], krv[0], 4096);
    WAITK(5, ksl[3]); p1 = __builtin_amdgcn_mfma_f32_32x32x16_bf16(ksl[3], qr[6], p1, 0, 0, 0);
    RD128(ksl[3], krv[1], 0); RD128(qsl[0], qpkv, 1024);
    WAITK(6, ksl[4]); p0 = __builtin_amdgcn_mfma_f32_32x32x16_bf16(ksl[4], qr[7], p0, 0, 0, 0);
    RD128(ksl[4], krv[1], 4096);
    WAITK(6, ksl[0]); p1 = __builtin_amdgcn_mfma_f32_32x32x16_bf16(ksl[0], qr[7], p1, 0, 0, 0);
    RD128(ksl[0], krv[2], 0); RD128(qsl[1], qpkv, 2048);
    WAITKQ(6, ksl[1], qsl[2]); p0 = __builtin_amdgcn_mfma_f32_32x32x16_bf16(ksl[1], qsl[2], p0, 0, 0, 0);
    RD128(ksl[1], krv[2], 4096);
    WAITKQ(6, ksl[2], qsl[2]); p1 = __builtin_amdgcn_mfma_f32_32x32x16_bf16(ksl[2], qsl[2], p1, 0, 0, 0);
    RD128(ksl[2], krv[3], 0); RD128(qsl[2], qpkv, 3072);
    WAITKQ(6, ksl[3], qsl[0]); p0 = __builtin_amdgcn_mfma_f32_32x32x16_bf16(ksl[3], qsl[0], p0, 0, 0, 0);
    RD128(ksl[3], krv[3], 4096);
    WAITKQ(6, ksl[4], qsl[0]); p1 = __builtin_amdgcn_mfma_f32_32x32x16_bf16(ksl[4], qsl[0], p1, 0, 0, 0);
    WAITKQ(4, ksl[0], qsl[1]); p0 = __builtin_amdgcn_mfma_f32_32x32x16_bf16(ksl[0], qsl[1], p0, 0, 0, 0);
    WAITKQ(3, ksl[1], qsl[1]); p1 = __builtin_amdgcn_mfma_f32_32x32x16_bf16(ksl[1], qsl[1], p1, 0, 0, 0);
    WAITKQ(1, ksl[2], qsl[2]); p0 = __builtin_amdgcn_mfma_f32_32x32x16_bf16(ksl[2], qsl[2], p0, 0, 0, 0);
    WAITKQ(0, ksl[3], qsl[2]); p1 = __builtin_amdgcn_mfma_f32_32x32x16_bf16(ksl[3], qsl[2], p1, 0, 0, 0);
}
__device__ __forceinline__ void mblock_fox_q(f32x16& p0, f32x16& p1, f32x16* o, const bf16x8* qr, bf16x8 pa0, bf16x8 pa1, bf16x8 pa2, bf16x8 pa3, const unsigned* kbv, const unsigned* krv, unsigned qpkv, unsigned vbv) {
    bf16x8 ksl[5], qsl[3]; s16x4 vlo[5], vhi[5];
    p0 = f32x16{}; p1 = f32x16{};
    RD128(ksl[0], kbv[0], 0);
    RD128(ksl[1], kbv[0], 8192);
    RD128(ksl[2], kbv[1], 0);
    RD128(ksl[3], kbv[1], 8192);
    RD128(ksl[4], kbv[2], 0);
    WAITK(4, ksl[0]); p0 = __builtin_amdgcn_mfma_f32_32x32x16_bf16(ksl[0], qr[0], p0, 0, 0, 0);
    RD128(ksl[0], kbv[2], 8192);
    WAITK(4, ksl[1]); p1 = __builtin_amdgcn_mfma_f32_32x32x16_bf16(ksl[1], qr[0], p1, 0, 0, 0);
    RD128(ksl[1], kbv[3], 0);
    WAITK(4, ksl[2]); p0 = __builtin_amdgcn_mfma_f32_32x32x16_bf16(ksl[2], qr[1], p0, 0, 0, 0);
    RD128(ksl[2], kbv[3], 8192);
    WAITK(4, ksl[3]); p1 = __builtin_amdgcn_mfma_f32_32x32x16_bf16(ksl[3], qr[1], p1, 0, 0, 0);
    RD128(ksl[3], kbv[0], 128); RD128(qsl[1], qpkv, 0);
    WAITK(5, ksl[4]); p0 = __builtin_amdgcn_mfma_f32_32x32x16_bf16(ksl[4], qr[2], p0, 0, 0, 0);
    RD128(ksl[4], kbv[0], 8320);
    WAITK(5, ksl[0]); p1 = __builtin_amdgcn_mfma_f32_32x32x16_bf16(ksl[0], qr[2], p1, 0, 0, 0);
    RD128(ksl[0], kbv[1], 128); RD128(qsl[2], qpkv, 1024);
    WAITK(6, ksl[1]); p0 = __builtin_amdgcn_mfma_f32_32x32x16_bf16(ksl[1], qr[3], p0, 0, 0, 0);
    RD128(ksl[1], kbv[1], 8320);
    WAITK(6, ksl[2]); p1 = __builtin_amdgcn_mfma_f32_32x32x16_bf16(ksl[2], qr[3], p1, 0, 0, 0);
    RD128(ksl[2], kbv[2], 128); RD128(qsl[0], qpkv, 2048);
    WAITKQ(6, ksl[3], qsl[1]); p0 = __builtin_amdgcn_mfma_f32_32x32x16_bf16(ksl[3], qsl[1], p0, 0, 0, 0);
    RD128(ksl[3], kbv[2], 8320);
    WAITKQ(6, ksl[4], qsl[1]); p1 = __builtin_amdgcn_mfma_f32_32x32x16_bf16(ksl[4], qsl[1], p1, 0, 0, 0);
    RD128(ksl[4], kbv[3], 128); RD128(qsl[1], qpkv, 3072);
    WAITKQ(6, ksl[0], qsl[2]); p0 = __builtin_amdgcn_mfma_f32_32x32x16_bf16(ksl[0], qsl[2], p0, 0, 0, 0);
    RD128(ksl[0], kbv[3], 8320);
    WAITKQ(6, ksl[1], qsl[2]); p1 = __builtin_amdgcn_mfma_f32_32x32x16_bf16(ksl[1], qsl[2], p1, 0, 0, 0);
    WAITKQ(4, ksl[2], qsl[0]); p0 = __builtin_amdgcn_mfma_f32_32x32x16_bf16(ksl[2], qsl[0], p0, 0, 0, 0);
    WAITKQ(3, ksl[3], qsl[0]); p1 = __builtin_amdgcn_mfma_f32_32x32x16_bf16(ksl[3], qsl[0], p1, 0, 0, 0);
    WAITKQ(1, ksl[4], qsl[1]); p0 = __builtin_amdgcn_mfma_f32_32x32x16_bf16(ksl[4], qsl[1], p0, 0, 0, 0);
    WAITKQ(0, ksl[0], qsl[1]); p1 = __builtin_amdgcn_mfma_f32_32x32x16_bf16(ksl[0], qsl[1], p1, 0, 0, 0);
}
#undef RD128
#undef RDTR
#undef WAITK
#undef WAITKQ
#undef WAITV

template <int DQK, bool FOX, int ABL = 0>
__device__ __forceinline__ void attn_unit(char* lds, const bf16* Q, int ldq, const bf16* K, int ldk, const bf16* V, int ldv, const float* cfs, const bf16* Gp, bf16* Op, int qb) {
    const int tid = threadIdx.x, wid = __builtin_amdgcn_readfirstlane(tid >> 6), lane = tid & 63, r32 = lane & 31, hi = lane >> 5;
    const bool grpA = wid < 4; const int w4 = wid & 3;
    const int q0 = qb * QB, NT = 4 * (qb + 1);
    char* K_lds = lds + OFF_K; char* V_lds = lds + OFF_V; float* ck_l = (float*)(lds + OFF_CK);
    float* wsf = (float*)(lds + OFF_WS) + wid * 64; float* li_l = wsf; float* al_l = wsf + 32;
    constexpr int NPARK = 4, NQR = DQK / 16 - NPARK;
    bf16x8 qr[NQR];
    char* qpk = lds + OFF_QP + wid * 4096 + (hi * 32 + r32) * 16;
    unsigned koff, kroff = 0, voff;
    { const int row = 4 * w4 + (lane >> 4), c = (lane & 15) ^ (row & 7); koff = (unsigned)(row * ldk + c * 8) * 2u; }
    { const int s0 = 2 * w4 + (lane >> 5), kk = 8 * (s0 >> 2) + ((lane & 31) >> 2), k = (kk & ~0xC) | ((kk & 4) << 1) | ((kk & 8) >> 1); voff = (unsigned)(k * ldv + 32 * (s0 & 3) + 8 * (lane & 3)) * 2u; }
    if constexpr (DQK == 192) { const int row = 8 * w4 + (lane >> 3), c = (lane & 7) ^ (row & 7); kroff = (unsigned)(row * ldk + 128 + c * 8) * 2u; }
    const int vb0 = (int)(uintptr_t)V_lds + v_rd_base(lane);
    LAS unsigned char* ldsl = (LAS unsigned char*)(uintptr_t)(unsigned)(uintptr_t)lds;
    unsigned kb0[4], kr0[4];
#pragma unroll
    for (int i = 0; i < 4; ++i) { const unsigned xo = (unsigned)((i * 32 + hi * 16) ^ ((r32 & 7) << 4)); kb0[i] = (unsigned)(uintptr_t)K_lds + r32 * 256 + xo; kr0[i] = (unsigned)(uintptr_t)K_lds + 16384 + r32 * 128 + xo; }
    const unsigned qpkv = (unsigned)(uintptr_t)qpk;
#define DMA_K(t, bf) do { const char* kt_ = (const char*)K + (size_t)(t) * KVBLK * ldk * 2; \
        _Pragma("unroll") for (int j_ = 0; j_ < 4; ++j_) \
            __builtin_amdgcn_global_load_lds((const unsigned*)(kt_ + koff + (size_t)j_ * 16 * ldk * 2), (LAS unsigned*)(ldsl + OFF_K + (bf) * SHM_K + (w4 + 4 * j_) * 1024), 16, 0, 0); \
        if constexpr (DQK == 192) { _Pragma("unroll") for (int j_ = 0; j_ < 2; ++j_) \
            __builtin_amdgcn_global_load_lds((const unsigned*)(kt_ + kroff + (size_t)j_ * 32 * ldk * 2), (LAS unsigned*)(ldsl + OFF_K + (bf) * SHM_K + 16384 + (w4 + 4 * j_) * 1024), 16, 0, 0); } \
        if constexpr (FOX) { __builtin_amdgcn_global_load_lds((const unsigned*)(cfs + (t) * KVBLK + lane), (LAS unsigned*)(ldsl + OFF_CK + ((t) & 3) * 256), 4, 0, 0); } } while (0)
#define DMA_V(t, bf) do { const char* vt_ = (const char*)V + (size_t)(t) * KVBLK * ldv * 2; \
        _Pragma("unroll") for (int j_ = 0; j_ < 4; ++j_) \
            __builtin_amdgcn_global_load_lds((const unsigned*)(vt_ + voff + (size_t)j_ * 16 * ldv * 2), (LAS unsigned*)(ldsl + OFF_V + (bf) * SHM_V + (w4 + 4 * j_) * 1024), 16, 0, 0); } while (0)
#define BAR_L() asm volatile("s_waitcnt lgkmcnt(0)\n\ts_barrier" ::: "memory")
#define BAR_VL() asm volatile("s_waitcnt vmcnt(0) lgkmcnt(0)\n\ts_barrier" ::: "memory")
    constexpr int NDK = 4 + (DQK == 192 ? 2 : 0) + (FOX ? 1 : 0), NDV = 4;
#define BAR_VN(n) asm volatile("s_waitcnt vmcnt(%0) lgkmcnt(0)\n\ts_barrier" :: "n"(n) : "memory")
    if (grpA) { DMA_K(0, 0); DMA_K(1, 1); DMA_V(0, 0); }
    { const bf16* qp = Q + (size_t)(q0 + wid * QBLK + r32) * ldq + hi * 8;
#pragma unroll
      for (int d0 = 0; d0 < NQR; ++d0) qr[d0] = *(const bf16x8*)(qp + d0 * 16);
#pragma unroll
      for (int d0 = 0; d0 < NPARK; ++d0) *(bf16x8*)(qpk + d0 * 1024) = *(const bf16x8*)(qp + (NQR + d0) * 16); }
    float cq = 0.f; if constexpr (FOX) cq = cfs[q0 + wid * QBLK + r32];
    BAR_VL();
    if (!grpA) BAR_L();
    float m_reg = -1e30f, l_reg = 0.f; f32x16 o[4] = {}; f32x16 p0 = {}, p1 = {}; bf16x8 pa0 = {}, pa1 = {}, pa2 = {}, pa3 = {};
#define ACTW(tt) ((tt) - (NT - 4) < 0 || 64 * ((tt) - (NT - 4)) <= 32 * wid + 31)
    int rc = 0, rp = 2, rn = 1;
#pragma unroll 1
    for (int t = 0; t < NT; ++t) {
        if (grpA && !(ABL & 1)) { if (t + 2 < NT) DMA_K(t + 2, rp); if (t + 1 < NT) DMA_V(t + 1, rn); }
        const int jb_ = t - (NT - 4); const bool act_ = ACTW(t);
        if (act_ && !(ABL & 4)) { unsigned kbv[4], krv[4];
#pragma unroll
            for (int i = 0; i < 4; ++i) { kbv[i] = kb0[i] + rc * SHM_K; krv[i] = kr0[i] + rc * SHM_K; }
            if constexpr (DQK == 192) mblock_mla_q(p0, p1, o, qr, pa0, pa1, pa2, pa3, kbv, krv, qpkv, 0u); else mblock_fox_q(p0, p1, o, qr, pa0, pa1, pa2, pa3, kbv, krv, qpkv, 0u); }
        if (t > 0 && ACTW(t - 1) && !(ABL & 4)) { SBAR(); pv_tile<0>(o, vb0 + rp * SHM_V, pa0, pa1, pa2, pa3); }
        BAR_L();
        if (act_ && (ABL & 8)) {
#define PK4(P, B_, OUT) do { unsigned a0 = cvtpk(P[B_+0], P[B_+1]), a1 = cvtpk(P[B_+2], P[B_+3]); unsigned b0 = cvtpk(P[B_+4], P[B_+5]), b1 = cvtpk(P[B_+6], P[B_+7]); \
        auto r0 = __builtin_amdgcn_permlane32_swap(a0, b0, false, false); auto r1 = __builtin_amdgcn_permlane32_swap(a1, b1, false, false); u32x4 w = {r0[0], r1[0], r0[1], r1[1]}; OUT = *reinterpret_cast<bf16x8*>(&w); } while (0)
            PK4(p0, 0, pa0); PK4(p0, 8, pa1); PK4(p1, 0, pa2); PK4(p1, 8, pa3);
#undef PK4
        }
        if (act_ && !(ABL & 2)) { float alpha;
            if constexpr (FOX) { const float* ckp = ck_l + (t & 3) * 64 + 4 * hi;
#pragma unroll
                for (int g_ = 0; g_ < 4; ++g_) { const f32x4 c0 = *(const f32x4*)(ckp + 8 * g_), c1 = *(const f32x4*)(ckp + 32 + 8 * g_);
#pragma unroll
                    for (int e_ = 0; e_ < 4; ++e_) { p0[4 * g_ + e_] += cq - c0[e_]; p1[4 * g_ + e_] += cq - c1[e_]; } } }
            if (jb_ >= 0 && 64 * jb_ + 63 > 32 * wid) mask_tile(p0, p1, 32 * wid + r32 - 64 * jb_ - 4 * hi);
            softmax_tile(p0, p1, m_reg, l_reg, alpha, pa0, pa1, pa2, pa3);
            if (__any(alpha < 1.f)) { if (hi == 0) al_l[r32] = alpha; asm volatile("s_waitcnt lgkmcnt(0)" ::: "memory");
#pragma unroll
                for (int d_ = 0; d_ < 4; ++d_)
#pragma unroll
                    for (int r = 0; r < 16; ++r) o[d_][r] *= al_l[crow(r, hi)]; }
        }
        if (ABL & 1) BAR_VN(0); else if (t + 2 < NT) BAR_VN(NDK + NDV); else if (t + 1 < NT) BAR_VN(NDV); else BAR_VN(0);
        rp = rc; rc = rn; rn = (rn == NRING - 1) ? 0 : rn + 1;
    }
    if (ACTW(NT - 1)) { SBAR(); pv_tile<0>(o, vb0 + rp * SHM_V, pa0, pa1, pa2, pa3); }
    if (grpA) BAR_L();
#undef BAR_VN
#undef ACTW
#undef DMA_K
#undef DMA_V
    if (hi == 0) li_l[r32] = l_reg; asm volatile("s_waitcnt lgkmcnt(0)" ::: "memory");
    bf16* stg = (bf16*)(lds + wid * 8192);
    const int lane_e = launder(lane);
#pragma unroll
    for (int r = 0; r < 16; ++r) { const int orow = crow(r, hi); const float rl = __builtin_amdgcn_rcpf(li_l[orow]);
#pragma unroll
        for (int d0 = 0; d0 < 4; ++d0) stg[orow * 128 + d0 * 32 + r32] = (bf16)f2bf(o[d0][r] * rl); }
    asm volatile("s_waitcnt lgkmcnt(0)" ::: "memory");
#pragma unroll
    for (int i = 0; i < 8; ++i) { const int row = i * 4 + (lane_e >> 4), ch = lane_e & 15;
        const u32x4 v = *(const u32x4*)(stg + row * 128 + ch * 8);
        const size_t go = (size_t)(q0 + wid * QBLK + row) * 2048 + ch * 8;
        const u32x4 g = *(const u32x4*)(Gp + go); u32x4 w;
        w.x = cvtpk(bflo(v.x) * bflo(g.x), bfhi(v.x) * bfhi(g.x)); w.y = cvtpk(bflo(v.y) * bflo(g.y), bfhi(v.y) * bfhi(g.y));
        w.z = cvtpk(bflo(v.z) * bflo(g.z), bfhi(v.z) * bfhi(g.z)); w.w = cvtpk(bflo(v.w) * bflo(g.w), bfhi(v.w) * bfhi(g.w));
        *(u32x4*)(Op + go) = w; }
    BAR_VL();
#undef BAR_L
#undef BAR_VL
}
#undef KSWZ
#undef SBAR
}

__device__ __forceinline__ void transpose_item(const float* W, int ldw, int K, const float* g, bf16* WT, int dst_row0, int src_col0, int nvalid, int k0, LAS float* scr, int lane) {
    const int n = lane & 31; const bool ok = (src_col0 >= 0) && (n < nvalid);
    float tv[32];
#pragma unroll
    for (int i = 0; i < 32; ++i) { const int kk = 2 * i + (lane >> 5); tv[i] = ok ? W[(size_t)(k0 + kk) * ldw + src_col0 + n] : 0.f; }
    if (g) {
#pragma unroll
        for (int i = 0; i < 32; ++i) tv[i] *= g[k0 + 2 * i + (lane >> 5)]; }
#pragma unroll
    for (int i = 0; i < 32; ++i) scr[(2 * i + (lane >> 5)) * 33 + n] = tv[i];
    asm volatile("s_waitcnt lgkmcnt(0)" ::: "memory");
    const int c = lane & 7;
#pragma unroll
    for (int j = 0; j < 4; ++j) { const int nn = (lane >> 3) + 8 * j; const LAS float* s = scr + (8 * c) * 33 + nn;
        u32x4 o; o.x = pk2(s[0 * 33], s[1 * 33]); o.y = pk2(s[2 * 33], s[3 * 33]); o.z = pk2(s[4 * 33], s[5 * 33]); o.w = pk2(s[6 * 33], s[7 * 33]);
        *(u32x4*)(WT + (size_t)(dst_row0 + nn) * K + k0 + 8 * c) = o; }
    asm volatile("s_waitcnt lgkmcnt(0)" ::: "memory");
}
__device__ __forceinline__ void win_src(int r0, int& src, int& nv) {
    nv = 32;
    if (r0 < 1280) src = r0;
    else if (r0 < 2304) src = 1344 + (r0 - 1280);
    else if (r0 < 3328) src = 2368 + (r0 - 2304);
    else if (r0 < 4352) src = 3392 + (r0 - 3328);
    else if (r0 < 5376) src = 4416 + (r0 - 4352);
    else if (r0 < 6400) src = 5448 + (r0 - 5376);
    else if (r0 == 6400) src = 1280;
    else if (r0 == 6432) { src = 5440; nv = 8; }
    else if (r0 == 6528) src = 1312;
    else src = -1;
}
__device__ __forceinline__ int wuq_src(int r0) {
    if (r0 < 1024) return (r0 >> 7) * 192 + (r0 & 127);
    const int q = r0 - 1024, t = q >> 8, bj = (q >> 7) & 1, wc = (q >> 5) & 3;
    return (4 * t + wc) * 192 + 128 + 32 * bj;
}


#define XB_TMO      128
#define XB_XCNT(j)  (256  + 64 * (j))
#define XB_XSUB(j)  (1280 + 64 * (j))
#define XB_XGEN(j)  (2304 + 64 * (j))
#define XB_TOP      3328
#define XB_TOPGEN   3392
#define XCD_BAR_WORDS 3456
#define XB_SPIN_CAP (1u << 18)
__device__ __forceinline__ unsigned xb_ld(unsigned* p)              { return __hip_atomic_load(p, __ATOMIC_RELAXED, __HIP_MEMORY_SCOPE_AGENT); }
__device__ __forceinline__ unsigned xb_add(unsigned* p, unsigned v) { return __hip_atomic_fetch_add(p, v, __ATOMIC_RELAXED, __HIP_MEMORY_SCOPE_AGENT); }
__device__ __forceinline__ unsigned xb_xcc_id() { return (unsigned)__builtin_amdgcn_s_getreg((3 << 11) | 20) & 0xFu; }
#define XB_SPIN(cond, bar) do { unsigned _sp = 0; while (cond) { __builtin_amdgcn_s_sleep(1); \
    if ((++_sp & 255u) == 0u) { if (xb_ld(&(bar)[XB_TMO])) break; if (_sp > XB_SPIN_CAP) { atomicAdd(&(bar)[XB_TMO], 1u); break; } } } } while (0)
struct XcdBarrier { unsigned* bar; unsigned x; volatile LAS unsigned* st; };
__device__ __forceinline__ XcdBarrier xcd_barrier_post(unsigned* bar, volatile LAS unsigned* st) {
    XcdBarrier b; b.bar = bar; b.x = xb_xcc_id(); b.st = st;
    if (threadIdx.x == 0) (void)xb_add(&bar[XB_XCNT(b.x)], 1u);
    return b;
}
__device__ __forceinline__ void xcd_barrier_complete(unsigned* bar, unsigned x, unsigned& nloc, unsigned& nx) {
    const unsigned G = gridDim.x * gridDim.y * gridDim.z;
    unsigned sum, cnt, mine, sp = 0u;
    for (;;) {
        sum = 0u; cnt = 0u; mine = 0u;
#pragma unroll
        for (unsigned j = 0; j < 16; ++j) { const unsigned c = xb_ld(&bar[XB_XCNT(j)]); sum += c; cnt += (c > 0u) ? 1u : 0u; mine = (j == x) ? c : mine; }
        if (sum == G) break;
        __builtin_amdgcn_s_sleep(1);
        if ((++sp & 255u) == 0u) { if (xb_ld(&bar[XB_TMO])) break; if (sp > XB_SPIN_CAP) { atomicAdd(&bar[XB_TMO], 1u); break; } }
    }
    nloc = mine > 0u ? mine : 1u; nx = cnt > 0u ? cnt : 1u;
}
__device__ __forceinline__ void xcd_barrier(const XcdBarrier& b) {
    asm volatile("s_waitcnt vmcnt(0)" ::: "memory");
    __syncthreads();
    if (threadIdx.x == 0) {
        unsigned* bar = b.bar;
        __builtin_amdgcn_s_waitcnt(0);
        unsigned nloc = b.st[0], nx = b.st[1];
        if (nloc == 0u) { xcd_barrier_complete(bar, b.x, nloc, nx); b.st[0] = nloc; b.st[1] = nx; }
        const unsigned old = xb_add(&bar[XB_XSUB(b.x)], 1u);
        const unsigned gen = old / nloc;
        if (old + 1u == (gen + 1u) * nloc) {
            __builtin_amdgcn_fence(__ATOMIC_RELEASE, "agent");
            asm volatile("s_waitcnt vmcnt(0)" ::: "memory");
            const unsigned og = xb_add(&bar[XB_TOP], 1u);
            const unsigned tg = og / nx;
            if (og + 1u == (tg + 1u) * nx) xb_add(&bar[XB_TOPGEN], 1u);
            else XB_SPIN(xb_ld(&bar[XB_TOPGEN]) == tg, bar);
            __builtin_amdgcn_fence(__ATOMIC_ACQUIRE, "agent");
            xb_add(&bar[XB_XGEN(b.x)], 1u);
            asm volatile("s_waitcnt vmcnt(0)" ::: "memory");
        } else {
            XB_SPIN(xb_ld(&bar[XB_XGEN(b.x)]) == gen, bar);
            __builtin_amdgcn_fence(__ATOMIC_ACQUIRE, "agent");
            asm volatile("s_waitcnt vmcnt(0)" ::: "memory");
        }
    }
    __syncthreads();
}

struct Args { const float* x; const int* pos; const float* g_pre; const float* w_in; const float* g_q; const float* w_uq; const float* g_kv; const float* w_ukv;
              const float* b_forget; const float* w_out; const float* g_post; float* out; unsigned char* ws; int ph_lo, ph_hi; };

__global__ void __launch_bounds__(512, 2) hybrid_fwd(Args a) {
    extern __shared__ __attribute__((aligned(16))) unsigned char lds[];
    cg::grid_group grid = cg::this_grid();
    const int tid_k = threadIdx.x, lane_k = tid_k & 63, wave = __builtin_amdgcn_readfirstlane(tid_k >> 6);
    const int G = gridDim.x, bx = blockIdx.x; const int vcu = (G % 8 == 0) ? (bx % 8) * (G / 8) + bx / 8 : bx;
    unsigned char* ws = a.ws;
    float* rstd_x = (float*)(ws + WS_RSTDX); float* partq = (float*)(ws + WS_PARTQ); float* partkv = (float*)(ws + WS_PARTKV); float* party = (float*)(ws + WS_PARTY);
    float* flog = (float*)(ws + WS_FLOG); float* cf = (float*)(ws + WS_CF); float* cosT = (float*)(ws + WS_COS); float* sinT = (float*)(ws + WS_SIN);
    bf16* Win_t = (bf16*)(ws + WS_WIN); bf16* Wuq_t = (bf16*)(ws + WS_WUQ); bf16* Wukv_t = (bf16*)(ws + WS_WUKV); bf16* Wout_t = (bf16*)(ws + WS_WOUT);
    bf16* Xb = (bf16*)(ws + WS_XB); bf16* Ob = (bf16*)(ws + WS_O); bf16* qlat = (bf16*)(ws + WS_QLAT); bf16* kvlat = (bf16*)(ws + WS_KVLAT); bf16* Gb = (bf16*)(ws + WS_G);
    bf16* Qf = (bf16*)(ws + WS_QF); bf16* Kf = (bf16*)(ws + WS_KF); bf16* Vf = (bf16*)(ws + WS_VF); bf16* Yb = (bf16*)(ws + WS_Y);
    bf16* Qm = (bf16*)(ws + WS_QM); bf16* Km = (bf16*)(ws + WS_KM); bf16* Vm = (bf16*)(ws + WS_VM);
    const int lo = a.ph_lo, hi = a.ph_hi;
#ifndef PH_MASK
#define PH_MASK 63
#endif
#define IN(k) (((PH_MASK >> (k)) & 1) && lo <= (k) && (k) < hi)
#define BOTH(k) (IN(k) && IN((k) + 1))
    LAS unsigned char* ldsl = (LAS unsigned char*)lds;
    volatile LAS unsigned* bst = (volatile LAS unsigned*)(ldsl + LDS_BYTES - 64);
    if (tid_k < 2) bst[tid_k] = 0u;
    __syncthreads();
    XcdBarrier xbar = xcd_barrier_post((unsigned*)(ws + WS_CTL), bst);

    if (IN(0)) for (int rep_ = 0; rep_ < PROBE_REP0; ++rep_) {
        const int lane = launder(lane_k), tid = launder(tid_k);
        LAS float* scr = (LAS float*)(ldsl + wave * 16384);
        const int gw = vcu * 8 + wave, NGW = G * 8;
        constexpr int I_IN = 32 * 208, I_UQ = 12 * 48, I_UKV = 8 * 64, I_OUT = 32 * 64, NITEMS = I_IN + I_UQ + I_UKV + I_OUT;
        for (int it = gw; it < NITEMS; it += NGW) {
            int r = it;
            if (r < I_IN) { const int kb = r / 208, nb = r % 208; int src, nv; win_src(nb * 32, src, nv); transpose_item(a.w_in, DIN, 2048, a.g_pre, Win_t, nb * 32, src, nv, kb * 64, scr, lane); continue; } r -= I_IN;
            if (r < I_UQ) { const int kb = r / 48, nb = r % 48; transpose_item(a.w_uq, 1536, 768, a.g_q, Wuq_t, nb * 32, wuq_src(nb * 32), 32, kb * 64, scr, lane); continue; } r -= I_UQ;
            if (r < I_UKV) { const int kb = r / 64, nb = r % 64; transpose_item(a.w_ukv, 2048, 512, a.g_kv, Wukv_t, nb * 32, nb * 32, 32, kb * 64, scr, lane); continue; } r -= I_UKV;
            { const int kb = r / 64, nb = r % 64; transpose_item(a.w_out, 2048, 2048, nullptr, Wout_t, nb * 32, nb * 32, 32, kb * 64, scr, lane); }
        }
        for (int m = gw; m < M; m += 2 * NGW) {
            const int m2 = m + NGW;
            const f32x4* xr = (const f32x4*)(a.x + (size_t)m * DM) + lane; const f32x4* xr2 = (const f32x4*)(a.x + (size_t)m2 * DM) + lane; f32x4 v[8], v2[8]; float s = 0.f, s2 = 0.f;
#pragma unroll
            for (int j = 0; j < 8; ++j) { v[j] = __builtin_nontemporal_load(xr + 64 * j); v2[j] = __builtin_nontemporal_load(xr2 + 64 * j); }
#pragma unroll
            for (int j = 0; j < 8; ++j) { s += (v[j][0] * v[j][0] + v[j][1] * v[j][1]) + (v[j][2] * v[j][2] + v[j][3] * v[j][3]); s2 += (v2[j][0] * v2[j][0] + v2[j][1] * v2[j][1]) + (v2[j][2] * v2[j][2] + v2[j][3] * v2[j][3]); }
            s = wave_sum(s); s2 = wave_sum(s2);
            if (lane == 0) { rstd_x[m] = 1.f / sqrtf(s * (1.f / DM) + EPS); rstd_x[m2] = 1.f / sqrtf(s2 * (1.f / DM) + EPS); }
            u32x2* o8 = (u32x2*)(Xb + (size_t)m * DM) + lane; u32x2* o82 = (u32x2*)(Xb + (size_t)m2 * DM) + lane;
#pragma unroll
            for (int j = 0; j < 8; ++j) { u32x2 w; w.x = pk2(v[j][0], v[j][1]); w.y = pk2(v[j][2], v[j][3]); o8[64 * j] = w; u32x2 w2; w2.x = pk2(v2[j][0], v2[j][1]); w2.y = pk2(v2[j][2], v2[j][3]); o82[64 * j] = w2; }
        }
        for (int e = (vcu * 512 + tid); e < M * 32; e += G * 512) { const int row = e >> 5, i = e & 31;
            const float inv = exp2f(-(float)i * (13.287712379549449f / 32.f)); const float ang = (float)a.pos[row] * inv;
            const float n = rintf(ang * 0.15915494309189535f); float r = fmaf(-n, 6.28318548202514648f, ang); r = fmaf(-n, -1.7484555e-7f, r);
            cosT[e] = __cosf(r); sinT[e] = __sinf(r); }
    }
    if (BOTH(0)) grid.sync();

    if (IN(1)) for (int rep_ = 0; rep_ < PROBE_REP1; ++rep_) {
        pg8::Gemm g{Xb, Win_t, M, NIN_PAD, 2048}; pg8::StaticOrder S; S.init(M, NIN_PAD, G, bx);
        EpiIn E{rstd_x, qlat, kvlat, Gb, Qf, Kf, Vf, Km, flog, partq, partkv, cosT, sinT};
        pg8::gemm_phase<EpiIn, pg8::StaticOrder, true, true>(ldsl, g, S, E);
    }
    if (BOTH(1)) xcd_barrier(xbar);

    if (IN(2)) for (int rep_ = 0; rep_ < PROBE_REP2; ++rep_) {
        const int lane = launder(lane_k), tid = launder(tid_k);
        if (bx < BATCH * NH) {
            const int b = bx >> 3, h = bx & 7; const float bf = a.b_forget[h];
            const float* fl = flog + ((size_t)b * SEQ + 8 * tid) * 8 + h; float lf[8];
#pragma unroll
            for (int j = 0; j < 8; ++j) lf[j] = fl[j * 8] + bf;
#pragma unroll
            for (int j = 0; j < 8; ++j) { const float z = lf[j]; lf[j] = fminf(z, 0.f) - log1pf(expf(-fabsf(z))); }
#pragma unroll
            for (int j = 1; j < 8; ++j) lf[j] += lf[j - 1];
            float incl = lf[7];
#pragma unroll
            for (int o = 1; o < 64; o <<= 1) { const float t = __shfl_up(incl, o); if (lane >= o) incl += t; }
            volatile LAS float* wtot = (volatile LAS float*)(ldsl + LDS_BYTES - 128);
            if (lane == 63) wtot[wave] = incl;
            __syncthreads();
            float off = incl - lf[7];
            for (int w2 = 0; w2 < wave; ++w2) off += wtot[w2];
            float* cp = cf + (size_t)bx * SEQ + 8 * tid;
            f32x4 o0, o1;
#pragma unroll
            for (int j = 0; j < 4; ++j) { o0[j] = (off + lf[j]) * LOG2E; o1[j] = (off + lf[4 + j]) * LOG2E; }
            *(f32x4*)cp = o0; *(f32x4*)(cp + 4) = o1;
            __syncthreads();
        }
        { pg8::Gemm g{qlat, Wuq_t, M, 1536, QRANK}; pg8::StaticOrder S; S.init(M, 1536, G, bx);
          EpiQ E{partq, Qm, cosT, sinT};
          pg8::gemm_phase<EpiQ, pg8::StaticOrder, true, true>(ldsl, g, S, E); }
        { pg8::Gemm g{kvlat, Wukv_t, M, 2048, KVRANK}; pg8::StaticOrder S; S.init(M, 2048, G, bx);
          EpiKV E{partkv, Km, Vm};
          pg8::gemm_phase<EpiKV, pg8::StaticOrder, true, true>(ldsl, g, S, E); }
    }
    if (BOTH(2)) xcd_barrier(xbar);

    if (IN(3)) for (int rep_ = 0; rep_ < PROBE_REP3; ++rep_) {
        for (int v = vcu; v < 256; v += G) {
            const int s = v & 3, w = v >> 2, b = w >> 4, hh = w & 15, hd = hh & 7, swp = hh >> 3;
            const size_t rb = (size_t)b * SEQ;
#pragma unroll 1
            for (int i = 0; i < 2; ++i) {
                const int qb = __builtin_amdgcn_readfirstlane(swp ? (i == 0 ? 8 + s : 7 - s) : (i == 0 ? 15 - s : s));
                att::attn_unit<192, false>((char*)lds, Qm + rb * 1536 + hd * 192, 1536, Km + rb * 1536 + hd * 192, 1536, Vm + rb * 1024 + hd * 128, 1024, nullptr,
                                           Gb + rb * 2048 + hd * 128, Ob + rb * 2048 + hd * 128, qb);
            }
#pragma unroll 1
            for (int i = 0; i < 2; ++i) {
                const int qb = __builtin_amdgcn_readfirstlane(swp ? (i == 0 ? 15 - s : s) : (i == 0 ? 8 + s : 7 - s));
                att::attn_unit<128, true>((char*)lds, Qf + rb * 1024 + hd * 128, 1024, Kf + rb * 1024 + hd * 128, 1024, Vf + rb * 1024 + hd * 128, 1024, cf + (size_t)(b * 8 + hd) * SEQ,
                                          Gb + rb * 2048 + 1024 + hd * 128, Ob + rb * 2048 + 1024 + hd * 128, qb);
            }
        }
    }
#if PROBE_ABL >= 0
    if (IN(3)) {
        for (int v = vcu; v < 256; v += G) {
            const int s = v & 3, w = v >> 2, b = w >> 4, hh = w & 15, hd = hh & 7, swp = hh >> 3;
            const size_t rb = (size_t)b * SEQ;
#pragma unroll 1
            for (int i = 0; i < 2; ++i) {
                const int qb = __builtin_amdgcn_readfirstlane(swp ? (i == 0 ? 8 + s : 7 - s) : (i == 0 ? 15 - s : s));
                att::attn_unit<192, false, PROBE_ABL>((char*)lds, Qm + rb * 1536 + hd * 192, 1536, Km + rb * 1536 + hd * 192, 1536, Vm + rb * 1024 + hd * 128, 1024, nullptr,
                                           Gb + rb * 2048 + hd * 128, qlat, qb);
            }
#pragma unroll 1
            for (int i = 0; i < 2; ++i) {
                const int qb = __builtin_amdgcn_readfirstlane(swp ? (i == 0 ? 15 - s : s) : (i == 0 ? 8 + s : 7 - s));
                att::attn_unit<128, true, PROBE_ABL>((char*)lds, Qf + rb * 1024 + hd * 128, 1024, Kf + rb * 1024 + hd * 128, 1024, Vf + rb * 1024 + hd * 128, 1024, cf + (size_t)(b * 8 + hd) * SEQ,
                                          Gb + rb * 2048 + 1024 + hd * 128, qlat, qb);
            }
        }
    }
#endif
    if (BOTH(3)) xcd_barrier(xbar);

    if (IN(4)) for (int rep_ = 0; rep_ < PROBE_REP4; ++rep_) {
        pg8::Gemm g{Ob, Wout_t, M, 2048, 2048}; pg8::StaticOrder S; S.init(M, 2048, G, bx);
        EpiOut E{Yb, party};
        pg8::gemm_phase<EpiOut, pg8::StaticOrder, true, true>(ldsl, g, S, E);
    }
    if (BOTH(4)) xcd_barrier(xbar);

    if (IN(5)) for (int rep_ = 0; rep_ < PROBE_REP5; ++rep_) {
        const int lane = launder(lane_k);
        const int gw = vcu * 8 + wave, NGW = G * 8;
        const f32x4* gp = (const f32x4*)a.g_post + lane; f32x4 gv[8];
#pragma unroll
        for (int j = 0; j < 8; ++j) gv[j] = gp[64 * j];
        for (int m = gw; m < M; m += 2 * NGW) {
            const int m2 = m + NGW;
            float s = (lane < 32) ? party[(size_t)m * 32 + lane] : 0.f, s2 = (lane < 32) ? party[(size_t)m2 * 32 + lane] : 0.f;
            const f32x4* xr = (const f32x4*)(a.x + (size_t)m * DM) + lane; const f32x4* xr2 = (const f32x4*)(a.x + (size_t)m2 * DM) + lane;
            const u32x2* yr = (const u32x2*)(Yb + (size_t)m * DM) + lane; const u32x2* yr2 = (const u32x2*)(Yb + (size_t)m2 * DM) + lane;
            f32x4 xv[8], xv2[8]; u32x2 y[8], y2[8];
#pragma unroll
            for (int j = 0; j < 8; ++j) { xv[j] = __builtin_nontemporal_load(xr + 64 * j); xv2[j] = __builtin_nontemporal_load(xr2 + 64 * j); y[j] = __builtin_nontemporal_load(yr + 64 * j); y2[j] = __builtin_nontemporal_load(yr2 + 64 * j); }
            s = wave_sum(s); s2 = wave_sum(s2);
            const float rs = 1.f / sqrtf(s * (1.f / DM) + EPS), rs2 = 1.f / sqrtf(s2 * (1.f / DM) + EPS);
            f32x4* orow = (f32x4*)(a.out + (size_t)m * DM) + lane; f32x4* orow2 = (f32x4*)(a.out + (size_t)m2 * DM) + lane;
#pragma unroll
            for (int j = 0; j < 8; ++j) {
                f32x4 o; o[0] = xv[j][0] + bflo(y[j].x) * rs * gv[j][0]; o[1] = xv[j][1] + bfhi(y[j].x) * rs * gv[j][1]; o[2] = xv[j][2] + bflo(y[j].y) * rs * gv[j][2]; o[3] = xv[j][3] + bfhi(y[j].y) * rs * gv[j][3];
                __builtin_nontemporal_store(o, orow + 64 * j);
                f32x4 o2; o2[0] = xv2[j][0] + bflo(y2[j].x) * rs2 * gv[j][0]; o2[1] = xv2[j][1] + bfhi(y2[j].x) * rs2 * gv[j][1]; o2[2] = xv2[j][2] + bflo(y2[j].y) * rs2 * gv[j][2]; o2[3] = xv2[j][3] + bfhi(y2[j].y) * rs2 * gv[j][3];
                __builtin_nontemporal_store(o2, orow2 + 64 * j); }
        }
    }
#undef IN
#undef BOTH
}

extern "C" void kernel_launch(void* const* d_in, const int* in_sizes, int n_in, void* d_out, int out_size, void* d_ws, size_t ws_size, hipStream_t stream) {
    static int grid = 0;
    if (grid == 0) {
        if (n_in != 11 || in_sizes[0] != M * DM || out_size != M * DM || ws_size < WS_END) { fprintf(stderr, "kernel_launch: shape mismatch n_in %d in0 %d out %d ws %zu\n", n_in, n_in > 0 ? in_sizes[0] : -1, out_size, ws_size); grid = -1; return; }
        int dev = 0, cus = 0, per_cu = 0;
        if (hipGetDevice(&dev) != hipSuccess || hipDeviceGetAttribute(&cus, hipDeviceAttributeMultiprocessorCount, dev) != hipSuccess) { grid = -1; return; }
        if (hipFuncSetAttribute((const void*)hybrid_fwd, hipFuncAttributeMaxDynamicSharedMemorySize, LDS_BYTES) != hipSuccess) { fprintf(stderr, "kernel_launch: hipFuncSetAttribute failed\n"); grid = -1; return; }
        if (hipOccupancyMaxActiveBlocksPerMultiprocessor(&per_cu, (const void*)hybrid_fwd, 512, LDS_BYTES) != hipSuccess || per_cu < 1) { fprintf(stderr, "kernel_launch: occupancy query says %d\n", per_cu); per_cu = 1; }
        (void)hipGetLastError();
        grid = cus;
    }
    if (grid < 0) return;
    if (hipMemsetAsync((char*)d_ws + WS_CTL, 0, CTL_BYTES, stream) != hipSuccess) { fprintf(stderr, "kernel_launch: memset failed\n"); return; }
    Args a{};
    a.x = (const float*)d_in[0]; a.pos = (const int*)d_in[1]; a.g_pre = (const float*)d_in[2]; a.w_in = (const float*)d_in[3]; a.g_q = (const float*)d_in[4]; a.w_uq = (const float*)d_in[5];
    a.g_kv = (const float*)d_in[6]; a.w_ukv = (const float*)d_in[7]; a.b_forget = (const float*)d_in[8]; a.w_out = (const float*)d_in[9]; a.g_post = (const float*)d_in[10];
    a.out = (float*)d_out; a.ws = (unsigned char*)d_ws;
#if MK_N_LAUNCHES == 1
    a.ph_lo = 0; a.ph_hi = 6;
    void* args[] = {&a};
    hipError_t e = hipLaunchCooperativeKernel((const void*)hybrid_fwd, dim3(grid), dim3(512), args, LDS_BYTES, stream);
    if (e != hipSuccess) fprintf(stderr, "cooperative launch failed: %s (grid %d)\n", hipGetErrorString(e), grid);
#else
    for (int p = 0; p < 6; ++p) { a.ph_lo = p; a.ph_hi = p + 1; for (int r = 0; r < (p == PROBE_DUP ? 2 : 1); ++r) hipLaunchKernelGGL(hybrid_fwd, dim3(grid), dim3(512), LDS_BYTES, stream, a); }
#endif
}
```

```cpp
#include <hip/hip_runtime.h>
#include <hip/hip_cooperative_groups.h>
#include <cstdio>
#include <cstdint>
namespace cg = cooperative_groups;

#ifndef PROBE_REP0
#define PROBE_REP0 1
#endif
#ifndef PROBE_REP1
#define PROBE_REP1 1
#endif
#ifndef PROBE_REP2
#define PROBE_REP2 1
#endif
#ifndef PROBE_REP3
#define PROBE_REP3 1
#endif
#ifndef PROBE_REP4
#define PROBE_REP4 1
#endif
#ifndef PROBE_REP5
#define PROBE_REP5 1
#endif
#ifndef PROBE_ABL
#define PROBE_ABL -1
#endif
#ifndef PROBE_DUP
#define PROBE_DUP -1
#endif
#ifndef MK_N_LAUNCHES
#define MK_N_LAUNCHES 1
#endif

namespace pg8 {
#define PG8_LAS __attribute__((address_space(3)))
typedef unsigned short bf16_t;
typedef short bf16x8 __attribute__((ext_vector_type(8)));
typedef float f32x4 __attribute__((ext_vector_type(4)));
typedef unsigned u32x4 __attribute__((ext_vector_type(4)));
constexpr int BM = 256, BK = 64, HALF = 128, HTB = HALF * BK * 2, STAGE_BYTES = 8 * HTB, NXCD = 8, WGM = 8;

__host__ __device__ __forceinline__ int lds_byte(int r, int c) { const int st = (r >> 4) * 2 + (c >> 5), rr = r & 15, cc = c & 31, ob = rr * 64 + cc * 2; return st * 1024 + (ob ^ (((ob >> 9) & 1) << 5)); }
__host__ __device__ __forceinline__ void stage_rc(int b, int& R, int& C) { const int st = b / 1024, sb = b % 1024, swz = sb ^ (((sb >> 9) & 1) << 5); R = (st >> 1) * 16 + swz / 64; C = (st & 1) * 32 + (swz % 64) / 2; }
__host__ __device__ __forceinline__ int perm32(int rho) { const int n = rho >> 4, i = rho & 15; return 8 * (i >> 2) + 4 * n + (i & 3); }

struct Unit { int pm, pn; };
struct Gemm { const bf16_t* A; const bf16_t* Bt; int M, N, K; };

struct StaticOrder {
    int nM, nN, nwg, G, c;
    __host__ __device__ void init(int M, int N, int G_, int c_) { nM = M / BM; nN = N / BM; nwg = nM * nN; G = G_; c = c_; }
    __host__ __device__ bool next(int i, Unit& u) const {
        const long L = (long)i * G + c; if (L >= nwg) return false;
        int wgid = (int)L; { const int q = nwg / NXCD, r = nwg % NXCD, xcd = wgid % NXCD, off = wgid / NXCD; wgid = (xcd < r ? xcd * (q + 1) : r * (q + 1) + (xcd - r) * q) + off; }
        const int nig = WGM * nN, gid = wgid / nig, fm = gid * WGM, gsz = (nM - fm) < WGM ? (nM - fm) : WGM;
        u.pm = fm + ((wgid % nig) % gsz); u.pn = (wgid % nig) / gsz; return true;
    }
    __device__ __forceinline__ void a_ready(const Unit&) const {}
    __device__ __forceinline__ void done(const Unit&) const {}
};

__device__ __forceinline__ unsigned cvt_pk_bf16(float lo, float hi) { unsigned r; asm volatile("v_cvt_pk_bf16_f32 %0, %1, %2" : "=v"(r) : "v"(lo), "v"(hi)); return r; }

template <class Epi, class Sched, bool ALIGN_EPI = false, bool SP2 = false>
__device__ __forceinline__ void gemm_phase(PG8_LAS unsigned char* lds, const Gemm g, const Sched& S, const Epi& E) {
    const int tid = threadIdx.x, wid = __builtin_amdgcn_readfirstlane(tid >> 6), lane = tid & 63, wr = wid >> 2, wc = wid & 3, fr = lane & 15, fq = lane >> 4;
    const int K = g.K, nt = K / BK;
    unsigned voffA[2], voffB[2];
#pragma unroll
    for (int i = 0; i < 2; ++i) { int R, C; stage_rc(tid * 16 + i * 8192, R, C); const int Rb = Epi::PERM ? ((R & ~31) + perm32(R & 31)) : R;
        voffA[i] = (unsigned)(R * K + C) * 2u; voffB[i] = (unsigned)(Rb * K + C) * 2u; }
    const size_t kstep = (size_t)(BK * 2);
    const size_t hstep = (size_t)HALF * K * 2;
    const size_t tstep = 2 * hstep;
    const unsigned ldsw = (unsigned)wid * 1024u;
    const int aoff = lds_byte(wr * 64 + fr, fq * 8), boff = lds_byte(wc * 32 + fr, fq * 8);
#define PG8_SA(b, h) (((b) * 2 + (h)) * HTB)
#define PG8_SB(b, h) ((4 + (b) * 2 + (h)) * HTB)
#define PG8_STAGE(bufoff, gbase, voff) do { _Pragma("unroll") for (int _i = 0; _i < 2; ++_i) \
        __builtin_amdgcn_global_load_lds((const unsigned*)((const char*)(gbase) + (voff)[_i]), (PG8_LAS unsigned*)(lds + (bufoff) + ldsw + _i * 8192), 16, 0, 0); } while (0)
#define PG8_LDA(dst, b, h) do { _Pragma("unroll") for (int m = 0; m < 4; ++m) _Pragma("unroll") for (int k = 0; k < 2; ++k) dst[m][k] = *(const PG8_LAS bf16x8*)(lds + PG8_SA(b, h) + aoff + m * 2048 + k * 1024); } while (0)
#define PG8_LDB(dst, b, h) do { _Pragma("unroll") for (int n = 0; n < 2; ++n) _Pragma("unroll") for (int k = 0; k < 2; ++k) dst[n][k] = *(const PG8_LAS bf16x8*)(lds + PG8_SB(b, h) + boff + n * 2048 + k * 1024); } while (0)
#define PG8_MMA(ai, bj, At, Bt) do { __builtin_amdgcn_s_setprio(1); _Pragma("unroll") for (int m = 0; m < 4; ++m) _Pragma("unroll") for (int n = 0; n < 2; ++n) _Pragma("unroll") for (int k = 0; k < 2; ++k) \
        acc[ai][bj][m][n] = __builtin_amdgcn_mfma_f32_16x16x32_bf16(Bt[n][k], At[m][k], acc[ai][bj][m][n], 0, 0, 0); __builtin_amdgcn_s_setprio(0); } while (0)
#define PG8_WAIT_V(n) asm volatile("s_waitcnt vmcnt(" #n ")" ::: "memory")
#define PG8_WAIT_L(n) asm volatile("s_waitcnt lgkmcnt(" #n ")" ::: "memory")
#define PG8_BAR __builtin_amdgcn_s_barrier()
#define PG8_SCHED __builtin_amdgcn_sched_barrier(0)
    Unit cur, nxt; int ui = 0;
    if (!S.next(0, cur)) return;
    f32x4 acc[2][2][4][2];
#pragma unroll
    for (int a = 0; a < 2; ++a)
#pragma unroll
        for (int b = 0; b < 2; ++b)
#pragma unroll
            for (int m = 0; m < 4; ++m)
#pragma unroll
                for (int n = 0; n < 2; ++n) acc[a][b][m][n] = (f32x4){0.f, 0.f, 0.f, 0.f};
    bf16x8 At[4][2], B0[2][2], B1[2][2];
    const char* cA = (const char*)g.A + (size_t)cur.pm * tstep; const char* cB = (const char*)g.Bt + (size_t)cur.pn * tstep;
    S.a_ready(cur);
    if constexpr (SP2) {
        PG8_STAGE(PG8_SB(0, 0), cB, voffB); PG8_STAGE(PG8_SB(0, 1), cB + hstep, voffB); PG8_STAGE(PG8_SA(0, 0), cA, voffA); PG8_STAGE(PG8_SA(0, 1), cA + hstep, voffA);
        if (wr == 1) PG8_BAR;
        PG8_WAIT_V(2); PG8_BAR;
        PG8_STAGE(PG8_SB(1, 0), cB + kstep, voffB); PG8_STAGE(PG8_SA(1, 0), cA + kstep, voffA); PG8_STAGE(PG8_SB(1, 1), cB + hstep + kstep, voffB);
        PG8_WAIT_V(6); PG8_BAR;
    } else {
        PG8_STAGE(PG8_SB(0, 0), cB, voffB); PG8_STAGE(PG8_SA(0, 0), cA, voffA); PG8_STAGE(PG8_SB(0, 1), cB + hstep, voffB); PG8_STAGE(PG8_SA(0, 1), cA + hstep, voffA);
        if (wr == 1) PG8_BAR;
        PG8_WAIT_V(4); PG8_BAR;
        PG8_STAGE(PG8_SB(1, 0), cB + kstep, voffB); PG8_STAGE(PG8_SA(1, 0), cA + kstep, voffA); PG8_STAGE(PG8_SB(1, 1), cB + hstep + kstep, voffB);
        PG8_WAIT_V(6); PG8_BAR;
    }
    for (;;) {
        const bool has_next = S.next(ui + 1, nxt);
        const char* nA = has_next ? (const char*)g.A + (size_t)nxt.pm * tstep : cA; const char* nB = has_next ? (const char*)g.Bt + (size_t)nxt.pn * tstep : cB;
        for (int t = 0; t < nt; t += 2) {
            const bool last = (t == nt - 2);
            const char* a1 = cA + (size_t)(t + 1) * kstep;
            const char* a2 = last ? nA : cA + (size_t)(t + 2) * kstep; const char* b2 = last ? nB : cB + (size_t)(t + 2) * kstep;
            const char* a3 = a2 + kstep; const char* b3 = b2 + kstep;
            if (last && has_next) S.a_ready(nxt);
            if constexpr (SP2) {
            PG8_LDB(B0, 0, 0); PG8_LDB(B1, 0, 1); PG8_SCHED; PG8_LDA(At, 0, 0); PG8_STAGE(PG8_SA(1, 1), a1 + hstep, voffA);
            PG8_WAIT_V(8); PG8_WAIT_L(0); PG8_BAR; PG8_MMA(0, 0, At, B0); PG8_MMA(0, 1, At, B1); PG8_BAR; PG8_SCHED;
            PG8_LDA(At, 0, 1); PG8_STAGE(PG8_SB(0, 0), b2, voffB); PG8_STAGE(PG8_SB(0, 1), b2 + hstep, voffB); PG8_STAGE(PG8_SA(0, 0), a2, voffA);
            PG8_WAIT_V(8); PG8_WAIT_L(0); PG8_BAR; PG8_MMA(1, 0, At, B0); PG8_MMA(1, 1, At, B1); PG8_BAR; PG8_SCHED;
            PG8_LDB(B0, 1, 0); PG8_LDB(B1, 1, 1); PG8_SCHED; PG8_LDA(At, 1, 0); PG8_STAGE(PG8_SA(0, 1), a2 + hstep, voffA);
            PG8_WAIT_V(8); PG8_WAIT_L(0); PG8_BAR; PG8_MMA(0, 0, At, B0); PG8_MMA(0, 1, At, B1); PG8_BAR; PG8_SCHED;
            PG8_LDA(At, 1, 1); PG8_STAGE(PG8_SB(1, 0), b3, voffB); PG8_STAGE(PG8_SB(1, 1), b3 + hstep, voffB); PG8_STAGE(PG8_SA(1, 0), a3, voffA);
            PG8_WAIT_V(8); PG8_WAIT_L(0); PG8_BAR; PG8_MMA(1, 0, At, B0); PG8_MMA(1, 1, At, B1); PG8_BAR; PG8_SCHED;
            } else {
            PG8_LDB(B0, 0, 0); PG8_SCHED; PG8_LDA(At, 0, 0); PG8_STAGE(PG8_SA(1, 1), a1 + hstep, voffA);
            PG8_WAIT_L(8); PG8_BAR; PG8_WAIT_L(0); PG8_MMA(0, 0, At, B0); PG8_BAR; PG8_SCHED;
            PG8_LDB(B1, 0, 1); PG8_STAGE(PG8_SB(0, 0), b2, voffB);
            PG8_BAR; PG8_WAIT_L(0); PG8_MMA(0, 1, At, B1); PG8_BAR;
            PG8_LDA(At, 0, 1); PG8_STAGE(PG8_SA(0, 0), a2, voffA);
            PG8_BAR; PG8_WAIT_L(0); PG8_MMA(1, 0, At, B0); PG8_BAR; PG8_SCHED;
            PG8_STAGE(PG8_SB(0, 1), b2 + hstep, voffB);
            PG8_WAIT_V(6); PG8_BAR; PG8_MMA(1, 1, At, B1); PG8_BAR;
            PG8_LDB(B0, 1, 0); PG8_SCHED; PG8_LDA(At, 1, 0); PG8_STAGE(PG8_SA(0, 1), a2 + hstep, voffA);
            PG8_WAIT_L(8); PG8_BAR; PG8_WAIT_L(0); PG8_MMA(0, 0, At, B0); PG8_BAR; PG8_SCHED;
            PG8_LDB(B1, 1, 1); PG8_STAGE(PG8_SB(1, 0), b3, voffB);
            PG8_BAR; PG8_WAIT_L(0); PG8_MMA(0, 1, At, B1); PG8_BAR;
            PG8_LDA(At, 1, 1); PG8_STAGE(PG8_SA(1, 0), a3, voffA);
            PG8_BAR; PG8_WAIT_L(0); PG8_MMA(1, 0, At, B0); PG8_BAR; PG8_SCHED;
            PG8_STAGE(PG8_SB(1, 1), b3 + hstep, voffB);
            PG8_WAIT_V(6); PG8_BAR; PG8_MMA(1, 1, At, B1); PG8_BAR;
            }
        }
        if constexpr (ALIGN_EPI) { if (wr == 0) PG8_BAR; }
        if constexpr (!Epi::AFTER_DRAIN) { E(acc, cur, wr, wc, fr, fq); S.done(cur); }
        if (!has_next) break;
#pragma unroll
        for (int a = 0; a < 2; ++a)
#pragma unroll
            for (int b = 0; b < 2; ++b)
#pragma unroll
                for (int m = 0; m < 4; ++m)
#pragma unroll
                    for (int n = 0; n < 2; ++n) acc[a][b][m][n] = (f32x4){0.f, 0.f, 0.f, 0.f};
        cur = nxt; cA = nA; cB = nB; ++ui;
        if constexpr (ALIGN_EPI) { if (wr == 1) PG8_BAR; }
    }
    PG8_WAIT_V(0);
    if constexpr (!ALIGN_EPI) { if (wr == 0) PG8_BAR; }
    PG8_BAR;
#undef PG8_SA
#undef PG8_SB
#undef PG8_STAGE
#undef PG8_LDA
#undef PG8_LDB
#undef PG8_MMA
#undef PG8_WAIT_V
#undef PG8_WAIT_L
#undef PG8_BAR
#undef PG8_SCHED
}
}

typedef unsigned short bf16;
typedef float f32x4 __attribute__((ext_vector_type(4)));
typedef unsigned u32x4 __attribute__((ext_vector_type(4)));
typedef unsigned u32x2 __attribute__((ext_vector_type(2)));
typedef short bf16x8 __attribute__((ext_vector_type(8)));
typedef short s16x4 __attribute__((ext_vector_type(4)));
typedef float f32x16 __attribute__((ext_vector_type(16)));
#define LAS __attribute__((address_space(3)))

constexpr int BATCH = 4, SEQ = 4096, DM = 2048, M = BATCH * SEQ;
constexpr int NH = 8, QKD = 192, QRANK = 768, KVRANK = 512, DIN = 6472;
constexpr int NIN_PAD = 6656;
constexpr float EPS = 1e-6f;
constexpr float LOG2E = 1.4426950408889634f;
constexpr float C2M = 0.07216878364870322f * LOG2E;
constexpr float C2F = 0.08838834764831845f * LOG2E;

constexpr size_t MiB = 1u << 20;
constexpr size_t WS_RSTDX = 0, WS_PARTQ = 1 * MiB, WS_PARTKV = 2 * MiB, WS_PARTY = 3 * MiB, WS_FLOG = 5 * MiB, WS_CF = 6 * MiB, WS_COS = 7 * MiB, WS_SIN = 9 * MiB;
constexpr size_t WS_CTL = 11 * MiB, CTL_BYTES = 16384;
constexpr size_t WS_WIN = 16 * MiB, WS_WUQ = 42 * MiB, WS_WUKV = 45 * MiB, WS_WOUT = 47 * MiB;
constexpr size_t WS_XB = 56 * MiB, WS_O = 56 * MiB;
constexpr size_t WS_QLAT = 120 * MiB, WS_KVLAT = 144 * MiB, WS_G = 160 * MiB;
constexpr size_t WS_QF = 224 * MiB, WS_Y = 224 * MiB, WS_KF = 256 * MiB, WS_VF = 288 * MiB;
constexpr size_t WS_QM = 320 * MiB, WS_KM = 368 * MiB, WS_VM = 416 * MiB, WS_END = 448 * MiB;

constexpr int LDS_BYTES = 163840;

__device__ __forceinline__ unsigned f2bf(float f) { unsigned u = __builtin_bit_cast(unsigned, f); return (u + 0x7fffu + ((u >> 16) & 1u)) >> 16; }
__device__ __forceinline__ unsigned pk2(float lo, float hi) { return pg8::cvt_pk_bf16(lo, hi); }
__device__ __forceinline__ float bflo(unsigned w) { return __builtin_bit_cast(float, w << 16); }
__device__ __forceinline__ float bfhi(unsigned w) { return __builtin_bit_cast(float, w & 0xffff0000u); }
__device__ __forceinline__ int launder(int v) { asm volatile("" : "+v"(v)); return v; }
__device__ __forceinline__ float wave_sum(float v) {
#pragma unroll
    for (int o = 1; o < 64; o <<= 1) v += __shfl_xor(v, o);
    return v;
}
__device__ __forceinline__ float silu_f(float v) { return v * __builtin_amdgcn_rcpf(1.f + __builtin_amdgcn_exp2f(-v * LOG2E)); }
__device__ __forceinline__ u32x4 pack8f(f32x4 a, f32x4 b) { u32x4 w; w.x = pk2(a[0], a[1]); w.y = pk2(a[2], a[3]); w.z = pk2(b[0], b[1]); w.w = pk2(b[2], b[3]); return w; }

typedef pg8::f32x4 af4;
struct EpiIn {
    static constexpr bool PERM = true, AFTER_DRAIN = false;
    const float* rstd_x; bf16 *qlat, *kvlat, *G, *Qf, *Kf, *Vf, *Km; float *flog, *partq, *partkv; const float *cosT, *sinT;
    __device__ __forceinline__ void operator()(const af4 (&acc)[2][2][4][2], const pg8::Unit& u, int wr, int wc, int fr, int fq) const {
        const int pn = u.pn; const int row0 = u.pm * 256 + wr * 64 + fr;
        if (pn == 25) {
            if (wc == 0) {
#pragma unroll
                for (int ai = 0; ai < 2; ++ai)
#pragma unroll
                    for (int m = 0; m < 4; ++m) { const int row = row0 + ai * 128 + m * 16; const float rs = rstd_x[row];
                        f32x4 o1[2], o2[2];
#pragma unroll
                        for (int n = 0; n < 2; ++n) { const f32x4 c = *(const f32x4*)(cosT + (size_t)row * 32 + 8 * fq + 4 * n), s = *(const f32x4*)(sinT + (size_t)row * 32 + 8 * fq + 4 * n);
                            const f32x4 x1 = acc[ai][0][m][n] * rs, x2 = acc[ai][1][m][n] * rs; o1[n] = x1 * c - x2 * s; o2[n] = x2 * c + x1 * s; }
                        const u32x4 w1 = pack8f(o1[0], o1[1]), w2 = pack8f(o2[0], o2[1]);
                        bf16* kp = Km + (size_t)row * 1536 + 128 + 8 * fq;
#pragma unroll
                        for (int h = 0; h < 8; ++h) { *(u32x4*)(kp + h * 192) = w1; *(u32x4*)(kp + h * 192 + 32) = w2; } }
            } else if (wc == 1 && fq == 0) {
#pragma unroll
                for (int ai = 0; ai < 2; ++ai)
#pragma unroll
                    for (int m = 0; m < 4; ++m) { const int row = row0 + ai * 128 + m * 16; const float rs = rstd_x[row];
                        *(f32x4*)(flog + (size_t)row * 8) = acc[ai][0][m][0] * rs; *(f32x4*)(flog + (size_t)row * 8 + 4) = acc[ai][0][m][1] * rs; }
            }
            return;
        }
        bf16* base; int ld, colt, mode = 0; float* part = nullptr; int nslot = 0, slot0 = 0;
        if (pn < 3) { base = qlat; ld = 768; colt = pn * 256; part = partq; nslot = 12; slot0 = pn * 4; }
        else if (pn < 5) { base = kvlat; ld = 512; colt = (pn - 3) * 256; part = partkv; nslot = 8; slot0 = (pn - 3) * 4; }
        else if (pn < 9) { base = G; ld = 2048; colt = (pn - 5) * 256; mode = 1; }
        else if (pn < 13) { base = Qf; ld = 1024; colt = (pn - 9) * 256; mode = 2; }
        else if (pn < 17) { base = Kf; ld = 1024; colt = (pn - 13) * 256; }
        else if (pn < 21) { base = Vf; ld = 1024; colt = (pn - 17) * 256; }
        else { base = G; ld = 2048; colt = 1024 + (pn - 21) * 256; mode = 1; }
        const int col0 = colt + wc * 32 + 8 * fq;
#pragma unroll
        for (int ai = 0; ai < 2; ++ai)
#pragma unroll
            for (int m = 0; m < 4; ++m) { const int row = row0 + ai * 128 + m * 16; float rs = rstd_x[row]; if (mode == 2) rs *= C2F;
                bf16* rowp = base + (size_t)row * ld + col0; float ss = 0.f;
#pragma unroll
                for (int bj = 0; bj < 2; ++bj) { f32x4 v0 = acc[ai][bj][m][0] * rs, v1 = acc[ai][bj][m][1] * rs;
                    ss += (v0[0] * v0[0] + v0[1] * v0[1]) + (v0[2] * v0[2] + v0[3] * v0[3]) + (v1[0] * v1[0] + v1[1] * v1[1]) + (v1[2] * v1[2] + v1[3] * v1[3]);
                    if (mode == 1) {
#pragma unroll
                        for (int e = 0; e < 4; ++e) { v0[e] = silu_f(v0[e]); v1[e] = silu_f(v1[e]); } }
                    *(u32x4*)(rowp + bj * 128) = pack8f(v0, v1); }
                if (part) { ss += __shfl_xor(ss, 16); ss += __shfl_xor(ss, 32); if (fq == 0) part[(size_t)row * nslot + slot0 + wc] = ss; } }
    }
};
struct EpiQ {
    static constexpr bool PERM = true, AFTER_DRAIN = false;
    const float* partq; bf16* Qm; const float *cosT, *sinT;
    __device__ __forceinline__ void operator()(const af4 (&acc)[2][2][4][2], const pg8::Unit& u, int wr, int wc, int fr, int fq) const {
        const int pn = u.pn; const int row0 = u.pm * 256 + wr * 64 + fr;
#pragma unroll
        for (int ai = 0; ai < 2; ++ai)
#pragma unroll
            for (int m = 0; m < 4; ++m) { const int row = row0 + ai * 128 + m * 16;
                const f32x4 pa = *(const f32x4*)(partq + (size_t)row * 12), pb = *(const f32x4*)(partq + (size_t)row * 12 + 4), pc = *(const f32x4*)(partq + (size_t)row * 12 + 8);
                const float ssq = ((pa[0] + pa[1]) + (pa[2] + pa[3])) + ((pb[0] + pb[1]) + (pb[2] + pb[3])) + ((pc[0] + pc[1]) + (pc[2] + pc[3]));
                const float rs = C2M / sqrtf(ssq * (1.f / 768.f) + EPS);
                if (pn < 4) {
#pragma unroll
                    for (int bj = 0; bj < 2; ++bj) *(u32x4*)(Qm + (size_t)row * 1536 + (2 * pn + bj) * 192 + wc * 32 + 8 * fq) = pack8f(acc[ai][bj][m][0] * rs, acc[ai][bj][m][1] * rs);
                } else { const int head = 4 * (pn - 4) + wc; f32x4 o1[2], o2[2];
#pragma unroll
                    for (int n = 0; n < 2; ++n) { const f32x4 c = *(const f32x4*)(cosT + (size_t)row * 32 + 8 * fq + 4 * n), s = *(const f32x4*)(sinT + (size_t)row * 32 + 8 * fq + 4 * n);
                        const f32x4 x1 = acc[ai][0][m][n] * rs, x2 = acc[ai][1][m][n] * rs; o1[n] = x1 * c - x2 * s; o2[n] = x2 * c + x1 * s; }
                    bf16* qp = Qm + (size_t)row * 1536 + head * 192 + 128 + 8 * fq;
                    *(u32x4*)qp = pack8f(o1[0], o1[1]); *(u32x4*)(qp + 32) = pack8f(o2[0], o2[1]); } }
    }
};
struct EpiKV {
    static constexpr bool PERM = true, AFTER_DRAIN = false;
    const float* partkv; bf16 *Km, *Vm;
    __device__ __forceinline__ void operator()(const af4 (&acc)[2][2][4][2], const pg8::Unit& u, int wr, int wc, int fr, int fq) const {
        const int pn = u.pn; const int row0 = u.pm * 256 + wr * 64 + fr;
#pragma unroll
        for (int ai = 0; ai < 2; ++ai)
#pragma unroll
            for (int m = 0; m < 4; ++m) { const int row = row0 + ai * 128 + m * 16;
                const f32x4 pa = *(const f32x4*)(partkv + (size_t)row * 8), pb = *(const f32x4*)(partkv + (size_t)row * 8 + 4);
                const float ssq = ((pa[0] + pa[1]) + (pa[2] + pa[3])) + ((pb[0] + pb[1]) + (pb[2] + pb[3]));
                const float rs = 1.f / sqrtf(ssq * (1.f / 512.f) + EPS);
                *(u32x4*)(Km + (size_t)row * 1536 + pn * 192 + wc * 32 + 8 * fq) = pack8f(acc[ai][0][m][0] * rs, acc[ai][0][m][1] * rs);
                *(u32x4*)(Vm + (size_t)row * 1024 + pn * 128 + wc * 32 + 8 * fq) = pack8f(acc[ai][1][m][0] * rs, acc[ai][1][m][1] * rs); }
    }
};
struct EpiOut {
    static constexpr bool PERM = true, AFTER_DRAIN = false;
    bf16* Y; float* party;
    __device__ __forceinline__ void operator()(const af4 (&acc)[2][2][4][2], const pg8::Unit& u, int wr, int wc, int fr, int fq) const {
        const int pn = u.pn; const int row0 = u.pm * 256 + wr * 64 + fr; const int col0 = pn * 256 + wc * 32 + 8 * fq;
#pragma unroll
        for (int ai = 0; ai < 2; ++ai)
#pragma unroll
            for (int m = 0; m < 4; ++m) { const int row = row0 + ai * 128 + m * 16; float ss = 0.f;
#pragma unroll
                for (int bj = 0; bj < 2; ++bj) { const f32x4 v0 = acc[ai][bj][m][0], v1 = acc[ai][bj][m][1];
                    ss += (v0[0] * v0[0] + v0[1] * v0[1]) + (v0[2] * v0[2] + v0[3] * v0[3]) + (v1[0] * v1[0] + v1[1] * v1[1]) + (v1[2] * v1[2] + v1[3] * v1[3]);
                    *(u32x4*)(Y + (size_t)row * 2048 + col0 + bj * 128) = pack8f(v0, v1); }
                ss += __shfl_xor(ss, 16); ss += __shfl_xor(ss, 32); if (fq == 0) party[(size_t)row * 32 + pn * 4 + wc] = ss; }
    }
};

namespace att {
constexpr int KVBLK = 64, QBLK = 32, QB = 256;
constexpr int SHM_K = 24576, SHM_V = 16384;
constexpr int NRING = 3;
constexpr int OFF_K = 0, OFF_V = NRING * SHM_K, OFF_CK = OFF_V + NRING * SHM_V, OFF_WS = OFF_CK + 1024, OFF_QP = OFF_WS + 2048;
constexpr float THR = 8.f;
#define KSWZ(row, colB) ((row) * 256 + ((colB) ^ (((row) & 7) << 4)))
#define SBAR() __builtin_amdgcn_sched_barrier(0)
__device__ __forceinline__ int v_st(int k, int c) { const int kk = (k & ~0xC) | ((k & 4) << 1) | ((k & 8) >> 1); return ((kk >> 3) * 4 + (c >> 5)) * 512 + ((kk & 7) * 32 + (c & 31)) * 2; }
__device__ __forceinline__ int v_rd_base(int lane) { return ((lane & 3) << 3) | (((lane >> 2) & 3) << 6) | (((lane >> 4) & 1) << 5) | (((lane >> 5) & 1) << 8); }
constexpr int v_rd_off(int d0, int ks, int half) { return d0 * 512 + ks * 4096 + half * 2048; }
__device__ __forceinline__ int crow(int r, int hi) { return (r & 3) + 8 * (r >> 2) + 4 * hi; }
__device__ __forceinline__ unsigned cvtpk(float lo, float hi) { unsigned r; asm volatile("v_cvt_pk_bf16_f32 %0, %1, %2" : "=v"(r) : "v"(lo), "v"(hi)); return r; }

__device__ __forceinline__ void mask_tile(f32x16& p0, f32x16& p1, int dq) {
    const float NEG = -__builtin_inff();
#pragma unroll
    for (int r = 0; r < 16; ++r) { const int c = (r & 3) + 8 * (r >> 2);
        if (dq - c < 0) p0[r] = NEG;
        if (dq - c - 32 < 0) p1[r] = NEG; }
}
__device__ __forceinline__ void softmax_tile(f32x16& p0, f32x16& p1, float& m_reg, float& l_reg, float& alpha, bf16x8& pa0, bf16x8& pa1, bf16x8& pa2, bf16x8& pa3) {
    float pmax = p0[0];
#pragma unroll
    for (int r = 1; r < 16; ++r) pmax = fmaxf(pmax, p0[r]);
#pragma unroll
    for (int r = 0; r < 16; ++r) pmax = fmaxf(pmax, p1[r]);
    { auto rr = __builtin_amdgcn_permlane32_swap(__float_as_uint(pmax), __float_as_uint(pmax), false, false);
      pmax = fmaxf(__uint_as_float(rr[0]), __uint_as_float(rr[1])); }
    float mn;
    if (__builtin_expect(__all(pmax - m_reg <= THR), 1)) { mn = m_reg; alpha = 1.f; }
    else { mn = fmaxf(m_reg, pmax); alpha = __builtin_amdgcn_exp2f(m_reg - mn); m_reg = mn; }
#pragma unroll
    for (int r = 0; r < 16; ++r) { p0[r] = __builtin_amdgcn_exp2f(p0[r] - mn); p1[r] = __builtin_amdgcn_exp2f(p1[r] - mn); }
    float ps = 0.f;
#pragma unroll
    for (int r = 0; r < 16; ++r) ps += p0[r];
#pragma unroll
    for (int r = 0; r < 16; ++r) ps += p1[r];
    { auto rr = __builtin_amdgcn_permlane32_swap(__float_as_uint(ps), __float_as_uint(ps), false, false);
      ps = __uint_as_float(rr[0]) + __uint_as_float(rr[1]); }
    l_reg = l_reg * alpha + ps;
#define PK4(P, B_, OUT) do { unsigned a0 = cvtpk(P[B_+0], P[B_+1]), a1 = cvtpk(P[B_+2], P[B_+3]);                          \
        unsigned b0 = cvtpk(P[B_+4], P[B_+5]), b1 = cvtpk(P[B_+6], P[B_+7]);                                             \
        auto r0 = __builtin_amdgcn_permlane32_swap(a0, b0, false, false); auto r1 = __builtin_amdgcn_permlane32_swap(a1, b1, false, false); \
        u32x4 w = {r0[0], r1[0], r0[1], r1[1]}; OUT = *reinterpret_cast<bf16x8*>(&w); } while (0)
    PK4(p0, 0, pa0); PK4(p0, 8, pa1); PK4(p1, 0, pa2); PK4(p1, 8, pa3);
#undef PK4
}
template <int DQK, int NPARK>
__device__ __forceinline__ void qkt(f32x16& p0, f32x16& p1, const char* Kb, int r32, int hi, const bf16x8* qr, const char* qpk) {
    constexpr int ND = DQK / 16, NQR = ND - NPARK;
    p0 = f32x16{}; p1 = f32x16{};
    const char* kb[4];
#pragma unroll
    for (int dd = 0; dd < 4; ++dd) kb[dd] = Kb + KSWZ(r32, (dd * 16 + hi * 8) * 2);
    const char* kr = Kb + 16384 + r32 * 128;
    const int rx = (r32 & 7) << 4;
    bf16x8 kf[3][2], qf[3];
#define QK_LD(set, d_) do { \
            if ((d_) < 8) { const char* a_ = kb[(d_) & 3] + ((d_) >> 2) * 128; kf[set][0] = *reinterpret_cast<const bf16x8*>(a_); kf[set][1] = *reinterpret_cast<const bf16x8*>(a_ + 32 * 256); } \
            else { const char* a_ = kr + (((((d_) - 8) * 16 + hi * 8) * 2) ^ rx); kf[set][0] = *reinterpret_cast<const bf16x8*>(a_); kf[set][1] = *reinterpret_cast<const bf16x8*>(a_ + 32 * 128); } \
            if ((d_) >= NQR) qf[set] = *reinterpret_cast<const bf16x8*>(qpk + ((d_) - NQR) * 1024); } while (0)
    QK_LD(0, 0); QK_LD(1, 1); SBAR();
#pragma unroll
    for (int d = 0; d < ND; ++d) {
        const int cs = d % 3;
        if (d + 2 < ND) { const int ns = (d + 2) % 3; if (ns == 0) QK_LD(0, d + 2); else if (ns == 1) QK_LD(1, d + 2); else QK_LD(2, d + 2); SBAR(); }
        const bf16x8 q = (d < NQR) ? qr[d < NQR ? d : 0] : qf[cs];
        p0 = __builtin_amdgcn_mfma_f32_32x32x16_bf16(kf[cs][0], q, p0, 0, 0, 0);
        p1 = __builtin_amdgcn_mfma_f32_32x32x16_bf16(kf[cs][1], q, p1, 0, 0, 0);
        SBAR();
    }
#undef QK_LD
}
template <int VOFF>
__device__ __forceinline__ void pv_tile(f32x16* o, int vb0, bf16x8 pa0, bf16x8 pa1, bf16x8 pa2, bf16x8 pa3) {
#define TRRD(dst, off) asm volatile("ds_read_b64_tr_b16 %0, %1 offset:%2" : "=&v"(dst) : "v"(vb0), "i"(off) : "memory")
#define PV_D0(d0) do { s16x4 l0, l1, l2, l3, h0, h1, h2, h3; constexpr int b_ = VOFF + v_rd_off(d0, 0, 0); \
        TRRD(l0, b_); TRRD(h0, b_ + 2048); TRRD(l1, b_ + 4096); TRRD(h1, b_ + 6144); TRRD(l2, b_ + 8192); TRRD(h2, b_ + 10240); TRRD(l3, b_ + 12288); TRRD(h3, b_ + 14336); \
        asm volatile("s_waitcnt lgkmcnt(0)" ::: "memory"); SBAR(); \
        o[d0] = __builtin_amdgcn_mfma_f32_32x32x16_bf16(pa0, (bf16x8){l0[0], l0[1], l0[2], l0[3], h0[0], h0[1], h0[2], h0[3]}, o[d0], 0, 0, 0);   \
        o[d0] = __builtin_amdgcn_mfma_f32_32x32x16_bf16(pa1, (bf16x8){l1[0], l1[1], l1[2], l1[3], h1[0], h1[1], h1[2], h1[3]}, o[d0], 0, 0, 0);   \
        o[d0] = __builtin_amdgcn_mfma_f32_32x32x16_bf16(pa2, (bf16x8){l2[0], l2[1], l2[2], l2[3], h2[0], h2[1], h2[2], h2[3]}, o[d0], 0, 0, 0);   \
        o[d0] = __builtin_amdgcn_mfma_f32_32x32x16_bf16(pa3, (bf16x8){l3[0], l3[1], l3[2], l3[3], h3[0], h3[1], h3[2], h3[3]}, o[d0], 0, 0, 0); } while (0)
    PV_D0(0); PV_D0(1); PV_D0(2); PV_D0(3);
#undef PV_D0
#undef TRRD
}

#define RD128(dst, addr, off) asm volatile("ds_read_b128 %0, %1 offset:%2" : "=&v"(dst) : "v"(addr), "i"(off) : "memory")
#define RDTR(dst, addr, off) asm volatile("ds_read_b64_tr_b16 %0, %1 offset:%2" : "=&v"(dst) : "v"(addr), "i"(off) : "memory")
#define WAITK(n, x) asm volatile("s_waitcnt lgkmcnt(%1)" : "+v"(x) : "n"(n) : "memory")
#define WAITKQ(n, x, q) asm volatile("s_waitcnt lgkmcnt(%2)" : "+v"(x), "+v"(q) : "n"(n) : "memory")
#define WAITV(n, x, y) asm volatile("s_waitcnt lgkmcnt(%2)" : "+v"(x), "+v"(y) : "n"(n) : "memory")

__device__ __forceinline__ void mblock_mla_q(f32x16& p0, f32x16& p1, f32x16* o, const bf16x8* qr, bf16x8 pa0, bf16x8 pa1, bf16x8 pa2, bf16x8 pa3, const unsigned* kbv, const unsigned* krv, unsigned qpkv, unsigned vbv) {
    bf16x8 ksl[5], qsl[3]; s16x4 vlo[5], vhi[5];
    p0 = f32x16{}; p1 = f32x16{};
    RD128(ksl[0], kbv[0], 0);
    RD128(ksl[1], kbv[0], 8192);
    RD128(ksl[2], kbv[1], 0);
    RD128(ksl[3], kbv[1], 8192);
    RD128(ksl[4], kbv[2], 0);
    WAITK(4, ksl[0]); p0 = __builtin_amdgcn_mfma_f32_32x32x16_bf16(ksl[0], qr[0], p0, 0, 0, 0);
    RD128(ksl[0], kbv[2], 8192);
    WAITK(4, ksl[1]); p1 = __builtin_amdgcn_mfma_f32_32x32x16_bf16(ksl[1], qr[0], p1, 0, 0, 0);
    RD128(ksl[1], kbv[3], 0);
    WAITK(4, ksl[2]); p0 = __builtin_amdgcn_mfma_f32_32x32x16_bf16(ksl[2], qr[1], p0, 0, 0, 0);
    RD128(ksl[2], kbv[3], 8192);
    WAITK(4, ksl[3]); p1 = __builtin_amdgcn_mfma_f32_32x32x16_bf16(ksl[3], qr[1], p1, 0, 0, 0);
    RD128(ksl[3], kbv[0], 128);
    WAITK(4, ksl[4]); p0 = __builtin_amdgcn_mfma_f32_32x32x16_bf16(ksl[4], qr[2], p0, 0, 0, 0);
    RD128(ksl[4], kbv[0], 8320);
    WAITK(4, ksl[0]); p1 = __builtin_amdgcn_mfma_f32_32x32x16_bf16(ksl[0], qr[2], p1, 0, 0, 0);
    RD128(ksl[0], kbv[1], 128);
    WAITK(4, ksl[1]); p0 = __builtin_amdgcn_mfma_f32_32x32x16_bf16(ksl[1], qr[3], p0, 0, 0, 0);
    RD128(ksl[1], kbv[1], 8320);
    WAITK(4, ksl[2]); p1 = __builtin_amdgcn_mfma_f32_32x32x16_bf16(ksl[2], qr[3], p1, 0, 0, 0);
    RD128(ksl[2], kbv[2], 128);
    WAITK(4, ksl[3]); p0 = __builtin_amdgcn_mfma_f32_32x32x16_bf16(ksl[3], qr[4], p0, 0, 0, 0);
    RD128(ksl[3], kbv[2], 8320);
    WAITK(4, ksl[4]); p1 = __builtin_amdgcn_mfma_f32_32x32x16_bf16(ksl[4], qr[4], p1, 0, 0, 0);
    RD128(ksl[4], kbv[3], 128);
    WAITK(4, ksl[0]); p0 = __builtin_amdgcn_mfma_f32_32x32x16_bf16(ksl[0], qr[5], p0, 0, 0, 0);
    RD128(ksl[0], kbv[3], 8320);
    WAITK(4, ksl[1]); p1 = __builtin_amdgcn_mfma_f32_32x32x16_bf16(ksl[1], qr[5], p1, 0, 0, 0);
    RD128(ksl[1], krv[0], 0); RD128(qsl[2], qpkv, 0);
    WAITK(5, ksl[2]); p0 = __builtin_amdgcn_mfma_f32_32x32x16_bf16(ksl[2], qr[6], p0, 0, 0, 0);
    RD128(ksl[2], krv[0], 4096);
    WAITK(5, ksl[3]); p1 = __builtin_amdgcn_mfma_f32_32x32x16_bf16(ksl[3], qr[6], p1, 0, 0, 0);
    RD128(ksl[3], krv[1], 0); RD128(qsl[0], qpkv, 1024);
    WAITK(6, ksl[4]); p0 = __builtin_amdgcn_mfma_f32_32x32x16_bf16(ksl[4], qr[7], p0, 0, 0, 0);
    RD128(ksl[4], krv[1], 4096);
    WAITK(6, ksl[0]); p1 = __builtin_amdgcn_mfma_f32_32x32x16_bf16(ksl[0], qr[7], p1, 0, 0, 0);
    RD128(ksl[0], krv[2], 0); RD128(qsl[1], qpkv, 2048);
    WAITKQ(6, ksl[1], qsl[2]); p0 = __builtin_amdgcn_mfma_f32_32x32x16_bf16(ksl[1], qsl[2], p0, 0, 0, 0);
    RD128(ksl[1], krv[2], 4096);
    WAITKQ(6, ksl[2], qsl[2]); p1 = __builtin_amdgcn_mfma_f32_32x32x16_bf16(ksl[2], qsl[2], p1, 0, 0, 0);
    RD128(ksl[2], krv[3], 0); RD128(qsl[2], qpkv, 3072);
    WAITKQ(6, ksl[3], qsl[0]); p0 = __builtin_amdgcn_mfma_f32_32x32x16_bf16(ksl[3], qsl[0], p0, 0, 0, 0);
    RD128(ksl[3], krv[3], 4096);
    WAITKQ(6, ksl[4], qsl[0]); p1 = __builtin_amdgcn_mfma_f32_32x32x16_bf16(ksl[4], qsl[0], p1, 0, 0, 0);
    WAITKQ(4, ksl[0], qsl[1]); p0 = __builtin_amdgcn_mfma_f32_32x32x16_bf16(ksl[0], qsl[1], p0, 0, 0, 0);
    WAITKQ(3, ksl[1], qsl[1]); p1 = __builtin_amdgcn_mfma_f32_32x32x16_bf16(ksl[1], qsl[1], p1, 0, 0, 0);
    WAITKQ(1, ksl[2], qsl[2]); p0 = __builtin_amdgcn_mfma_f32_32x32x16_bf16(ksl[2], qsl[2], p0, 0, 0, 0);
    WAITKQ(0, ksl[3], qsl[2]); p1 = __builtin_amdgcn_mfma_f32_32x32x16_bf16(ksl[3], qsl[2], p1, 0, 0, 0);
}
__device__ __forceinline__ void mblock_fox_q(f32x16& p0, f32x16& p1, f32x16* o, const bf16x8* qr, bf16x8 pa0, bf16x8 pa1, bf16x8 pa2, bf16x8 pa3, const unsigned* kbv, const unsigned* krv, unsigned qpkv, unsigned vbv) {
    bf16x8 ksl[5], qsl[3]; s16x4 vlo[5], vhi[5];
    p0 = f32x16{}; p1 = f32x16{};
    RD128(ksl[0], kbv[0], 0);
    RD128(ksl[1], kbv[0], 8192);
    RD128(ksl[2], kbv[1], 0);
    RD128(ksl[3], kbv[1], 8192);
    RD128(ksl[4], kbv[2], 0);
    WAITK(4, ksl[0]); p0 = __builtin_amdgcn_mfma_f32_32x32x16_bf16(ksl[0], qr[0], p0, 0, 0, 0);
    RD128(ksl[0], kbv[2], 8192);
    WAITK(4, ksl[1]); p1 = __builtin_amdgcn_mfma_f32_32x32x16_bf16(ksl[1], qr[0], p1, 0, 0, 0);
    RD128(ksl[1], kbv[3], 0);
    WAITK(4, ksl[2]); p0 = __builtin_amdgcn_mfma_f32_32x32x16_bf16(ksl[2], qr[1], p0, 0, 0, 0);
    RD128(ksl[2], kbv[3], 8192);
    WAITK(4, ksl[3]); p1 = __builtin_amdgcn_mfma_f32_32x32x16_bf16(ksl[3], qr[1], p1, 0, 0, 0);
    RD128(ksl[3], kbv[0], 128); RD128(qsl[1], qpkv, 0);
    WAITK(5, ksl[4]); p0 = __builtin_amdgcn_mfma_f32_32x32x16_bf16(ksl[4], qr[2], p0, 0, 0, 0);
    RD128(ksl[4], kbv[0], 8320);
    WAITK(5, ksl[0]); p1 = __builtin_amdgcn_mfma_f32_32x32x16_bf16(ksl[0], qr[2], p1, 0, 0, 0);
    RD128(ksl[0], kbv[1], 128); RD128(qsl[2], qpkv, 1024);
    WAITK(6, ksl[1]); p0 = __builtin_amdgcn_mfma_f32_32x32x16_bf16(ksl[1], qr[3], p0, 0, 0, 0);
    RD128(ksl[1], kbv[1], 8320);
    WAITK(6, ksl[2]); p1 = __builtin_amdgcn_mfma_f32_32x32x16_bf16(ksl[2], qr[3], p1, 0, 0, 0);
    RD128(ksl[2], kbv[2], 128); RD128(qsl[0], qpkv, 2048);
    WAITKQ(6, ksl[3], qsl[1]); p0 = __builtin_amdgcn_mfma_f32_32x32x16_bf16(ksl[3], qsl[1], p0, 0, 0, 0);
    RD128(ksl[3], kbv[2], 8320);
    WAITKQ(6, ksl[4], qsl[1]); p1 = __builtin_amdgcn_mfma_f32_32x32x16_bf16(ksl[4], qsl[1], p1, 0, 0, 0);
    RD128(ksl[4], kbv[3], 128); RD128(qsl[1], qpkv, 3072);
    WAITKQ(6, ksl[0], qsl[2]); p0 = __builtin_amdgcn_mfma_f32_32x32x16_bf16(ksl[0], qsl[2], p0, 0, 0, 0);
    RD128(ksl[0], kbv[3], 8320);
    WAITKQ(6, ksl[1], qsl[2]); p1 = __builtin_amdgcn_mfma_f32_32x32x16_bf16(ksl[1], qsl[2], p1, 0, 0, 0);
    WAITKQ(4, ksl[2], qsl[0]); p0 = __builtin_amdgcn_mfma_f32_32x32x16_bf16(ksl[2], qsl[0], p0, 0, 0, 0);
    WAITKQ(3, ksl[3], qsl[0]); p1 = __builtin_amdgcn_mfma_f32_32x32x16_bf16(ksl[3], qsl[0], p1, 0, 0, 0);
    WAITKQ(1, ksl[4], qsl[1]); p0 = __builtin_amdgcn_mfma_f32_32x32x16_bf16(ksl[4], qsl[1], p0, 0, 0, 0);
    WAITKQ(0, ksl[0], qsl[1]); p1 = __builtin_amdgcn_mfma_f32_32x32x16_bf16(ksl[0], qsl[1], p1, 0, 0, 0);
}
#undef RD128
#undef RDTR
#undef WAITK
#undef WAITKQ
#undef WAITV

template <int DQK, bool FOX, int ABL = 0>
__device__ __forceinline__ void attn_unit(char* lds, const bf16* Q, int ldq, const bf16* K, int ldk, const bf16* V, int ldv, const float* cfs, const bf16* Gp, bf16* Op, int qb) {
    const int tid = threadIdx.x, wid = __builtin_amdgcn_readfirstlane(tid >> 6), lane = tid & 63, r32 = lane & 31, hi = lane >> 5;
    const bool grpA = wid < 4; const int w4 = wid & 3;
    const int q0 = qb * QB, NT = 4 * (qb + 1);
    char* K_lds = lds + OFF_K; char* V_lds = lds + OFF_V; float* ck_l = (float*)(lds + OFF_CK);
    float* wsf = (float*)(lds + OFF_WS) + wid * 64; float* li_l = wsf; float* al_l = wsf + 32;
    constexpr int NPARK = 4, NQR = DQK / 16 - NPARK;
    bf16x8 qr[NQR];
    char* qpk = lds + OFF_QP + wid * 4096 + (hi * 32 + r32) * 16;
    unsigned koff, kroff = 0, voff;
    { const int row = 4 * w4 + (lane >> 4), c = (lane & 15) ^ (row & 7); koff = (unsigned)(row * ldk + c * 8) * 2u; }
    { const int s0 = 2 * w4 + (lane >> 5), kk = 8 * (s0 >> 2) + ((lane & 31) >> 2), k = (kk & ~0xC) | ((kk & 4) << 1) | ((kk & 8) >> 1); voff = (unsigned)(k * ldv + 32 * (s0 & 3) + 8 * (lane & 3)) * 2u; }
    if constexpr (DQK == 192) { const int row = 8 * w4 + (lane >> 3), c = (lane & 7) ^ (row & 7); kroff = (unsigned)(row * ldk + 128 + c * 8) * 2u; }
    const int vb0 = (int)(uintptr_t)V_lds + v_rd_base(lane);
    LAS unsigned char* ldsl = (LAS unsigned char*)(uintptr_t)(unsigned)(uintptr_t)lds;
    unsigned kb0[4], kr0[4];
#pragma unroll
    for (int i = 0; i < 4; ++i) { const unsigned xo = (unsigned)((i * 32 + hi * 16) ^ ((r32 & 7) << 4)); kb0[i] = (unsigned)(uintptr_t)K_lds + r32 * 256 + xo; kr0[i] = (unsigned)(uintptr_t)K_lds + 16384 + r32 * 128 + xo; }
    const unsigned qpkv = (unsigned)(uintptr_t)qpk;
#define DMA_K(t, bf) do { const char* kt_ = (const char*)K + (size_t)(t) * KVBLK * ldk * 2; \
        _Pragma("unroll") for (int j_ = 0; j_ < 4; ++j_) \
            __builtin_amdgcn_global_load_lds((const unsigned*)(kt_ + koff + (size_t)j_ * 16 * ldk * 2), (LAS unsigned*)(ldsl + OFF_K + (bf) * SHM_K + (w4 + 4 * j_) * 1024), 16, 0, 0); \
        if constexpr (DQK == 192) { _Pragma("unroll") for (int j_ = 0; j_ < 2; ++j_) \
            __builtin_amdgcn_global_load_lds((const unsigned*)(kt_ + kroff + (size_t)j_ * 32 * ldk * 2), (LAS unsigned*)(ldsl + OFF_K + (bf) * SHM_K + 16384 + (w4 + 4 * j_) * 1024), 16, 0, 0); } \
        if constexpr (FOX) { __builtin_amdgcn_global_load_lds((const unsigned*)(cfs + (t) * KVBLK + lane), (LAS unsigned*)(ldsl + OFF_CK + ((t) & 3) * 256), 4, 0, 0); } } while (0)
#define DMA_V(t, bf) do { const char* vt_ = (const char*)V + (size_t)(t) * KVBLK * ldv * 2; \
        _Pragma("unroll") for (int j_ = 0; j_ < 4; ++j_) \
            __builtin_amdgcn_global_load_lds((const unsigned*)(vt_ + voff + (size_t)j_ * 16 * ldv * 2), (LAS unsigned*)(ldsl + OFF_V + (bf) * SHM_V + (w4 + 4 * j_) * 1024), 16, 0, 0); } while (0)
#define BAR_L() asm volatile("s_waitcnt lgkmcnt(0)\n\ts_barrier" ::: "memory")
#define BAR_VL() asm volatile("s_waitcnt vmcnt(0) lgkmcnt(0)\n\ts_barrier" ::: "memory")
    constexpr int NDK = 4 + (DQK == 192 ? 2 : 0) + (FOX ? 1 : 0), NDV = 4;
#define BAR_VN(n) asm volatile("s_waitcnt vmcnt(%0) lgkmcnt(0)\n\ts_barrier" :: "n"(n) : "memory")
    if (grpA) { DMA_K(0, 0); DMA_K(1, 1); DMA_V(0, 0); }
    { const bf16* qp = Q + (size_t)(q0 + wid * QBLK + r32) * ldq + hi * 8;
#pragma unroll
      for (int d0 = 0; d0 < NQR; ++d0) qr[d0] = *(const bf16x8*)(qp + d0 * 16);
#pragma unroll
      for (int d0 = 0; d0 < NPARK; ++d0) *(bf16x8*)(qpk + d0 * 1024) = *(const bf16x8*)(qp + (NQR + d0) * 16); }
    float cq = 0.f; if constexpr (FOX) cq = cfs[q0 + wid * QBLK + r32];
    BAR_VL();
    if (!grpA) BAR_L();
    float m_reg = -1e30f, l_reg = 0.f; f32x16 o[4] = {}; f32x16 p0 = {}, p1 = {}; bf16x8 pa0 = {}, pa1 = {}, pa2 = {}, pa3 = {};
#define ACTW(tt) ((tt) - (NT - 4) < 0 || 64 * ((tt) - (NT - 4)) <= 32 * wid + 31)
    int rc = 0, rp = 2, rn = 1;
#pragma unroll 1
    for (int t = 0; t < NT; ++t) {
        if (grpA && !(ABL & 1)) { if (t + 2 < NT) DMA_K(t + 2, rp); if (t + 1 < NT) DMA_V(t + 1, rn); }
        const int jb_ = t - (NT - 4); const bool act_ = ACTW(t);
        if (act_ && !(ABL & 4)) { unsigned kbv[4], krv[4];
#pragma unroll
            for (int i = 0; i < 4; ++i) { kbv[i] = kb0[i] + rc * SHM_K; krv[i] = kr0[i] + rc * SHM_K; }
            if constexpr (DQK == 192) mblock_mla_q(p0, p1, o, qr, pa0, pa1, pa2, pa3, kbv, krv, qpkv, 0u); else mblock_fox_q(p0, p1, o, qr, pa0, pa1, pa2, pa3, kbv, krv, qpkv, 0u); }
        if (t > 0 && ACTW(t - 1) && !(ABL & 4)) { SBAR(); pv_tile<0>(o, vb0 + rp * SHM_V, pa0, pa1, pa2, pa3); }
        BAR_L();
        if (act_ && (ABL & 8)) {
#define PK4(P, B_, OUT) do { unsigned a0 = cvtpk(P[B_+0], P[B_+1]), a1 = cvtpk(P[B_+2], P[B_+3]); unsigned b0 = cvtpk(P[B_+4], P[B_+5]), b1 = cvtpk(P[B_+6], P[B_+7]); \
        auto r0 = __builtin_amdgcn_permlane32_swap(a0, b0, false, false); auto r1 = __builtin_amdgcn_permlane32_swap(a1, b1, false, false); u32x4 w = {r0[0], r1[0], r0[1], r1[1]}; OUT = *reinterpret_cast<bf16x8*>(&w); } while (0)
            PK4(p0, 0, pa0); PK4(p0, 8, pa1); PK4(p1, 0, pa2); PK4(p1, 8, pa3);
#undef PK4
        }
        if (act_ && !(ABL & 2)) { float alpha;
            if constexpr (FOX) { const float* ckp = ck_l + (t & 3) * 64 + 4 * hi;
#pragma unroll
                for (int g_ = 0; g_ < 4; ++g_) { const f32x4 c0 = *(const f32x4*)(ckp + 8 * g_), c1 = *(const f32x4*)(ckp + 32 + 8 * g_);
#pragma unroll
                    for (int e_ = 0; e_ < 4; ++e_) { p0[4 * g_ + e_] += cq - c0[e_]; p1[4 * g_ + e_] += cq - c1[e_]; } } }
            if (jb_ >= 0 && 64 * jb_ + 63 > 32 * wid) mask_tile(p0, p1, 32 * wid + r32 - 64 * jb_ - 4 * hi);
            softmax_tile(p0, p1, m_reg, l_reg, alpha, pa0, pa1, pa2, pa3);
            if (__any(alpha < 1.f)) { if (hi == 0) al_l[r32] = alpha; asm volatile("s_waitcnt lgkmcnt(0)" ::: "memory");
#pragma unroll
                for (int d_ = 0; d_ < 4; ++d_)
#pragma unroll
                    for (int r = 0; r < 16; ++r) o[d_][r] *= al_l[crow(r, hi)]; }
        }
        if (ABL & 1) BAR_VN(0); else if (t + 2 < NT) BAR_VN(NDK + NDV); else if (t + 1 < NT) BAR_VN(NDV); else BAR_VN(0);
        rp = rc; rc = rn; rn = (rn == NRING - 1) ? 0 : rn + 1;
    }
    if (ACTW(NT - 1)) { SBAR(); pv_tile<0>(o, vb0 + rp * SHM_V, pa0, pa1, pa2, pa3); }
    if (grpA) BAR_L();
#undef BAR_VN
#undef ACTW
#undef DMA_K
#undef DMA_V
    if (hi == 0) li_l[r32] = l_reg; asm volatile("s_waitcnt lgkmcnt(0)" ::: "memory");
    bf16* stg = (bf16*)(lds + wid * 8192);
    const int lane_e = launder(lane);
#pragma unroll
    for (int r = 0; r < 16; ++r) { const int orow = crow(r, hi); const float rl = __builtin_amdgcn_rcpf(li_l[orow]);
#pragma unroll
        for (int d0 = 0; d0 < 4; ++d0) stg[orow * 128 + d0 * 32 + r32] = (bf16)f2bf(o[d0][r] * rl); }
    asm volatile("s_waitcnt lgkmcnt(0)" ::: "memory");
#pragma unroll
    for (int i = 0; i < 8; ++i) { const int row = i * 4 + (lane_e >> 4), ch = lane_e & 15;
        const u32x4 v = *(const u32x4*)(stg + row * 128 + ch * 8);
        const size_t go = (size_t)(q0 + wid * QBLK + row) * 2048 + ch * 8;
        const u32x4 g = *(const u32x4*)(Gp + go); u32x4 w;
        w.x = cvtpk(bflo(v.x) * bflo(g.x), bfhi(v.x) * bfhi(g.x)); w.y = cvtpk(bflo(v.y) * bflo(g.y), bfhi(v.y) * bfhi(g.y));
        w.z = cvtpk(bflo(v.z) * bflo(g.z), bfhi(v.z) * bfhi(g.z)); w.w = cvtpk(bflo(v.w) * bflo(g.w), bfhi(v.w) * bfhi(g.w));
        *(u32x4*)(Op + go) = w; }
    BAR_VL();
#undef BAR_L
#undef BAR_VL
}
#undef KSWZ
#undef SBAR
}

__device__ __forceinline__ void transpose_item(const float* W, int ldw, int K, const float* g, bf16* WT, int dst_row0, int src_col0, int nvalid, int k0, LAS float* scr, int lane) {
    const int n = lane & 31; const bool ok = (src_col0 >= 0) && (n < nvalid);
    float tv[32];
#pragma unroll
    for (int i = 0; i < 32; ++i) { const int kk = 2 * i + (lane >> 5); tv[i] = ok ? W[(size_t)(k0 + kk) * ldw + src_col0 + n] : 0.f; }
    if (g) {
#pragma unroll
        for (int i = 0; i < 32; ++i) tv[i] *= g[k0 + 2 * i + (lane >> 5)]; }
#pragma unroll
    for (int i = 0; i < 32; ++i) scr[(2 * i + (lane >> 5)) * 33 + n] = tv[i];
    asm volatile("s_waitcnt lgkmcnt(0)" ::: "memory");
    const int c = lane & 7;
#pragma unroll
    for (int j = 0; j < 4; ++j) { const int nn = (lane >> 3) + 8 * j; const LAS float* s = scr + (8 * c) * 33 + nn;
        u32x4 o; o.x = pk2(s[0 * 33], s[1 * 33]); o.y = pk2(s[2 * 33], s[3 * 33]); o.z = pk2(s[4 * 33], s[5 * 33]); o.w = pk2(s[6 * 33], s[7 * 33]);
        *(u32x4*)(WT + (size_t)(dst_row0 + nn) * K + k0 + 8 * c) = o; }
    asm volatile("s_waitcnt lgkmcnt(0)" ::: "memory");
}
__device__ __forceinline__ void win_src(int r0, int& src, int& nv) {
    nv = 32;
    if (r0 < 1280) src = r0;
    else if (r0 < 2304) src = 1344 + (r0 - 1280);
    else if (r0 < 3328) src = 2368 + (r0 - 2304);
    else if (r0 < 4352) src = 3392 + (r0 - 3328);
    else if (r0 < 5376) src = 4416 + (r0 - 4352);
    else if (r0 < 6400) src = 5448 + (r0 - 5376);
    else if (r0 == 6400) src = 1280;
    else if (r0 == 6432) { src = 5440; nv = 8; }
    else if (r0 == 6528) src = 1312;
    else src = -1;
}
__device__ __forceinline__ int wuq_src(int r0) {
    if (r0 < 1024) return (r0 >> 7) * 192 + (r0 & 127);
    const int q = r0 - 1024, t = q >> 8, bj = (q >> 7) & 1, wc = (q >> 5) & 3;
    return (4 * t + wc) * 192 + 128 + 32 * bj;
}


#define XB_TMO      128
#define XB_XCNT(j)  (256  + 64 * (j))
#define XB_XSUB(j)  (1280 + 64 * (j))
#define XB_XGEN(j)  (2304 + 64 * (j))
#define XB_TOP      3328
#define XB_TOPGEN   3392
#define XCD_BAR_WORDS 3456
#define XB_SPIN_CAP (1u << 18)
__device__ __forceinline__ unsigned xb_ld(unsigned* p)              { return __hip_atomic_load(p, __ATOMIC_RELAXED, __HIP_MEMORY_SCOPE_AGENT); }
__device__ __forceinline__ unsigned xb_add(unsigned* p, unsigned v) { return __hip_atomic_fetch_add(p, v, __ATOMIC_RELAXED, __HIP_MEMORY_SCOPE_AGENT); }
__device__ __forceinline__ unsigned xb_xcc_id() { return (unsigned)__builtin_amdgcn_s_getreg((3 << 11) | 20) & 0xFu; }
#define XB_SPIN(cond, bar) do { unsigned _sp = 0; while (cond) { __builtin_amdgcn_s_sleep(1); \
    if ((++_sp & 255u) == 0u) { if (xb_ld(&(bar)[XB_TMO])) break; if (_sp > XB_SPIN_CAP) { atomicAdd(&(bar)[XB_TMO], 1u); break; } } } } while (0)
struct XcdBarrier { unsigned* bar; unsigned x; volatile LAS unsigned* st; };
__device__ __forceinline__ XcdBarrier xcd_barrier_post(unsigned* bar, volatile LAS unsigned* st) {
    XcdBarrier b; b.bar = bar; b.x = xb_xcc_id(); b.st = st;
    if (threadIdx.x == 0) (void)xb_add(&bar[XB_XCNT(b.x)], 1u);
    return b;
}
__device__ __forceinline__ void xcd_barrier_complete(unsigned* bar, unsigned x, unsigned& nloc, unsigned& nx) {
    const unsigned G = gridDim.x * gridDim.y * gridDim.z;
    unsigned sum, cnt, mine, sp = 0u;
    for (;;) {
        sum = 0u; cnt = 0u; mine = 0u;
#pragma unroll
        for (unsigned j = 0; j < 16; ++j) { const unsigned c = xb_ld(&bar[XB_XCNT(j)]); sum += c; cnt += (c > 0u) ? 1u : 0u; mine = (j == x) ? c : mine; }
        if (sum == G) break;
        __builtin_amdgcn_s_sleep(1);
        if ((++sp & 255u) == 0u) { if (xb_ld(&bar[XB_TMO])) break; if (sp > XB_SPIN_CAP) { atomicAdd(&bar[XB_TMO], 1u); break; } }
    }
    nloc = mine > 0u ? mine : 1u; nx = cnt > 0u ? cnt : 1u;
}
__device__ __forceinline__ void xcd_barrier(const XcdBarrier& b) {
    asm volatile("s_waitcnt vmcnt(0)" ::: "memory");
    __syncthreads();
    if (threadIdx.x == 0) {
        unsigned* bar = b.bar;
        __builtin_amdgcn_s_waitcnt(0);
        unsigned nloc = b.st[0], nx = b.st[1];
        if (nloc == 0u) { xcd_barrier_complete(bar, b.x, nloc, nx); b.st[0] = nloc; b.st[1] = nx; }
        const unsigned old = xb_add(&bar[XB_XSUB(b.x)], 1u);
        const unsigned gen = old / nloc;
        if (old + 1u == (gen + 1u) * nloc) {
            __builtin_amdgcn_fence(__ATOMIC_RELEASE, "agent");
            asm volatile("s_waitcnt vmcnt(0)" ::: "memory");
            const unsigned og = xb_add(&bar[XB_TOP], 1u);
            const unsigned tg = og / nx;
            if (og + 1u == (tg + 1u) * nx) xb_add(&bar[XB_TOPGEN], 1u);
            else XB_SPIN(xb_ld(&bar[XB_TOPGEN]) == tg, bar);
            __builtin_amdgcn_fence(__ATOMIC_ACQUIRE, "agent");
            xb_add(&bar[XB_XGEN(b.x)], 1u);
            asm volatile("s_waitcnt vmcnt(0)" ::: "memory");
        } else {
            XB_SPIN(xb_ld(&bar[XB_XGEN(b.x)]) == gen, bar);
            __builtin_amdgcn_fence(__ATOMIC_ACQUIRE, "agent");
            asm volatile("s_waitcnt vmcnt(0)" ::: "memory");
        }
    }
    __syncthreads();
}

struct Args { const float* x; const int* pos; const float* g_pre; const float* w_in; const float* g_q; const float* w_uq; const float* g_kv; const float* w_ukv;
              const float* b_forget; const float* w_out; const float* g_post; float* out; unsigned char* ws; int ph_lo, ph_hi; };

__global__ void __launch_bounds__(512, 2) hybrid_fwd(Args a) {
    extern __shared__ __attribute__((aligned(16))) unsigned char lds[];
    cg::grid_group grid = cg::this_grid();
    const int tid_k = threadIdx.x, lane_k = tid_k & 63, wave = __builtin_amdgcn_readfirstlane(tid_k >> 6);
    const int G = gridDim.x, bx = blockIdx.x; const int vcu = (G % 8 == 0) ? (bx % 8) * (G / 8) + bx / 8 : bx;
    unsigned char* ws = a.ws;
    float* rstd_x = (float*)(ws + WS_RSTDX); float* partq = (float*)(ws + WS_PARTQ); float* partkv = (float*)(ws + WS_PARTKV); float* party = (float*)(ws + WS_PARTY);
    float* flog = (float*)(ws + WS_FLOG); float* cf = (float*)(ws + WS_CF); float* cosT = (float*)(ws + WS_COS); float* sinT = (float*)(ws + WS_SIN);
    bf16* Win_t = (bf16*)(ws + WS_WIN); bf16* Wuq_t = (bf16*)(ws + WS_WUQ); bf16* Wukv_t = (bf16*)(ws + WS_WUKV); bf16* Wout_t = (bf16*)(ws + WS_WOUT);
    bf16* Xb = (bf16*)(ws + WS_XB); bf16* Ob = (bf16*)(ws + WS_O); bf16* qlat = (bf16*)(ws + WS_QLAT); bf16* kvlat = (bf16*)(ws + WS_KVLAT); bf16* Gb = (bf16*)(ws + WS_G);
    bf16* Qf = (bf16*)(ws + WS_QF); bf16* Kf = (bf16*)(ws + WS_KF); bf16* Vf = (bf16*)(ws + WS_VF); bf16* Yb = (bf16*)(ws + WS_Y);
    bf16* Qm = (bf16*)(ws + WS_QM); bf16* Km = (bf16*)(ws + WS_KM); bf16* Vm = (bf16*)(ws + WS_VM);
    const int lo = a.ph_lo, hi = a.ph_hi;
#ifndef PH_MASK
#define PH_MASK 63
#endif
#define IN(k) (((PH_MASK >> (k)) & 1) && lo <= (k) && (k) < hi)
#define BOTH(k) (IN(k) && IN((k) + 1))
    LAS unsigned char* ldsl = (LAS unsigned char*)lds;
    volatile LAS unsigned* bst = (volatile LAS unsigned*)(ldsl + LDS_BYTES - 64);
    if (tid_k < 2) bst[tid_k] = 0u;
    __syncthreads();
    XcdBarrier xbar = xcd_barrier_post((unsigned*)(ws + WS_CTL), bst);

    if (IN(0)) for (int rep_ = 0; rep_ < PROBE_REP0; ++rep_) {
        const int lane = launder(lane_k), tid = launder(tid_k);
        LAS float* scr = (LAS float*)(ldsl + wave * 16384);
        const int gw = vcu * 8 + wave, NGW = G * 8;
        constexpr int I_IN = 32 * 208, I_UQ = 12 * 48, I_UKV = 8 * 64, I_OUT = 32 * 64, NITEMS = I_IN + I_UQ + I_UKV + I_OUT;
        for (int it = gw; it < NITEMS; it += NGW) {
            int r = it;
            if (r < I_IN) { const int kb = r / 208, nb = r % 208; int src, nv; win_src(nb * 32, src, nv); transpose_item(a.w_in, DIN, 2048, a.g_pre, Win_t, nb * 32, src, nv, kb * 64, scr, lane); continue; } r -= I_IN;
            if (r < I_UQ) { const int kb = r / 48, nb = r % 48; transpose_item(a.w_uq, 1536, 768, a.g_q, Wuq_t, nb * 32, wuq_src(nb * 32), 32, kb * 64, scr, lane); continue; } r -= I_UQ;
            if (r < I_UKV) { const int kb = r / 64, nb = r % 64; transpose_item(a.w_ukv, 2048, 512, a.g_kv, Wukv_t, nb * 32, nb * 32, 32, kb * 64, scr, lane); continue; } r -= I_UKV;
            { const int kb = r / 64, nb = r % 64; transpose_item(a.w_out, 2048, 2048, nullptr, Wout_t, nb * 32, nb * 32, 32, kb * 64, scr, lane); }
        }
        for (int m = gw; m < M; m += 2 * NGW) {
            const int m2 = m + NGW;
            const f32x4* xr = (const f32x4*)(a.x + (size_t)m * DM) + lane; const f32x4* xr2 = (const f32x4*)(a.x + (size_t)m2 * DM) + lane; f32x4 v[8], v2[8]; float s = 0.f, s2 = 0.f;
#pragma unroll
            for (int j = 0; j < 8; ++j) { v[j] = __builtin_nontemporal_load(xr + 64 * j); v2[j] = __builtin_nontemporal_load(xr2 + 64 * j); }
#pragma unroll
            for (int j = 0; j < 8; ++j) { s += (v[j][0] * v[j][0] + v[j][1] * v[j][1]) + (v[j][2] * v[j][2] + v[j][3] * v[j][3]); s2 += (v2[j][0] * v2[j][0] + v2[j][1] * v2[j][1]) + (v2[j][2] * v2[j][2] + v2[j][3] * v2[j][3]); }
            s = wave_sum(s); s2 = wave_sum(s2);
            if (lane == 0) { rstd_x[m] = 1.f / sqrtf(s * (1.f / DM) + EPS); rstd_x[m2] = 1.f / sqrtf(s2 * (1.f / DM) + EPS); }
            u32x2* o8 = (u32x2*)(Xb + (size_t)m * DM) + lane; u32x2* o82 = (u32x2*)(Xb + (size_t)m2 * DM) + lane;
#pragma unroll
            for (int j = 0; j < 8; ++j) { u32x2 w; w.x = pk2(v[j][0], v[j][1]); w.y = pk2(v[j][2], v[j][3]); o8[64 * j] = w; u32x2 w2; w2.x = pk2(v2[j][0], v2[j][1]); w2.y = pk2(v2[j][2], v2[j][3]); o82[64 * j] = w2; }
        }
        for (int e = (vcu * 512 + tid); e < M * 32; e += G * 512) { const int row = e >> 5, i = e & 31;
            const float inv = exp2f(-(float)i * (13.287712379549449f / 32.f)); const float ang = (float)a.pos[row] * inv;
            const float n = rintf(ang * 0.15915494309189535f); float r = fmaf(-n, 6.28318548202514648f, ang); r = fmaf(-n, -1.7484555e-7f, r);
            cosT[e] = __cosf(r); sinT[e] = __sinf(r); }
    }
    if (BOTH(0)) xcd_barrier(xbar);
    if (a.ph_hi > 64) grid.sync();

    if (IN(1)) for (int rep_ = 0; rep_ < PROBE_REP1; ++rep_) {
        pg8::Gemm g{Xb, Win_t, M, NIN_PAD, 2048}; pg8::StaticOrder S; S.init(M, NIN_PAD, G, bx);
        EpiIn E{rstd_x, qlat, kvlat, Gb, Qf, Kf, Vf, Km, flog, partq, partkv, cosT, sinT};
        pg8::gemm_phase<EpiIn, pg8::StaticOrder, true, true>(ldsl, g, S, E);
    }
    if (BOTH(1)) xcd_barrier(xbar);

    if (IN(2)) for (int rep_ = 0; rep_ < PROBE_REP2; ++rep_) {
        const int lane = launder(lane_k), tid = launder(tid_k);
        if (bx < BATCH * NH) {
            const int b = bx >> 3, h = bx & 7; const float bf = a.b_forget[h];
            const float* fl = flog + ((size_t)b * SEQ + 8 * tid) * 8 + h; float lf[8];
#pragma unroll
            for (int j = 0; j < 8; ++j) lf[j] = fl[j * 8] + bf;
#pragma unroll
            for (int j = 0; j < 8; ++j) { const float z = lf[j]; lf[j] = fminf(z, 0.f) - log1pf(expf(-fabsf(z))); }
#pragma unroll
            for (int j = 1; j < 8; ++j) lf[j] += lf[j - 1];
            float incl = lf[7];
#pragma unroll
            for (int o = 1; o < 64; o <<= 1) { const float t = __shfl_up(incl, o); if (lane >= o) incl += t; }
            volatile LAS float* wtot = (volatile LAS float*)(ldsl + LDS_BYTES - 128);
            if (lane == 63) wtot[wave] = incl;
            __syncthreads();
            float off = incl - lf[7];
            for (int w2 = 0; w2 < wave; ++w2) off += wtot[w2];
            float* cp = cf + (size_t)bx * SEQ + 8 * tid;
            f32x4 o0, o1;
#pragma unroll
            for (int j = 0; j < 4; ++j) { o0[j] = (off + lf[j]) * LOG2E; o1[j] = (off + lf[4 + j]) * LOG2E; }
            *(f32x4*)cp = o0; *(f32x4*)(cp + 4) = o1;
            __syncthreads();
        }
        { pg8::Gemm g{qlat, Wuq_t, M, 1536, QRANK}; pg8::StaticOrder S; S.init(M, 1536, G, bx);
          EpiQ E{partq, Qm, cosT, sinT};
          pg8::gemm_phase<EpiQ, pg8::StaticOrder, true, true>(ldsl, g, S, E); }
        { pg8::Gemm g{kvlat, Wukv_t, M, 2048, KVRANK}; pg8::StaticOrder S; S.init(M, 2048, G, bx);
          EpiKV E{partkv, Km, Vm};
          pg8::gemm_phase<EpiKV, pg8::StaticOrder, true, true>(ldsl, g, S, E); }
    }
    if (BOTH(2)) xcd_barrier(xbar);

    if (IN(3)) for (int rep_ = 0; rep_ < PROBE_REP3; ++rep_) {
        for (int v = vcu; v < 256; v += G) {
            const int s = v & 3, w = v >> 2, b = w >> 4, hh = w & 15, hd = hh & 7, swp = hh >> 3;
            const size_t rb = (size_t)b * SEQ;
#pragma unroll 1
            for (int i = 0; i < 2; ++i) {
                const int qb = __builtin_amdgcn_readfirstlane(swp ? (i == 0 ? 8 + s : 7 - s) : (i == 0 ? 15 - s : s));
                att::attn_unit<192, false>((char*)lds, Qm + rb * 1536 + hd * 192, 1536, Km + rb * 1536 + hd * 192, 1536, Vm + rb * 1024 + hd * 128, 1024, nullptr,
                                           Gb + rb * 2048 + hd * 128, Ob + rb * 2048 + hd * 128, qb);
            }
#pragma unroll 1
            for (int i = 0; i < 2; ++i) {
                const int qb = __builtin_amdgcn_readfirstlane(swp ? (i == 0 ? 15 - s : s) : (i == 0 ? 8 + s : 7 - s));
                att::attn_unit<128, true>((char*)lds, Qf + rb * 1024 + hd * 128, 1024, Kf + rb * 1024 + hd * 128, 1024, Vf + rb * 1024 + hd * 128, 1024, cf + (size_t)(b * 8 + hd) * SEQ,
                                          Gb + rb * 2048 + 1024 + hd * 128, Ob + rb * 2048 + 1024 + hd * 128, qb);
            }
        }
    }
#if PROBE_ABL >= 0
    if (IN(3)) {
        for (int v = vcu; v < 256; v += G) {
            const int s = v & 3, w = v >> 2, b = w >> 4, hh = w & 15, hd = hh & 7, swp = hh >> 3;
            const size_t rb = (size_t)b * SEQ;
#pragma unroll 1
            for (int i = 0; i < 2; ++i) {
                const int qb = __builtin_amdgcn_readfirstlane(swp ? (i == 0 ? 8 + s : 7 - s) : (i == 0 ? 15 - s : s));
                att::attn_unit<192, false, PROBE_ABL>((char*)lds, Qm + rb * 1536 + hd * 192, 1536, Km + rb * 1536 + hd * 192, 1536, Vm + rb * 1024 + hd * 128, 1024, nullptr,
                                           Gb + rb * 2048 + hd * 128, qlat, qb);
            }
#pragma unroll 1
            for (int i = 0; i < 2; ++i) {
                const int qb = __builtin_amdgcn_readfirstlane(swp ? (i == 0 ? 15 - s : s) : (i == 0 ? 8 + s : 7 - s));
                att::attn_unit<128, true, PROBE_ABL>((char*)lds, Qf + rb * 1024 + hd * 128, 1024, Kf + rb * 1024 + hd * 128, 1024, Vf + rb * 1024 + hd * 128, 1024, cf + (size_t)(b * 8 + hd) * SEQ,
                                          Gb + rb * 2048 + 1024 + hd * 128, qlat, qb);
            }
        }
    }
#endif
    if (BOTH(3)) xcd_barrier(xbar);

    if (IN(4)) for (int rep_ = 0; rep_ < PROBE_REP4; ++rep_) {
        pg8::Gemm g{Ob, Wout_t, M, 2048, 2048}; pg8::StaticOrder S; S.init(M, 2048, G, bx);
        EpiOut E{Yb, party};
        pg8::gemm_phase<EpiOut, pg8::StaticOrder, true, true>(ldsl, g, S, E);
    }
    if (BOTH(4)) xcd_barrier(xbar);

    if (IN(5)) for (int rep_ = 0; rep_ < PROBE_REP5; ++rep_) {
        const int lane = launder(lane_k);
        const int gw = vcu * 8 + wave, NGW = G * 8;
        const f32x4* gp = (const f32x4*)a.g_post + lane; f32x4 gv[8];
#pragma unroll
        for (int j = 0; j < 8; ++j) gv[j] = gp[64 * j];
        for (int m = gw; m < M; m += 2 * NGW) {
            const int m2 = m + NGW;
            float s = (lane < 32) ? party[(size_t)m * 32 + lane] : 0.f, s2 = (lane < 32) ? party[(size_t)m2 * 32 + lane] : 0.f;
            const f32x4* xr = (const f32x4*)(a.x + (size_t)m * DM) + lane; const f32x4* xr2 = (const f32x4*)(a.x + (size_t)m2 * DM) + lane;
            const u32x2* yr = (const u32x2*)(Yb + (size_t)m * DM) + lane; const u32x2* yr2 = (const u32x2*)(Yb + (size_t)m2 * DM) + lane;
            f32x4 xv[8], xv2[8]; u32x2 y[8], y2[8];
#pragma unroll
            for (int j = 0; j < 8; ++j) { xv[j] = __builtin_nontemporal_load(xr + 64 * j); xv2[j] = __builtin_nontemporal_load(xr2 + 64 * j); y[j] = __builtin_nontemporal_load(yr + 64 * j); y2[j] = __builtin_nontemporal_load(yr2 + 64 * j); }
            s = wave_sum(s); s2 = wave_sum(s2);
            const float rs = 1.f / sqrtf(s * (1.f / DM) + EPS), rs2 = 1.f / sqrtf(s2 * (1.f / DM) + EPS);
            f32x4* orow = (f32x4*)(a.out + (size_t)m * DM) + lane; f32x4* orow2 = (f32x4*)(a.out + (size_t)m2 * DM) + lane;
#pragma unroll
            for (int j = 0; j < 8; ++j) {
                f32x4 o; o[0] = xv[j][0] + bflo(y[j].x) * rs * gv[j][0]; o[1] = xv[j][1] + bfhi(y[j].x) * rs * gv[j][1]; o[2] = xv[j][2] + bflo(y[j].y) * rs * gv[j][2]; o[3] = xv[j][3] + bfhi(y[j].y) * rs * gv[j][3];
                __builtin_nontemporal_store(o, orow + 64 * j);
                f32x4 o2; o2[0] = xv2[j][0] + bflo(y2[j].x) * rs2 * gv[j][0]; o2[1] = xv2[j][1] + bfhi(y2[j].x) * rs2 * gv[j][1]; o2[2] = xv2[j][2] + bflo(y2[j].y) * rs2 * gv[j][2]; o2[3] = xv2[j][3] + bfhi(y2[j].y) * rs2 * gv[j][3];
                __builtin_nontemporal_store(o2, orow2 + 64 * j); }
        }
    }
#undef IN
#undef BOTH
}

extern "C" void kernel_launch(void* const* d_in, const int* in_sizes, int n_in, void* d_out, int out_size, void* d_ws, size_t ws_size, hipStream_t stream) {
    static int grid = 0;
    if (grid == 0) {
        if (n_in != 11 || in_sizes[0] != M * DM || out_size != M * DM || ws_size < WS_END) { fprintf(stderr, "kernel_launch: shape mismatch n_in %d in0 %d out %d ws %zu\n", n_in, n_in > 0 ? in_sizes[0] : -1, out_size, ws_size); grid = -1; return; }
        int dev = 0, cus = 0, per_cu = 0;
        if (hipGetDevice(&dev) != hipSuccess || hipDeviceGetAttribute(&cus, hipDeviceAttributeMultiprocessorCount, dev) != hipSuccess) { grid = -1; return; }
        if (hipFuncSetAttribute((const void*)hybrid_fwd, hipFuncAttributeMaxDynamicSharedMemorySize, LDS_BYTES) != hipSuccess) { fprintf(stderr, "kernel_launch: hipFuncSetAttribute failed\n"); grid = -1; return; }
        if (hipOccupancyMaxActiveBlocksPerMultiprocessor(&per_cu, (const void*)hybrid_fwd, 512, LDS_BYTES) != hipSuccess || per_cu < 1) { fprintf(stderr, "kernel_launch: occupancy query says %d\n", per_cu); per_cu = 1; }
        (void)hipGetLastError();
        grid = cus;
    }
    if (grid < 0) return;
    if (hipMemsetAsync((char*)d_ws + WS_CTL, 0, CTL_BYTES, stream) != hipSuccess) { fprintf(stderr, "kernel_launch: memset failed\n"); return; }
    Args a{};
    a.x = (const float*)d_in[0]; a.pos = (const int*)d_in[1]; a.g_pre = (const float*)d_in[2]; a.w_in = (const float*)d_in[3]; a.g_q = (const float*)d_in[4]; a.w_uq = (const float*)d_in[5];
    a.g_kv = (const float*)d_in[6]; a.w_ukv = (const float*)d_in[7]; a.b_forget = (const float*)d_in[8]; a.w_out = (const float*)d_in[9]; a.g_post = (const float*)d_in[10];
    a.out = (float*)d_out; a.ws = (unsigned char*)d_ws;
#if MK_N_LAUNCHES == 1
    a.ph_lo = 0; a.ph_hi = 6;
    void* args[] = {&a};
    hipError_t e = hipLaunchCooperativeKernel((const void*)hybrid_fwd, dim3(grid), dim3(512), args, LDS_BYTES, stream);
    if (e != hipSuccess) fprintf(stderr, "cooperative launch failed: %s (grid %d)\n", hipGetErrorString(e), grid);
#else
    for (int p = 0; p < 6; ++p) { a.ph_lo = p; a.ph_hi = p + 1; for (int r = 0; r < (p == PROBE_DUP ? 2 : 1); ++r) hipLaunchKernelGGL(hybrid_fwd, dim3(grid), dim3(512), LDS_BYTES, stream, a); }
#endif
}
```

```cpp
#include <hip/hip_runtime.h>
#include <hip/hip_cooperative_groups.h>
#include <cstdio>
#include <cstdint>
namespace cg = cooperative_groups;

#ifndef PROBE_REP0
#define PROBE_REP0 1
#endif
#ifndef PROBE_REP1
#define PROBE_REP1 1
#endif
#ifndef PROBE_REP2
#define PROBE_REP2 1
#endif
#ifndef PROBE_REP3
#define PROBE_REP3 1
#endif
#ifndef PROBE_REP4
#define PROBE_REP4 1
#endif
#ifndef PROBE_REP5
#define PROBE_REP5 1
#endif
#ifndef PROBE_ABL
#define PROBE_ABL -1
#endif
#ifndef PROBE_DUP
#define PROBE_DUP -1
#endif
#ifndef MK_N_LAUNCHES
#define MK_N_LAUNCHES 1
#endif

namespace pg8 {
#define PG8_LAS __attribute__((address_space(3)))
typedef unsigned short bf16_t;
typedef short bf16x8 __attribute__((ext_vector_type(8)));
typedef float f32x4 __attribute__((ext_vector_type(4)));
typedef unsigned u32x4 __attribute__((ext_vector_type(4)));
constexpr int BM = 256, BK = 64, HALF = 128, HTB = HALF * BK * 2, STAGE_BYTES = 8 * HTB, NXCD = 8, WGM = 8;

__host__ __device__ __forceinline__ int lds_byte(int r, int c) { const int st = (r >> 4) * 2 + (c >> 5), rr = r & 15, cc = c & 31, ob = rr * 64 + cc * 2; return st * 1024 + (ob ^ (((ob >> 9) & 1) << 5)); }
__host__ __device__ __forceinline__ void stage_rc(int b, int& R, int& C) { const int st = b / 1024, sb = b % 1024, swz = sb ^ (((sb >> 9) & 1) << 5); R = (st >> 1) * 16 + swz / 64; C = (st & 1) * 32 + (swz % 64) / 2; }
__host__ __device__ __forceinline__ int perm32(int rho) { const int n = rho >> 4, i = rho & 15; return 8 * (i >> 2) + 4 * n + (i & 3); }

struct Unit { int pm, pn; };
struct Gemm { const bf16_t* A; const bf16_t* Bt; int M, N, K; };

struct StaticOrder {
    int nM, nN, nwg, G, c;
    __host__ __device__ void init(int M, int N, int G_, int c_) { nM = M / BM; nN = N / BM; nwg = nM * nN; G = G_; c = c_; }
    __host__ __device__ bool next(int i, Unit& u) const {
        const long L = (long)i * G + c; if (L >= nwg) return false;
        int wgid = (int)L; { const int q = nwg / NXCD, r = nwg % NXCD, xcd = wgid % NXCD, off = wgid / NXCD; wgid = (xcd < r ? xcd * (q + 1) : r * (q + 1) + (xcd - r) * q) + off; }
        const int nig = WGM * nN, gid = wgid / nig, fm = gid * WGM, gsz = (nM - fm) < WGM ? (nM - fm) : WGM;
        u.pm = fm + ((wgid % nig) % gsz); u.pn = (wgid % nig) / gsz; return true;
    }
    __device__ __forceinline__ void a_ready(const Unit&) const {}
    __device__ __forceinline__ void done(const Unit&) const {}
};

__device__ __forceinline__ unsigned cvt_pk_bf16(float lo, float hi) { unsigned r; asm volatile("v_cvt_pk_bf16_f32 %0, %1, %2" : "=v"(r) : "v"(lo), "v"(hi)); return r; }

template <class Epi, class Sched, bool ALIGN_EPI = false, bool SP2 = false>
__device__ __forceinline__ void gemm_phase(PG8_LAS unsigned char* lds, const Gemm g, const Sched& S, const Epi& E) {
    const int tid = threadIdx.x, wid = __builtin_amdgcn_readfirstlane(tid >> 6), lane = tid & 63, wr = wid >> 2, wc = wid & 3, fr = lane & 15, fq = lane >> 4;
    const int K = g.K, nt = K / BK;
    unsigned voffA[2], voffB[2];
#pragma unroll
    for (int i = 0; i < 2; ++i) { int R, C; stage_rc(tid * 16 + i * 8192, R, C); const int Rb = Epi::PERM ? ((R & ~31) + perm32(R & 31)) : R;
        voffA[i] = (unsigned)(R * K + C) * 2u; voffB[i] = (unsigned)(Rb * K + C) * 2u; }
    const size_t kstep = (size_t)(BK * 2);
    const size_t hstep = (size_t)HALF * K * 2;
    const size_t tstep = 2 * hstep;
    const unsigned ldsw = (unsigned)wid * 1024u;
    const int aoff = lds_byte(wr * 64 + fr, fq * 8), boff = lds_byte(wc * 32 + fr, fq * 8);
#define PG8_SA(b, h) (((b) * 2 + (h)) * HTB)
#define PG8_SB(b, h) ((4 + (b) * 2 + (h)) * HTB)
#define PG8_STAGE(bufoff, gbase, voff) do { _Pragma("unroll") for (int _i = 0; _i < 2; ++_i) \
        __builtin_amdgcn_global_load_lds((const unsigned*)((const char*)(gbase) + (voff)[_i]), (PG8_LAS unsigned*)(lds + (bufoff) + ldsw + _i * 8192), 16, 0, 0); } while (0)
#define PG8_LDA(dst, b, h) do { _Pragma("unroll") for (int m = 0; m < 4; ++m) _Pragma("unroll") for (int k = 0; k < 2; ++k) dst[m][k] = *(const PG8_LAS bf16x8*)(lds + PG8_SA(b, h) + aoff + m * 2048 + k * 1024); } while (0)
#define PG8_LDB(dst, b, h) do { _Pragma("unroll") for (int n = 0; n < 2; ++n) _Pragma("unroll") for (int k = 0; k < 2; ++k) dst[n][k] = *(const PG8_LAS bf16x8*)(lds + PG8_SB(b, h) + boff + n * 2048 + k * 1024); } while (0)
#define PG8_MMA(ai, bj, At, Bt) do { __builtin_amdgcn_s_setprio(1); _Pragma("unroll") for (int m = 0; m < 4; ++m) _Pragma("unroll") for (int n = 0; n < 2; ++n) _Pragma("unroll") for (int k = 0; k < 2; ++k) \
        acc[ai][bj][m][n] = __builtin_amdgcn_mfma_f32_16x16x32_bf16(Bt[n][k], At[m][k], acc[ai][bj][m][n], 0, 0, 0); __builtin_amdgcn_s_setprio(0); } while (0)
#define PG8_WAIT_V(n) asm volatile("s_waitcnt vmcnt(" #n ")" ::: "memory")
#define PG8_WAIT_L(n) asm volatile("s_waitcnt lgkmcnt(" #n ")" ::: "memory")
#define PG8_BAR __builtin_amdgcn_s_barrier()
#define PG8_SCHED __builtin_amdgcn_sched_barrier(0)
    Unit cur, nxt; int ui = 0;
    if (!S.next(0, cur)) return;
    f32x4 acc[2][2][4][2];
#pragma unroll
    for (int a = 0; a < 2; ++a)
#pragma unroll
        for (int b = 0; b < 2; ++b)
#pragma unroll
            for (int m = 0; m < 4; ++m)
#pragma unroll
                for (int n = 0; n < 2; ++n) acc[a][b][m][n] = (f32x4){0.f, 0.f, 0.f, 0.f};
    bf16x8 At[4][2], B0[2][2], B1[2][2];
    const char* cA = (const char*)g.A + (size_t)cur.pm * tstep; const char* cB = (const char*)g.Bt + (size_t)cur.pn * tstep;
    S.a_ready(cur);
    if constexpr (SP2) {
        PG8_STAGE(PG8_SB(0, 0), cB, voffB); PG8_STAGE(PG8_SB(0, 1), cB + hstep, voffB); PG8_STAGE(PG8_SA(0, 0), cA, voffA); PG8_STAGE(PG8_SA(0, 1), cA + hstep, voffA);
        if (wr == 1) PG8_BAR;
        PG8_WAIT_V(2); PG8_BAR;
        PG8_STAGE(PG8_SB(1, 0), cB + kstep, voffB); PG8_STAGE(PG8_SA(1, 0), cA + kstep, voffA); PG8_STAGE(PG8_SB(1, 1), cB + hstep + kstep, voffB);
        PG8_WAIT_V(6); PG8_BAR;
    } else {
        PG8_STAGE(PG8_SB(0, 0), cB, voffB); PG8_STAGE(PG8_SA(0, 0), cA, voffA); PG8_STAGE(PG8_SB(0, 1), cB + hstep, voffB); PG8_STAGE(PG8_SA(0, 1), cA + hstep, voffA);
        if (wr == 1) PG8_BAR;
        PG8_WAIT_V(4); PG8_BAR;
        PG8_STAGE(PG8_SB(1, 0), cB + kstep, voffB); PG8_STAGE(PG8_SA(1, 0), cA + kstep, voffA); PG8_STAGE(PG8_SB(1, 1), cB + hstep + kstep, voffB);
        PG8_WAIT_V(6); PG8_BAR;
    }
    for (;;) {
        const bool has_next = S.next(ui + 1, nxt);
        const char* nA = has_next ? (const char*)g.A + (size_t)nxt.pm * tstep : cA; const char* nB = has_next ? (const char*)g.Bt + (size_t)nxt.pn * tstep : cB;
        for (int t = 0; t < nt; t += 2) {
            const bool last = (t == nt - 2);
            const char* a1 = cA + (size_t)(t + 1) * kstep;
            const char* a2 = last ? nA : cA + (size_t)(t + 2) * kstep; const char* b2 = last ? nB : cB + (size_t)(t + 2) * kstep;
            const char* a3 = a2 + kstep; const char* b3 = b2 + kstep;
            if (last && has_next) S.a_ready(nxt);
            if constexpr (SP2) {
            PG8_LDB(B0, 0, 0); PG8_LDB(B1, 0, 1); PG8_SCHED; PG8_LDA(At, 0, 0); PG8_STAGE(PG8_SA(1, 1), a1 + hstep, voffA);
            PG8_WAIT_V(8); PG8_WAIT_L(0); PG8_BAR; PG8_MMA(0, 0, At, B0); PG8_MMA(0, 1, At, B1); PG8_BAR; PG8_SCHED;
            PG8_LDA(At, 0, 1); PG8_STAGE(PG8_SB(0, 0), b2, voffB); PG8_STAGE(PG8_SB(0, 1), b2 + hstep, voffB); PG8_STAGE(PG8_SA(0, 0), a2, voffA);
            PG8_WAIT_V(8); PG8_WAIT_L(0); PG8_BAR; PG8_MMA(1, 0, At, B0); PG8_MMA(1, 1, At, B1); PG8_BAR; PG8_SCHED;
            PG8_LDB(B0, 1, 0); PG8_LDB(B1, 1, 1); PG8_SCHED; PG8_LDA(At, 1, 0); PG8_STAGE(PG8_SA(0, 1), a2 + hstep, voffA);
            PG8_WAIT_V(8); PG8_WAIT_L(0); PG8_BAR; PG8_MMA(0, 0, At, B0); PG8_MMA(0, 1, At, B1); PG8_BAR; PG8_SCHED;
            PG8_LDA(At, 1, 1); PG8_STAGE(PG8_SB(1, 0), b3, voffB); PG8_STAGE(PG8_SB(1, 1), b3 + hstep, voffB); PG8_STAGE(PG8_SA(1, 0), a3, voffA);
            PG8_WAIT_V(8); PG8_WAIT_L(0); PG8_BAR; PG8_MMA(1, 0, At, B0); PG8_MMA(1, 1, At, B1); PG8_BAR; PG8_SCHED;
            } else {
            PG8_LDB(B0, 0, 0); PG8_SCHED; PG8_LDA(At, 0, 0); PG8_STAGE(PG8_SA(1, 1), a1 + hstep, voffA);
            PG8_WAIT_L(8); PG8_BAR; PG8_WAIT_L(0); PG8_MMA(0, 0, At, B0); PG8_BAR; PG8_SCHED;
            PG8_LDB(B1, 0, 1); PG8_STAGE(PG8_SB(0, 0), b2, voffB);
            PG8_BAR; PG8_WAIT_L(0); PG8_MMA(0, 1, At, B1); PG8_BAR;
            PG8_LDA(At, 0, 1); PG8_STAGE(PG8_SA(0, 0), a2, voffA);
            PG8_BAR; PG8_WAIT_L(0); PG8_MMA(1, 0, At, B0); PG8_BAR; PG8_SCHED;
            PG8_STAGE(PG8_SB(0, 1), b2 + hstep, voffB);
            PG8_WAIT_V(6); PG8_BAR; PG8_MMA(1, 1, At, B1); PG8_BAR;
            PG8_LDB(B0, 1, 0); PG8_SCHED; PG8_LDA(At, 1, 0); PG8_STAGE(PG8_SA(0, 1), a2 + hstep, voffA);
            PG8_WAIT_L(8); PG8_BAR; PG8_WAIT_L(0); PG8_MMA(0, 0, At, B0); PG8_BAR; PG8_SCHED;
            PG8_LDB(B1, 1, 1); PG8_STAGE(PG8_SB(1, 0), b3, voffB);
            PG8_BAR; PG8_WAIT_L(0); PG8_MMA(0, 1, At, B1); PG8_BAR;
            PG8_LDA(At, 1, 1); PG8_STAGE(PG8_SA(1, 0), a3, voffA);
            PG8_BAR; PG8_WAIT_L(0); PG8_MMA(1, 0, At, B0); PG8_BAR; PG8_SCHED;
            PG8_STAGE(PG8_SB(1, 1), b3 + hstep, voffB);
            PG8_WAIT_V(6); PG8_BAR; PG8_MMA(1, 1, At, B1); PG8_BAR;
            }
        }
        if constexpr (ALIGN_EPI) { if (wr == 0) PG8_BAR; }
        if constexpr (!Epi::AFTER_DRAIN) { E(acc, cur, wr, wc, fr, fq); S.done(cur); }
        if (!has_next) break;
#pragma unroll
        for (int a = 0; a < 2; ++a)
#pragma unroll
            for (int b = 0; b < 2; ++b)
#pragma unroll
                for (int m = 0; m < 4; ++m)
#pragma unroll
                    for (int n = 0; n < 2; ++n) acc[a][b][m][n] = (f32x4){0.f, 0.f, 0.f, 0.f};
        cur = nxt; cA = nA; cB = nB; ++ui;
        if constexpr (ALIGN_EPI) { if (wr == 1) PG8_BAR; }
    }
    PG8_WAIT_V(0);
    if constexpr (!ALIGN_EPI) { if (wr == 0) PG8_BAR; }
    PG8_BAR;
#undef PG8_SA
#undef PG8_SB
#undef PG8_STAGE
#undef PG8_LDA
#undef PG8_LDB
#undef PG8_MMA
#undef PG8_WAIT_V
#undef PG8_WAIT_L
#undef PG8_BAR
#undef PG8_SCHED
}
}

typedef unsigned short bf16;
typedef float f32x4 __attribute__((ext_vector_type(4)));
typedef unsigned u32x4 __attribute__((ext_vector_type(4)));
typedef unsigned u32x2 __attribute__((ext_vector_type(2)));
typedef short bf16x8 __attribute__((ext_vector_type(8)));
typedef short s16x4 __attribute__((ext_vector_type(4)));
typedef float f32x16 __attribute__((ext_vector_type(16)));
#define LAS __attribute__((address_space(3)))

constexpr int BATCH = 4, SEQ = 4096, DM = 2048, M = BATCH * SEQ;
constexpr int NH = 8, QKD = 192, QRANK = 768, KVRANK = 512, DIN = 6472;
constexpr int NIN_PAD = 6656;
constexpr float EPS = 1e-6f;
constexpr float LOG2E = 1.4426950408889634f;
constexpr float C2M = 0.07216878364870322f * LOG2E;
constexpr float C2F = 0.08838834764831845f * LOG2E;

constexpr size_t MiB = 1u << 20;
constexpr size_t WS_RSTDX = 0, WS_PARTQ = 1 * MiB, WS_PARTKV = 2 * MiB, WS_PARTY = 3 * MiB, WS_FLOG = 5 * MiB, WS_CF = 6 * MiB, WS_COS = 7 * MiB, WS_SIN = 9 * MiB;
constexpr size_t WS_CTL = 11 * MiB, CTL_BYTES = 16384;
constexpr size_t WS_WIN = 16 * MiB, WS_WUQ = 42 * MiB, WS_WUKV = 45 * MiB, WS_WOUT = 47 * MiB;
constexpr size_t WS_XB = 56 * MiB, WS_O = 56 * MiB;
constexpr size_t WS_QLAT = 120 * MiB, WS_KVLAT = 144 * MiB, WS_G = 160 * MiB;
constexpr size_t WS_QF = 224 * MiB, WS_Y = 224 * MiB, WS_KF = 256 * MiB, WS_VF = 288 * MiB;
constexpr size_t WS_QM = 320 * MiB, WS_KM = 368 * MiB, WS_VM = 416 * MiB, WS_END = 448 * MiB;

constexpr int LDS_BYTES = 163840;

__device__ __forceinline__ unsigned f2bf(float f) { unsigned u = __builtin_bit_cast(unsigned, f); return (u + 0x7fffu + ((u >> 16) & 1u)) >> 16; }
__device__ __forceinline__ unsigned pk2(float lo, float hi) { return pg8::cvt_pk_bf16(lo, hi); }
__device__ __forceinline__ float bflo(unsigned w) { return __builtin_bit_cast(float, w << 16); }
__device__ __forceinline__ float bfhi(unsigned w) { return __builtin_bit_cast(float, w & 0xffff0000u); }
__device__ __forceinline__ int launder(int v) { asm volatile("" : "+v"(v)); return v; }
__device__ __forceinline__ float wave_sum(float v) {
#pragma unroll
    for (int o = 1; o < 64; o <<= 1) v += __shfl_xor(v, o);
    return v;
}
__device__ __forceinline__ float silu_f(float v) { return v * __builtin_amdgcn_rcpf(1.f + __builtin_amdgcn_exp2f(-v * LOG2E)); }
__device__ __forceinline__ u32x4 pack8f(f32x4 a, f32x4 b) { u32x4 w; w.x = pk2(a[0], a[1]); w.y = pk2(a[2], a[3]); w.z = pk2(b[0], b[1]); w.w = pk2(b[2], b[3]); return w; }

typedef pg8::f32x4 af4;
struct EpiIn {
    static constexpr bool PERM = true, AFTER_DRAIN = false;
    const float* rstd_x; bf16 *qlat, *kvlat, *G, *Qf, *Kf, *Vf, *Km; float *flog, *partq, *partkv; const float *cosT, *sinT;
    __device__ __forceinline__ void operator()(const af4 (&acc)[2][2][4][2], const pg8::Unit& u, int wr, int wc, int fr, int fq) const {
        const int pn = u.pn; const int row0 = u.pm * 256 + wr * 64 + fr;
        if (pn == 25) {
            if (wc == 0) {
#pragma unroll
                for (int ai = 0; ai < 2; ++ai)
#pragma unroll
                    for (int m = 0; m < 4; ++m) { const int row = row0 + ai * 128 + m * 16; const float rs = rstd_x[row];
                        f32x4 o1[2], o2[2];
#pragma unroll
                        for (int n = 0; n < 2; ++n) { const f32x4 c = *(const f32x4*)(cosT + (size_t)row * 32 + 8 * fq + 4 * n), s = *(const f32x4*)(sinT + (size_t)row * 32 + 8 * fq + 4 * n);
                            const f32x4 x1 = acc[ai][0][m][n] * rs, x2 = acc[ai][1][m][n] * rs; o1[n] = x1 * c - x2 * s; o2[n] = x2 * c + x1 * s; }
                        const u32x4 w1 = pack8f(o1[0], o1[1]), w2 = pack8f(o2[0], o2[1]);
                        bf16* kp = Km + (size_t)row * 1536 + 128 + 8 * fq;
#pragma unroll
                        for (int h = 0; h < 8; ++h) { *(u32x4*)(kp + h * 192) = w1; *(u32x4*)(kp + h * 192 + 32) = w2; } }
            } else if (wc == 1 && fq == 0) {
#pragma unroll
                for (int ai = 0; ai < 2; ++ai)
#pragma unroll
                    for (int m = 0; m < 4; ++m) { const int row = row0 + ai * 128 + m * 16; const float rs = rstd_x[row];
                        *(f32x4*)(flog + (size_t)row * 8) = acc[ai][0][m][0] * rs; *(f32x4*)(flog + (size_t)row * 8 + 4) = acc[ai][0][m][1] * rs; }
            }
            return;
        }
        bf16* base; int ld, colt, mode = 0; float* part = nullptr; int nslot = 0, slot0 = 0;
        if (pn < 3) { base = qlat; ld = 768; colt = pn * 256; part = partq; nslot = 12; slot0 = pn * 4; }
        else if (pn < 5) { base = kvlat; ld = 512; colt = (pn - 3) * 256; part = partkv; nslot = 8; slot0 = (pn - 3) * 4; }
        else if (pn < 9) { base = G; ld = 2048; colt = (pn - 5) * 256; mode = 1; }
        else if (pn < 13) { base = Qf; ld = 1024; colt = (pn - 9) * 256; mode = 2; }
        else if (pn < 17) { base = Kf; ld = 1024; colt = (pn - 13) * 256; }
        else if (pn < 21) { base = Vf; ld = 1024; colt = (pn - 17) * 256; }
        else { base = G; ld = 2048; colt = 1024 + (pn - 21) * 256; mode = 1; }
        const int col0 = colt + wc * 32 + 8 * fq;
#pragma unroll
        for (int ai = 0; ai < 2; ++ai)
#pragma unroll
            for (int m = 0; m < 4; ++m) { const int row = row0 + ai * 128 + m * 16; float rs = rstd_x[row]; if (mode == 2) rs *= C2F;
                bf16* rowp = base + (size_t)row * ld + col0; float ss = 0.f;
#pragma unroll
                for (int bj = 0; bj < 2; ++bj) { f32x4 v0 = acc[ai][bj][m][0] * rs, v1 = acc[ai][bj][m][1] * rs;
                    ss += (v0[0] * v0[0] + v0[1] * v0[1]) + (v0[2] * v0[2] + v0[3] * v0[3]) + (v1[0] * v1[0] + v1[1] * v1[1]) + (v1[2] * v1[2] + v1[3] * v1[3]);
                    if (mode == 1) {
#pragma unroll
                        for (int e = 0; e < 4; ++e) { v0[e] = silu_f(v0[e]); v1[e] = silu_f(v1[e]); } }
                    *(u32x4*)(rowp + bj * 128) = pack8f(v0, v1); }
                if (part) { ss += __shfl_xor(ss, 16); ss += __shfl_xor(ss, 32); if (fq == 0) part[(size_t)row * nslot + slot0 + wc] = ss; } }
    }
};
struct EpiQ {
    static constexpr bool PERM = true, AFTER_DRAIN = false;
    const float* partq; bf16* Qm; const float *cosT, *sinT;
    __device__ __forceinline__ void operator()(const af4 (&acc)[2][2][4][2], const pg8::Unit& u, int wr, int wc, int fr, int fq) const {
        const int pn = u.pn; const int row0 = u.pm * 256 + wr * 64 + fr;
#pragma unroll
        for (int ai = 0; ai < 2; ++ai)
#pragma unroll
            for (int m = 0; m < 4; ++m) { const int row = row0 + ai * 128 + m * 16;
                const f32x4 pa = *(const f32x4*)(partq + (size_t)row * 12), pb = *(const f32x4*)(partq + (size_t)row * 12 + 4), pc = *(const f32x4*)(partq + (size_t)row * 12 + 8);
                const float ssq = ((pa[0] + pa[1]) + (pa[2] + pa[3])) + ((pb[0] + pb[1]) + (pb[2] + pb[3])) + ((pc[0] + pc[1]) + (pc[2] + pc[3]));
                const float rs = C2M / sqrtf(ssq * (1.f / 768.f) + EPS);
                if (pn < 4) {
#pragma unroll
                    for (int bj = 0; bj < 2; ++bj) *(u32x4*)(Qm + (size_t)row * 1536 + (2 * pn + bj) * 192 + wc * 32 + 8 * fq) = pack8f(acc[ai][bj][m][0] * rs, acc[ai][bj][m][1] * rs);
                } else { const int head = 4 * (pn - 4) + wc; f32x4 o1[2], o2[2];
#pragma unroll
                    for (int n = 0; n < 2; ++n) { const f32x4 c = *(const f32x4*)(cosT + (size_t)row * 32 + 8 * fq + 4 * n), s = *(const f32x4*)(sinT + (size_t)row * 32 + 8 * fq + 4 * n);
                        const f32x4 x1 = acc[ai][0][m][n] * rs, x2 = acc[ai][1][m][n] * rs; o1[n] = x1 * c - x2 * s; o2[n] = x2 * c + x1 * s; }
                    bf16* qp = Qm + (size_t)row * 1536 + head * 192 + 128 + 8 * fq;
                    *(u32x4*)qp = pack8f(o1[0], o1[1]); *(u32x4*)(qp + 32) = pack8f(o2[0], o2[1]); } }
    }
};
struct EpiKV {
    static constexpr bool PERM = true, AFTER_DRAIN = false;
    const float* partkv; bf16 *Km, *Vm;
    __device__ __forceinline__ void operator()(const af4 (&acc)[2][2][4][2], const pg8::Unit& u, int wr, int wc, int fr, int fq) const {
        const int pn = u.pn; const int row0 = u.pm * 256 + wr * 64 + fr;
#pragma unroll
        for (int ai = 0; ai < 2; ++ai)
#pragma unroll
            for (int m = 0; m < 4; ++m) { const int row = row0 + ai * 128 + m * 16;
                const f32x4 pa = *(const f32x4*)(partkv + (size_t)row * 8), pb = *(const f32x4*)(partkv + (size_t)row * 8 + 4);
                const float ssq = ((pa[0] + pa[1]) + (pa[2] + pa[3])) + ((pb[0] + pb[1]) + (pb[2] + pb[3]));
                const float rs = 1.f / sqrtf(ssq * (1.f / 512.f) + EPS);
                *(u32x4*)(Km + (size_t)row * 1536 + pn * 192 + wc * 32 + 8 * fq) = pack8f(acc[ai][0][m][0] * rs, acc[ai][0][m][1] * rs);
                *(u32x4*)(Vm + (size_t)row * 1024 + pn * 128 + wc * 32 + 8 * fq) = pack8f(acc[ai][1][m][0] * rs, acc[ai][1][m][1] * rs); }
    }
};
struct EpiOut {
    static constexpr bool PERM = true, AFTER_DRAIN = false;
    bf16* Y; float* party;
    __device__ __forceinline__ void operator()(const af4 (&acc)[2][2][4][2], const pg8::Unit& u, int wr, int wc, int fr, int fq) const {
        const int pn = u.pn; const int row0 = u.pm * 256 + wr * 64 + fr; const int col0 = pn * 256 + wc * 32 + 8 * fq;
#pragma unroll
        for (int ai = 0; ai < 2; ++ai)
#pragma unroll
            for (int m = 0; m < 4; ++m) { const int row = row0 + ai * 128 + m * 16; float ss = 0.f;
#pragma unroll
                for (int bj = 0; bj < 2; ++bj) { const f32x4 v0 = acc[ai][bj][m][0], v1 = acc[ai][bj][m][1];
                    ss += (v0[0] * v0[0] + v0[1] * v0[1]) + (v0[2] * v0[2] + v0[3] * v0[3]) + (v1[0] * v1[0] + v1[1] * v1[1]) + (v1[2] * v1[2] + v1[3] * v1[3]);
                    *(u32x4*)(Y + (size_t)row * 2048 + col0 + bj * 128) = pack8f(v0, v1); }
                ss += __shfl_xor(ss, 16); ss += __shfl_xor(ss, 32); if (fq == 0) party[(size_t)row * 32 + pn * 4 + wc] = ss; }
    }
};

namespace att {
constexpr int KVBLK = 64, QBLK = 32, QB = 256;
constexpr int SHM_K = 24576, SHM_V = 16384;
constexpr int NRING = 3;
constexpr int OFF_K = 0, OFF_V = NRING * SHM_K, OFF_CK = OFF_V + NRING * SHM_V, OFF_WS = OFF_CK + 1024, OFF_QP = OFF_WS + 2048;
constexpr float THR = 8.f;
#define KSWZ(row, colB) ((row) * 256 + ((colB) ^ (((row) & 7) << 4)))
#define SBAR() __builtin_amdgcn_sched_barrier(0)
__device__ __forceinline__ int v_st(int k, int c) { const int kk = (k & ~0xC) | ((k & 4) << 1) | ((k & 8) >> 1); return ((kk >> 3) * 4 + (c >> 5)) * 512 + ((kk & 7) * 32 + (c & 31)) * 2; }
__device__ __forceinline__ int v_rd_base(int lane) { return ((lane & 3) << 3) | (((lane >> 2) & 3) << 6) | (((lane >> 4) & 1) << 5) | (((lane >> 5) & 1) << 8); }
constexpr int v_rd_off(int d0, int ks, int half) { return d0 * 512 + ks * 4096 + half * 2048; }
__device__ __forceinline__ int crow(int r, int hi) { return (r & 3) + 8 * (r >> 2) + 4 * hi; }
__device__ __forceinline__ unsigned cvtpk(float lo, float hi) { unsigned r; asm volatile("v_cvt_pk_bf16_f32 %0, %1, %2" : "=v"(r) : "v"(lo), "v"(hi)); return r; }

__device__ __forceinline__ void mask_tile(f32x16& p0, f32x16& p1, int dq) {
    const float NEG = -__builtin_inff();
#pragma unroll
    for (int r = 0; r < 16; ++r) { const int c = (r & 3) + 8 * (r >> 2);
        if (dq - c < 0) p0[r] = NEG;
        if (dq - c - 32 < 0) p1[r] = NEG; }
}
__device__ __forceinline__ void softmax_tile(f32x16& p0, f32x16& p1, float& m_reg, float& l_reg, float& alpha, bf16x8& pa0, bf16x8& pa1, bf16x8& pa2, bf16x8& pa3) {
    float pmax = p0[0];
#pragma unroll
    for (int r = 1; r < 16; ++r) pmax = fmaxf(pmax, p0[r]);
#pragma unroll
    for (int r = 0; r < 16; ++r) pmax = fmaxf(pmax, p1[r]);
    { auto rr = __builtin_amdgcn_permlane32_swap(__float_as_uint(pmax), __float_as_uint(pmax), false, false);
      pmax = fmaxf(__uint_as_float(rr[0]), __uint_as_float(rr[1])); }
    float mn;
    if (__builtin_expect(__all(pmax - m_reg <= THR), 1)) { mn = m_reg; alpha = 1.f; }
    else { mn = fmaxf(m_reg, pmax); alpha = __builtin_amdgcn_exp2f(m_reg - mn); m_reg = mn; }
#pragma unroll
    for (int r = 0; r < 16; ++r) { p0[r] = __builtin_amdgcn_exp2f(p0[r] - mn); p1[r] = __builtin_amdgcn_exp2f(p1[r] - mn); }
    float ps = 0.f;
#pragma unroll
    for (int r = 0; r < 16; ++r) ps += p0[r];
#pragma unroll
    for (int r = 0; r < 16; ++r) ps += p1[r];
    { auto rr = __builtin_amdgcn_permlane32_swap(__float_as_uint(ps), __float_as_uint(ps), false, false);
      ps = __uint_as_float(rr[0]) + __uint_as_float(rr[1]); }
    l_reg = l_reg * alpha + ps;
#define PK4(P, B_, OUT) do { unsigned a0 = cvtpk(P[B_+0], P[B_+1]), a1 = cvtpk(P[B_+2], P[B_+3]);                          \
        unsigned b0 = cvtpk(P[B_+4], P[B_+5]), b1 = cvtpk(P[B_+6], P[B_+7]);                                             \
        auto r0 = __builtin_amdgcn_permlane32_swap(a0, b0, false, false); auto r1 = __builtin_amdgcn_permlane32_swap(a1, b1, false, false); \
        u32x4 w = {r0[0], r1[0], r0[1], r1[1]}; OUT = *reinterpret_cast<bf16x8*>(&w); } while (0)
    PK4(p0, 0, pa0); PK4(p0, 8, pa1); PK4(p1, 0, pa2); PK4(p1, 8, pa3);
#undef PK4
}
template <int DQK, int NPARK>
__device__ __forceinline__ void qkt(f32x16& p0, f32x16& p1, const char* Kb, int r32, int hi, const bf16x8* qr, const char* qpk) {
    constexpr int ND = DQK / 16, NQR = ND - NPARK;
    p0 = f32x16{}; p1 = f32x16{};
    const char* kb[4];
#pragma unroll
    for (int dd = 0; dd < 4; ++dd) kb[dd] = Kb + KSWZ(r32, (dd * 16 + hi * 8) * 2);
    const char* kr = Kb + 16384 + r32 * 128;
    const int rx = (r32 & 7) << 4;
    bf16x8 kf[3][2], qf[3];
#define QK_LD(set, d_) do { \
            if ((d_) < 8) { const char* a_ = kb[(d_) & 3] + ((d_) >> 2) * 128; kf[set][0] = *reinterpret_cast<const bf16x8*>(a_); kf[set][1] = *reinterpret_cast<const bf16x8*>(a_ + 32 * 256); } \
            else { const char* a_ = kr + (((((d_) - 8) * 16 + hi * 8) * 2) ^ rx); kf[set][0] = *reinterpret_cast<const bf16x8*>(a_); kf[set][1] = *reinterpret_cast<const bf16x8*>(a_ + 32 * 128); } \
            if ((d_) >= NQR) qf[set] = *reinterpret_cast<const bf16x8*>(qpk + ((d_) - NQR) * 1024); } while (0)
    QK_LD(0, 0); QK_LD(1, 1); SBAR();
#pragma unroll
    for (int d = 0; d < ND; ++d) {
        const int cs = d % 3;
        if (d + 2 < ND) { const int ns = (d + 2) % 3; if (ns == 0) QK_LD(0, d + 2); else if (ns == 1) QK_LD(1, d + 2); else QK_LD(2, d + 2); SBAR(); }
        const bf16x8 q = (d < NQR) ? qr[d < NQR ? d : 0] : qf[cs];
        p0 = __builtin_amdgcn_mfma_f32_32x32x16_bf16(kf[cs][0], q, p0, 0, 0, 0);
        p1 = __builtin_amdgcn_mfma_f32_32x32x16_bf16(kf[cs][1], q, p1, 0, 0, 0);
        SBAR();
    }
#undef QK_LD
}
template <int VOFF>
__device__ __forceinline__ void pv_tile(f32x16* o, int vb0, bf16x8 pa0, bf16x8 pa1, bf16x8 pa2, bf16x8 pa3) {
#define TRRD(dst, off) asm volatile("ds_read_b64_tr_b16 %0, %1 offset:%2" : "=&v"(dst) : "v"(vb0), "i"(off) : "memory")
#define PV_D0(d0) do { s16x4 l0, l1, l2, l3, h0, h1, h2, h3; constexpr int b_ = VOFF + v_rd_off(d0, 0, 0); \
        TRRD(l0, b_); TRRD(h0, b_ + 2048); TRRD(l1, b_ + 4096); TRRD(h1, b_ + 6144); TRRD(l2, b_ + 8192); TRRD(h2, b_ + 10240); TRRD(l3, b_ + 12288); TRRD(h3, b_ + 14336); \
        asm volatile("s_waitcnt lgkmcnt(0)" ::: "memory"); SBAR(); \
        o[d0] = __builtin_amdgcn_mfma_f32_32x32x16_bf16(pa0, (bf16x8){l0[0], l0[1], l0[2], l0[3], h0[0], h0[1], h0[2], h0[3]}, o[d0], 0, 0, 0);   \
        o[d0] = __builtin_amdgcn_mfma_f32_32x32x16_bf16(pa1, (bf16x8){l1[0], l1[1], l1[2], l1[3], h1[0], h1[1], h1[2], h1[3]}, o[d0], 0, 0, 0);   \
        o[d0] = __builtin_amdgcn_mfma_f32_32x32x16_bf16(pa2, (bf16x8){l2[0], l2[1], l2[2], l2[3], h2[0], h2[1], h2[2], h2[3]}, o[d0], 0, 0, 0);   \
        o[d0] = __builtin_amdgcn_mfma_f32_32x32x16_bf16(pa3, (bf16x8){l3[0], l3[1], l3[2], l3[3], h3[0], h3[1], h3[2], h3[3]}, o[d0], 0, 0, 0); } while (0)
    PV_D0(0); PV_D0(1); PV_D0(2); PV_D0(3);
#undef PV_D0
#undef TRRD
}

#define RD128(dst, addr, off) asm volatile("ds_read_b128 %0, %1 offset:%2" : "=&v"(dst) : "v"(addr), "i"(off) : "memory")
#define RDTR(dst, addr, off) asm volatile("ds_read_b64_tr_b16 %0, %1 offset:%2" : "=&v"(dst) : "v"(addr), "i"(off) : "memory")
#define WAITK(n, x) asm volatile("s_waitcnt lgkmcnt(%1)" : "+v"(x) : "n"(n) : "memory")
#define WAITKQ(n, x, q) asm volatile("s_waitcnt lgkmcnt(%2)" : "+v"(x), "+v"(q) : "n"(n) : "memory")
#define WAITV(n, x, y) asm volatile("s_waitcnt lgkmcnt(%2)" : "+v"(x), "+v"(y) : "n"(n) : "memory")

__device__ __forceinline__ void mblock_mla_q(f32x16& p0, f32x16& p1, f32x16* o, const bf16x8* qr, bf16x8 pa0, bf16x8 pa1, bf16x8 pa2, bf16x8 pa3, const unsigned* kbv, const unsigned* krv, unsigned qpkv, unsigned vbv) {
    bf16x8 ksl[5], qsl[3]; s16x4 vlo[5], vhi[5];
    p0 = f32x16{}; p1 = f32x16{};
    RD128(ksl[0], kbv[0], 0);
    RD128(ksl[1], kbv[0], 8192);
    RD128(ksl[2], kbv[1], 0);
    RD128(ksl[3], kbv[1], 8192);
    RD128(ksl[4], kbv[2], 0);
    WAITK(4, ksl[0]); p0 = __builtin_amdgcn_mfma_f32_32x32x16_bf16(ksl[0], qr[0], p0, 0, 0, 0);
    RD128(ksl[0], kbv[2], 8192);
    WAITK(4, ksl[1]); p1 = __builtin_amdgcn_mfma_f32_32x32x16_bf16(ksl[1], qr[0], p1, 0, 0, 0);
    RD128(ksl[1], kbv[3], 0);
    WAITK(4, ksl[2]); p0 = __builtin_amdgcn_mfma_f32_32x32x16_bf16(ksl[2], qr[1], p0, 0, 0, 0);
    RD128(ksl[2], kbv[3], 8192);
    WAITK(4, ksl[3]); p1 = __builtin_amdgcn_mfma_f32_32x32x16_bf16(ksl[3], qr[1], p1, 0, 0, 0);
    RD128(ksl[3], kbv[0], 128);
    WAITK(4, ksl[4]); p0 = __builtin_amdgcn_mfma_f32_32x32x16_bf16(ksl[4], qr[2], p0, 0, 0, 0);
    RD128(ksl[4], kbv[0], 8320);
    WAITK(4, ksl[0]); p1 = __builtin_amdgcn_mfma_f32_32x32x16_bf16(ksl[0], qr[2], p1, 0, 0, 0);
    RD128(ksl[0], kbv[1], 128);
    WAITK(4, ksl[1]); p0 = __builtin_amdgcn_mfma_f32_32x32x16_bf16(ksl[1], qr[3], p0, 0, 0, 0);
    RD128(ksl[1], kbv[1], 8320);
    WAITK(4, ksl[2]); p1 = __builtin_amdgcn_mfma_f32_32x32x16_bf16(ksl[2], qr[3], p1, 0, 0, 0);
    RD128(ksl[2], kbv[2], 128);
    WAITK(4, ksl[3]); p0 = __builtin_amdgcn_mfma_f32_32x32x16_bf16(ksl[3], qr[4], p0, 0, 0, 0);
    RD128(ksl[3], kbv[2], 8320);
    WAITK(4, ksl[4]); p1 = __builtin_amdgcn_mfma_f32_32x32x16_bf16(ksl[4], qr[4], p1, 0, 0, 0);
    RD128(ksl[4], kbv[3], 128);
    WAITK(4, ksl[0]); p0 = __builtin_amdgcn_mfma_f32_32x32x16_bf16(ksl[0], qr[5], p0, 0, 0, 0);
    RD128(ksl[0], kbv[3], 8320);
    WAITK(4, ksl[1]); p1 = __builtin_amdgcn_mfma_f32_32x32x16_bf16(ksl[1], qr[5], p1, 0, 0, 0);
    RD128(ksl[1], krv[0], 0); RD128(qsl[2], qpkv, 0);
    WAITK(5, ksl[2]); p0 = __builtin_amdgcn_mfma_f32_32x32x16_bf16(ksl[2], qr[6], p0, 0, 0, 0);
    RD128(ksl[2], krv[0], 4096);
    WAITK(5, ksl[3]); p1 = __builtin_amdgcn_mfma_f32_32x32x16_bf16(ksl[3], qr[6], p1, 0, 0, 0);
    RD128(ksl[3], krv[1], 0); RD128(qsl[0], qpkv, 1024);
    WAITK(6, ksl[4]); p0 = __builtin_amdgcn_mfma_f32_32x32x16_bf16(ksl[4], qr[7], p0, 0, 0, 0);
    RD128(ksl[4], krv[1], 4096);
    WAITK(6, ksl[0]); p1 = __builtin_amdgcn_mfma_f32_32x32x16_bf16(ksl[0], qr[7], p1, 0, 0, 0);
    RD128(ksl[0], krv[2], 0); RD128(qsl[1], qpkv, 2048);
    WAITKQ(6, ksl[1], qsl[2]); p0 = __builtin_amdgcn_mfma_f32_32x32x16_bf16(ksl[1], qsl[2], p0, 0, 0, 0);
    RD128(ksl[1], krv[2], 4096);
    WAITKQ(6, ksl[2], qsl[2]); p1 = __builtin_amdgcn_mfma_f32_32x32x16_bf16(ksl[2], qsl[2], p1, 0, 0, 0);
    RD128(ksl[2], krv[3], 0); RD128(qsl[2], qpkv, 3072);
    WAITKQ(6, ksl[3], qsl[0]); p0 = __builtin_amdgcn_mfma_f32_32x32x16_bf16(ksl[3], qsl[0], p0, 0, 0, 0);
    RD128(ksl[3], krv[3], 4096);
    WAITKQ(6, ksl[4], qsl[0]); p1 = __builtin_amdgcn_mfma_f32_32x32x16_bf16(ksl[4], qsl[0], p1, 0, 0, 0);
    WAITKQ(4, ksl[0], qsl[1]); p0 = __builtin_amdgcn_mfma_f32_32x32x16_bf16(ksl[0], qsl[1], p0, 0, 0, 0);
    WAITKQ(3, ksl[1], qsl[1]); p1 = __builtin_amdgcn_mfma_f32_32x32x16_bf16(ksl[1], qsl[1], p1, 0, 0, 0);
    WAITKQ(1, ksl[2], qsl[2]); p0 = __builtin_amdgcn_mfma_f32_32x32x16_bf16(ksl[2], qsl[2], p0, 0, 0, 0);
    WAITKQ(0, ksl[3], qsl[2]); p1 = __builtin_amdgcn_mfma_f32_32x32x16_bf16(ksl[3], qsl[2], p1, 0, 0, 0);
}
__device__ __forceinline__ void mblock_fox_q(f32x16& p0, f32x16& p1, f32x16* o, const bf16x8* qr, bf16x8 pa0, bf16x8 pa1, bf16x8 pa2, bf16x8 pa3, const unsigned* kbv, const unsigned* krv, unsigned qpkv, unsigned vbv) {
    bf16x8 ksl[5], qsl[3]; s16x4 vlo[5], vhi[5];
    p0 = f32x16{}; p1 = f32x16{};
    RD128(ksl[0], kbv[0], 0);
    RD128(ksl[1], kbv[0], 8192);
    RD128(ksl[2], kbv[1], 0);
    RD128(ksl[3], kbv[1], 8192);
    RD128(ksl[4], kbv[2], 0);
    WAITK(4, ksl[0]); p0 = __builtin_amdgcn_mfma_f32_32x32x16_bf16(ksl[0], qr[0], p0, 0, 0, 0);
    RD128(ksl[0], kbv[2], 8192);
    WAITK(4, ksl[1]); p1 = __builtin_amdgcn_mfma_f32_32x32x16_bf16(ksl[1], qr[0], p1, 0, 0, 0);
    RD128(ksl[1], kbv[3], 0);
    WAITK(4, ksl[2]); p0 = __builtin_amdgcn_mfma_f32_32x32x16_bf16(ksl[2], qr[1], p0, 0, 0, 0);
    RD128(ksl[2], kbv[3], 8192);
    WAITK(4, ksl[3]); p1 = __builtin_amdgcn_mfma_f32_32x32x16_bf16(ksl[3], qr[1], p1, 0, 0, 0);
    RD128(ksl[3], kbv[0], 128); RD128(qsl[1], qpkv, 0);
    WAITK(5, ksl[4]); p0 = __builtin_amdgcn_mfma_f32_32x32x16_bf16(ksl[4], qr[2], p0, 0, 0, 0);
    RD128(ksl[4], kbv[0], 8320);
    WAITK(5, ksl[0]); p1 = __builtin_amdgcn_mfma_f32_32x32x16_bf16(ksl[0], qr[2], p1, 0, 0, 0);
    RD128(ksl[0], kbv[1], 128); RD128(qsl[2], qpkv, 1024);
    WAITK(6, ksl[1]); p0 = __builtin_amdgcn_mfma_f32_32x32x16_bf16(ksl[1], qr[3], p0, 0, 0, 0);
    RD128(ksl[1], kbv[1], 8320);
    WAITK(6, ksl[2]); p1 = __builtin_amdgcn_mfma_f32_32x32x16_bf16(ksl[2], qr[3], p1, 0, 0, 0);
    RD128(ksl[2], kbv[2], 128); RD128(qsl[0], qpkv, 2048);
    WAITKQ(6, ksl[3], qsl[1]); p0 = __builtin_amdgcn_mfma_f32_32x32x16_bf16(ksl[3], qsl[1], p0, 0, 0, 0);
    RD128(ksl[3], kbv[2], 8320);
    WAITKQ(6, ksl[4], qsl[1]); p1 = __builtin_amdgcn_mfma_f32_32x32x16_bf16(ksl[4], qsl[1], p1, 0, 0, 0);
    RD128(ksl[4], kbv[3], 128); RD128(qsl[1], qpkv, 3072);
    WAITKQ(6, ksl[0], qsl[2]); p0 = __builtin_amdgcn_mfma_f32_32x32x16_bf16(ksl[0], qsl[2], p0, 0, 0, 0);
    RD128(ksl[0], kbv[3], 8320);
    WAITKQ(6, ksl[1], qsl[2]); p1 = __builtin_amdgcn_mfma_f32_32x32x16_bf16(ksl[1], qsl[2], p1, 0, 0, 0);
    WAITKQ(4, ksl[2], qsl[0]); p0 = __builtin_amdgcn_mfma_f32_32x32x16_bf16(ksl[2], qsl[0], p0, 0, 0, 0);
    WAITKQ(3, ksl[3], qsl[0]); p1 = __builtin_amdgcn_mfma_f32_32x32x16_bf16(ksl[3], qsl[0], p1, 0, 0, 0);
    WAITKQ(1, ksl[4], qsl[1]); p0 = __builtin_amdgcn_mfma_f32_32x32x16_bf16(ksl[4], qsl[1], p0, 0, 0, 0);
    WAITKQ(0, ksl[0], qsl[1]); p1 = __builtin_amdgcn_mfma_f32_32x32x16_bf16(ksl[0], qsl[1], p1, 0, 0, 0);
}
#undef RD128
#undef RDTR
#undef WAITK
#undef WAITKQ
#undef WAITV

template <int DQK, bool FOX, int ABL = 0>
__device__ __forceinline__ void attn_unit(char* lds, const bf16* Q, int ldq, const bf16* K, int ldk, const bf16* V, int ldv, const float* cfs, const bf16* Gp, bf16* Op, int qb) {
    const int tid = threadIdx.x, wid = __builtin_amdgcn_readfirstlane(tid >> 6), lane = tid & 63, r32 = lane & 31, hi = lane >> 5;
    const bool grpA = wid < 4; const int w4 = wid & 3;
    const int q0 = qb * QB, NT = 4 * (qb + 1);
    char* K_lds = lds + OFF_K; char* V_lds = lds + OFF_V; float* ck_l = (float*)(lds + OFF_CK);
    float* wsf = (float*)(lds + OFF_WS) + wid * 64; float* li_l = wsf; float* al_l = wsf + 32;
    constexpr int NPARK = 4, NQR = DQK / 16 - NPARK;
    bf16x8 qr[NQR];
    char* qpk = lds + OFF_QP + wid * 4096 + (hi * 32 + r32) * 16;
    unsigned koff, kroff = 0, voff;
    { const int row = 4 * w4 + (lane >> 4), c = (lane & 15) ^ (row & 7); koff = (unsigned)(row * ldk + c * 8) * 2u; }
    { const int s0 = 2 * w4 + (lane >> 5), kk = 8 * (s0 >> 2) + ((lane & 31) >> 2), k = (kk & ~0xC) | ((kk & 4) << 1) | ((kk & 8) >> 1); voff = (unsigned)(k * ldv + 32 * (s0 & 3) + 8 * (lane & 3)) * 2u; }
    if constexpr (DQK == 192) { const int row = 8 * w4 + (lane >> 3), c = (lane & 7) ^ (row & 7); kroff = (unsigned)(row * ldk + 128 + c * 8) * 2u; }
    const int vb0 = (int)(uintptr_t)V_lds + v_rd_base(lane);
    LAS unsigned char* ldsl = (LAS unsigned char*)(uintptr_t)(unsigned)(uintptr_t)lds;
    unsigned kb0[4], kr0[4];
#pragma unroll
    for (int i = 0; i < 4; ++i) { const unsigned xo = (unsigned)((i * 32 + hi * 16) ^ ((r32 & 7) << 4)); kb0[i] = (unsigned)(uintptr_t)K_lds + r32 * 256 + xo; kr0[i] = (unsigned)(uintptr_t)K_lds + 16384 + r32 * 128 + xo; }
    const unsigned qpkv = (unsigned)(uintptr_t)qpk;
#define DMA_K(t, bf) do { const char* kt_ = (const char*)K + (size_t)(t) * KVBLK * ldk * 2; \
        _Pragma("unroll") for (int j_ = 0; j_ < 4; ++j_) \
            __builtin_amdgcn_global_load_lds((const unsigned*)(kt_ + koff + (size_t)j_ * 16 * ldk * 2), (LAS unsigned*)(ldsl + OFF_K + (bf) * SHM_K + (w4 + 4 * j_) * 1024), 16, 0, 0); \
        if constexpr (DQK == 192) { _Pragma("unroll") for (int j_ = 0; j_ < 2; ++j_) \
            __builtin_amdgcn_global_load_lds((const unsigned*)(kt_ + kroff + (size_t)j_ * 32 * ldk * 2), (LAS unsigned*)(ldsl + OFF_K + (bf) * SHM_K + 16384 + (w4 + 4 * j_) * 1024), 16, 0, 0); } \
        if constexpr (FOX) { __builtin_amdgcn_global_load_lds((const unsigned*)(cfs + (t) * KVBLK + lane), (LAS unsigned*)(ldsl + OFF_CK + ((t) & 3) * 256), 4, 0, 0); } } while (0)
#define DMA_V(t, bf) do { const char* vt_ = (const char*)V + (size_t)(t) * KVBLK * ldv * 2; \
        _Pragma("unroll") for (int j_ = 0; j_ < 4; ++j_) \
            __builtin_amdgcn_global_load_lds((const unsigned*)(vt_ + voff + (size_t)j_ * 16 * ldv * 2), (LAS unsigned*)(ldsl + OFF_V + (bf) * SHM_V + (w4 + 4 * j_) * 1024), 16, 0, 0); } while (0)
#define BAR_L() asm volatile("s_waitcnt lgkmcnt(0)\n\ts_barrier" ::: "memory")
#define BAR_VL() asm volatile("s_waitcnt vmcnt(0) lgkmcnt(0)\n\ts_barrier" ::: "memory")
    constexpr int NDK = 4 + (DQK == 192 ? 2 : 0) + (FOX ? 1 : 0), NDV = 4;
#define BAR_VN(n) asm volatile("s_waitcnt vmcnt(%0) lgkmcnt(0)\n\ts_barrier" :: "n"(n) : "memory")
    if (grpA) { DMA_K(0, 0); DMA_K(1, 1); DMA_V(0, 0); }
    { const bf16* qp = Q + (size_t)(q0 + wid * QBLK + r32) * ldq + hi * 8;
#pragma unroll
      for (int d0 = 0; d0 < NQR; ++d0) qr[d0] = *(const bf16x8*)(qp + d0 * 16);
#pragma unroll
      for (int d0 = 0; d0 < NPARK; ++d0) *(bf16x8*)(qpk + d0 * 1024) = *(const bf16x8*)(qp + (NQR + d0) * 16); }
    float cq = 0.f; if constexpr (FOX) cq = cfs[q0 + wid * QBLK + r32];
    BAR_VL();
    if (!grpA) BAR_L();
    float m_reg = -1e30f, l_reg = 0.f; f32x16 o[4] = {}; f32x16 p0 = {}, p1 = {}; bf16x8 pa0 = {}, pa1 = {}, pa2 = {}, pa3 = {};
#define ACTW(tt) ((tt) - (NT - 4) < 0 || 64 * ((tt) - (NT - 4)) <= 32 * wid + 31)
    int rc = 0, rp = 2, rn = 1;
#pragma unroll 1
    for (int t = 0; t < NT; ++t) {
        if (grpA && !(ABL & 1)) { if (t + 2 < NT) DMA_K(t + 2, rp); if (t + 1 < NT) DMA_V(t + 1, rn); }
        const int jb_ = t - (NT - 4); const bool act_ = ACTW(t);
        if (act_ && !(ABL & 4)) { unsigned kbv[4], krv[4];
#pragma unroll
            for (int i = 0; i < 4; ++i) { kbv[i] = kb0[i] + rc * SHM_K; krv[i] = kr0[i] + rc * SHM_K; }
            if constexpr (DQK == 192) mblock_mla_q(p0, p1, o, qr, pa0, pa1, pa2, pa3, kbv, krv, qpkv, 0u); else mblock_fox_q(p0, p1, o, qr, pa0, pa1, pa2, pa3, kbv, krv, qpkv, 0u); }
        if (t > 0 && ACTW(t - 1) && !(ABL & 4)) { SBAR(); pv_tile<0>(o, vb0 + rp * SHM_V, pa0, pa1, pa2, pa3); }
        BAR_L();
        if (act_ && (ABL & 8)) {
#define PK4(P, B_, OUT) do { unsigned a0 = cvtpk(P[B_+0], P[B_+1]), a1 = cvtpk(P[B_+2], P[B_+3]); unsigned b0 = cvtpk(P[B_+4], P[B_+5]), b1 = cvtpk(P[B_+6], P[B_+7]); \
        auto r0 = __builtin_amdgcn_permlane32_swap(a0, b0, false, false); auto r1 = __builtin_amdgcn_permlane32_swap(a1, b1, false, false); u32x4 w = {r0[0], r1[0], r0[1], r1[1]}; OUT = *reinterpret_cast<bf16x8*>(&w); } while (0)
            PK4(p0, 0, pa0); PK4(p0, 8, pa1); PK4(p1, 0, pa2); PK4(p1, 8, pa3);
#undef PK4
        }
        if (act_ && !(ABL & 2)) { float alpha;
            if constexpr (FOX) { const float* ckp = ck_l + (t & 3) * 64 + 4 * hi;
#pragma unroll
                for (int g_ = 0; g_ < 4; ++g_) { const f32x4 c0 = *(const f32x4*)(ckp + 8 * g_), c1 = *(const f32x4*)(ckp + 32 + 8 * g_);
#pragma unroll
                    for (int e_ = 0; e_ < 4; ++e_) { p0[4 * g_ + e_] += cq - c0[e_]; p1[4 * g_ + e_] += cq - c1[e_]; } } }
            if (jb_ >= 0 && 64 * jb_ + 63 > 32 * wid) mask_tile(p0, p1, 32 * wid + r32 - 64 * jb_ - 4 * hi);
            softmax_tile(p0, p1, m_reg, l_reg, alpha, pa0, pa1, pa2, pa3);
            if (__any(alpha < 1.f)) { if (hi == 0) al_l[r32] = alpha; asm volatile("s_waitcnt lgkmcnt(0)" ::: "memory");
#pragma unroll
                for (int d_ = 0; d_ < 4; ++d_)
#pragma unroll
                    for (int r = 0; r < 16; ++r) o[d_][r] *= al_l[crow(r, hi)]; }
        }
        if (ABL & 1) BAR_VN(0); else if (t + 2 < NT) BAR_VN(NDK + NDV); else if (t + 1 < NT) BAR_VN(NDV); else BAR_VN(0);
        rp = rc; rc = rn; rn = (rn == NRING - 1) ? 0 : rn + 1;
    }
    if (ACTW(NT - 1)) { SBAR(); pv_tile<0>(o, vb0 + rp * SHM_V, pa0, pa1, pa2, pa3); }
    if (grpA) BAR_L();
#undef BAR_VN
#undef ACTW
#undef DMA_K
#undef DMA_V
    if (hi == 0) li_l[r32] = l_reg; asm volatile("s_waitcnt lgkmcnt(0)" ::: "memory");
    bf16* stg = (bf16*)(lds + wid * 8192);
    const int lane_e = launder(lane);
#pragma unroll
    for (int r = 0; r < 16; ++r) { const int orow = crow(r, hi); const float rl = __builtin_amdgcn_rcpf(li_l[orow]);
#pragma unroll
        for (int d0 = 0; d0 < 4; ++d0) stg[orow * 128 + d0 * 32 + r32] = (bf16)f2bf(o[d0][r] * rl); }
    asm volatile("s_waitcnt lgkmcnt(0)" ::: "memory");
#pragma unroll
    for (int i = 0; i < 8; ++i) { const int row = i * 4 + (lane_e >> 4), ch = lane_e & 15;
        const u32x4 v = *(const u32x4*)(stg + row * 128 + ch * 8);
        const size_t go = (size_t)(q0 + wid * QBLK + row) * 2048 + ch * 8;
        const u32x4 g = *(const u32x4*)(Gp + go); u32x4 w;
        w.x = cvtpk(bflo(v.x) * bflo(g.x), bfhi(v.x) * bfhi(g.x)); w.y = cvtpk(bflo(v.y) * bflo(g.y), bfhi(v.y) * bfhi(g.y));
        w.z = cvtpk(bflo(v.z) * bflo(g.z), bfhi(v.z) * bfhi(g.z)); w.w = cvtpk(bflo(v.w) * bflo(g.w), bfhi(v.w) * bfhi(g.w));
        *(u32x4*)(Op + go) = w; }
    BAR_VL();
#undef BAR_L
#undef BAR_VL
}
#undef KSWZ
#undef SBAR
}

__device__ __forceinline__ void transpose_item(const float* W, int ldw, int K, const float* g, bf16* WT, int dst_row0, int src_col0, int nvalid, int k0, LAS float* scr, int lane) {
    const int n = lane & 31; const bool ok = (src_col0 >= 0) && (n < nvalid);
    float tv[32];
#pragma unroll
    for (int i = 0; i < 32; ++i) { const int kk = 2 * i + (lane >> 5); tv[i] = ok ? W[(size_t)(k0 + kk) * ldw + src_col0 + n] : 0.f; }
    if (g) {
#pragma unroll
        for (int i = 0; i < 32; ++i) tv[i] *= g[k0 + 2 * i + (lane >> 5)]; }
#pragma unroll
    for (int i = 0; i < 32; ++i) scr[(2 * i + (lane >> 5)) * 33 + n] = tv[i];
    asm volatile("s_waitcnt lgkmcnt(0)" ::: "memory");
    const int c = lane & 7;
#pragma unroll
    for (int j = 0; j < 4; ++j) { const int nn = (lane >> 3) + 8 * j; const LAS float* s = scr + (8 * c) * 33 + nn;
        u32x4 o; o.x = pk2(s[0 * 33], s[1 * 33]); o.y = pk2(s[2 * 33], s[3 * 33]); o.z = pk2(s[4 * 33], s[5 * 33]); o.w = pk2(s[6 * 33], s[7 * 33]);
        *(u32x4*)(WT + (size_t)(dst_row0 + nn) * K + k0 + 8 * c) = o; }
    asm volatile("s_waitcnt lgkmcnt(0)" ::: "memory");
}
__device__ __forceinline__ void win_src(int r0, int& src, int& nv) {
    nv = 32;
    if (r0 < 1280) src = r0;
    else if (r0 < 2304) src = 1344 + (r0 - 1280);
    else if (r0 < 3328) src = 2368 + (r0 - 2304);
    else if (r0 < 4352) src = 3392 + (r0 - 3328);
    else if (r0 < 5376) src = 4416 + (r0 - 4352);
    else if (r0 < 6400) src = 5448 + (r0 - 5376);
    else if (r0 == 6400) src = 1280;
    else if (r0 == 6432) { src = 5440; nv = 8; }
    else if (r0 == 6528) src = 1312;
    else src = -1;
}
__device__ __forceinline__ int wuq_src(int r0) {
    if (r0 < 1024) return (r0 >> 7) * 192 + (r0 & 127);
    const int q = r0 - 1024, t = q >> 8, bj = (q >> 7) & 1, wc = (q >> 5) & 3;
    return (4 * t + wc) * 192 + 128 + 32 * bj;
}


#define XB_TMO      128
#define XB_XCNT(j)  (256  + 64 * (j))
#define XB_XSUB(j)  (1280 + 64 * (j))
#define XB_XGEN(j)  (2304 + 64 * (j))
#define XB_TOP      3328
#define XB_TOPGEN   3392
#define XCD_BAR_WORDS 3456
#define XB_SPIN_CAP (1u << 18)
__device__ __forceinline__ unsigned xb_ld(unsigned* p)              { return __hip_atomic_load(p, __ATOMIC_RELAXED, __HIP_MEMORY_SCOPE_AGENT); }
__device__ __forceinline__ unsigned xb_add(unsigned* p, unsigned v) { return __hip_atomic_fetch_add(p, v, __ATOMIC_RELAXED, __HIP_MEMORY_SCOPE_AGENT); }
__device__ __forceinline__ unsigned xb_xcc_id() { return (unsigned)__builtin_amdgcn_s_getreg((3 << 11) | 20) & 0xFu; }
#define XB_SPIN(cond, bar) do { unsigned _sp = 0; while (cond) { __builtin_amdgcn_s_sleep(1); \
    if ((++_sp & 255u) == 0u) { if (xb_ld(&(bar)[XB_TMO])) break; if (_sp > XB_SPIN_CAP) { atomicAdd(&(bar)[XB_TMO], 1u); break; } } } } while (0)
struct XcdBarrier { unsigned* bar; unsigned x; volatile LAS unsigned* st; };
__device__ __forceinline__ XcdBarrier xcd_barrier_post(unsigned* bar, volatile LAS unsigned* st) {
    XcdBarrier b; b.bar = bar; b.x = xb_xcc_id(); b.st = st;
    if (threadIdx.x == 0) (void)xb_add(&bar[XB_XCNT(b.x)], 1u);
    return b;
}
__device__ __forceinline__ void xcd_barrier_complete(unsigned* bar, unsigned x, unsigned& nloc, unsigned& nx) {
    const unsigned G = gridDim.x * gridDim.y * gridDim.z;
    unsigned sum, cnt, mine, sp = 0u;
    for (;;) {
        sum = 0u; cnt = 0u; mine = 0u;
#pragma unroll
        for (unsigned j = 0; j < 16; ++j) { const unsigned c = xb_ld(&bar[XB_XCNT(j)]); sum += c; cnt += (c > 0u) ? 1u : 0u; mine = (j == x) ? c : mine; }
        if (sum == G) break;
        __builtin_amdgcn_s_sleep(1);
        if ((++sp & 255u) == 0u) { if (xb_ld(&bar[XB_TMO])) break; if (sp > XB_SPIN_CAP) { atomicAdd(&bar[XB_TMO], 1u); break; } }
    }
    nloc = mine > 0u ? mine : 1u; nx = cnt > 0u ? cnt : 1u;
}
__device__ __forceinline__ void xcd_barrier(const XcdBarrier& b) {
    asm volatile("s_waitcnt vmcnt(0)" ::: "memory");
    __syncthreads();
    if (threadIdx.x == 0) {
        unsigned* bar = b.bar;
        __builtin_amdgcn_s_waitcnt(0);
        unsigned nloc = b.st[0], nx = b.st[1];
        if (nloc == 0u) { xcd_barrier_complete(bar, b.x, nloc, nx); b.st[0] = nloc; b.st[1] = nx; }
        const unsigned old = xb_add(&bar[XB_XSUB(b.x)], 1u);
        const unsigned gen = old / nloc;
        if (old + 1u == (gen + 1u) * nloc) {
            __builtin_amdgcn_fence(__ATOMIC_RELEASE, "agent");
            asm volatile("s_waitcnt vmcnt(0)" ::: "memory");
            const unsigned og = xb_add(&bar[XB_TOP], 1u);
            const unsigned tg = og / nx;
            if (og + 1u == (tg + 1u) * nx) xb_add(&bar[XB_TOPGEN], 1u);
            else XB_SPIN(xb_ld(&bar[XB_TOPGEN]) == tg, bar);
            __builtin_amdgcn_fence(__ATOMIC_ACQUIRE, "agent");
            xb_add(&bar[XB_XGEN(b.x)], 1u);
            asm volatile("s_waitcnt vmcnt(0)" ::: "memory");
        } else {
            XB_SPIN(xb_ld(&bar[XB_XGEN(b.x)]) == gen, bar);
            __builtin_amdgcn_fence(__ATOMIC_ACQUIRE, "agent");
            asm volatile("s_waitcnt vmcnt(0)" ::: "memory");
        }
    }
    __syncthreads();
}

struct Args { const float* x; const int* pos; const float* g_pre; const float* w_in; const float* g_q; const float* w_uq; const float* g_kv; const float* w_ukv;
              const float* b_forget; const float* w_out; const float* g_post; float* out; unsigned char* ws; int ph_lo, ph_hi; };

__global__ void __launch_bounds__(512, 2) hybrid_fwd(Args a) {
    extern __shared__ __attribute__((aligned(16))) unsigned char lds[];
    cg::grid_group grid = cg::this_grid();
    const int tid_k = threadIdx.x, lane_k = tid_k & 63, wave = __builtin_amdgcn_readfirstlane(tid_k >> 6);
    const int G = gridDim.x, bx = blockIdx.x; const int vcu = (G % 8 == 0) ? (bx % 8) * (G / 8) + bx / 8 : bx;
    unsigned char* ws = a.ws;
    float* rstd_x = (float*)(ws + WS_RSTDX); float* partq = (float*)(ws + WS_PARTQ); float* partkv = (float*)(ws + WS_PARTKV); float* party = (float*)(ws + WS_PARTY);
    float* flog = (float*)(ws + WS_FLOG); float* cf = (float*)(ws + WS_CF); float* cosT = (float*)(ws + WS_COS); float* sinT = (float*)(ws + WS_SIN);
    bf16* Win_t = (bf16*)(ws + WS_WIN); bf16* Wuq_t = (bf16*)(ws + WS_WUQ); bf16* Wukv_t = (bf16*)(ws + WS_WUKV); bf16* Wout_t = (bf16*)(ws + WS_WOUT);
    bf16* Xb = (bf16*)(ws + WS_XB); bf16* Ob = (bf16*)(ws + WS_O); bf16* qlat = (bf16*)(ws + WS_QLAT); bf16* kvlat = (bf16*)(ws + WS_KVLAT); bf16* Gb = (bf16*)(ws + WS_G);
    bf16* Qf = (bf16*)(ws + WS_QF); bf16* Kf = (bf16*)(ws + WS_KF); bf16* Vf = (bf16*)(ws + WS_VF); bf16* Yb = (bf16*)(ws + WS_Y);
    bf16* Qm = (bf16*)(ws + WS_QM); bf16* Km = (bf16*)(ws + WS_KM); bf16* Vm = (bf16*)(ws + WS_VM);
    const int lo = a.ph_lo, hi = a.ph_hi;
#ifndef PH_MASK
#define PH_MASK 63
#endif
#define IN(k) (((PH_MASK >> (k)) & 1) && lo <= (k) && (k) < hi)
#define BOTH(k) (IN(k) && IN((k) + 1))
    LAS unsigned char* ldsl = (LAS unsigned char*)lds;
    volatile LAS unsigned* bst = (volatile LAS unsigned*)(ldsl + LDS_BYTES - 64);
    if (tid_k < 2) bst[tid_k] = 0u;
    __syncthreads();
    XcdBarrier xbar = xcd_barrier_post((unsigned*)(ws + WS_CTL), bst);

    if (IN(0)) for (int rep_ = 0; rep_ < PROBE_REP0; ++rep_) {
        const int lane = launder(lane_k), tid = launder(tid_k);
        LAS float* scr = (LAS float*)(ldsl + wave * 16384);
        const int gw = vcu * 8 + wave, NGW = G * 8;
        constexpr int I_IN = 32 * 208, I_UQ = 12 * 48, I_UKV = 8 * 64, I_OUT = 32 * 64, NITEMS = I_IN + I_UQ + I_UKV + I_OUT;
        for (int it = gw; it < NITEMS; it += NGW) {
            int r = it;
            if (r < I_IN) { const int kb = r / 208, nb = r % 208; int src, nv; win_src(nb * 32, src, nv); transpose_item(a.w_in, DIN, 2048, a.g_pre, Win_t, nb * 32, src, nv, kb * 64, scr, lane); continue; } r -= I_IN;
            if (r < I_UQ) { const int kb = r / 48, nb = r % 48; transpose_item(a.w_uq, 1536, 768, a.g_q, Wuq_t, nb * 32, wuq_src(nb * 32), 32, kb * 64, scr, lane); continue; } r -= I_UQ;
            if (r < I_UKV) { const int kb = r / 64, nb = r % 64; transpose_item(a.w_ukv, 2048, 512, a.g_kv, Wukv_t, nb * 32, nb * 32, 32, kb * 64, scr, lane); continue; } r -= I_UKV;
            { const int kb = r / 64, nb = r % 64; transpose_item(a.w_out, 2048, 2048, nullptr, Wout_t, nb * 32, nb * 32, 32, kb * 64, scr, lane); }
        }
        for (int m = gw; m < M; m += 2 * NGW) {
            const int m2 = m + NGW;
            const f32x4* xr = (const f32x4*)(a.x + (size_t)m * DM) + lane; const f32x4* xr2 = (const f32x4*)(a.x + (size_t)m2 * DM) + lane; f32x4 v[8], v2[8]; float s = 0.f, s2 = 0.f;
#pragma unroll
            for (int j = 0; j < 8; ++j) { v[j] = __builtin_nontemporal_load(xr + 64 * j); v2[j] = __builtin_nontemporal_load(xr2 + 64 * j); }
#pragma unroll
            for (int j = 0; j < 8; ++j) { s += (v[j][0] * v[j][0] + v[j][1] * v[j][1]) + (v[j][2] * v[j][2] + v[j][3] * v[j][3]); s2 += (v2[j][0] * v2[j][0] + v2[j][1] * v2[j][1]) + (v2[j][2] * v2[j][2] + v2[j][3] * v2[j][3]); }
            s = wave_sum(s); s2 = wave_sum(s2);
            if (lane == 0) { rstd_x[m] = 1.f / sqrtf(s * (1.f / DM) + EPS); rstd_x[m2] = 1.f / sqrtf(s2 * (1.f / DM) + EPS); }
            u32x2* o8 = (u32x2*)(Xb + (size_t)m * DM) + lane; u32x2* o82 = (u32x2*)(Xb + (size_t)m2 * DM) + lane;
#pragma unroll
            for (int j = 0; j < 8; ++j) { u32x2 w; w.x = pk2(v[j][0], v[j][1]); w.y = pk2(v[j][2], v[j][3]); o8[64 * j] = w; u32x2 w2; w2.x = pk2(v2[j][0], v2[j][1]); w2.y = pk2(v2[j][2], v2[j][3]); o82[64 * j] = w2; }
        }
        for (int e = (vcu * 512 + tid); e < M * 32; e += G * 512) { const int row = e >> 5, i = e & 31;
            const float inv = exp2f(-(float)i * (13.287712379549449f / 32.f)); const float ang = (float)a.pos[row] * inv;
            const float n = rintf(ang * 0.15915494309189535f); float r = fmaf(-n, 6.28318548202514648f, ang); r = fmaf(-n, -1.7484555e-7f, r);
            cosT[e] = __cosf(r); sinT[e] = __sinf(r); }
    }
    if (BOTH(0)) xcd_barrier(xbar);
    if (a.ph_hi > 64) grid.sync();

    if (IN(1)) for (int rep_ = 0; rep_ < PROBE_REP1; ++rep_) {
        pg8::Gemm g{Xb, Win_t, M, NIN_PAD, 2048}; pg8::StaticOrder S; S.init(M, NIN_PAD, G, bx);
        EpiIn E{rstd_x, qlat, kvlat, Gb, Qf, Kf, Vf, Km, flog, partq, partkv, cosT, sinT};
        pg8::gemm_phase<EpiIn, pg8::StaticOrder, true, true>(ldsl, g, S, E);
    }
    if (BOTH(1)) xcd_barrier(xbar);

    if (IN(2)) for (int rep_ = 0; rep_ < PROBE_REP2; ++rep_) {
        const int lane = launder(lane_k), tid = launder(tid_k);
        if (bx >= G - BATCH * NH) { const int sq_ = bx - (G - BATCH * NH);
            const int b = sq_ >> 3, h = sq_ & 7; const float bf = a.b_forget[h];
            const float* fl = flog + ((size_t)b * SEQ + 8 * tid) * 8 + h; float lf[8];
#pragma unroll
            for (int j = 0; j < 8; ++j) lf[j] = fl[j * 8] + bf;
#pragma unroll
            for (int j = 0; j < 8; ++j) { const float z = lf[j]; lf[j] = fminf(z, 0.f) - log1pf(expf(-fabsf(z))); }
#pragma unroll
            for (int j = 1; j < 8; ++j) lf[j] += lf[j - 1];
            float incl = lf[7];
#pragma unroll
            for (int o = 1; o < 64; o <<= 1) { const float t = __shfl_up(incl, o); if (lane >= o) incl += t; }
            volatile LAS float* wtot = (volatile LAS float*)(ldsl + LDS_BYTES - 128);
            if (lane == 63) wtot[wave] = incl;
            __syncthreads();
            float off = incl - lf[7];
            for (int w2 = 0; w2 < wave; ++w2) off += wtot[w2];
            float* cp = cf + (size_t)sq_ * SEQ + 8 * tid;
            f32x4 o0, o1;
#pragma unroll
            for (int j = 0; j < 4; ++j) { o0[j] = (off + lf[j]) * LOG2E; o1[j] = (off + lf[4 + j]) * LOG2E; }
            *(f32x4*)cp = o0; *(f32x4*)(cp + 4) = o1;
            __syncthreads();
        }
        { pg8::Gemm g{qlat, Wuq_t, M, 1536, QRANK}; pg8::StaticOrder S; S.init(M, 1536, G, bx);
          EpiQ E{partq, Qm, cosT, sinT};
          pg8::gemm_phase<EpiQ, pg8::StaticOrder, true, true>(ldsl, g, S, E); }
        { pg8::Gemm g{kvlat, Wukv_t, M, 2048, KVRANK}; pg8::StaticOrder S; S.init(M, 2048, G, bx);
          EpiKV E{partkv, Km, Vm};
          pg8::gemm_phase<EpiKV, pg8::StaticOrder, true, true>(ldsl, g, S, E); }
    }
    if (BOTH(2)) xcd_barrier(xbar);

    if (IN(3)) for (int rep_ = 0; rep_ < PROBE_REP3; ++rep_) {
        for (int v = vcu; v < 256; v += G) {
            const int s = v & 3, w = v >> 2, b = w >> 4, hh = w & 15, hd = hh & 7, swp = hh >> 3;
            const size_t rb = (size_t)b * SEQ;
#pragma unroll 1
            for (int i = 0; i < 2; ++i) {
                const int qb = __builtin_amdgcn_readfirstlane(swp ? (i == 0 ? 8 + s : 7 - s) : (i == 0 ? 15 - s : s));
                att::attn_unit<192, false>((char*)lds, Qm + rb * 1536 + hd * 192, 1536, Km + rb * 1536 + hd * 192, 1536, Vm + rb * 1024 + hd * 128, 1024, nullptr,
                                           Gb + rb * 2048 + hd * 128, Ob + rb * 2048 + hd * 128, qb);
            }
#pragma unroll 1
            for (int i = 0; i < 2; ++i) {
                const int qb = __builtin_amdgcn_readfirstlane(swp ? (i == 0 ? 15 - s : s) : (i == 0 ? 8 + s : 7 - s));
                att::attn_unit<128, true>((char*)lds, Qf + rb * 1024 + hd * 128, 1024, Kf + rb * 1024 + hd * 128, 1024, Vf + rb * 1024 + hd * 128, 1024, cf + (size_t)(b * 8 + hd) * SEQ,
                                          Gb + rb * 2048 + 1024 + hd * 128, Ob + rb * 2048 + 1024 + hd * 128, qb);
            }
        }
    }
#if PROBE_ABL >= 0
    if (IN(3)) {
        for (int v = vcu; v < 256; v += G) {
            const int s = v & 3, w = v >> 2, b = w >> 4, hh = w & 15, hd = hh & 7, swp = hh >> 3;
            const size_t rb = (size_t)b * SEQ;
#pragma unroll 1
            for (int i = 0; i < 2; ++i) {
                const int qb = __builtin_amdgcn_readfirstlane(swp ? (i == 0 ? 8 + s : 7 - s) : (i == 0 ? 15 - s : s));
                att::attn_unit<192, false, PROBE_ABL>((char*)lds, Qm + rb * 1536 + hd * 192, 1536, Km + rb * 1536 + hd * 192, 1536, Vm + rb * 1024 + hd * 128, 1024, nullptr,
                                           Gb + rb * 2048 + hd * 128, qlat, qb);
            }
#pragma unroll 1
            for (int i = 0; i < 2; ++i) {
                const int qb = __builtin_amdgcn_readfirstlane(swp ? (i == 0 ? 15 - s : s) : (i == 0 ? 8 + s : 7 - s));
                att::attn_unit<128, true, PROBE_ABL>((char*)lds, Qf + rb * 1024 + hd * 128, 1024, Kf + rb * 1024 + hd * 128, 1024, Vf + rb * 1024 + hd * 128, 1024, cf + (size_t)(b * 8 + hd) * SEQ,
                                          Gb + rb * 2048 + 1024 + hd * 128, qlat, qb);
            }
        }
    }
#endif
    if (BOTH(3)) xcd_barrier(xbar);

    if (IN(4)) for (int rep_ = 0; rep_ < PROBE_REP4; ++rep_) {
        pg8::Gemm g{Ob, Wout_t, M, 2048, 2048}; pg8::StaticOrder S; S.init(M, 2048, G, bx);
        EpiOut E{Yb, party};
        pg8::gemm_phase<EpiOut, pg8::StaticOrder, true, true>(ldsl, g, S, E);
    }
    if (BOTH(4)) xcd_barrier(xbar);

    if (IN(5)) for (int rep_ = 0; rep_ < PROBE_REP5; ++rep_) {
        const int lane = launder(lane_k);
        const int gw = vcu * 8 + wave, NGW = G * 8;
        const f32x4* gp = (const f32x4*)a.g_post + lane; f32x4 gv[8];
#pragma unroll
        for (int j = 0; j < 8; ++j) gv[j] = gp[64 * j];
        for (int m = gw; m < M; m += 2 * NGW) {
            const int m2 = m + NGW;
            float s = (lane < 32) ? party[(size_t)m * 32 + lane] : 0.f, s2 = (lane < 32) ? party[(size_t)m2 * 32 + lane] : 0.f;
            const f32x4* xr = (const f32x4*)(a.x + (size_t)m * DM) + lane; const f32x4* xr2 = (const f32x4*)(a.x + (size_t)m2 * DM) + lane;
            const u32x2* yr = (const u32x2*)(Yb + (size_t)m * DM) + lane; const u32x2* yr2 = (const u32x2*)(Yb + (size_t)m2 * DM) + lane;
            f32x4 xv[8], xv2[8]; u32x2 y[8], y2[8];
#pragma unroll
            for (int j = 0; j < 8; ++j) { xv[j] = __builtin_nontemporal_load(xr + 64 * j); xv2[j] = __builtin_nontemporal_load(xr2 + 64 * j); y[j] = __builtin_nontemporal_load(yr + 64 * j); y2[j] = __builtin_nontemporal_load(yr2 + 64 * j); }
            s = wave_sum(s); s2 = wave_sum(s2);
            const float rs = 1.f / sqrtf(s * (1.f / DM) + EPS), rs2 = 1.f / sqrtf(s2 * (1.f / DM) + EPS);
            f32x4* orow = (f32x4*)(a.out + (size_t)m * DM) + lane; f32x4* orow2 = (f32x4*)(a.out + (size_t)m2 * DM) + lane;
#pragma unroll
            for (int j = 0; j < 8; ++j) {
                f32x4 o; o[0] = xv[j][0] + bflo(y[j].x) * rs * gv[j][0]; o[1] = xv[j][1] + bfhi(y[j].x) * rs * gv[j][1]; o[2] = xv[j][2] + bflo(y[j].y) * rs * gv[j][2]; o[3] = xv[j][3] + bfhi(y[j].y) * rs * gv[j][3];
                __builtin_nontemporal_store(o, orow + 64 * j);
                f32x4 o2; o2[0] = xv2[j][0] + bflo(y2[j].x) * rs2 * gv[j][0]; o2[1] = xv2[j][1] + bfhi(y2[j].x) * rs2 * gv[j][1]; o2[2] = xv2[j][2] + bflo(y2[j].y) * rs2 * gv[j][2]; o2[3] = xv2[j][3] + bfhi(y2[j].y) * rs2 * gv[j][3];
                __builtin_nontemporal_store(o2, orow2 + 64 * j); }
        }
    }
#undef IN
#undef BOTH
}

extern "C" void kernel_launch(void* const* d_in, const int* in_sizes, int n_in, void* d_out, int out_size, void* d_ws, size_t ws_size, hipStream_t stream) {
    static int grid = 0;
    if (grid == 0) {
        if (n_in != 11 || in_sizes[0] != M * DM || out_size != M * DM || ws_size < WS_END) { fprintf(stderr, "kernel_launch: shape mismatch n_in %d in0 %d out %d ws %zu\n", n_in, n_in > 0 ? in_sizes[0] : -1, out_size, ws_size); grid = -1; return; }
        int dev = 0, cus = 0, per_cu = 0;
        if (hipGetDevice(&dev) != hipSuccess || hipDeviceGetAttribute(&cus, hipDeviceAttributeMultiprocessorCount, dev) != hipSuccess) { grid = -1; return; }
        if (hipFuncSetAttribute((const void*)hybrid_fwd, hipFuncAttributeMaxDynamicSharedMemorySize, LDS_BYTES) != hipSuccess) { fprintf(stderr, "kernel_launch: hipFuncSetAttribute failed\n"); grid = -1; return; }
        if (hipOccupancyMaxActiveBlocksPerMultiprocessor(&per_cu, (const void*)hybrid_fwd, 512, LDS_BYTES) != hipSuccess || per_cu < 1) { fprintf(stderr, "kernel_launch: occupancy query says %d\n", per_cu); per_cu = 1; }
        (void)hipGetLastError();
        grid = cus;
    }
    if (grid < 0) return;
    if (hipMemsetAsync((char*)d_ws + WS_CTL, 0, CTL_BYTES, stream) != hipSuccess) { fprintf(stderr, "kernel_launch: memset failed\n"); return; }
    Args a{};
    a.x = (const float*)d_in[0]; a.pos = (const int*)d_in[1]; a.g_pre = (const float*)d_in[2]; a.w_in = (const float*)d_in[3]; a.g_q = (const float*)d_in[4]; a.w_uq = (const float*)d_in[5];
    a.g_kv = (const float*)d_in[6]; a.w_ukv = (const float*)d_in[7]; a.b_forget = (const float*)d_in[8]; a.w_out = (const float*)d_in[9]; a.g_post = (const float*)d_in[10];
    a.out = (float*)d_out; a.ws = (unsigned char*)d_ws;
#if MK_N_LAUNCHES == 1
    a.ph_lo = 0; a.ph_hi = 6;
    void* args[] = {&a};
    hipError_t e = hipLaunchCooperativeKernel((const void*)hybrid_fwd, dim3(grid), dim3(512), args, LDS_BYTES, stream);
    if (e != hipSuccess) fprintf(stderr, "cooperative launch failed: %s (grid %d)\n", hipGetErrorString(e), grid);
#else
    for (int p = 0; p < 6; ++p) { a.ph_lo = p; a.ph_hi = p + 1; for (int r = 0; r < (p == PROBE_DUP ? 2 : 1); ++r) hipLaunchKernelGGL(hybrid_fwd, dim3(grid), dim3(512), LDS_BYTES, stream, a); }
#endif
}
```

```cpp
#include <hip/hip_runtime.h>
#include <hip/hip_cooperative_groups.h>
#include <cstdio>
#include <cstdint>
namespace cg = cooperative_groups;

#ifndef PROBE_REP0
#define PROBE_REP0 1
#endif
#ifndef PROBE_REP1
#define PROBE_REP1 1
#endif
#ifndef PROBE_REP2
#define PROBE_REP2 1
#endif
#ifndef PROBE_REP3
#define PROBE_REP3 1
#endif
#ifndef PROBE_REP4
#define PROBE_REP4 1
#endif
#ifndef PROBE_REP5
#define PROBE_REP5 1
#endif
#ifndef PROBE_ABL
#define PROBE_ABL -1
#endif
#ifndef PROBE_DUP
#define PROBE_DUP -1
#endif
#ifndef MK_N_LAUNCHES
#define MK_N_LAUNCHES 1
#endif

namespace pg8 {
#define PG8_LAS __attribute__((address_space(3)))
typedef unsigned short bf16_t;
typedef short bf16x8 __attribute__((ext_vector_type(8)));
typedef float f32x4 __attribute__((ext_vector_type(4)));
typedef unsigned u32x4 __attribute__((ext_vector_type(4)));
constexpr int BM = 256, BK = 64, HALF = 128, HTB = HALF * BK * 2, STAGE_BYTES = 8 * HTB, NXCD = 8, WGM = 8;

__host__ __device__ __forceinline__ int lds_byte(int r, int c) { const int st = (r >> 4) * 2 + (c >> 5), rr = r & 15, cc = c & 31, ob = rr * 64 + cc * 2; return st * 1024 + (ob ^ (((ob >> 9) & 1) << 5)); }
__host__ __device__ __forceinline__ void stage_rc(int b, int& R, int& C) { const int st = b / 1024, sb = b % 1024, swz = sb ^ (((sb >> 9) & 1) << 5); R = (st >> 1) * 16 + swz / 64; C = (st & 1) * 32 + (swz % 64) / 2; }
__host__ __device__ __forceinline__ int perm32(int rho) { const int n = rho >> 4, i = rho & 15; return 8 * (i >> 2) + 4 * n + (i & 3); }

struct Unit { int pm, pn; };
struct Gemm { const bf16_t* A; const bf16_t* Bt; int M, N, K; };

struct StaticOrder {
    int nM, nN, nwg, G, c;
    __host__ __device__ void init(int M, int N, int G_, int c_) { nM = M / BM; nN = N / BM; nwg = nM * nN; G = G_; c = c_; }
    __host__ __device__ bool next(int i, Unit& u) const {
        const long L = (long)i * G + c; if (L >= nwg) return false;
        int wgid = (int)L; { const int q = nwg / NXCD, r = nwg % NXCD, xcd = wgid % NXCD, off = wgid / NXCD; wgid = (xcd < r ? xcd * (q + 1) : r * (q + 1) + (xcd - r) * q) + off; }
        const int nig = WGM * nN, gid = wgid / nig, fm = gid * WGM, gsz = (nM - fm) < WGM ? (nM - fm) : WGM;
        u.pm = fm + ((wgid % nig) % gsz); u.pn = (wgid % nig) / gsz; return true;
    }
    __device__ __forceinline__ void a_ready(const Unit&) const {}
    __device__ __forceinline__ void done(const Unit&) const {}
};

__device__ __forceinline__ unsigned cvt_pk_bf16(float lo, float hi) { unsigned r; asm volatile("v_cvt_pk_bf16_f32 %0, %1, %2" : "=v"(r) : "v"(lo), "v"(hi)); return r; }

template <class Epi, class Sched, bool ALIGN_EPI = false, bool SP2 = false>
__device__ __forceinline__ void gemm_phase(PG8_LAS unsigned char* lds, const Gemm g, const Sched& S, const Epi& E) {
    const int tid = threadIdx.x, wid = __builtin_amdgcn_readfirstlane(tid >> 6), lane = tid & 63, wr = wid >> 2, wc = wid & 3, fr = lane & 15, fq = lane >> 4;
    const int K = g.K, nt = K / BK;
    unsigned voffA[2], voffB[2];
#pragma unroll
    for (int i = 0; i < 2; ++i) { int R, C; stage_rc(tid * 16 + i * 8192, R, C); const int Rb = Epi::PERM ? ((R & ~31) + perm32(R & 31)) : R;
        voffA[i] = (unsigned)(R * K + C) * 2u; voffB[i] = (unsigned)(Rb * K + C) * 2u; }
    const size_t kstep = (size_t)(BK * 2);
    const size_t hstep = (size_t)HALF * K * 2;
    const size_t tstep = 2 * hstep;
    const unsigned ldsw = (unsigned)wid * 1024u;
    const int aoff = lds_byte(wr * 64 + fr, fq * 8), boff = lds_byte(wc * 32 + fr, fq * 8);
#define PG8_SA(b, h) (((b) * 2 + (h)) * HTB)
#define PG8_SB(b, h) ((4 + (b) * 2 + (h)) * HTB)
#define PG8_STAGE(bufoff, gbase, voff) do { _Pragma("unroll") for (int _i = 0; _i < 2; ++_i) \
        __builtin_amdgcn_global_load_lds((const unsigned*)((const char*)(gbase) + (voff)[_i]), (PG8_LAS unsigned*)(lds + (bufoff) + ldsw + _i * 8192), 16, 0, 0); } while (0)
#define PG8_LDA(dst, b, h) do { _Pragma("unroll") for (int m = 0; m < 4; ++m) _Pragma("unroll") for (int k = 0; k < 2; ++k) dst[m][k] = *(const PG8_LAS bf16x8*)(lds + PG8_SA(b, h) + aoff + m * 2048 + k * 1024); } while (0)
#define PG8_LDB(dst, b, h) do { _Pragma("unroll") for (int n = 0; n < 2; ++n) _Pragma("unroll") for (int k = 0; k < 2; ++k) dst[n][k] = *(const PG8_LAS bf16x8*)(lds + PG8_SB(b, h) + boff + n * 2048 + k * 1024); } while (0)
#define PG8_MMA(ai, bj, At, Bt) do { __builtin_amdgcn_s_setprio(1); _Pragma("unroll") for (int m = 0; m < 4; ++m) _Pragma("unroll") for (int n = 0; n < 2; ++n) _Pragma("unroll") for (int k = 0; k < 2; ++k) \
        acc[ai][bj][m][n] = __builtin_amdgcn_mfma_f32_16x16x32_bf16(Bt[n][k], At[m][k], acc[ai][bj][m][n], 0, 0, 0); __builtin_amdgcn_s_setprio(0); } while (0)
#define PG8_WAIT_V(n) asm volatile("s_waitcnt vmcnt(" #n ")" ::: "memory")
#define PG8_WAIT_L(n) asm volatile("s_waitcnt lgkmcnt(" #n ")" ::: "memory")
#define PG8_BAR __builtin_amdgcn_s_barrier()
#define PG8_SCHED __builtin_amdgcn_sched_barrier(0)
    Unit cur, nxt; int ui = 0;
    if (!S.next(0, cur)) return;
    f32x4 acc[2][2][4][2];
#pragma unroll
    for (int a = 0; a < 2; ++a)
#pragma unroll
        for (int b = 0; b < 2; ++b)
#pragma unroll
            for (int m = 0; m < 4; ++m)
#pragma unroll
                for (int n = 0; n < 2; ++n) acc[a][b][m][n] = (f32x4){0.f, 0.f, 0.f, 0.f};
    bf16x8 At[4][2], B0[2][2], B1[2][2];
    const char* cA = (const char*)g.A + (size_t)cur.pm * tstep; const char* cB = (const char*)g.Bt + (size_t)cur.pn * tstep;
    S.a_ready(cur);
    if constexpr (SP2) {
        PG8_STAGE(PG8_SB(0, 0), cB, voffB); PG8_STAGE(PG8_SB(0, 1), cB + hstep, voffB); PG8_STAGE(PG8_SA(0, 0), cA, voffA); PG8_STAGE(PG8_SA(0, 1), cA + hstep, voffA);
        if (wr == 1) PG8_BAR;
        PG8_WAIT_V(2); PG8_BAR;
        PG8_STAGE(PG8_SB(1, 0), cB + kstep, voffB); PG8_STAGE(PG8_SA(1, 0), cA + kstep, voffA); PG8_STAGE(PG8_SB(1, 1), cB + hstep + kstep, voffB);
        PG8_WAIT_V(6); PG8_BAR;
    } else {
        PG8_STAGE(PG8_SB(0, 0), cB, voffB); PG8_STAGE(PG8_SA(0, 0), cA, voffA); PG8_STAGE(PG8_SB(0, 1), cB + hstep, voffB); PG8_STAGE(PG8_SA(0, 1), cA + hstep, voffA);
        if (wr == 1) PG8_BAR;
        PG8_WAIT_V(4); PG8_BAR;
        PG8_STAGE(PG8_SB(1, 0), cB + kstep, voffB); PG8_STAGE(PG8_SA(1, 0), cA + kstep, voffA); PG8_STAGE(PG8_SB(1, 1), cB + hstep + kstep, voffB);
        PG8_WAIT_V(6); PG8_BAR;
    }
    for (;;) {
        const bool has_next = S.next(ui + 1, nxt);
        const char* nA = has_next ? (const char*)g.A + (size_t)nxt.pm * tstep : cA; const char* nB = has_next ? (const char*)g.Bt + (size_t)nxt.pn * tstep : cB;
        for (int t = 0; t < nt; t += 2) {
            const bool last = (t == nt - 2);
            const char* a1 = cA + (size_t)(t + 1) * kstep;
            const char* a2 = last ? nA : cA + (size_t)(t + 2) * kstep; const char* b2 = last ? nB : cB + (size_t)(t + 2) * kstep;
            const char* a3 = a2 + kstep; const char* b3 = b2 + kstep;
            if (last && has_next) S.a_ready(nxt);
            if constexpr (SP2) {
            PG8_LDB(B0, 0, 0); PG8_LDB(B1, 0, 1); PG8_SCHED; PG8_LDA(At, 0, 0); PG8_STAGE(PG8_SA(1, 1), a1 + hstep, voffA);
            PG8_WAIT_V(8); PG8_WAIT_L(0); PG8_BAR; PG8_MMA(0, 0, At, B0); PG8_MMA(0, 1, At, B1); PG8_BAR; PG8_SCHED;
            PG8_LDA(At, 0, 1); PG8_STAGE(PG8_SB(0, 0), b2, voffB); PG8_STAGE(PG8_SB(0, 1), b2 + hstep, voffB); PG8_STAGE(PG8_SA(0, 0), a2, voffA);
            PG8_WAIT_V(8); PG8_WAIT_L(0); PG8_BAR; PG8_MMA(1, 0, At, B0); PG8_MMA(1, 1, At, B1); PG8_BAR; PG8_SCHED;
            PG8_LDB(B0, 1, 0); PG8_LDB(B1, 1, 1); PG8_SCHED; PG8_LDA(At, 1, 0); PG8_STAGE(PG8_SA(0, 1), a2 + hstep, voffA);
            PG8_WAIT_V(8); PG8_WAIT_L(0); PG8_BAR; PG8_MMA(0, 0, At, B0); PG8_MMA(0, 1, At, B1); PG8_BAR; PG8_SCHED;
            PG8_LDA(At, 1, 1); PG8_STAGE(PG8_SB(1, 0), b3, voffB); PG8_STAGE(PG8_SB(1, 1), b3 + hstep, voffB); PG8_STAGE(PG8_SA(1, 0), a3, voffA);
            PG8_WAIT_V(8); PG8_WAIT_L(0); PG8_BAR; PG8_MMA(1, 0, At, B0); PG8_MMA(1, 1, At, B1); PG8_BAR; PG8_SCHED;
            } else {
            PG8_LDB(B0, 0, 0); PG8_SCHED; PG8_LDA(At, 0, 0); PG8_STAGE(PG8_SA(1, 1), a1 + hstep, voffA);
            PG8_WAIT_L(8); PG8_BAR; PG8_WAIT_L(0); PG8_MMA(0, 0, At, B0); PG8_BAR; PG8_SCHED;
            PG8_LDB(B1, 0, 1); PG8_STAGE(PG8_SB(0, 0), b2, voffB);
            PG8_BAR; PG8_WAIT_L(0); PG8_MMA(0, 1, At, B1); PG8_BAR;
            PG8_LDA(At, 0, 1); PG8_STAGE(PG8_SA(0, 0), a2, voffA);
            PG8_BAR; PG8_WAIT_L(0); PG8_MMA(1, 0, At, B0); PG8_BAR; PG8_SCHED;
            PG8_STAGE(PG8_SB(0, 1), b2 + hstep, voffB);
            PG8_WAIT_V(6); PG8_BAR; PG8_MMA(1, 1, At, B1); PG8_BAR;
            PG8_LDB(B0, 1, 0); PG8_SCHED; PG8_LDA(At, 1, 0); PG8_STAGE(PG8_SA(0, 1), a2 + hstep, voffA);
            PG8_WAIT_L(8); PG8_BAR; PG8_WAIT_L(0); PG8_MMA(0, 0, At, B0); PG8_BAR; PG8_SCHED;
            PG8_LDB(B1, 1, 1); PG8_STAGE(PG8_SB(1, 0), b3, voffB);
            PG8_BAR; PG8_WAIT_L(0); PG8_MMA(0, 1, At, B1); PG8_BAR;
            PG8_LDA(At, 1, 1); PG8_STAGE(PG8_SA(1, 0), a3, voffA);
            PG8_BAR; PG8_WAIT_L(0); PG8_MMA(1, 0, At, B0); PG8_BAR; PG8_SCHED;
            PG8_STAGE(PG8_SB(1, 1), b3 + hstep, voffB);
            PG8_WAIT_V(6); PG8_BAR; PG8_MMA(1, 1, At, B1); PG8_BAR;
            }
        }
        if constexpr (ALIGN_EPI) { if (wr == 0) PG8_BAR; }
        if constexpr (!Epi::AFTER_DRAIN) { E(acc, cur, wr, wc, fr, fq); S.done(cur); }
        if (!has_next) break;
#pragma unroll
        for (int a = 0; a < 2; ++a)
#pragma unroll
            for (int b = 0; b < 2; ++b)
#pragma unroll
                for (int m = 0; m < 4; ++m)
#pragma unroll
                    for (int n = 0; n < 2; ++n) acc[a][b][m][n] = (f32x4){0.f, 0.f, 0.f, 0.f};
        cur = nxt; cA = nA; cB = nB; ++ui;
        if constexpr (ALIGN_EPI) { if (wr == 1) PG8_BAR; }
    }
    PG8_WAIT_V(0);
    if constexpr (!ALIGN_EPI) { if (wr == 0) PG8_BAR; }
    PG8_BAR;
#undef PG8_SA
#undef PG8_SB
#undef PG8_STAGE
#undef PG8_LDA
#undef PG8_LDB
#undef PG8_MMA
#undef PG8_WAIT_V
#undef PG8_WAIT_L
#undef PG8_BAR
#undef PG8_SCHED
}
}

typedef unsigned short bf16;
typedef float f32x4 __attribute__((ext_vector_type(4)));
typedef unsigned u32x4 __attribute__((ext_vector_type(4)));
typedef unsigned u32x2 __attribute__((ext_vector_type(2)));
typedef short bf16x8 __attribute__((ext_vector_type(8)));
typedef short s16x4 __attribute__((ext_vector_type(4)));
typedef float f32x16 __attribute__((ext_vector_type(16)));
#define LAS __attribute__((address_space(3)))

constexpr int BATCH = 4, SEQ = 4096, DM = 2048, M = BATCH * SEQ;
constexpr int NH = 8, QKD = 192, QRANK = 768, KVRANK = 512, DIN = 6472;
constexpr int NIN_PAD = 6656;
constexpr float EPS = 1e-6f;
constexpr float LOG2E = 1.4426950408889634f;
constexpr float C2M = 0.07216878364870322f * LOG2E;
constexpr float C2F = 0.08838834764831845f * LOG2E;

constexpr size_t MiB = 1u << 20;
constexpr size_t WS_RSTDX = 0, WS_PARTQ = 1 * MiB, WS_PARTKV = 2 * MiB, WS_PARTY = 3 * MiB, WS_FLOG = 5 * MiB, WS_CF = 6 * MiB, WS_COS = 7 * MiB, WS_SIN = 9 * MiB;
constexpr size_t WS_CTL = 11 * MiB, CTL_BYTES = 16384;
constexpr size_t WS_WIN = 16 * MiB, WS_WUQ = 42 * MiB, WS_WUKV = 45 * MiB, WS_WOUT = 47 * MiB;
constexpr size_t WS_XB = 56 * MiB, WS_O = 56 * MiB;
constexpr size_t WS_QLAT = 120 * MiB, WS_KVLAT = 144 * MiB, WS_G = 160 * MiB;
constexpr size_t WS_QF = 224 * MiB, WS_Y = 224 * MiB, WS_KF = 256 * MiB, WS_VF = 288 * MiB;
constexpr size_t WS_QM = 320 * MiB, WS_KM = 368 * MiB, WS_VM = 416 * MiB, WS_END = 448 * MiB;

constexpr int LDS_BYTES = 163840;

__device__ __forceinline__ unsigned f2bf(float f) { unsigned u = __builtin_bit_cast(unsigned, f); return (u + 0x7fffu + ((u >> 16) & 1u)) >> 16; }
__device__ __forceinline__ unsigned pk2(float lo, float hi) { return pg8::cvt_pk_bf16(lo, hi); }
__device__ __forceinline__ float bflo(unsigned w) { return __builtin_bit_cast(float, w << 16); }
__device__ __forceinline__ float bfhi(unsigned w) { return __builtin_bit_cast(float, w & 0xffff0000u); }
__device__ __forceinline__ int launder(int v) { asm volatile("" : "+v"(v)); return v; }
__device__ __forceinline__ float wave_sum(float v) {
#pragma unroll
    for (int o = 1; o < 64; o <<= 1) v += __shfl_xor(v, o);
    return v;
}
__device__ __forceinline__ float silu_f(float v) { return v * __builtin_amdgcn_rcpf(1.f + __builtin_amdgcn_exp2f(-v * LOG2E)); }
__device__ __forceinline__ u32x4 pack8f(f32x4 a, f32x4 b) { u32x4 w; w.x = pk2(a[0], a[1]); w.y = pk2(a[2], a[3]); w.z = pk2(b[0], b[1]); w.w = pk2(b[2], b[3]); return w; }

typedef pg8::f32x4 af4;
struct EpiIn {
    static constexpr bool PERM = true, AFTER_DRAIN = false;
    const float* rstd_x; bf16 *qlat, *kvlat, *G, *Qf, *Kf, *Vf, *Km; float *flog, *partq, *partkv; const float *cosT, *sinT;
    __device__ __forceinline__ void operator()(const af4 (&acc)[2][2][4][2], const pg8::Unit& u, int wr, int wc, int fr, int fq) const {
        const int pn = u.pn; const int row0 = u.pm * 256 + wr * 64 + fr;
        if (pn == 25) {
            if (wc == 0) {
#pragma unroll
                for (int ai = 0; ai < 2; ++ai)
#pragma unroll
                    for (int m = 0; m < 4; ++m) { const int row = row0 + ai * 128 + m * 16; const float rs = rstd_x[row];
                        f32x4 o1[2], o2[2];
#pragma unroll
                        for (int n = 0; n < 2; ++n) { const f32x4 c = *(const f32x4*)(cosT + (size_t)row * 32 + 8 * fq + 4 * n), s = *(const f32x4*)(sinT + (size_t)row * 32 + 8 * fq + 4 * n);
                            const f32x4 x1 = acc[ai][0][m][n] * rs, x2 = acc[ai][1][m][n] * rs; o1[n] = x1 * c - x2 * s; o2[n] = x2 * c + x1 * s; }
                        const u32x4 w1 = pack8f(o1[0], o1[1]), w2 = pack8f(o2[0], o2[1]);
                        bf16* kp = Km + (size_t)row * 1536 + 128 + 8 * fq;
#pragma unroll
                        for (int h = 0; h < 8; ++h) { *(u32x4*)(kp + h * 192) = w1; *(u32x4*)(kp + h * 192 + 32) = w2; } }
            } else if (wc == 1 && fq == 0) {
#pragma unroll
                for (int ai = 0; ai < 2; ++ai)
#pragma unroll
                    for (int m = 0; m < 4; ++m) { const int row = row0 + ai * 128 + m * 16; const float rs = rstd_x[row];
                        *(f32x4*)(flog + (size_t)row * 8) = acc[ai][0][m][0] * rs; *(f32x4*)(flog + (size_t)row * 8 + 4) = acc[ai][0][m][1] * rs; }
            }
            return;
        }
        bf16* base; int ld, colt, mode = 0; float* part = nullptr; int nslot = 0, slot0 = 0;
        if (pn < 3) { base = qlat; ld = 768; colt = pn * 256; part = partq; nslot = 12; slot0 = pn * 4; }
        else if (pn < 5) { base = kvlat; ld = 512; colt = (pn - 3) * 256; part = partkv; nslot = 8; slot0 = (pn - 3) * 4; }
        else if (pn < 9) { base = G; ld = 2048; colt = (pn - 5) * 256; mode = 1; }
        else if (pn < 13) { base = Qf; ld = 1024; colt = (pn - 9) * 256; mode = 2; }
        else if (pn < 17) { base = Kf; ld = 1024; colt = (pn - 13) * 256; }
        else if (pn < 21) { base = Vf; ld = 1024; colt = (pn - 17) * 256; }
        else { base = G; ld = 2048; colt = 1024 + (pn - 21) * 256; mode = 1; }
        const int col0 = colt + wc * 32 + 8 * fq;
#pragma unroll
        for (int ai = 0; ai < 2; ++ai)
#pragma unroll
            for (int m = 0; m < 4; ++m) { const int row = row0 + ai * 128 + m * 16; float rs = rstd_x[row]; if (mode == 2) rs *= C2F;
                bf16* rowp = base + (size_t)row * ld + col0; float ss = 0.f;
#pragma unroll
                for (int bj = 0; bj < 2; ++bj) { f32x4 v0 = acc[ai][bj][m][0] * rs, v1 = acc[ai][bj][m][1] * rs;
                    ss += (v0[0] * v0[0] + v0[1] * v0[1]) + (v0[2] * v0[2] + v0[3] * v0[3]) + (v1[0] * v1[0] + v1[1] * v1[1]) + (v1[2] * v1[2] + v1[3] * v1[3]);
                    if (mode == 1) {
#pragma unroll
                        for (int e = 0; e < 4; ++e) { v0[e] = silu_f(v0[e]); v1[e] = silu_f(v1[e]); } }
                    *(u32x4*)(rowp + bj * 128) = pack8f(v0, v1); }
                if (part) { ss += __shfl_xor(ss, 16); ss += __shfl_xor(ss, 32); if (fq == 0) part[(size_t)row * nslot + slot0 + wc] = ss; } }
    }
};
struct EpiQ {
    static constexpr bool PERM = true, AFTER_DRAIN = false;
    const float* partq; bf16* Qm; const float *cosT, *sinT;
    __device__ __forceinline__ void operator()(const af4 (&acc)[2][2][4][2], const pg8::Unit& u, int wr, int wc, int fr, int fq) const {
        const int pn = u.pn; const int row0 = u.pm * 256 + wr * 64 + fr;
#pragma unroll
        for (int ai = 0; ai < 2; ++ai)
#pragma unroll
            for (int m = 0; m < 4; ++m) { const int row = row0 + ai * 128 + m * 16;
                const f32x4 pa = *(const f32x4*)(partq + (size_t)row * 12), pb = *(const f32x4*)(partq + (size_t)row * 12 + 4), pc = *(const f32x4*)(partq + (size_t)row * 12 + 8);
                const float ssq = ((pa[0] + pa[1]) + (pa[2] + pa[3])) + ((pb[0] + pb[1]) + (pb[2] + pb[3])) + ((pc[0] + pc[1]) + (pc[2] + pc[3]));
                const float rs = C2M / sqrtf(ssq * (1.f / 768.f) + EPS);
                if (pn < 4) {
#pragma unroll
                    for (int bj = 0; bj < 2; ++bj) *(u32x4*)(Qm + (size_t)row * 1536 + (2 * pn + bj) * 192 + wc * 32 + 8 * fq) = pack8f(acc[ai][bj][m][0] * rs, acc[ai][bj][m][1] * rs);
                } else { const int head = 4 * (pn - 4) + wc; f32x4 o1[2], o2[2];
#pragma unroll
                    for (int n = 0; n < 2; ++n) { const f32x4 c = *(const f32x4*)(cosT + (size_t)row * 32 + 8 * fq + 4 * n), s = *(const f32x4*)(sinT + (size_t)row * 32 + 8 * fq + 4 * n);
                        const f32x4 x1 = acc[ai][0][m][n] * rs, x2 = acc[ai][1][m][n] * rs; o1[n] = x1 * c - x2 * s; o2[n] = x2 * c + x1 * s; }
                    bf16* qp = Qm + (size_t)row * 1536 + head * 192 + 128 + 8 * fq;
                    *(u32x4*)qp = pack8f(o1[0], o1[1]); *(u32x4*)(qp + 32) = pack8f(o2[0], o2[1]); } }
    }
};
struct EpiKV {
    static constexpr bool PERM = true, AFTER_DRAIN = false;
    const float* partkv; bf16 *Km, *Vm;
    __device__ __forceinline__ void operator()(const af4 (&acc)[2][2][4][2], const pg8::Unit& u, int wr, int wc, int fr, int fq) const {
        const int pn = u.pn; const int row0 = u.pm * 256 + wr * 64 + fr;
#pragma unroll
        for (int ai = 0; ai < 2; ++ai)
#pragma unroll
            for (int m = 0; m < 4; ++m) { const int row = row0 + ai * 128 + m * 16;
                const f32x4 pa = *(const f32x4*)(partkv + (size_t)row * 8), pb = *(const f32x4*)(partkv + (size_t)row * 8 + 4);
                const float ssq = ((pa[0] + pa[1]) + (pa[2] + pa[3])) + ((pb[0] + pb[1]) + (pb[2] + pb[3]));
                const float rs = 1.f / sqrtf(ssq * (1.f / 512.f) + EPS);
                *(u32x4*)(Km + (size_t)row * 1536 + pn * 192 + wc * 32 + 8 * fq) = pack8f(acc[ai][0][m][0] * rs, acc[ai][0][m][1] * rs);
                *(u32x4*)(Vm + (size_t)row * 1024 + pn * 128 + wc * 32 + 8 * fq) = pack8f(acc[ai][1][m][0] * rs, acc[ai][1][m][1] * rs); }
    }
};
struct EpiOut {
    static constexpr bool PERM = true, AFTER_DRAIN = false;
    bf16* Y; float* party;
    __device__ __forceinline__ void operator()(const af4 (&acc)[2][2][4][2], const pg8::Unit& u, int wr, int wc, int fr, int fq) const {
        const int pn = u.pn; const int row0 = u.pm * 256 + wr * 64 + fr; const int col0 = pn * 256 + wc * 32 + 8 * fq;
#pragma unroll
        for (int ai = 0; ai < 2; ++ai)
#pragma unroll
            for (int m = 0; m < 4; ++m) { const int row = row0 + ai * 128 + m * 16; float ss = 0.f;
#pragma unroll
                for (int bj = 0; bj < 2; ++bj) { const f32x4 v0 = acc[ai][bj][m][0], v1 = acc[ai][bj][m][1];
                    ss += (v0[0] * v0[0] + v0[1] * v0[1]) + (v0[2] * v0[2] + v0[3] * v0[3]) + (v1[0] * v1[0] + v1[1] * v1[1]) + (v1[2] * v1[2] + v1[3] * v1[3]);
                    *(u32x4*)(Y + (size_t)row * 2048 + col0 + bj * 128) = pack8f(v0, v1); }
                ss += __shfl_xor(ss, 16); ss += __shfl_xor(ss, 32); if (fq == 0) party[(size_t)row * 32 + pn * 4 + wc] = ss; }
    }
};

namespace att {
constexpr int KVBLK = 64, QBLK = 32, QB = 256;
constexpr int SHM_K = 24576, SHM_V = 16384;
constexpr int NRING = 3;
constexpr int OFF_K = 0, OFF_V = NRING * SHM_K, OFF_CK = OFF_V + NRING * SHM_V, OFF_WS = OFF_CK + 1024, OFF_QP = OFF_WS + 2048;
constexpr float THR = 8.f;
#define KSWZ(row, colB) ((row) * 256 + ((colB) ^ (((row) & 7) << 4)))
#define SBAR() __builtin_amdgcn_sched_barrier(0)
__device__ __forceinline__ int v_st(int k, int c) { const int kk = (k & ~0xC) | ((k & 4) << 1) | ((k & 8) >> 1); return ((kk >> 3) * 4 + (c >> 5)) * 512 + ((kk & 7) * 32 + (c & 31)) * 2; }
__device__ __forceinline__ int v_rd_base(int lane) { return ((lane & 3) << 3) | (((lane >> 2) & 3) << 6) | (((lane >> 4) & 1) << 5) | (((lane >> 5) & 1) << 8); }
constexpr int v_rd_off(int d0, int ks, int half) { return d0 * 512 + ks * 4096 + half * 2048; }
__device__ __forceinline__ int crow(int r, int hi) { return (r & 3) + 8 * (r >> 2) + 4 * hi; }
__device__ __forceinline__ unsigned cvtpk(float lo, float hi) { unsigned r; asm volatile("v_cvt_pk_bf16_f32 %0, %1, %2" : "=v"(r) : "v"(lo), "v"(hi)); return r; }

__device__ __forceinline__ void mask_tile(f32x16& p0, f32x16& p1, int dq) {
    const float NEG = -__builtin_inff();
#pragma unroll
    for (int r = 0; r < 16; ++r) { const int c = (r & 3) + 8 * (r >> 2);
        if (dq - c < 0) p0[r] = NEG;
        if (dq - c - 32 < 0) p1[r] = NEG; }
}
__device__ __forceinline__ void softmax_tile(f32x16& p0, f32x16& p1, float cq, float& m_reg, float& l_reg, float& alpha, bf16x8& pa0, bf16x8& pa1, bf16x8& pa2, bf16x8& pa3) {
    float ma = __builtin_fmaxf(__builtin_fmaxf(p0[0], p0[1]), p0[2]), mb = __builtin_fmaxf(__builtin_fmaxf(p1[0], p1[1]), p1[2]);
#pragma unroll
    for (int r = 3; r < 15; r += 2) { ma = __builtin_fmaxf(__builtin_fmaxf(ma, p0[r]), p0[r + 1]); mb = __builtin_fmaxf(__builtin_fmaxf(mb, p1[r]), p1[r + 1]); }
    float pmax = __builtin_fmaxf(__builtin_fmaxf(ma, mb), __builtin_fmaxf(p0[15], p1[15]));
    { auto rr = __builtin_amdgcn_permlane32_swap(__float_as_uint(pmax), __float_as_uint(pmax), false, false);
      pmax = fmaxf(__uint_as_float(rr[0]), __uint_as_float(rr[1])); }
    pmax += cq;
    float mn;
    if (__builtin_expect(__all(pmax - m_reg <= THR), 1)) { mn = m_reg; alpha = 1.f; }
    else { mn = fmaxf(m_reg, pmax); alpha = __builtin_amdgcn_exp2f(m_reg - mn); m_reg = mn; }
    const float sh = mn - cq;
#pragma unroll
    for (int r = 0; r < 16; ++r) { p0[r] = __builtin_amdgcn_exp2f(p0[r] - sh); p1[r] = __builtin_amdgcn_exp2f(p1[r] - sh); }
    float ps = 0.f;
#pragma unroll
    for (int r = 0; r < 16; ++r) ps += p0[r];
#pragma unroll
    for (int r = 0; r < 16; ++r) ps += p1[r];
    { auto rr = __builtin_amdgcn_permlane32_swap(__float_as_uint(ps), __float_as_uint(ps), false, false);
      ps = __uint_as_float(rr[0]) + __uint_as_float(rr[1]); }
    l_reg = l_reg * alpha + ps;
#define PK4(P, B_, OUT) do { unsigned a0 = cvtpk(P[B_+0], P[B_+1]), a1 = cvtpk(P[B_+2], P[B_+3]);                          \
        unsigned b0 = cvtpk(P[B_+4], P[B_+5]), b1 = cvtpk(P[B_+6], P[B_+7]);                                             \
        auto r0 = __builtin_amdgcn_permlane32_swap(a0, b0, false, false); auto r1 = __builtin_amdgcn_permlane32_swap(a1, b1, false, false); \
        u32x4 w = {r0[0], r1[0], r0[1], r1[1]}; OUT = *reinterpret_cast<bf16x8*>(&w); } while (0)
    PK4(p0, 0, pa0); PK4(p0, 8, pa1); PK4(p1, 0, pa2); PK4(p1, 8, pa3);
#undef PK4
}
template <int DQK, int NPARK>
__device__ __forceinline__ void qkt(f32x16& p0, f32x16& p1, const char* Kb, int r32, int hi, const bf16x8* qr, const char* qpk) {
    constexpr int ND = DQK / 16, NQR = ND - NPARK;
    p0 = f32x16{}; p1 = f32x16{};
    const char* kb[4];
#pragma unroll
    for (int dd = 0; dd < 4; ++dd) kb[dd] = Kb + KSWZ(r32, (dd * 16 + hi * 8) * 2);
    const char* kr = Kb + 16384 + r32 * 128;
    const int rx = (r32 & 7) << 4;
    bf16x8 kf[3][2], qf[3];
#define QK_LD(set, d_) do { \
            if ((d_) < 8) { const char* a_ = kb[(d_) & 3] + ((d_) >> 2) * 128; kf[set][0] = *reinterpret_cast<const bf16x8*>(a_); kf[set][1] = *reinterpret_cast<const bf16x8*>(a_ + 32 * 256); } \
            else { const char* a_ = kr + (((((d_) - 8) * 16 + hi * 8) * 2) ^ rx); kf[set][0] = *reinterpret_cast<const bf16x8*>(a_); kf[set][1] = *reinterpret_cast<const bf16x8*>(a_ + 32 * 128); } \
            if ((d_) >= NQR) qf[set] = *reinterpret_cast<const bf16x8*>(qpk + ((d_) - NQR) * 1024); } while (0)
    QK_LD(0, 0); QK_LD(1, 1); SBAR();
#pragma unroll
    for (int d = 0; d < ND; ++d) {
        const int cs = d % 3;
        if (d + 2 < ND) { const int ns = (d + 2) % 3; if (ns == 0) QK_LD(0, d + 2); else if (ns == 1) QK_LD(1, d + 2); else QK_LD(2, d + 2); SBAR(); }
        const bf16x8 q = (d < NQR) ? qr[d < NQR ? d : 0] : qf[cs];
        p0 = __builtin_amdgcn_mfma_f32_32x32x16_bf16(kf[cs][0], q, p0, 0, 0, 0);
        p1 = __builtin_amdgcn_mfma_f32_32x32x16_bf16(kf[cs][1], q, p1, 0, 0, 0);
        SBAR();
    }
#undef QK_LD
}
template <int VOFF>
__device__ __forceinline__ void pv_tile(f32x16* o, int vb0, bf16x8 pa0, bf16x8 pa1, bf16x8 pa2, bf16x8 pa3) {
#define TRRD(dst, off) asm volatile("ds_read_b64_tr_b16 %0, %1 offset:%2" : "=&v"(dst) : "v"(vb0), "i"(off) : "memory")
#define PV_D0(d0) do { s16x4 l0, l1, l2, l3, h0, h1, h2, h3; constexpr int b_ = VOFF + v_rd_off(d0, 0, 0); \
        TRRD(l0, b_); TRRD(h0, b_ + 2048); TRRD(l1, b_ + 4096); TRRD(h1, b_ + 6144); TRRD(l2, b_ + 8192); TRRD(h2, b_ + 10240); TRRD(l3, b_ + 12288); TRRD(h3, b_ + 14336); \
        asm volatile("s_waitcnt lgkmcnt(0)" ::: "memory"); SBAR(); \
        o[d0] = __builtin_amdgcn_mfma_f32_32x32x16_bf16(pa0, (bf16x8){l0[0], l0[1], l0[2], l0[3], h0[0], h0[1], h0[2], h0[3]}, o[d0], 0, 0, 0);   \
        o[d0] = __builtin_amdgcn_mfma_f32_32x32x16_bf16(pa1, (bf16x8){l1[0], l1[1], l1[2], l1[3], h1[0], h1[1], h1[2], h1[3]}, o[d0], 0, 0, 0);   \
        o[d0] = __builtin_amdgcn_mfma_f32_32x32x16_bf16(pa2, (bf16x8){l2[0], l2[1], l2[2], l2[3], h2[0], h2[1], h2[2], h2[3]}, o[d0], 0, 0, 0);   \
        o[d0] = __builtin_amdgcn_mfma_f32_32x32x16_bf16(pa3, (bf16x8){l3[0], l3[1], l3[2], l3[3], h3[0], h3[1], h3[2], h3[3]}, o[d0], 0, 0, 0); } while (0)
    PV_D0(0); PV_D0(1); PV_D0(2); PV_D0(3);
#undef PV_D0
#undef TRRD
}

#define RD128(dst, addr, off) asm volatile("ds_read_b128 %0, %1 offset:%2" : "=&v"(dst) : "v"(addr), "i"(off) : "memory")
#define RDTR(dst, addr, off) asm volatile("ds_read_b64_tr_b16 %0, %1 offset:%2" : "=&v"(dst) : "v"(addr), "i"(off) : "memory")
#define WAITK(n, x) asm volatile("s_waitcnt lgkmcnt(%1)" : "+v"(x) : "n"(n) : "memory")
#define WAITKQ(n, x, q) asm volatile("s_waitcnt lgkmcnt(%2)" : "+v"(x), "+v"(q) : "n"(n) : "memory")
#define WAITV(n, x, y) asm volatile("s_waitcnt lgkmcnt(%2)" : "+v"(x), "+v"(y) : "n"(n) : "memory")

__device__ __forceinline__ void mblock_mla_q(f32x16& p0, f32x16& p1, f32x16* o, const bf16x8* qr, bf16x8 pa0, bf16x8 pa1, bf16x8 pa2, bf16x8 pa3, const unsigned* kbv, const unsigned* krv, unsigned qpkv, unsigned vbv) {
    bf16x8 ksl[5], qsl[3]; s16x4 vlo[5], vhi[5];
    p0 = f32x16{}; p1 = f32x16{};
    RD128(ksl[0], kbv[0], 0);
    RD128(ksl[1], kbv[0], 8192);
    RD128(ksl[2], kbv[1], 0);
    RD128(ksl[3], kbv[1], 8192);
    RD128(ksl[4], kbv[2], 0);
    WAITK(4, ksl[0]); p0 = __builtin_amdgcn_mfma_f32_32x32x16_bf16(ksl[0], qr[0], p0, 0, 0, 0);
    RD128(ksl[0], kbv[2], 8192);
    WAITK(4, ksl[1]); p1 = __builtin_amdgcn_mfma_f32_32x32x16_bf16(ksl[1], qr[0], p1, 0, 0, 0);
    RD128(ksl[1], kbv[3], 0);
    WAITK(4, ksl[2]); p0 = __builtin_amdgcn_mfma_f32_32x32x16_bf16(ksl[2], qr[1], p0, 0, 0, 0);
    RD128(ksl[2], kbv[3], 8192);
    WAITK(4, ksl[3]); p1 = __builtin_amdgcn_mfma_f32_32x32x16_bf16(ksl[3], qr[1], p1, 0, 0, 0);
    RD128(ksl[3], kbv[0], 128);
    WAITK(4, ksl[4]); p0 = __builtin_amdgcn_mfma_f32_32x32x16_bf16(ksl[4], qr[2], p0, 0, 0, 0);
    RD128(ksl[4], kbv[0], 8320);
    WAITK(4, ksl[0]); p1 = __builtin_amdgcn_mfma_f32_32x32x16_bf16(ksl[0], qr[2], p1, 0, 0, 0);
    RD128(ksl[0], kbv[1], 128);
    WAITK(4, ksl[1]); p0 = __builtin_amdgcn_mfma_f32_32x32x16_bf16(ksl[1], qr[3], p0, 0, 0, 0);
    RD128(ksl[1], kbv[1], 8320);
    WAITK(4, ksl[2]); p1 = __builtin_amdgcn_mfma_f32_32x32x16_bf16(ksl[2], qr[3], p1, 0, 0, 0);
    RD128(ksl[2], kbv[2], 128);
    WAITK(4, ksl[3]); p0 = __builtin_amdgcn_mfma_f32_32x32x16_bf16(ksl[3], qr[4], p0, 0, 0, 0);
    RD128(ksl[3], kbv[2], 8320);
    WAITK(4, ksl[4]); p1 = __builtin_amdgcn_mfma_f32_32x32x16_bf16(ksl[4], qr[4], p1, 0, 0, 0);
    RD128(ksl[4], kbv[3], 128);
    WAITK(4, ksl[0]); p0 = __builtin_amdgcn_mfma_f32_32x32x16_bf16(ksl[0], qr[5], p0, 0, 0, 0);
    RD128(ksl[0], kbv[3], 8320);
    WAITK(4, ksl[1]); p1 = __builtin_amdgcn_mfma_f32_32x32x16_bf16(ksl[1], qr[5], p1, 0, 0, 0);
    RD128(ksl[1], krv[0], 0); RD128(qsl[2], qpkv, 0);
    WAITK(5, ksl[2]); p0 = __builtin_amdgcn_mfma_f32_32x32x16_bf16(ksl[2], qr[6], p0, 0, 0, 0);
    RD128(ksl[2], krv[0], 4096);
    WAITK(5, ksl[3]); p1 = __builtin_amdgcn_mfma_f32_32x32x16_bf16(ksl[3], qr[6], p1, 0, 0, 0);
    RD128(ksl[3], krv[1], 0); RD128(qsl[0], qpkv, 1024);
    WAITK(6, ksl[4]); p0 = __builtin_amdgcn_mfma_f32_32x32x16_bf16(ksl[4], qr[7], p0, 0, 0, 0);
    RD128(ksl[4], krv[1], 4096);
    WAITK(6, ksl[0]); p1 = __builtin_amdgcn_mfma_f32_32x32x16_bf16(ksl[0], qr[7], p1, 0, 0, 0);
    RD128(ksl[0], krv[2], 0); RD128(qsl[1], qpkv, 2048);
    WAITKQ(6, ksl[1], qsl[2]); p0 = __builtin_amdgcn_mfma_f32_32x32x16_bf16(ksl[1], qsl[2], p0, 0, 0, 0);
    RD128(ksl[1], krv[2], 4096);
    WAITKQ(6, ksl[2], qsl[2]); p1 = __builtin_amdgcn_mfma_f32_32x32x16_bf16(ksl[2], qsl[2], p1, 0, 0, 0);
    RD128(ksl[2], krv[3], 0); RD128(qsl[2], qpkv, 3072);
    WAITKQ(6, ksl[3], qsl[0]); p0 = __builtin_amdgcn_mfma_f32_32x32x16_bf16(ksl[3], qsl[0], p0, 0, 0, 0);
    RD128(ksl[3], krv[3], 4096);
    WAITKQ(6, ksl[4], qsl[0]); p1 = __builtin_amdgcn_mfma_f32_32x32x16_bf16(ksl[4], qsl[0], p1, 0, 0, 0);
    WAITKQ(4, ksl[0], qsl[1]); p0 = __builtin_amdgcn_mfma_f32_32x32x16_bf16(ksl[0], qsl[1], p0, 0, 0, 0);
    WAITKQ(3, ksl[1], qsl[1]); p1 = __builtin_amdgcn_mfma_f32_32x32x16_bf16(ksl[1], qsl[1], p1, 0, 0, 0);
    WAITKQ(1, ksl[2], qsl[2]); p0 = __builtin_amdgcn_mfma_f32_32x32x16_bf16(ksl[2], qsl[2], p0, 0, 0, 0);
    WAITKQ(0, ksl[3], qsl[2]); p1 = __builtin_amdgcn_mfma_f32_32x32x16_bf16(ksl[3], qsl[2], p1, 0, 0, 0);
}
__device__ __forceinline__ void mblock_fox_q(f32x16& p0, f32x16& p1, f32x16* o, const bf16x8* qr, bf16x8 pa0, bf16x8 pa1, bf16x8 pa2, bf16x8 pa3, const unsigned* kbv, const unsigned* krv, unsigned qpkv, unsigned vbv) {
    bf16x8 ksl[5], qsl[3]; s16x4 vlo[5], vhi[5];
    p0 = f32x16{}; p1 = f32x16{};
    RD128(ksl[0], kbv[0], 0);
    RD128(ksl[1], kbv[0], 8192);
    RD128(ksl[2], kbv[1], 0);
    RD128(ksl[3], kbv[1], 8192);
    RD128(ksl[4], kbv[2], 0);
    WAITK(4, ksl[0]); p0 = __builtin_amdgcn_mfma_f32_32x32x16_bf16(ksl[0], qr[0], p0, 0, 0, 0);
    RD128(ksl[0], kbv[2], 8192);
    WAITK(4, ksl[1]); p1 = __builtin_amdgcn_mfma_f32_32x32x16_bf16(ksl[1], qr[0], p1, 0, 0, 0);
    RD128(ksl[1], kbv[3], 0);
    WAITK(4, ksl[2]); p0 = __builtin_amdgcn_mfma_f32_32x32x16_bf16(ksl[2], qr[1], p0, 0, 0, 0);
    RD128(ksl[2], kbv[3], 8192);
    WAITK(4, ksl[3]); p1 = __builtin_amdgcn_mfma_f32_32x32x16_bf16(ksl[3], qr[1], p1, 0, 0, 0);
    RD128(ksl[3], kbv[0], 128); RD128(qsl[1], qpkv, 0);
    WAITK(5, ksl[4]); p0 = __builtin_amdgcn_mfma_f32_32x32x16_bf16(ksl[4], qr[2], p0, 0, 0, 0);
    RD128(ksl[4], kbv[0], 8320);
    WAITK(5, ksl[0]); p1 = __builtin_amdgcn_mfma_f32_32x32x16_bf16(ksl[0], qr[2], p1, 0, 0, 0);
    RD128(ksl[0], kbv[1], 128); RD128(qsl[2], qpkv, 1024);
    WAITK(6, ksl[1]); p0 = __builtin_amdgcn_mfma_f32_32x32x16_bf16(ksl[1], qr[3], p0, 0, 0, 0);
    RD128(ksl[1], kbv[1], 8320);
    WAITK(6, ksl[2]); p1 = __builtin_amdgcn_mfma_f32_32x32x16_bf16(ksl[2], qr[3], p1, 0, 0, 0);
    RD128(ksl[2], kbv[2], 128); RD128(qsl[0], qpkv, 2048);
    WAITKQ(6, ksl[3], qsl[1]); p0 = __builtin_amdgcn_mfma_f32_32x32x16_bf16(ksl[3], qsl[1], p0, 0, 0, 0);
    RD128(ksl[3], kbv[2], 8320);
    WAITKQ(6, ksl[4], qsl[1]); p1 = __builtin_amdgcn_mfma_f32_32x32x16_bf16(ksl[4], qsl[1], p1, 0, 0, 0);
    RD128(ksl[4], kbv[3], 128); RD128(qsl[1], qpkv, 3072);
    WAITKQ(6, ksl[0], qsl[2]); p0 = __builtin_amdgcn_mfma_f32_32x32x16_bf16(ksl[0], qsl[2], p0, 0, 0, 0);
    RD128(ksl[0], kbv[3], 8320);
    WAITKQ(6, ksl[1], qsl[2]); p1 = __builtin_amdgcn_mfma_f32_32x32x16_bf16(ksl[1], qsl[2], p1, 0, 0, 0);
    WAITKQ(4, ksl[2], qsl[0]); p0 = __builtin_amdgcn_mfma_f32_32x32x16_bf16(ksl[2], qsl[0], p0, 0, 0, 0);
    WAITKQ(3, ksl[3], qsl[0]); p1 = __builtin_amdgcn_mfma_f32_32x32x16_bf16(ksl[3], qsl[0], p1, 0, 0, 0);
    WAITKQ(1, ksl[4], qsl[1]); p0 = __builtin_amdgcn_mfma_f32_32x32x16_bf16(ksl[4], qsl[1], p0, 0, 0, 0);
    WAITKQ(0, ksl[0], qsl[1]); p1 = __builtin_amdgcn_mfma_f32_32x32x16_bf16(ksl[0], qsl[1], p1, 0, 0, 0);
}
#undef RD128
#undef RDTR
#undef WAITK
#undef WAITKQ
#undef WAITV

template <int DQK, bool FOX, int ABL = 0>
__device__ __forceinline__ void attn_unit(char* lds, const bf16* Q, int ldq, const bf16* K, int ldk, const bf16* V, int ldv, const float* cfs, const bf16* Gp, bf16* Op, int qb) {
    const int tid = threadIdx.x, wid = __builtin_amdgcn_readfirstlane(tid >> 6), lane = tid & 63, r32 = lane & 31, hi = lane >> 5;
    const bool grpA = wid < 4; const int w4 = wid & 3;
    const int q0 = qb * QB, NT = 4 * (qb + 1);
    char* K_lds = lds + OFF_K; char* V_lds = lds + OFF_V; float* ck_l = (float*)(lds + OFF_CK);
    float* wsf = (float*)(lds + OFF_WS) + wid * 64; float* li_l = wsf; float* al_l = wsf + 32;
    constexpr int NPARK = 4, NQR = DQK / 16 - NPARK;
    bf16x8 qr[NQR];
    char* qpk = lds + OFF_QP + wid * 4096 + (hi * 32 + r32) * 16;
    unsigned koff, kroff = 0, voff;
    { const int row = 4 * w4 + (lane >> 4), c = (lane & 15) ^ (row & 7); koff = (unsigned)(row * ldk + c * 8) * 2u; }
    { const int s0 = 2 * w4 + (lane >> 5), kk = 8 * (s0 >> 2) + ((lane & 31) >> 2), k = (kk & ~0xC) | ((kk & 4) << 1) | ((kk & 8) >> 1); voff = (unsigned)(k * ldv + 32 * (s0 & 3) + 8 * (lane & 3)) * 2u; }
    if constexpr (DQK == 192) { const int row = 8 * w4 + (lane >> 3), c = (lane & 7) ^ (row & 7); kroff = (unsigned)(row * ldk + 128 + c * 8) * 2u; }
    const int vb0 = (int)(uintptr_t)V_lds + v_rd_base(lane);
    LAS unsigned char* ldsl = (LAS unsigned char*)(uintptr_t)(unsigned)(uintptr_t)lds;
    unsigned kb0[4], kr0[4];
#pragma unroll
    for (int i = 0; i < 4; ++i) { const unsigned xo = (unsigned)((i * 32 + hi * 16) ^ ((r32 & 7) << 4)); kb0[i] = (unsigned)(uintptr_t)K_lds + r32 * 256 + xo; kr0[i] = (unsigned)(uintptr_t)K_lds + 16384 + r32 * 128 + xo; }
    const unsigned qpkv = (unsigned)(uintptr_t)qpk;
#define DMA_K(t, bf) do { const char* kt_ = (const char*)K + (size_t)(t) * KVBLK * ldk * 2; \
        _Pragma("unroll") for (int j_ = 0; j_ < 4; ++j_) \
            __builtin_amdgcn_global_load_lds((const unsigned*)(kt_ + koff + (size_t)j_ * 16 * ldk * 2), (LAS unsigned*)(ldsl + OFF_K + (bf) * SHM_K + (w4 + 4 * j_) * 1024), 16, 0, 0); \
        if constexpr (DQK == 192) { _Pragma("unroll") for (int j_ = 0; j_ < 2; ++j_) \
            __builtin_amdgcn_global_load_lds((const unsigned*)(kt_ + kroff + (size_t)j_ * 32 * ldk * 2), (LAS unsigned*)(ldsl + OFF_K + (bf) * SHM_K + 16384 + (w4 + 4 * j_) * 1024), 16, 0, 0); } \
        if constexpr (FOX) { __builtin_amdgcn_global_load_lds((const unsigned*)(cfs + (t) * KVBLK + lane), (LAS unsigned*)(ldsl + OFF_CK + ((t) & 3) * 256), 4, 0, 0); } } while (0)
#define DMA_V(t, bf) do { const char* vt_ = (const char*)V + (size_t)(t) * KVBLK * ldv * 2; \
        _Pragma("unroll") for (int j_ = 0; j_ < 4; ++j_) \
            __builtin_amdgcn_global_load_lds((const unsigned*)(vt_ + voff + (size_t)j_ * 16 * ldv * 2), (LAS unsigned*)(ldsl + OFF_V + (bf) * SHM_V + (w4 + 4 * j_) * 1024), 16, 0, 0); } while (0)
#define BAR_L() asm volatile("s_waitcnt lgkmcnt(0)\n\ts_barrier" ::: "memory")
#define BAR_VL() asm volatile("s_waitcnt vmcnt(0) lgkmcnt(0)\n\ts_barrier" ::: "memory")
    constexpr int NDK = 4 + (DQK == 192 ? 2 : 0) + (FOX ? 1 : 0), NDV = 4;
#define BAR_VN(n) asm volatile("s_waitcnt vmcnt(%0) lgkmcnt(0)\n\ts_barrier" :: "n"(n) : "memory")
    if (grpA) { DMA_K(0, 0); DMA_K(1, 1); DMA_V(0, 0); }
    { const bf16* qp = Q + (size_t)(q0 + wid * QBLK + r32) * ldq + hi * 8;
#pragma unroll
      for (int d0 = 0; d0 < NQR; ++d0) qr[d0] = *(const bf16x8*)(qp + d0 * 16);
#pragma unroll
      for (int d0 = 0; d0 < NPARK; ++d0) *(bf16x8*)(qpk + d0 * 1024) = *(const bf16x8*)(qp + (NQR + d0) * 16); }
    float cq = 0.f; if constexpr (FOX) cq = cfs[q0 + wid * QBLK + r32];
    BAR_VL();
    if (!grpA) BAR_L();
    float m_reg = -1e30f, l_reg = 0.f; f32x16 o[4] = {}; f32x16 p0 = {}, p1 = {}; bf16x8 pa0 = {}, pa1 = {}, pa2 = {}, pa3 = {};
#define ACTW(tt) ((tt) - (NT - 4) < 0 || 64 * ((tt) - (NT - 4)) <= 32 * wid + 31)
    int rc = 0, rp = 2, rn = 1;
#pragma unroll 1
    for (int t = 0; t < NT; ++t) {
        if (grpA && !(ABL & 1)) { if (t + 2 < NT) DMA_K(t + 2, rp); if (t + 1 < NT) DMA_V(t + 1, rn); }
        const int jb_ = t - (NT - 4); const bool act_ = ACTW(t);
        if (act_ && !(ABL & 4)) { unsigned kbv[4], krv[4];
#pragma unroll
            for (int i = 0; i < 4; ++i) { kbv[i] = kb0[i] + rc * SHM_K; krv[i] = kr0[i] + rc * SHM_K; }
            if constexpr (DQK == 192) mblock_mla_q(p0, p1, o, qr, pa0, pa1, pa2, pa3, kbv, krv, qpkv, 0u); else mblock_fox_q(p0, p1, o, qr, pa0, pa1, pa2, pa3, kbv, krv, qpkv, 0u); }
        if (t > 0 && ACTW(t - 1) && !(ABL & 4)) { SBAR(); pv_tile<0>(o, vb0 + rp * SHM_V, pa0, pa1, pa2, pa3); }
        BAR_L();
        if (act_ && (ABL & 8)) {
#define PK4(P, B_, OUT) do { unsigned a0 = cvtpk(P[B_+0], P[B_+1]), a1 = cvtpk(P[B_+2], P[B_+3]); unsigned b0 = cvtpk(P[B_+4], P[B_+5]), b1 = cvtpk(P[B_+6], P[B_+7]); \
        auto r0 = __builtin_amdgcn_permlane32_swap(a0, b0, false, false); auto r1 = __builtin_amdgcn_permlane32_swap(a1, b1, false, false); u32x4 w = {r0[0], r1[0], r0[1], r1[1]}; OUT = *reinterpret_cast<bf16x8*>(&w); } while (0)
            PK4(p0, 0, pa0); PK4(p0, 8, pa1); PK4(p1, 0, pa2); PK4(p1, 8, pa3);
#undef PK4
        }
        if (act_ && !(ABL & 2)) { float alpha;
            if constexpr (FOX) { const float* ckp = ck_l + (t & 3) * 64 + 4 * hi;
#pragma unroll
                for (int g_ = 0; g_ < 4; ++g_) { const f32x4 c0 = *(const f32x4*)(ckp + 8 * g_), c1 = *(const f32x4*)(ckp + 32 + 8 * g_);
#pragma unroll
                    for (int e_ = 0; e_ < 4; ++e_) { p0[4 * g_ + e_] -= c0[e_]; p1[4 * g_ + e_] -= c1[e_]; } } }
            if (jb_ >= 0 && 64 * jb_ + 63 > 32 * wid) mask_tile(p0, p1, 32 * wid + r32 - 64 * jb_ - 4 * hi);
            softmax_tile(p0, p1, cq, m_reg, l_reg, alpha, pa0, pa1, pa2, pa3);
            if (__any(alpha < 1.f)) { if (hi == 0) al_l[r32] = alpha; asm volatile("s_waitcnt lgkmcnt(0)" ::: "memory");
#pragma unroll
                for (int d_ = 0; d_ < 4; ++d_)
#pragma unroll
                    for (int r = 0; r < 16; ++r) o[d_][r] *= al_l[crow(r, hi)]; }
        }
        if (ABL & 1) BAR_VN(0); else if (t + 2 < NT) BAR_VN(NDK + NDV); else if (t + 1 < NT) BAR_VN(NDV); else BAR_VN(0);
        rp = rc; rc = rn; rn = (rn == NRING - 1) ? 0 : rn + 1;
    }
    if (ACTW(NT - 1)) { SBAR(); pv_tile<0>(o, vb0 + rp * SHM_V, pa0, pa1, pa2, pa3); }
    if (grpA) BAR_L();
#undef BAR_VN
#undef ACTW
#undef DMA_K
#undef DMA_V
    if (hi == 0) li_l[r32] = l_reg; asm volatile("s_waitcnt lgkmcnt(0)" ::: "memory");
    bf16* stg = (bf16*)(lds + wid * 8192);
    const int lane_e = launder(lane);
#pragma unroll
    for (int r = 0; r < 16; ++r) { const int orow = crow(r, hi); const float rl = __builtin_amdgcn_rcpf(li_l[orow]);
#pragma unroll
        for (int d0 = 0; d0 < 4; ++d0) stg[orow * 128 + d0 * 32 + r32] = (bf16)f2bf(o[d0][r] * rl); }
    asm volatile("s_waitcnt lgkmcnt(0)" ::: "memory");
#pragma unroll
    for (int i = 0; i < 8; ++i) { const int row = i * 4 + (lane_e >> 4), ch = lane_e & 15;
        const u32x4 v = *(const u32x4*)(stg + row * 128 + ch * 8);
        const size_t go = (size_t)(q0 + wid * QBLK + row) * 2048 + ch * 8;
        const u32x4 g = *(const u32x4*)(Gp + go); u32x4 w;
        w.x = cvtpk(bflo(v.x) * bflo(g.x), bfhi(v.x) * bfhi(g.x)); w.y = cvtpk(bflo(v.y) * bflo(g.y), bfhi(v.y) * bfhi(g.y));
        w.z = cvtpk(bflo(v.z) * bflo(g.z), bfhi(v.z) * bfhi(g.z)); w.w = cvtpk(bflo(v.w) * bflo(g.w), bfhi(v.w) * bfhi(g.w));
        *(u32x4*)(Op + go) = w; }
    BAR_VL();
#undef BAR_L
#undef BAR_VL
}
#undef KSWZ
#undef SBAR
}

__device__ __forceinline__ void transpose_item(const float* W, int ldw, int K, const float* g, bf16* WT, int dst_row0, int src_col0, int nvalid, int k0, LAS float* scr, int lane) {
    const int n = lane & 31; const bool ok = (src_col0 >= 0) && (n < nvalid);
    float tv[32];
#pragma unroll
    for (int i = 0; i < 32; ++i) { const int kk = 2 * i + (lane >> 5); tv[i] = ok ? W[(size_t)(k0 + kk) * ldw + src_col0 + n] : 0.f; }
    if (g) {
#pragma unroll
        for (int i = 0; i < 32; ++i) tv[i] *= g[k0 + 2 * i + (lane >> 5)]; }
#pragma unroll
    for (int i = 0; i < 32; ++i) scr[(2 * i + (lane >> 5)) * 33 + n] = tv[i];
    asm volatile("s_waitcnt lgkmcnt(0)" ::: "memory");
    const int c = lane & 7;
#pragma unroll
    for (int j = 0; j < 4; ++j) { const int nn = (lane >> 3) + 8 * j; const LAS float* s = scr + (8 * c) * 33 + nn;
        u32x4 o; o.x = pk2(s[0 * 33], s[1 * 33]); o.y = pk2(s[2 * 33], s[3 * 33]); o.z = pk2(s[4 * 33], s[5 * 33]); o.w = pk2(s[6 * 33], s[7 * 33]);
        *(u32x4*)(WT + (size_t)(dst_row0 + nn) * K + k0 + 8 * c) = o; }
    asm volatile("s_waitcnt lgkmcnt(0)" ::: "memory");
}
__device__ __forceinline__ void win_src(int r0, int& src, int& nv) {
    nv = 32;
    if (r0 < 1280) src = r0;
    else if (r0 < 2304) src = 1344 + (r0 - 1280);
    else if (r0 < 3328) src = 2368 + (r0 - 2304);
    else if (r0 < 4352) src = 3392 + (r0 - 3328);
    else if (r0 < 5376) src = 4416 + (r0 - 4352);
    else if (r0 < 6400) src = 5448 + (r0 - 5376);
    else if (r0 == 6400) src = 1280;
    else if (r0 == 6432) { src = 5440; nv = 8; }
    else if (r0 == 6528) src = 1312;
    else src = -1;
}
__device__ __forceinline__ int wuq_src(int r0) {
    if (r0 < 1024) return (r0 >> 7) * 192 + (r0 & 127);
    const int q = r0 - 1024, t = q >> 8, bj = (q >> 7) & 1, wc = (q >> 5) & 3;
    return (4 * t + wc) * 192 + 128 + 32 * bj;
}


#define XB_TMO      128
#define XB_XCNT(j)  (256  + 64 * (j))
#define XB_XSUB(j)  (1280 + 64 * (j))
#define XB_XGEN(j)  (2304 + 64 * (j))
#define XB_TOP      3328
#define XB_TOPGEN   3392
#define XCD_BAR_WORDS 3456
#define XB_SPIN_CAP (1u << 18)
__device__ __forceinline__ unsigned xb_ld(unsigned* p)              { return __hip_atomic_load(p, __ATOMIC_RELAXED, __HIP_MEMORY_SCOPE_AGENT); }
__device__ __forceinline__ unsigned xb_add(unsigned* p, unsigned v) { return __hip_atomic_fetch_add(p, v, __ATOMIC_RELAXED, __HIP_MEMORY_SCOPE_AGENT); }
__device__ __forceinline__ unsigned xb_xcc_id() { return (unsigned)__builtin_amdgcn_s_getreg((3 << 11) | 20) & 0xFu; }
#define XB_SPIN(cond, bar) do { unsigned _sp = 0; while (cond) { __builtin_amdgcn_s_sleep(1); \
    if ((++_sp & 255u) == 0u) { if (xb_ld(&(bar)[XB_TMO])) break; if (_sp > XB_SPIN_CAP) { atomicAdd(&(bar)[XB_TMO], 1u); break; } } } } while (0)
struct XcdBarrier { unsigned* bar; unsigned x; volatile LAS unsigned* st; };
__device__ __forceinline__ XcdBarrier xcd_barrier_post(unsigned* bar, volatile LAS unsigned* st) {
    XcdBarrier b; b.bar = bar; b.x = xb_xcc_id(); b.st = st;
    if (threadIdx.x == 0) (void)xb_add(&bar[XB_XCNT(b.x)], 1u);
    return b;
}
__device__ __forceinline__ void xcd_barrier_complete(unsigned* bar, unsigned x, unsigned& nloc, unsigned& nx) {
    const unsigned G = gridDim.x * gridDim.y * gridDim.z;
    unsigned sum, cnt, mine, sp = 0u;
    for (;;) {
        sum = 0u; cnt = 0u; mine = 0u;
#pragma unroll
        for (unsigned j = 0; j < 16; ++j) { const unsigned c = xb_ld(&bar[XB_XCNT(j)]); sum += c; cnt += (c > 0u) ? 1u : 0u; mine = (j == x) ? c : mine; }
        if (sum == G) break;
        __builtin_amdgcn_s_sleep(1);
        if ((++sp & 255u) == 0u) { if (xb_ld(&bar[XB_TMO])) break; if (sp > XB_SPIN_CAP) { atomicAdd(&bar[XB_TMO], 1u); break; } }
    }
    nloc = mine > 0u ? mine : 1u; nx = cnt > 0u ? cnt : 1u;
}
__device__ __forceinline__ void xcd_barrier(const XcdBarrier& b) {
    asm volatile("s_waitcnt vmcnt(0)" ::: "memory");
    __syncthreads();
    if (threadIdx.x == 0) {
        unsigned* bar = b.bar;
        __builtin_amdgcn_s_waitcnt(0);
        unsigned nloc = b.st[0], nx = b.st[1];
        if (nloc == 0u) { xcd_barrier_complete(bar, b.x, nloc, nx); b.st[0] = nloc; b.st[1] = nx; }
        const unsigned old = xb_add(&bar[XB_XSUB(b.x)], 1u);
        const unsigned gen = old / nloc;
        if (old + 1u == (gen + 1u) * nloc) {
            __builtin_amdgcn_fence(__ATOMIC_RELEASE, "agent");
            asm volatile("s_waitcnt vmcnt(0)" ::: "memory");
            const unsigned og = xb_add(&bar[XB_TOP], 1u);
            const unsigned tg = og / nx;
            if (og + 1u == (tg + 1u) * nx) xb_add(&bar[XB_TOPGEN], 1u);
            else XB_SPIN(xb_ld(&bar[XB_TOPGEN]) == tg, bar);
            __builtin_amdgcn_fence(__ATOMIC_ACQUIRE, "agent");
            xb_add(&bar[XB_XGEN(b.x)], 1u);
            asm volatile("s_waitcnt vmcnt(0)" ::: "memory");
        } else {
            XB_SPIN(xb_ld(&bar[XB_XGEN(b.x)]) == gen, bar);
            __builtin_amdgcn_fence(__ATOMIC_ACQUIRE, "agent");
            asm volatile("s_waitcnt vmcnt(0)" ::: "memory");
        }
    }
    __syncthreads();
}

struct Args { const float* x; const int* pos; const float* g_pre; const float* w_in; const float* g_q; const float* w_uq; const float* g_kv; const float* w_ukv;
              const float* b_forget; const float* w_out; const float* g_post; float* out; unsigned char* ws; int ph_lo, ph_hi; };

__global__ void __launch_bounds__(512, 2) hybrid_fwd(Args a) {
    extern __shared__ __attribute__((aligned(16))) unsigned char lds[];
    cg::grid_group grid = cg::this_grid();
    const int tid_k = threadIdx.x, lane_k = tid_k & 63, wave = __builtin_amdgcn_readfirstlane(tid_k >> 6);
    const int G = gridDim.x, bx = blockIdx.x; const int vcu = (G % 8 == 0) ? (bx % 8) * (G / 8) + bx / 8 : bx;
    unsigned char* ws = a.ws;
    float* rstd_x = (float*)(ws + WS_RSTDX); float* partq = (float*)(ws + WS_PARTQ); float* partkv = (float*)(ws + WS_PARTKV); float* party = (float*)(ws + WS_PARTY);
    float* flog = (float*)(ws + WS_FLOG); float* cf = (float*)(ws + WS_CF); float* cosT = (float*)(ws + WS_COS); float* sinT = (float*)(ws + WS_SIN);
    bf16* Win_t = (bf16*)(ws + WS_WIN); bf16* Wuq_t = (bf16*)(ws + WS_WUQ); bf16* Wukv_t = (bf16*)(ws + WS_WUKV); bf16* Wout_t = (bf16*)(ws + WS_WOUT);
    bf16* Xb = (bf16*)(ws + WS_XB); bf16* Ob = (bf16*)(ws + WS_O); bf16* qlat = (bf16*)(ws + WS_QLAT); bf16* kvlat = (bf16*)(ws + WS_KVLAT); bf16* Gb = (bf16*)(ws + WS_G);
    bf16* Qf = (bf16*)(ws + WS_QF); bf16* Kf = (bf16*)(ws + WS_KF); bf16* Vf = (bf16*)(ws + WS_VF); bf16* Yb = (bf16*)(ws + WS_Y);
    bf16* Qm = (bf16*)(ws + WS_QM); bf16* Km = (bf16*)(ws + WS_KM); bf16* Vm = (bf16*)(ws + WS_VM);
    const int lo = a.ph_lo, hi = a.ph_hi;
#ifndef PH_MASK
#define PH_MASK 63
#endif
#define IN(k) (((PH_MASK >> (k)) & 1) && lo <= (k) && (k) < hi)
#define BOTH(k) (IN(k) && IN((k) + 1))
    LAS unsigned char* ldsl = (LAS unsigned char*)lds;
    volatile LAS unsigned* bst = (volatile LAS unsigned*)(ldsl + LDS_BYTES - 64);
    if (tid_k < 2) bst[tid_k] = 0u;
    __syncthreads();
    XcdBarrier xbar = xcd_barrier_post((unsigned*)(ws + WS_CTL), bst);

    if (IN(0)) for (int rep_ = 0; rep_ < PROBE_REP0; ++rep_) {
        const int lane = launder(lane_k), tid = launder(tid_k);
        LAS float* scr = (LAS float*)(ldsl + wave * 16384);
        const int gw = vcu * 8 + wave, NGW = G * 8;
        constexpr int I_IN = 32 * 208, I_UQ = 12 * 48, I_UKV = 8 * 64, I_OUT = 32 * 64, NITEMS = I_IN + I_UQ + I_UKV + I_OUT;
        for (int it = gw; it < NITEMS; it += NGW) {
            int r = it;
            if (r < I_IN) { const int kb = r / 208, nb = r % 208; int src, nv; win_src(nb * 32, src, nv); transpose_item(a.w_in, DIN, 2048, a.g_pre, Win_t, nb * 32, src, nv, kb * 64, scr, lane); continue; } r -= I_IN;
            if (r < I_UQ) { const int kb = r / 48, nb = r % 48; transpose_item(a.w_uq, 1536, 768, a.g_q, Wuq_t, nb * 32, wuq_src(nb * 32), 32, kb * 64, scr, lane); continue; } r -= I_UQ;
            if (r < I_UKV) { const int kb = r / 64, nb = r % 64; transpose_item(a.w_ukv, 2048, 512, a.g_kv, Wukv_t, nb * 32, nb * 32, 32, kb * 64, scr, lane); continue; } r -= I_UKV;
            { const int kb = r / 64, nb = r % 64; transpose_item(a.w_out, 2048, 2048, nullptr, Wout_t, nb * 32, nb * 32, 32, kb * 64, scr, lane); }
        }
        for (int m = gw; m < M; m += 2 * NGW) {
            const int m2 = m + NGW;
            const f32x4* xr = (const f32x4*)(a.x + (size_t)m * DM) + lane; const f32x4* xr2 = (const f32x4*)(a.x + (size_t)m2 * DM) + lane; f32x4 v[8], v2[8]; float s = 0.f, s2 = 0.f;
#pragma unroll
            for (int j = 0; j < 8; ++j) { v[j] = __builtin_nontemporal_load(xr + 64 * j); v2[j] = __builtin_nontemporal_load(xr2 + 64 * j); }
#pragma unroll
            for (int j = 0; j < 8; ++j) { s += (v[j][0] * v[j][0] + v[j][1] * v[j][1]) + (v[j][2] * v[j][2] + v[j][3] * v[j][3]); s2 += (v2[j][0] * v2[j][0] + v2[j][1] * v2[j][1]) + (v2[j][2] * v2[j][2] + v2[j][3] * v2[j][3]); }
            s = wave_sum(s); s2 = wave_sum(s2);
            if (lane == 0) { rstd_x[m] = 1.f / sqrtf(s * (1.f / DM) + EPS); rstd_x[m2] = 1.f / sqrtf(s2 * (1.f / DM) + EPS); }
            u32x2* o8 = (u32x2*)(Xb + (size_t)m * DM) + lane; u32x2* o82 = (u32x2*)(Xb + (size_t)m2 * DM) + lane;
#pragma unroll
            for (int j = 0; j < 8; ++j) { u32x2 w; w.x = pk2(v[j][0], v[j][1]); w.y = pk2(v[j][2], v[j][3]); o8[64 * j] = w; u32x2 w2; w2.x = pk2(v2[j][0], v2[j][1]); w2.y = pk2(v2[j][2], v2[j][3]); o82[64 * j] = w2; }
        }
        for (int e = (vcu * 512 + tid); e < M * 32; e += G * 512) { const int row = e >> 5, i = e & 31;
            const float inv = exp2f(-(float)i * (13.287712379549449f / 32.f)); const float ang = (float)a.pos[row] * inv;
            const float n = rintf(ang * 0.15915494309189535f); float r = fmaf(-n, 6.28318548202514648f, ang); r = fmaf(-n, -1.7484555e-7f, r);
            cosT[e] = __cosf(r); sinT[e] = __sinf(r); }
    }
    if (BOTH(0)) xcd_barrier(xbar);
    if (a.ph_hi > 64) grid.sync();

    if (IN(1)) for (int rep_ = 0; rep_ < PROBE_REP1; ++rep_) {
        pg8::Gemm g{Xb, Win_t, M, NIN_PAD, 2048}; pg8::StaticOrder S; S.init(M, NIN_PAD, G, bx);
        EpiIn E{rstd_x, qlat, kvlat, Gb, Qf, Kf, Vf, Km, flog, partq, partkv, cosT, sinT};
        pg8::gemm_phase<EpiIn, pg8::StaticOrder, true, true>(ldsl, g, S, E);
    }
    if (BOTH(1)) xcd_barrier(xbar);

    if (IN(2)) for (int rep_ = 0; rep_ < PROBE_REP2; ++rep_) {
        const int lane = launder(lane_k), tid = launder(tid_k);
        if (bx >= G - BATCH * NH) { const int sq_ = bx - (G - BATCH * NH);
            const int b = sq_ >> 3, h = sq_ & 7; const float bf = a.b_forget[h];
            const float* fl = flog + ((size_t)b * SEQ + 8 * tid) * 8 + h; float lf[8];
#pragma unroll
            for (int j = 0; j < 8; ++j) lf[j] = fl[j * 8] + bf;
#pragma unroll
            for (int j = 0; j < 8; ++j) { const float z = lf[j]; lf[j] = fminf(z, 0.f) - log1pf(expf(-fabsf(z))); }
#pragma unroll
            for (int j = 1; j < 8; ++j) lf[j] += lf[j - 1];
            float incl = lf[7];
#pragma unroll
            for (int o = 1; o < 64; o <<= 1) { const float t = __shfl_up(incl, o); if (lane >= o) incl += t; }
            volatile LAS float* wtot = (volatile LAS float*)(ldsl + LDS_BYTES - 128);
            if (lane == 63) wtot[wave] = incl;
            __syncthreads();
            float off = incl - lf[7];
            for (int w2 = 0; w2 < wave; ++w2) off += wtot[w2];
            float* cp = cf + (size_t)sq_ * SEQ + 8 * tid;
            f32x4 o0, o1;
#pragma unroll
            for (int j = 0; j < 4; ++j) { o0[j] = (off + lf[j]) * LOG2E; o1[j] = (off + lf[4 + j]) * LOG2E; }
            *(f32x4*)cp = o0; *(f32x4*)(cp + 4) = o1;
            __syncthreads();
        }
        { pg8::Gemm g{qlat, Wuq_t, M, 1536, QRANK}; pg8::StaticOrder S; S.init(M, 1536, G, bx);
          EpiQ E{partq, Qm, cosT, sinT};
          pg8::gemm_phase<EpiQ, pg8::StaticOrder, true, true>(ldsl, g, S, E); }
        { pg8::Gemm g{kvlat, Wukv_t, M, 2048, KVRANK}; pg8::StaticOrder S; S.init(M, 2048, G, bx);
          EpiKV E{partkv, Km, Vm};
          pg8::gemm_phase<EpiKV, pg8::StaticOrder, true, true>(ldsl, g, S, E); }
    }
    if (BOTH(2)) xcd_barrier(xbar);

    if (IN(3)) for (int rep_ = 0; rep_ < PROBE_REP3; ++rep_) {
        for (int v = vcu; v < 256; v += G) {
            const int s = v & 3, w = v >> 2, b = w >> 4, hh = w & 15, hd = hh & 7, swp = hh >> 3;
            const size_t rb = (size_t)b * SEQ;
#pragma unroll 1
            for (int i = 0; i < 2; ++i) {
                const int qb = __builtin_amdgcn_readfirstlane(swp ? (i == 0 ? 8 + s : 7 - s) : (i == 0 ? 15 - s : s));
                att::attn_unit<192, false>((char*)lds, Qm + rb * 1536 + hd * 192, 1536, Km + rb * 1536 + hd * 192, 1536, Vm + rb * 1024 + hd * 128, 1024, nullptr,
                                           Gb + rb * 2048 + hd * 128, Ob + rb * 2048 + hd * 128, qb);
            }
#pragma unroll 1
            for (int i = 0; i < 2; ++i) {
                const int qb = __builtin_amdgcn_readfirstlane(swp ? (i == 0 ? 15 - s : s) : (i == 0 ? 8 + s : 7 - s));
                att::attn_unit<128, true>((char*)lds, Qf + rb * 1024 + hd * 128, 1024, Kf + rb * 1024 + hd * 128, 1024, Vf + rb * 1024 + hd * 128, 1024, cf + (size_t)(b * 8 + hd) * SEQ,
                                          Gb + rb * 2048 + 1024 + hd * 128, Ob + rb * 2048 + 1024 + hd * 128, qb);
            }
        }
    }
#if PROBE_ABL >= 0
    if (IN(3)) {
        for (int v = vcu; v < 256; v += G) {
            const int s = v & 3, w = v >> 2, b = w >> 4, hh = w & 15, hd = hh & 7, swp = hh >> 3;
            const size_t rb = (size_t)b * SEQ;
#pragma unroll 1
            for (int i = 0; i < 2; ++i) {
                const int qb = __builtin_amdgcn_readfirstlane(swp ? (i == 0 ? 8 + s : 7 - s) : (i == 0 ? 15 - s : s));
                att::attn_unit<192, false, PROBE_ABL>((char*)lds, Qm + rb * 1536 + hd * 192, 1536, Km + rb * 1536 + hd * 192, 1536, Vm + rb * 1024 + hd * 128, 1024, nullptr,
                                           Gb + rb * 2048 + hd * 128, qlat, qb);
            }
#pragma unroll 1
            for (int i = 0; i < 2; ++i) {
                const int qb = __builtin_amdgcn_readfirstlane(swp ? (i == 0 ? 15 - s : s) : (i == 0 ? 8 + s : 7 - s));
                att::attn_unit<128, true, PROBE_ABL>((char*)lds, Qf + rb * 1024 + hd * 128, 1024, Kf + rb * 1024 + hd * 128, 1024, Vf + rb * 1024 + hd * 128, 1024, cf + (size_t)(b * 8 + hd) * SEQ,
                                          Gb + rb * 2048 + 1024 + hd * 128, qlat, qb);
            }
        }
    }
#endif
    if (BOTH(3)) xcd_barrier(xbar);

    if (IN(4)) for (int rep_ = 0; rep_ < PROBE_REP4; ++rep_) {
        pg8::Gemm g{Ob, Wout_t, M, 2048, 2048}; pg8::StaticOrder S; S.init(M, 2048, G, bx);
        EpiOut E{Yb, party};
        pg8::gemm_phase<EpiOut, pg8::StaticOrder, true, true>(ldsl, g, S, E);
    }
    if (BOTH(4)) xcd_barrier(xbar);

    if (IN(5)) for (int rep_ = 0; rep_ < PROBE_REP5; ++rep_) {
        const int lane = launder(lane_k);
        const int gw = vcu * 8 + wave, NGW = G * 8;
        const f32x4* gp = (const f32x4*)a.g_post + lane; f32x4 gv[8];
#pragma unroll
        for (int j = 0; j < 8; ++j) gv[j] = gp[64 * j];
        for (int m = gw; m < M; m += 2 * NGW) {
            const int m2 = m + NGW;
            float s = (lane < 32) ? party[(size_t)m * 32 + lane] : 0.f, s2 = (lane < 32) ? party[(size_t)m2 * 32 + lane] : 0.f;
            const f32x4* xr = (const f32x4*)(a.x + (size_t)m * DM) + lane; const f32x4* xr2 = (const f32x4*)(a.x + (size_t)m2 * DM) + lane;
            const u32x2* yr = (const u32x2*)(Yb + (size_t)m * DM) + lane; const u32x2* yr2 = (const u32x2*)(Yb + (size_t)m2 * DM) + lane;
            f32x4 xv[8], xv2[8]; u32x2 y[8], y2[8];
#pragma unroll
            for (int j = 0; j < 8; ++j) { xv[j] = __builtin_nontemporal_load(xr + 64 * j); xv2[j] = __builtin_nontemporal_load(xr2 + 64 * j); y[j] = __builtin_nontemporal_load(yr + 64 * j); y2[j] = __builtin_nontemporal_load(yr2 + 64 * j); }
            s = wave_sum(s); s2 = wave_sum(s2);
            const float rs = 1.f / sqrtf(s * (1.f / DM) + EPS), rs2 = 1.f / sqrtf(s2 * (1.f / DM) + EPS);
            f32x4* orow = (f32x4*)(a.out + (size_t)m * DM) + lane; f32x4* orow2 = (f32x4*)(a.out + (size_t)m2 * DM) + lane;
#pragma unroll
            for (int j = 0; j < 8; ++j) {
                f32x4 o; o[0] = xv[j][0] + bflo(y[j].x) * rs * gv[j][0]; o[1] = xv[j][1] + bfhi(y[j].x) * rs * gv[j][1]; o[2] = xv[j][2] + bflo(y[j].y) * rs * gv[j][2]; o[3] = xv[j][3] + bfhi(y[j].y) * rs * gv[j][3];
                __builtin_nontemporal_store(o, orow + 64 * j);
                f32x4 o2; o2[0] = xv2[j][0] + bflo(y2[j].x) * rs2 * gv[j][0]; o2[1] = xv2[j][1] + bfhi(y2[j].x) * rs2 * gv[j][1]; o2[2] = xv2[j][2] + bflo(y2[j].y) * rs2 * gv[j][2]; o2[3] = xv2[j][3] + bfhi(y2[j].y) * rs2 * gv[j][3];
                __builtin_nontemporal_store(o2, orow2 + 64 * j); }
        }
    }
#undef IN
#undef BOTH
}

extern "C" void kernel_launch(void* const* d_in, const int* in_sizes, int n_in, void* d_out, int out_size, void* d_ws, size_t ws_size, hipStream_t stream) {
    static int grid = 0;
    if (grid == 0) {
        if (n_in != 11 || in_sizes[0] != M * DM || out_size != M * DM || ws_size < WS_END) { fprintf(stderr, "kernel_launch: shape mismatch n_in %d in0 %d out %d ws %zu\n", n_in, n_in > 0 ? in_sizes[0] : -1, out_size, ws_size); grid = -1; return; }
        int dev = 0, cus = 0, per_cu = 0;
        if (hipGetDevice(&dev) != hipSuccess || hipDeviceGetAttribute(&cus, hipDeviceAttributeMultiprocessorCount, dev) != hipSuccess) { grid = -1; return; }
        if (hipFuncSetAttribute((const void*)hybrid_fwd, hipFuncAttributeMaxDynamicSharedMemorySize, LDS_BYTES) != hipSuccess) { fprintf(stderr, "kernel_launch: hipFuncSetAttribute failed\n"); grid = -1; return; }
        if (hipOccupancyMaxActiveBlocksPerMultiprocessor(&per_cu, (const void*)hybrid_fwd, 512, LDS_BYTES) != hipSuccess || per_cu < 1) { fprintf(stderr, "kernel_launch: occupancy query says %d\n", per_cu); per_cu = 1; }
        (void)hipGetLastError();
        grid = cus;
    }
    if (grid < 0) return;
    if (hipMemsetAsync((char*)d_ws + WS_CTL, 0, CTL_BYTES, stream) != hipSuccess) { fprintf(stderr, "kernel_launch: memset failed\n"); return; }
    Args a{};
    a.x = (const float*)d_in[0]; a.pos = (const int*)d_in[1]; a.g_pre = (const float*)d_in[2]; a.w_in = (const float*)d_in[3]; a.g_q = (const float*)d_in[4]; a.w_uq = (const float*)d_in[5];
    a.g_kv = (const float*)d_in[6]; a.w_ukv = (const float*)d_in[7]; a.b_forget = (const float*)d_in[8]; a.w_out = (const float*)d_in[9]; a.g_post = (const float*)d_in[10];
    a.out = (float*)d_out; a.ws = (unsigned char*)d_ws;
#if MK_N_LAUNCHES == 1
    a.ph_lo = 0; a.ph_hi = 6;
    void* args[] = {&a};
    hipError_t e = hipLaunchCooperativeKernel((const void*)hybrid_fwd, dim3(grid), dim3(512), args, LDS_BYTES, stream);
    if (e != hipSuccess) fprintf(stderr, "cooperative launch failed: %s (grid %d)\n", hipGetErrorString(e), grid);
#else
    for (int p = 0; p < 6; ++p) { a.ph_lo = p; a.ph_hi = p + 1; for (int r = 0; r < (p == PROBE_DUP ? 2 : 1); ++r) hipLaunchKernelGGL(hybrid_fwd, dim3(grid), dim3(512), LDS_BYTES, stream, a); }
#endif
}
```

```cpp
#include <hip/hip_runtime.h>
#include <hip/hip_cooperative_groups.h>
#include <cstdio>
#include <cstdint>
namespace cg = cooperative_groups;

#ifndef PROBE_REP0
#define PROBE_REP0 1
#endif
#ifndef PROBE_REP1
#define PROBE_REP1 1
#endif
#ifndef PROBE_REP2
#define PROBE_REP2 1
#endif
#ifndef PROBE_REP3
#define PROBE_REP3 1
#endif
#ifndef PROBE_REP4
#define PROBE_REP4 1
#endif
#ifndef PROBE_REP5
#define PROBE_REP5 1
#endif
#ifndef PROBE_ABL
#define PROBE_ABL -1
#endif
#ifndef PROBE_DUP
#define PROBE_DUP -1
#endif
#ifndef MK_N_LAUNCHES
#define MK_N_LAUNCHES 1
#endif

namespace pg8 {
#define PG8_LAS __attribute__((address_space(3)))
typedef unsigned short bf16_t;
typedef short bf16x8 __attribute__((ext_vector_type(8)));
typedef float f32x4 __attribute__((ext_vector_type(4)));
typedef unsigned u32x4 __attribute__((ext_vector_type(4)));
constexpr int BM = 256, BK = 64, HALF = 128, HTB = HALF * BK * 2, STAGE_BYTES = 8 * HTB, NXCD = 8, WGM = 8;

__host__ __device__ __forceinline__ int lds_byte(int r, int c) { const int st = (r >> 4) * 2 + (c >> 5), rr = r & 15, cc = c & 31, ob = rr * 64 + cc * 2; return st * 1024 + (ob ^ (((ob >> 9) & 1) << 5)); }
__host__ __device__ __forceinline__ void stage_rc(int b, int& R, int& C) { const int st = b / 1024, sb = b % 1024, swz = sb ^ (((sb >> 9) & 1) << 5); R = (st >> 1) * 16 + swz / 64; C = (st & 1) * 32 + (swz % 64) / 2; }
__host__ __device__ __forceinline__ int perm32(int rho) { const int n = rho >> 4, i = rho & 15; return 8 * (i >> 2) + 4 * n + (i & 3); }

struct Unit { int pm, pn; };
struct Gemm { const bf16_t* A; const bf16_t* Bt; int M, N, K; };

struct StaticOrder {
    int nM, nN, nwg, G, c;
    __host__ __device__ void init(int M, int N, int G_, int c_) { nM = M / BM; nN = N / BM; nwg = nM * nN; G = G_; c = c_; }
    __host__ __device__ bool next(int i, Unit& u) const {
        const long L = (long)i * G + c; if (L >= nwg) return false;
        int wgid = (int)L; { const int q = nwg / NXCD, r = nwg % NXCD, xcd = wgid % NXCD, off = wgid / NXCD; wgid = (xcd < r ? xcd * (q + 1) : r * (q + 1) + (xcd - r) * q) + off; }
        const int nig = WGM * nN, gid = wgid / nig, fm = gid * WGM, gsz = (nM - fm) < WGM ? (nM - fm) : WGM;
        u.pm = fm + ((wgid % nig) % gsz); u.pn = (wgid % nig) / gsz; return true;
    }
    __device__ __forceinline__ void a_ready(const Unit&) const {}
    __device__ __forceinline__ void done(const Unit&) const {}
};

__device__ __forceinline__ unsigned cvt_pk_bf16(float lo, float hi) { unsigned r; asm volatile("v_cvt_pk_bf16_f32 %0, %1, %2" : "=v"(r) : "v"(lo), "v"(hi)); return r; }

template <class Epi, class Sched, bool ALIGN_EPI = false, bool SP2 = false>
__device__ __forceinline__ void gemm_phase(PG8_LAS unsigned char* lds, const Gemm g, const Sched& S, const Epi& E) {
    const int tid = threadIdx.x, wid = __builtin_amdgcn_readfirstlane(tid >> 6), lane = tid & 63, wr = wid >> 2, wc = wid & 3, fr = lane & 15, fq = lane >> 4;
    const int K = g.K, nt = K / BK;
    unsigned voffA[2], voffB[2];
#pragma unroll
    for (int i = 0; i < 2; ++i) { int R, C; stage_rc(tid * 16 + i * 8192, R, C); const int Rb = Epi::PERM ? ((R & ~31) + perm32(R & 31)) : R;
        voffA[i] = (unsigned)(R * K + C) * 2u; voffB[i] = (unsigned)(Rb * K + C) * 2u; }
    const size_t kstep = (size_t)(BK * 2);
    const size_t hstep = (size_t)HALF * K * 2;
    const size_t tstep = 2 * hstep;
    const unsigned ldsw = (unsigned)wid * 1024u;
    const int aoff = lds_byte(wr * 64 + fr, fq * 8), boff = lds_byte(wc * 32 + fr, fq * 8);
#define PG8_SA(b, h) (((b) * 2 + (h)) * HTB)
#define PG8_SB(b, h) ((4 + (b) * 2 + (h)) * HTB)
#define PG8_STAGE(bufoff, gbase, voff) do { _Pragma("unroll") for (int _i = 0; _i < 2; ++_i) \
        __builtin_amdgcn_global_load_lds((const unsigned*)((const char*)(gbase) + (voff)[_i]), (PG8_LAS unsigned*)(lds + (bufoff) + ldsw + _i * 8192), 16, 0, 0); } while (0)
#define PG8_LDA(dst, b, h) do { _Pragma("unroll") for (int m = 0; m < 4; ++m) _Pragma("unroll") for (int k = 0; k < 2; ++k) dst[m][k] = *(const PG8_LAS bf16x8*)(lds + PG8_SA(b, h) + aoff + m * 2048 + k * 1024); } while (0)
#define PG8_LDB(dst, b, h) do { _Pragma("unroll") for (int n = 0; n < 2; ++n) _Pragma("unroll") for (int k = 0; k < 2; ++k) dst[n][k] = *(const PG8_LAS bf16x8*)(lds + PG8_SB(b, h) + boff + n * 2048 + k * 1024); } while (0)
#define PG8_MMA(ai, bj, At, Bt) do { __builtin_amdgcn_s_setprio(1); _Pragma("unroll") for (int m = 0; m < 4; ++m) _Pragma("unroll") for (int n = 0; n < 2; ++n) _Pragma("unroll") for (int k = 0; k < 2; ++k) \
        acc[ai][bj][m][n] = __builtin_amdgcn_mfma_f32_16x16x32_bf16(Bt[n][k], At[m][k], acc[ai][bj][m][n], 0, 0, 0); __builtin_amdgcn_s_setprio(0); } while (0)
#define PG8_WAIT_V(n) asm volatile("s_waitcnt vmcnt(" #n ")" ::: "memory")
#define PG8_WAIT_L(n) asm volatile("s_waitcnt lgkmcnt(" #n ")" ::: "memory")
#define PG8_BAR __builtin_amdgcn_s_barrier()
#define PG8_SCHED __builtin_amdgcn_sched_barrier(0)
    Unit cur, nxt; int ui = 0;
    if (!S.next(0, cur)) return;
    f32x4 acc[2][2][4][2];
#pragma unroll
    for (int a = 0; a < 2; ++a)
#pragma unroll
        for (int b = 0; b < 2; ++b)
#pragma unroll
            for (int m = 0; m < 4; ++m)
#pragma unroll
                for (int n = 0; n < 2; ++n) acc[a][b][m][n] = (f32x4){0.f, 0.f, 0.f, 0.f};
    bf16x8 At[4][2], B0[2][2], B1[2][2];
    const char* cA = (const char*)g.A + (size_t)cur.pm * tstep; const char* cB = (const char*)g.Bt + (size_t)cur.pn * tstep;
    S.a_ready(cur);
    if constexpr (SP2) {
        PG8_STAGE(PG8_SB(0, 0), cB, voffB); PG8_STAGE(PG8_SB(0, 1), cB + hstep, voffB); PG8_STAGE(PG8_SA(0, 0), cA, voffA); PG8_STAGE(PG8_SA(0, 1), cA + hstep, voffA);
        if (wr == 1) PG8_BAR;
        PG8_WAIT_V(2); PG8_BAR;
        PG8_STAGE(PG8_SB(1, 0), cB + kstep, voffB); PG8_STAGE(PG8_SA(1, 0), cA + kstep, voffA); PG8_STAGE(PG8_SB(1, 1), cB + hstep + kstep, voffB);
        PG8_WAIT_V(6); PG8_BAR;
    } else {
        PG8_STAGE(PG8_SB(0, 0), cB, voffB); PG8_STAGE(PG8_SA(0, 0), cA, voffA); PG8_STAGE(PG8_SB(0, 1), cB + hstep, voffB); PG8_STAGE(PG8_SA(0, 1), cA + hstep, voffA);
        if (wr == 1) PG8_BAR;
        PG8_WAIT_V(4); PG8_BAR;
        PG8_STAGE(PG8_SB(1, 0), cB + kstep, voffB); PG8_STAGE(PG8_SA(1, 0), cA + kstep, voffA); PG8_STAGE(PG8_SB(1, 1), cB + hstep + kstep, voffB);
        PG8_WAIT_V(6); PG8_BAR;
    }
    for (;;) {
        const bool has_next = S.next(ui + 1, nxt);
        const char* nA = has_next ? (const char*)g.A + (size_t)nxt.pm * tstep : cA; const char* nB = has_next ? (const char*)g.Bt + (size_t)nxt.pn * tstep : cB;
        for (int t = 0; t < nt; t += 2) {
            const bool last = (t == nt - 2);
            const char* a1 = cA + (size_t)(t + 1) * kstep;
            const char* a2 = last ? nA : cA + (size_t)(t + 2) * kstep; const char* b2 = last ? nB : cB + (size_t)(t + 2) * kstep;
            const char* a3 = a2 + kstep; const char* b3 = b2 + kstep;
            if (last && has_next) S.a_ready(nxt);
            if constexpr (SP2) {
            PG8_LDB(B0, 0, 0); PG8_LDB(B1, 0, 1); PG8_SCHED; PG8_LDA(At, 0, 0); PG8_STAGE(PG8_SA(1, 1), a1 + hstep, voffA);
            PG8_WAIT_V(8); PG8_WAIT_L(0); PG8_BAR; PG8_MMA(0, 0, At, B0); PG8_MMA(0, 1, At, B1); PG8_BAR; PG8_SCHED;
            PG8_LDA(At, 0, 1); PG8_STAGE(PG8_SB(0, 0), b2, voffB); PG8_STAGE(PG8_SB(0, 1), b2 + hstep, voffB); PG8_STAGE(PG8_SA(0, 0), a2, voffA);
            PG8_WAIT_V(8); PG8_WAIT_L(0); PG8_BAR; PG8_MMA(1, 0, At, B0); PG8_MMA(1, 1, At, B1); PG8_BAR; PG8_SCHED;
            PG8_LDB(B0, 1, 0); PG8_LDB(B1, 1, 1); PG8_SCHED; PG8_LDA(At, 1, 0); PG8_STAGE(PG8_SA(0, 1), a2 + hstep, voffA);
            PG8_WAIT_V(8); PG8_WAIT_L(0); PG8_BAR; PG8_MMA(0, 0, At, B0); PG8_MMA(0, 1, At, B1); PG8_BAR; PG8_SCHED;
            PG8_LDA(At, 1, 1); PG8_STAGE(PG8_SB(1, 0), b3, voffB); PG8_STAGE(PG8_SB(1, 1), b3 + hstep, voffB); PG8_STAGE(PG8_SA(1, 0), a3, voffA);
            PG8_WAIT_V(8); PG8_WAIT_L(0); PG8_BAR; PG8_MMA(1, 0, At, B0); PG8_MMA(1, 1, At, B1); PG8_BAR; PG8_SCHED;
            } else {
            PG8_LDB(B0, 0, 0); PG8_SCHED; PG8_LDA(At, 0, 0); PG8_STAGE(PG8_SA(1, 1), a1 + hstep, voffA);
            PG8_WAIT_L(8); PG8_BAR; PG8_WAIT_L(0); PG8_MMA(0, 0, At, B0); PG8_BAR; PG8_SCHED;
            PG8_LDB(B1, 0, 1); PG8_STAGE(PG8_SB(0, 0), b2, voffB);
            PG8_BAR; PG8_WAIT_L(0); PG8_MMA(0, 1, At, B1); PG8_BAR;
            PG8_LDA(At, 0, 1); PG8_STAGE(PG8_SA(0, 0), a2, voffA);
            PG8_BAR; PG8_WAIT_L(0); PG8_MMA(1, 0, At, B0); PG8_BAR; PG8_SCHED;
            PG8_STAGE(PG8_SB(0, 1), b2 + hstep, voffB);
            PG8_WAIT_V(6); PG8_BAR; PG8_MMA(1, 1, At, B1); PG8_BAR;
            PG8_LDB(B0, 1, 0); PG8_SCHED; PG8_LDA(At, 1, 0); PG8_STAGE(PG8_SA(0, 1), a2 + hstep, voffA);
            PG8_WAIT_L(8); PG8_BAR; PG8_WAIT_L(0); PG8_MMA(0, 0, At, B0); PG8_BAR; PG8_SCHED;
            PG8_LDB(B1, 1, 1); PG8_STAGE(PG8_SB(1, 0), b3, voffB);
            PG8_BAR; PG8_WAIT_L(0); PG8_MMA(0, 1, At, B1); PG8_BAR;
            PG8_LDA(At, 1, 1); PG8_STAGE(PG8_SA(1, 0), a3, voffA);
            PG8_BAR; PG8_WAIT_L(0); PG8_MMA(1, 0, At, B0); PG8_BAR; PG8_SCHED;
            PG8_STAGE(PG8_SB(1, 1), b3 + hstep, voffB);
            PG8_WAIT_V(6); PG8_BAR; PG8_MMA(1, 1, At, B1); PG8_BAR;
            }
        }
        if constexpr (ALIGN_EPI) { if (wr == 0) PG8_BAR; }
        if constexpr (!Epi::AFTER_DRAIN) { E(acc, cur, wr, wc, fr, fq); S.done(cur); }
        if (!has_next) break;
#pragma unroll
        for (int a = 0; a < 2; ++a)
#pragma unroll
            for (int b = 0; b < 2; ++b)
#pragma unroll
                for (int m = 0; m < 4; ++m)
#pragma unroll
                    for (int n = 0; n < 2; ++n) acc[a][b][m][n] = (f32x4){0.f, 0.f, 0.f, 0.f};
        cur = nxt; cA = nA; cB = nB; ++ui;
        if constexpr (ALIGN_EPI) { if (wr == 1) PG8_BAR; }
    }
    PG8_WAIT_V(0);
    if constexpr (!ALIGN_EPI) { if (wr == 0) PG8_BAR; }
    PG8_BAR;
#undef PG8_SA
#undef PG8_SB
#undef PG8_STAGE
#undef PG8_LDA
#undef PG8_LDB
#undef PG8_MMA
#undef PG8_WAIT_V
#undef PG8_WAIT_L
#undef PG8_BAR
#undef PG8_SCHED
}
}

typedef unsigned short bf16;
typedef float f32x4 __attribute__((ext_vector_type(4)));
typedef unsigned u32x4 __attribute__((ext_vector_type(4)));
typedef unsigned u32x2 __attribute__((ext_vector_type(2)));
typedef short bf16x8 __attribute__((ext_vector_type(8)));
typedef short s16x4 __attribute__((ext_vector_type(4)));
typedef float f32x16 __attribute__((ext_vector_type(16)));
#define LAS __attribute__((address_space(3)))

constexpr int BATCH = 4, SEQ = 4096, DM = 2048, M = BATCH * SEQ;
constexpr int NH = 8, QKD = 192, QRANK = 768, KVRANK = 512, DIN = 6472;
constexpr int NIN_PAD = 6656;
constexpr float EPS = 1e-6f;
constexpr float LOG2E = 1.4426950408889634f;
constexpr float C2M = 0.07216878364870322f * LOG2E;
constexpr float C2F = 0.08838834764831845f * LOG2E;

constexpr size_t MiB = 1u << 20;
constexpr size_t WS_RSTDX = 0, WS_PARTQ = 1 * MiB, WS_PARTKV = 2 * MiB, WS_PARTY = 3 * MiB, WS_FLOG = 5 * MiB, WS_CF = 6 * MiB, WS_COS = 7 * MiB, WS_SIN = 9 * MiB;
constexpr size_t WS_CTL = 11 * MiB, CTL_BYTES = 16384;
constexpr size_t WS_WIN = 16 * MiB, WS_WUQ = 42 * MiB, WS_WUKV = 45 * MiB, WS_WOUT = 47 * MiB;
constexpr size_t WS_XB = 56 * MiB, WS_O = 56 * MiB;
constexpr size_t WS_QLAT = 120 * MiB, WS_KVLAT = 144 * MiB, WS_G = 160 * MiB;
constexpr size_t WS_QF = 224 * MiB, WS_Y = 224 * MiB, WS_KF = 256 * MiB, WS_VF = 288 * MiB;
constexpr size_t WS_QM = 320 * MiB, WS_KM = 368 * MiB, WS_VM = 416 * MiB, WS_END = 448 * MiB;

constexpr int LDS_BYTES = 163840;

__device__ __forceinline__ unsigned f2bf(float f) { unsigned u = __builtin_bit_cast(unsigned, f); return (u + 0x7fffu + ((u >> 16) & 1u)) >> 16; }
__device__ __forceinline__ unsigned pk2(float lo, float hi) { return pg8::cvt_pk_bf16(lo, hi); }
__device__ __forceinline__ float bflo(unsigned w) { return __builtin_bit_cast(float, w << 16); }
__device__ __forceinline__ float bfhi(unsigned w) { return __builtin_bit_cast(float, w & 0xffff0000u); }
__device__ __forceinline__ int launder(int v) { asm volatile("" : "+v"(v)); return v; }
__device__ __forceinline__ float wave_sum(float v) {
#pragma unroll
    for (int o = 1; o < 64; o <<= 1) v += __shfl_xor(v, o);
    return v;
}
__device__ __forceinline__ float silu_f(float v) { return v * __builtin_amdgcn_rcpf(1.f + __builtin_amdgcn_exp2f(-v * LOG2E)); }
__device__ __forceinline__ u32x4 pack8f(f32x4 a, f32x4 b) { u32x4 w; w.x = pk2(a[0], a[1]); w.y = pk2(a[2], a[3]); w.z = pk2(b[0], b[1]); w.w = pk2(b[2], b[3]); return w; }

typedef pg8::f32x4 af4;
struct EpiIn {
    static constexpr bool PERM = true, AFTER_DRAIN = false;
    const float* rstd_x; bf16 *qlat, *kvlat, *G, *Qf, *Kf, *Vf, *Km; float *flog, *partq, *partkv; const float *cosT, *sinT;
    __device__ __forceinline__ void operator()(const af4 (&acc)[2][2][4][2], const pg8::Unit& u, int wr, int wc, int fr, int fq) const {
        const int pn = u.pn; const int row0 = u.pm * 256 + wr * 64 + fr;
        if (pn == 25) {
            if (wc == 0) {
#pragma unroll
                for (int ai = 0; ai < 2; ++ai)
#pragma unroll
                    for (int m = 0; m < 4; ++m) { const int row = row0 + ai * 128 + m * 16; const float rs = rstd_x[row];
                        f32x4 o1[2], o2[2];
#pragma unroll
                        for (int n = 0; n < 2; ++n) { const f32x4 c = *(const f32x4*)(cosT + (size_t)row * 32 + 8 * fq + 4 * n), s = *(const f32x4*)(sinT + (size_t)row * 32 + 8 * fq + 4 * n);
                            const f32x4 x1 = acc[ai][0][m][n] * rs, x2 = acc[ai][1][m][n] * rs; o1[n] = x1 * c - x2 * s; o2[n] = x2 * c + x1 * s; }
                        const u32x4 w1 = pack8f(o1[0], o1[1]), w2 = pack8f(o2[0], o2[1]);
                        bf16* kp = Km + (size_t)row * 1536 + 128 + 8 * fq;
#pragma unroll
                        for (int h = 0; h < 8; ++h) { *(u32x4*)(kp + h * 192) = w1; *(u32x4*)(kp + h * 192 + 32) = w2; } }
            } else if (wc == 1 && fq == 0) {
#pragma unroll
                for (int ai = 0; ai < 2; ++ai)
#pragma unroll
                    for (int m = 0; m < 4; ++m) { const int row = row0 + ai * 128 + m * 16; const float rs = rstd_x[row];
                        *(f32x4*)(flog + (size_t)row * 8) = acc[ai][0][m][0] * rs; *(f32x4*)(flog + (size_t)row * 8 + 4) = acc[ai][0][m][1] * rs; }
            }
            return;
        }
        bf16* base; int ld, colt, mode = 0; float* part = nullptr; int nslot = 0, slot0 = 0;
        if (pn < 3) { base = qlat; ld = 768; colt = pn * 256; part = partq; nslot = 12; slot0 = pn * 4; }
        else if (pn < 5) { base = kvlat; ld = 512; colt = (pn - 3) * 256; part = partkv; nslot = 8; slot0 = (pn - 3) * 4; }
        else if (pn < 9) { base = G; ld = 2048; colt = (pn - 5) * 256; mode = 1; }
        else if (pn < 13) { base = Qf; ld = 1024; colt = (pn - 9) * 256; mode = 2; }
        else if (pn < 17) { base = Kf; ld = 1024; colt = (pn - 13) * 256; }
        else if (pn < 21) { base = Vf; ld = 1024; colt = (pn - 17) * 256; }
        else { base = G; ld = 2048; colt = 1024 + (pn - 21) * 256; mode = 1; }
        const int col0 = colt + wc * 32 + 8 * fq;
#pragma unroll
        for (int ai = 0; ai < 2; ++ai)
#pragma unroll
            for (int m = 0; m < 4; ++m) { const int row = row0 + ai * 128 + m * 16; float rs = rstd_x[row]; if (mode == 2) rs *= C2F;
                bf16* rowp = base + (size_t)row * ld + col0; float ss = 0.f;
#pragma unroll
                for (int bj = 0; bj < 2; ++bj) { f32x4 v0 = acc[ai][bj][m][0] * rs, v1 = acc[ai][bj][m][1] * rs;
                    ss += (v0[0] * v0[0] + v0[1] * v0[1]) + (v0[2] * v0[2] + v0[3] * v0[3]) + (v1[0] * v1[0] + v1[1] * v1[1]) + (v1[2] * v1[2] + v1[3] * v1[3]);
                    if (mode == 1) {
#pragma unroll
                        for (int e = 0; e < 4; ++e) { v0[e] = silu_f(v0[e]); v1[e] = silu_f(v1[e]); } }
                    *(u32x4*)(rowp + bj * 128) = pack8f(v0, v1); }
                if (part) { ss += __shfl_xor(ss, 16); ss += __shfl_xor(ss, 32); if (fq == 0) part[(size_t)row * nslot + slot0 + wc] = ss; } }
    }
};
struct EpiQ {
    static constexpr bool PERM = true, AFTER_DRAIN = false;
    const float* partq; bf16* Qm; const float *cosT, *sinT;
    __device__ __forceinline__ void operator()(const af4 (&acc)[2][2][4][2], const pg8::Unit& u, int wr, int wc, int fr, int fq) const {
        const int pn = u.pn; const int row0 = u.pm * 256 + wr * 64 + fr;
#pragma unroll
        for (int ai = 0; ai < 2; ++ai)
#pragma unroll
            for (int m = 0; m < 4; ++m) { const int row = row0 + ai * 128 + m * 16;
                const f32x4 pa = *(const f32x4*)(partq + (size_t)row * 12), pb = *(const f32x4*)(partq + (size_t)row * 12 + 4), pc = *(const f32x4*)(partq + (size_t)row * 12 + 8);
                const float ssq = ((pa[0] + pa[1]) + (pa[2] + pa[3])) + ((pb[0] + pb[1]) + (pb[2] + pb[3])) + ((pc[0] + pc[1]) + (pc[2] + pc[3]));
                const float rs = C2M / sqrtf(ssq * (1.f / 768.f) + EPS);
                if (pn < 4) {
#pragma unroll
                    for (int bj = 0; bj < 2; ++bj) *(u32x4*)(Qm + (size_t)row * 1536 + (2 * pn + bj) * 192 + wc * 32 + 8 * fq) = pack8f(acc[ai][bj][m][0] * rs, acc[ai][bj][m][1] * rs);
                } else { const int head = 4 * (pn - 4) + wc; f32x4 o1[2], o2[2];
#pragma unroll
                    for (int n = 0; n < 2; ++n) { const f32x4 c = *(const f32x4*)(cosT + (size_t)row * 32 + 8 * fq + 4 * n), s = *(const f32x4*)(sinT + (size_t)row * 32 + 8 * fq + 4 * n);
                        const f32x4 x1 = acc[ai][0][m][n] * rs, x2 = acc[ai][1][m][n] * rs; o1[n] = x1 * c - x2 * s; o2[n] = x2 * c + x1 * s; }
                    bf16* qp = Qm + (size_t)row * 1536 + head * 192 + 128 + 8 * fq;
                    *(u32x4*)qp = pack8f(o1[0], o1[1]); *(u32x4*)(qp + 32) = pack8f(o2[0], o2[1]); } }
    }
};
struct EpiKV {
    static constexpr bool PERM = true, AFTER_DRAIN = false;
    const float* partkv; bf16 *Km, *Vm;
    __device__ __forceinline__ void operator()(const af4 (&acc)[2][2][4][2], const pg8::Unit& u, int wr, int wc, int fr, int fq) const {
        const int pn = u.pn; const int row0 = u.pm * 256 + wr * 64 + fr;
#pragma unroll
        for (int ai = 0; ai < 2; ++ai)
#pragma unroll
            for (int m = 0; m < 4; ++m) { const int row = row0 + ai * 128 + m * 16;
                const f32x4 pa = *(const f32x4*)(partkv + (size_t)row * 8), pb = *(const f32x4*)(partkv + (size_t)row * 8 + 4);
                const float ssq = ((pa[0] + pa[1]) + (pa[2] + pa[3])) + ((pb[0] + pb[1]) + (pb[2] + pb[3]));
                const float rs = 1.f / sqrtf(ssq * (1.f / 512.f) + EPS);
                *(u32x4*)(Km + (size_t)row * 1536 + pn * 192 + wc * 32 + 8 * fq) = pack8f(acc[ai][0][m][0] * rs, acc[ai][0][m][1] * rs);
                *(u32x4*)(Vm + (size_t)row * 1024 + pn * 128 + wc * 32 + 8 * fq) = pack8f(acc[ai][1][m][0] * rs, acc[ai][1][m][1] * rs); }
    }
};
struct EpiOut {
    static constexpr bool PERM = true, AFTER_DRAIN = false;
    bf16* Y; float* party;
    __device__ __forceinline__ void operator()(const af4 (&acc)[2][2][4][2], const pg8::Unit& u, int wr, int wc, int fr, int fq) const {
        const int pn = u.pn; const int row0 = u.pm * 256 + wr * 64 + fr; const int col0 = pn * 256 + wc * 32 + 8 * fq;
#pragma unroll
        for (int ai = 0; ai < 2; ++ai)
#pragma unroll
            for (int m = 0; m < 4; ++m) { const int row = row0 + ai * 128 + m * 16; float ss = 0.f;
#pragma unroll
                for (int bj = 0; bj < 2; ++bj) { const f32x4 v0 = acc[ai][bj][m][0], v1 = acc[ai][bj][m][1];
                    ss += (v0[0] * v0[0] + v0[1] * v0[1]) + (v0[2] * v0[2] + v0[3] * v0[3]) + (v1[0] * v1[0] + v1[1] * v1[1]) + (v1[2] * v1[2] + v1[3] * v1[3]);
                    *(u32x4*)(Y + (size_t)row * 2048 + col0 + bj * 128) = pack8f(v0, v1); }
                ss += __shfl_xor(ss, 16); ss += __shfl_xor(ss, 32); if (fq == 0) party[(size_t)row * 32 + pn * 4 + wc] = ss; }
    }
};

namespace att {
constexpr int KVBLK = 64, QBLK = 32, QB = 256;
constexpr int SHM_K = 24576, SHM_V = 16384;
constexpr int NRING = 3;
constexpr int OFF_K = 0, OFF_V = NRING * SHM_K, OFF_CK = OFF_V + NRING * SHM_V, OFF_WS = OFF_CK + 1024, OFF_QP = OFF_WS + 2048;
constexpr float THR = 20.f;
#define KSWZ(row, colB) ((row) * 256 + ((colB) ^ (((row) & 7) << 4)))
#define SBAR() __builtin_amdgcn_sched_barrier(0)
__device__ __forceinline__ int v_st(int k, int c) { const int kk = (k & ~0xC) | ((k & 4) << 1) | ((k & 8) >> 1); return ((kk >> 3) * 4 + (c >> 5)) * 512 + ((kk & 7) * 32 + (c & 31)) * 2; }
__device__ __forceinline__ int v_rd_base(int lane) { return ((lane & 3) << 3) | (((lane >> 2) & 3) << 6) | (((lane >> 4) & 1) << 5) | (((lane >> 5) & 1) << 8); }
constexpr int v_rd_off(int d0, int ks, int half) { return d0 * 512 + ks * 4096 + half * 2048; }
__device__ __forceinline__ int crow(int r, int hi) { return (r & 3) + 8 * (r >> 2) + 4 * hi; }
__device__ __forceinline__ unsigned cvtpk(float lo, float hi) { unsigned r; asm volatile("v_cvt_pk_bf16_f32 %0, %1, %2" : "=v"(r) : "v"(lo), "v"(hi)); return r; }

__device__ __forceinline__ void mask_tile(f32x16& p0, f32x16& p1, int dq) {
    const float NEG = -__builtin_inff();
#pragma unroll
    for (int r = 0; r < 16; ++r) { const int c = (r & 3) + 8 * (r >> 2);
        if (dq - c < 0) p0[r] = NEG;
        if (dq - c - 32 < 0) p1[r] = NEG; }
}
__device__ __forceinline__ void softmax_tile(f32x16& p0, f32x16& p1, float cq, float& m_reg, float& l_reg, float& alpha, bf16x8& pa0, bf16x8& pa1, bf16x8& pa2, bf16x8& pa3) {
    float ma = __builtin_fmaxf(__builtin_fmaxf(p0[0], p0[1]), p0[2]), mb = __builtin_fmaxf(__builtin_fmaxf(p1[0], p1[1]), p1[2]);
#pragma unroll
    for (int r = 3; r < 15; r += 2) { ma = __builtin_fmaxf(__builtin_fmaxf(ma, p0[r]), p0[r + 1]); mb = __builtin_fmaxf(__builtin_fmaxf(mb, p1[r]), p1[r + 1]); }
    float pmax = __builtin_fmaxf(__builtin_fmaxf(ma, mb), __builtin_fmaxf(p0[15], p1[15]));
    { auto rr = __builtin_amdgcn_permlane32_swap(__float_as_uint(pmax), __float_as_uint(pmax), false, false);
      pmax = fmaxf(__uint_as_float(rr[0]), __uint_as_float(rr[1])); }
    pmax += cq;
    float mn;
    if (__builtin_expect(__all(pmax - m_reg <= THR), 1)) { mn = m_reg; alpha = 1.f; }
    else { mn = fmaxf(m_reg, pmax); alpha = __builtin_amdgcn_exp2f(m_reg - mn); m_reg = mn; }
    const float sh = mn - cq;
#pragma unroll
    for (int r = 0; r < 16; ++r) { p0[r] = __builtin_amdgcn_exp2f(p0[r] - sh); p1[r] = __builtin_amdgcn_exp2f(p1[r] - sh); }
    float ps = 0.f;
#pragma unroll
    for (int r = 0; r < 16; ++r) ps += p0[r];
#pragma unroll
    for (int r = 0; r < 16; ++r) ps += p1[r];
    { auto rr = __builtin_amdgcn_permlane32_swap(__float_as_uint(ps), __float_as_uint(ps), false, false);
      ps = __uint_as_float(rr[0]) + __uint_as_float(rr[1]); }
    l_reg = l_reg * alpha + ps;
#define PK4(P, B_, OUT) do { unsigned a0 = cvtpk(P[B_+0], P[B_+1]), a1 = cvtpk(P[B_+2], P[B_+3]);                          \
        unsigned b0 = cvtpk(P[B_+4], P[B_+5]), b1 = cvtpk(P[B_+6], P[B_+7]);                                             \
        auto r0 = __builtin_amdgcn_permlane32_swap(a0, b0, false, false); auto r1 = __builtin_amdgcn_permlane32_swap(a1, b1, false, false); \
        u32x4 w = {r0[0], r1[0], r0[1], r1[1]}; OUT = *reinterpret_cast<bf16x8*>(&w); } while (0)
    PK4(p0, 0, pa0); PK4(p0, 8, pa1); PK4(p1, 0, pa2); PK4(p1, 8, pa3);
#undef PK4
}
template <int DQK, int NPARK>
__device__ __forceinline__ void qkt(f32x16& p0, f32x16& p1, const char* Kb, int r32, int hi, const bf16x8* qr, const char* qpk) {
    constexpr int ND = DQK / 16, NQR = ND - NPARK;
    p0 = f32x16{}; p1 = f32x16{};
    const char* kb[4];
#pragma unroll
    for (int dd = 0; dd < 4; ++dd) kb[dd] = Kb + KSWZ(r32, (dd * 16 + hi * 8) * 2);
    const char* kr = Kb + 16384 + r32 * 128;
    const int rx = (r32 & 7) << 4;
    bf16x8 kf[3][2], qf[3];
#define QK_LD(set, d_) do { \
            if ((d_) < 8) { const char* a_ = kb[(d_) & 3] + ((d_) >> 2) * 128; kf[set][0] = *reinterpret_cast<const bf16x8*>(a_); kf[set][1] = *reinterpret_cast<const bf16x8*>(a_ + 32 * 256); } \
            else { const char* a_ = kr + (((((d_) - 8) * 16 + hi * 8) * 2) ^ rx); kf[set][0] = *reinterpret_cast<const bf16x8*>(a_); kf[set][1] = *reinterpret_cast<const bf16x8*>(a_ + 32 * 128); } \
            if ((d_) >= NQR) qf[set] = *reinterpret_cast<const bf16x8*>(qpk + ((d_) - NQR) * 1024); } while (0)
    QK_LD(0, 0); QK_LD(1, 1); SBAR();
#pragma unroll
    for (int d = 0; d < ND; ++d) {
        const int cs = d % 3;
        if (d + 2 < ND) { const int ns = (d + 2) % 3; if (ns == 0) QK_LD(0, d + 2); else if (ns == 1) QK_LD(1, d + 2); else QK_LD(2, d + 2); SBAR(); }
        const bf16x8 q = (d < NQR) ? qr[d < NQR ? d : 0] : qf[cs];
        p0 = __builtin_amdgcn_mfma_f32_32x32x16_bf16(kf[cs][0], q, p0, 0, 0, 0);
        p1 = __builtin_amdgcn_mfma_f32_32x32x16_bf16(kf[cs][1], q, p1, 0, 0, 0);
        SBAR();
    }
#undef QK_LD
}
template <int VOFF>
__device__ __forceinline__ void pv_tile(f32x16* o, int vb0, bf16x8 pa0, bf16x8 pa1, bf16x8 pa2, bf16x8 pa3) {
#define TRRD(dst, off) asm volatile("ds_read_b64_tr_b16 %0, %1 offset:%2" : "=&v"(dst) : "v"(vb0), "i"(off) : "memory")
#define PV_D0(d0) do { s16x4 l0, l1, l2, l3, h0, h1, h2, h3; constexpr int b_ = VOFF + v_rd_off(d0, 0, 0); \
        TRRD(l0, b_); TRRD(h0, b_ + 2048); TRRD(l1, b_ + 4096); TRRD(h1, b_ + 6144); TRRD(l2, b_ + 8192); TRRD(h2, b_ + 10240); TRRD(l3, b_ + 12288); TRRD(h3, b_ + 14336); \
        asm volatile("s_waitcnt lgkmcnt(0)" ::: "memory"); SBAR(); \
        o[d0] = __builtin_amdgcn_mfma_f32_32x32x16_bf16(pa0, (bf16x8){l0[0], l0[1], l0[2], l0[3], h0[0], h0[1], h0[2], h0[3]}, o[d0], 0, 0, 0);   \
        o[d0] = __builtin_amdgcn_mfma_f32_32x32x16_bf16(pa1, (bf16x8){l1[0], l1[1], l1[2], l1[3], h1[0], h1[1], h1[2], h1[3]}, o[d0], 0, 0, 0);   \
        o[d0] = __builtin_amdgcn_mfma_f32_32x32x16_bf16(pa2, (bf16x8){l2[0], l2[1], l2[2], l2[3], h2[0], h2[1], h2[2], h2[3]}, o[d0], 0, 0, 0);   \
        o[d0] = __builtin_amdgcn_mfma_f32_32x32x16_bf16(pa3, (bf16x8){l3[0], l3[1], l3[2], l3[3], h3[0], h3[1], h3[2], h3[3]}, o[d0], 0, 0, 0); } while (0)
    PV_D0(0); PV_D0(1); PV_D0(2); PV_D0(3);
#undef PV_D0
#undef TRRD
}

#define RD128(dst, addr, off) asm volatile("ds_read_b128 %0, %1 offset:%2" : "=&v"(dst) : "v"(addr), "i"(off) : "memory")
#define RDTR(dst, addr, off) asm volatile("ds_read_b64_tr_b16 %0, %1 offset:%2" : "=&v"(dst) : "v"(addr), "i"(off) : "memory")
#define WAITK(n, x) asm volatile("s_waitcnt lgkmcnt(%1)" : "+v"(x) : "n"(n) : "memory")
#define WAITKQ(n, x, q) asm volatile("s_waitcnt lgkmcnt(%2)" : "+v"(x), "+v"(q) : "n"(n) : "memory")
#define WAITV(n, x, y) asm volatile("s_waitcnt lgkmcnt(%2)" : "+v"(x), "+v"(y) : "n"(n) : "memory")

__device__ __forceinline__ void mblock_mla_q(f32x16& p0, f32x16& p1, f32x16* o, const bf16x8* qr, bf16x8 pa0, bf16x8 pa1, bf16x8 pa2, bf16x8 pa3, const unsigned* kbv, const unsigned* krv, unsigned qpkv, unsigned vbv) {
    bf16x8 ksl[5], qsl[3]; s16x4 vlo[5], vhi[5];
    p0 = f32x16{}; p1 = f32x16{};
    RD128(ksl[0], kbv[0], 0);
    RD128(ksl[1], kbv[0], 8192);
    RD128(ksl[2], kbv[1], 0);
    RD128(ksl[3], kbv[1], 8192);
    RD128(ksl[4], kbv[2], 0);
    WAITK(4, ksl[0]); p0 = __builtin_amdgcn_mfma_f32_32x32x16_bf16(ksl[0], qr[0], p0, 0, 0, 0);
    RD128(ksl[0], kbv[2], 8192);
    WAITK(4, ksl[1]); p1 = __builtin_amdgcn_mfma_f32_32x32x16_bf16(ksl[1], qr[0], p1, 0, 0, 0);
    RD128(ksl[1], kbv[3], 0);
    WAITK(4, ksl[2]); p0 = __builtin_amdgcn_mfma_f32_32x32x16_bf16(ksl[2], qr[1], p0, 0, 0, 0);
    RD128(ksl[2], kbv[3], 8192);
    WAITK(4, ksl[3]); p1 = __builtin_amdgcn_mfma_f32_32x32x16_bf16(ksl[3], qr[1], p1, 0, 0, 0);
    RD128(ksl[3], kbv[0], 128);
    WAITK(4, ksl[4]); p0 = __builtin_amdgcn_mfma_f32_32x32x16_bf16(ksl[4], qr[2], p0, 0, 0, 0);
    RD128(ksl[4], kbv[0], 8320);
    WAITK(4, ksl[0]); p1 = __builtin_amdgcn_mfma_f32_32x32x16_bf16(ksl[0], qr[2], p1, 0, 0, 0);
    RD128(ksl[0], kbv[1], 128);
    WAITK(4, ksl[1]); p0 = __builtin_amdgcn_mfma_f32_32x32x16_bf16(ksl[1], qr[3], p0, 0, 0, 0);
    RD128(ksl[1], kbv[1], 8320);
    WAITK(4, ksl[2]); p1 = __builtin_amdgcn_mfma_f32_32x32x16_bf16(ksl[2], qr[3], p1, 0, 0, 0);
    RD128(ksl[2], kbv[2], 128);
    WAITK(4, ksl[3]); p0 = __builtin_amdgcn_mfma_f32_32x32x16_bf16(ksl[3], qr[4], p0, 0, 0, 0);
    RD128(ksl[3], kbv[2], 8320);
    WAITK(4, ksl[4]); p1 = __builtin_amdgcn_mfma_f32_32x32x16_bf16(ksl[4], qr[4], p1, 0, 0, 0);
    RD128(ksl[4], kbv[3], 128);
    WAITK(4, ksl[0]); p0 = __builtin_amdgcn_mfma_f32_32x32x16_bf16(ksl[0], qr[5], p0, 0, 0, 0);
    RD128(ksl[0], kbv[3], 8320);
    WAITK(4, ksl[1]); p1 = __builtin_amdgcn_mfma_f32_32x32x16_bf16(ksl[1], qr[5], p1, 0, 0, 0);
    RD128(ksl[1], krv[0], 0); RD128(qsl[2], qpkv, 0);
    WAITK(5, ksl[2]); p0 = __builtin_amdgcn_mfma_f32_32x32x16_bf16(ksl[2], qr[6], p0, 0, 0, 0);
    RD128(ksl[2], krv[0], 4096);
    WAITK(5, ksl[3]); p1 = __builtin_amdgcn_mfma_f32_32x32x16_bf16(ksl[3], qr[6], p1, 0, 0, 0);
    RD128(ksl[3], krv[1], 0); RD128(qsl[0], qpkv, 1024);
    WAITK(6, ksl[4]); p0 = __builtin_amdgcn_mfma_f32_32x32x16_bf16(ksl[4], qr[7], p0, 0, 0, 0);
    RD128(ksl[4], krv[1], 4096);
    WAITK(6, ksl[0]); p1 = __builtin_amdgcn_mfma_f32_32x32x16_bf16(ksl[0], qr[7], p1, 0, 0, 0);
    RD128(ksl[0], krv[2], 0); RD128(qsl[1], qpkv, 2048);
    WAITKQ(6, ksl[1], qsl[2]); p0 = __builtin_amdgcn_mfma_f32_32x32x16_bf16(ksl[1], qsl[2], p0, 0, 0, 0);
    RD128(ksl[1], krv[2], 4096);
    WAITKQ(6, ksl[2], qsl[2]); p1 = __builtin_amdgcn_mfma_f32_32x32x16_bf16(ksl[2], qsl[2], p1, 0, 0, 0);
    RD128(ksl[2], krv[3], 0); RD128(qsl[2], qpkv, 3072);
    WAITKQ(6, ksl[3], qsl[0]); p0 = __builtin_amdgcn_mfma_f32_32x32x16_bf16(ksl[3], qsl[0], p0, 0, 0, 0);
    RD128(ksl[3], krv[3], 4096);
    WAITKQ(6, ksl[4], qsl[0]); p1 = __builtin_amdgcn_mfma_f32_32x32x16_bf16(ksl[4], qsl[0], p1, 0, 0, 0);
    WAITKQ(4, ksl[0], qsl[1]); p0 = __builtin_amdgcn_mfma_f32_32x32x16_bf16(ksl[0], qsl[1], p0, 0, 0, 0);
    WAITKQ(3, ksl[1], qsl[1]); p1 = __builtin_amdgcn_mfma_f32_32x32x16_bf16(ksl[1], qsl[1], p1, 0, 0, 0);
    WAITKQ(1, ksl[2], qsl[2]); p0 = __builtin_amdgcn_mfma_f32_32x32x16_bf16(ksl[2], qsl[2], p0, 0, 0, 0);
    WAITKQ(0, ksl[3], qsl[2]); p1 = __builtin_amdgcn_mfma_f32_32x32x16_bf16(ksl[3], qsl[2], p1, 0, 0, 0);
}
__device__ __forceinline__ void mblock_fox_q(f32x16& p0, f32x16& p1, f32x16* o, const bf16x8* qr, bf16x8 pa0, bf16x8 pa1, bf16x8 pa2, bf16x8 pa3, const unsigned* kbv, const unsigned* krv, unsigned qpkv, unsigned vbv) {
    bf16x8 ksl[5], qsl[3]; s16x4 vlo[5], vhi[5];
    p0 = f32x16{}; p1 = f32x16{};
    RD128(ksl[0], kbv[0], 0);
    RD128(ksl[1], kbv[0], 8192);
    RD128(ksl[2], kbv[1], 0);
    RD128(ksl[3], kbv[1], 8192);
    RD128(ksl[4], kbv[2], 0);
    WAITK(4, ksl[0]); p0 = __builtin_amdgcn_mfma_f32_32x32x16_bf16(ksl[0], qr[0], p0, 0, 0, 0);
    RD128(ksl[0], kbv[2], 8192);
    WAITK(4, ksl[1]); p1 = __builtin_amdgcn_mfma_f32_32x32x16_bf16(ksl[1], qr[0], p1, 0, 0, 0);
    RD128(ksl[1], kbv[3], 0);
    WAITK(4, ksl[2]); p0 = __builtin_amdgcn_mfma_f32_32x32x16_bf16(ksl[2], qr[1], p0, 0, 0, 0);
    RD128(ksl[2], kbv[3], 8192);
    WAITK(4, ksl[3]); p1 = __builtin_amdgcn_mfma_f32_32x32x16_bf16(ksl[3], qr[1], p1, 0, 0, 0);
    RD128(ksl[3], kbv[0], 128); RD128(qsl[1], qpkv, 0);
    WAITK(5, ksl[4]); p0 = __builtin_amdgcn_mfma_f32_32x32x16_bf16(ksl[4], qr[2], p0, 0, 0, 0);
    RD128(ksl[4], kbv[0], 8320);
    WAITK(5, ksl[0]); p1 = __builtin_amdgcn_mfma_f32_32x32x16_bf16(ksl[0], qr[2], p1, 0, 0, 0);
    RD128(ksl[0], kbv[1], 128); RD128(qsl[2], qpkv, 1024);
    WAITK(6, ksl[1]); p0 = __builtin_amdgcn_mfma_f32_32x32x16_bf16(ksl[1], qr[3], p0, 0, 0, 0);
    RD128(ksl[1], kbv[1], 8320);
    WAITK(6, ksl[2]); p1 = __builtin_amdgcn_mfma_f32_32x32x16_bf16(ksl[2], qr[3], p1, 0, 0, 0);
    RD128(ksl[2], kbv[2], 128); RD128(qsl[0], qpkv, 2048);
    WAITKQ(6, ksl[3], qsl[1]); p0 = __builtin_amdgcn_mfma_f32_32x32x16_bf16(ksl[3], qsl[1], p0, 0, 0, 0);
    RD128(ksl[3], kbv[2], 8320);
    WAITKQ(6, ksl[4], qsl[1]); p1 = __builtin_amdgcn_mfma_f32_32x32x16_bf16(ksl[4], qsl[1], p1, 0, 0, 0);
    RD128(ksl[4], kbv[3], 128); RD128(qsl[1], qpkv, 3072);
    WAITKQ(6, ksl[0], qsl[2]); p0 = __builtin_amdgcn_mfma_f32_32x32x16_bf16(ksl[0], qsl[2], p0, 0, 0, 0);
    RD128(ksl[0], kbv[3], 8320);
    WAITKQ(6, ksl[1], qsl[2]); p1 = __builtin_amdgcn_mfma_f32_32x32x16_bf16(ksl[1], qsl[2], p1, 0, 0, 0);
    WAITKQ(4, ksl[2], qsl[0]); p0 = __builtin_amdgcn_mfma_f32_32x32x16_bf16(ksl[2], qsl[0], p0, 0, 0, 0);
    WAITKQ(3, ksl[3], qsl[0]); p1 = __builtin_amdgcn_mfma_f32_32x32x16_bf16(ksl[3], qsl[0], p1, 0, 0, 0);
    WAITKQ(1, ksl[4], qsl[1]); p0 = __builtin_amdgcn_mfma_f32_32x32x16_bf16(ksl[4], qsl[1], p0, 0, 0, 0);
    WAITKQ(0, ksl[0], qsl[1]); p1 = __builtin_amdgcn_mfma_f32_32x32x16_bf16(ksl[0], qsl[1], p1, 0, 0, 0);
}
#undef RD128
#undef RDTR
#undef WAITK
#undef WAITKQ
#undef WAITV

template <int DQK, bool FOX, int ABL = 0>
__device__ __forceinline__ void attn_unit(char* lds, const bf16* Q, int ldq, const bf16* K, int ldk, const bf16* V, int ldv, const float* cfs, const bf16* Gp, bf16* Op, int qb) {
    const int tid = threadIdx.x, wid = __builtin_amdgcn_readfirstlane(tid >> 6), lane = tid & 63, r32 = lane & 31, hi = lane >> 5;
    const bool grpA = wid < 4; const int w4 = wid & 3;
    const int q0 = qb * QB, NT = 4 * (qb + 1);
    char* K_lds = lds + OFF_K; char* V_lds = lds + OFF_V; float* ck_l = (float*)(lds + OFF_CK);
    float* wsf = (float*)(lds + OFF_WS) + wid * 64; float* li_l = wsf; float* al_l = wsf + 32;
    constexpr int NPARK = 4, NQR = DQK / 16 - NPARK;
    bf16x8 qr[NQR];
    char* qpk = lds + OFF_QP + wid * 4096 + (hi * 32 + r32) * 16;
    unsigned koff, kroff = 0, voff;
    { const int row = 4 * w4 + (lane >> 4), c = (lane & 15) ^ (row & 7); koff = (unsigned)(row * ldk + c * 8) * 2u; }
    { const int s0 = 2 * w4 + (lane >> 5), kk = 8 * (s0 >> 2) + ((lane & 31) >> 2), k = (kk & ~0xC) | ((kk & 4) << 1) | ((kk & 8) >> 1); voff = (unsigned)(k * ldv + 32 * (s0 & 3) + 8 * (lane & 3)) * 2u; }
    if constexpr (DQK == 192) { const int row = 8 * w4 + (lane >> 3), c = (lane & 7) ^ (row & 7); kroff = (unsigned)(row * ldk + 128 + c * 8) * 2u; }
    const int vb0 = (int)(uintptr_t)V_lds + v_rd_base(lane);
    LAS unsigned char* ldsl = (LAS unsigned char*)(uintptr_t)(unsigned)(uintptr_t)lds;
    unsigned kb0[4], kr0[4];
#pragma unroll
    for (int i = 0; i < 4; ++i) { const unsigned xo = (unsigned)((i * 32 + hi * 16) ^ ((r32 & 7) << 4)); kb0[i] = (unsigned)(uintptr_t)K_lds + r32 * 256 + xo; kr0[i] = (unsigned)(uintptr_t)K_lds + 16384 + r32 * 128 + xo; }
    const unsigned qpkv = (unsigned)(uintptr_t)qpk;
#define DMA_K(t, bf) do { const char* kt_ = (const char*)K + (size_t)(t) * KVBLK * ldk * 2; \
        _Pragma("unroll") for (int j_ = 0; j_ < 4; ++j_) \
            __builtin_amdgcn_global_load_lds((const unsigned*)(kt_ + koff + (size_t)j_ * 16 * ldk * 2), (LAS unsigned*)(ldsl + OFF_K + (bf) * SHM_K + (w4 + 4 * j_) * 1024), 16, 0, 0); \
        if constexpr (DQK == 192) { _Pragma("unroll") for (int j_ = 0; j_ < 2; ++j_) \
            __builtin_amdgcn_global_load_lds((const unsigned*)(kt_ + kroff + (size_t)j_ * 32 * ldk * 2), (LAS unsigned*)(ldsl + OFF_K + (bf) * SHM_K + 16384 + (w4 + 4 * j_) * 1024), 16, 0, 0); } \
        if constexpr (FOX) { __builtin_amdgcn_global_load_lds((const unsigned*)(cfs + (t) * KVBLK + lane), (LAS unsigned*)(ldsl + OFF_CK + ((t) & 3) * 256), 4, 0, 0); } } while (0)
#define DMA_V(t, bf) do { const char* vt_ = (const char*)V + (size_t)(t) * KVBLK * ldv * 2; \
        _Pragma("unroll") for (int j_ = 0; j_ < 4; ++j_) \
            __builtin_amdgcn_global_load_lds((const unsigned*)(vt_ + voff + (size_t)j_ * 16 * ldv * 2), (LAS unsigned*)(ldsl + OFF_V + (bf) * SHM_V + (w4 + 4 * j_) * 1024), 16, 0, 0); } while (0)
#define BAR_L() asm volatile("s_waitcnt lgkmcnt(0)\n\ts_barrier" ::: "memory")
#define BAR_VL() asm volatile("s_waitcnt vmcnt(0) lgkmcnt(0)\n\ts_barrier" ::: "memory")
    constexpr int NDK = 4 + (DQK == 192 ? 2 : 0) + (FOX ? 1 : 0), NDV = 4;
#define BAR_VN(n) asm volatile("s_waitcnt vmcnt(%0) lgkmcnt(0)\n\ts_barrier" :: "n"(n) : "memory")
    if (grpA) { DMA_K(0, 0); DMA_K(1, 1); DMA_V(0, 0); }
    { const bf16* qp = Q + (size_t)(q0 + wid * QBLK + r32) * ldq + hi * 8;
#pragma unroll
      for (int d0 = 0; d0 < NQR; ++d0) qr[d0] = *(const bf16x8*)(qp + d0 * 16);
#pragma unroll
      for (int d0 = 0; d0 < NPARK; ++d0) *(bf16x8*)(qpk + d0 * 1024) = *(const bf16x8*)(qp + (NQR + d0) * 16); }
    float cq = 0.f; if constexpr (FOX) cq = cfs[q0 + wid * QBLK + r32];
    BAR_VL();
    if (!grpA) BAR_L();
    float m_reg = -1e30f, l_reg = 0.f; f32x16 o[4] = {}; f32x16 p0 = {}, p1 = {}; bf16x8 pa0 = {}, pa1 = {}, pa2 = {}, pa3 = {};
#define ACTW(tt) ((tt) - (NT - 4) < 0 || 64 * ((tt) - (NT - 4)) <= 32 * wid + 31)
    int rc = 0, rp = 2, rn = 1;
#pragma unroll 1
    for (int t = 0; t < NT; ++t) {
        if (grpA && !(ABL & 1)) { if (t + 2 < NT) DMA_K(t + 2, rp); if (t + 1 < NT) DMA_V(t + 1, rn); }
        const int jb_ = t - (NT - 4); const bool act_ = ACTW(t);
        if (act_ && !(ABL & 4)) { unsigned kbv[4], krv[4];
#pragma unroll
            for (int i = 0; i < 4; ++i) { kbv[i] = kb0[i] + rc * SHM_K; krv[i] = kr0[i] + rc * SHM_K; }
            if constexpr (DQK == 192) mblock_mla_q(p0, p1, o, qr, pa0, pa1, pa2, pa3, kbv, krv, qpkv, 0u); else mblock_fox_q(p0, p1, o, qr, pa0, pa1, pa2, pa3, kbv, krv, qpkv, 0u); }
        if (t > 0 && ACTW(t - 1) && !(ABL & 4)) { SBAR(); pv_tile<0>(o, vb0 + rp * SHM_V, pa0, pa1, pa2, pa3); }
        BAR_L();
        if (act_ && (ABL & 8)) {
#define PK4(P, B_, OUT) do { unsigned a0 = cvtpk(P[B_+0], P[B_+1]), a1 = cvtpk(P[B_+2], P[B_+3]); unsigned b0 = cvtpk(P[B_+4], P[B_+5]), b1 = cvtpk(P[B_+6], P[B_+7]); \
        auto r0 = __builtin_amdgcn_permlane32_swap(a0, b0, false, false); auto r1 = __builtin_amdgcn_permlane32_swap(a1, b1, false, false); u32x4 w = {r0[0], r1[0], r0[1], r1[1]}; OUT = *reinterpret_cast<bf16x8*>(&w); } while (0)
            PK4(p0, 0, pa0); PK4(p0, 8, pa1); PK4(p1, 0, pa2); PK4(p1, 8, pa3);
#undef PK4
        }
        if (act_ && !(ABL & 2)) { float alpha;
            if constexpr (FOX) { const float* ckp = ck_l + (t & 3) * 64 + 4 * hi;
#pragma unroll
                for (int g_ = 0; g_ < 4; ++g_) { const f32x4 c0 = *(const f32x4*)(ckp + 8 * g_), c1 = *(const f32x4*)(ckp + 32 + 8 * g_);
#pragma unroll
                    for (int e_ = 0; e_ < 4; ++e_) { p0[4 * g_ + e_] -= c0[e_]; p1[4 * g_ + e_] -= c1[e_]; } } }
            if (jb_ >= 0 && 64 * jb_ + 63 > 32 * wid) mask_tile(p0, p1, 32 * wid + r32 - 64 * jb_ - 4 * hi);
            softmax_tile(p0, p1, cq, m_reg, l_reg, alpha, pa0, pa1, pa2, pa3);
            if (__any(alpha < 1.f)) { if (hi == 0) al_l[r32] = alpha; asm volatile("s_waitcnt lgkmcnt(0)" ::: "memory");
#pragma unroll
                for (int d_ = 0; d_ < 4; ++d_)
#pragma unroll
                    for (int r = 0; r < 16; ++r) o[d_][r] *= al_l[crow(r, hi)]; }
        }
        if (ABL & 1) BAR_VN(0); else if (t + 2 < NT) BAR_VN(NDK + NDV); else if (t + 1 < NT) BAR_VN(NDV); else BAR_VN(0);
        rp = rc; rc = rn; rn = (rn == NRING - 1) ? 0 : rn + 1;
    }
    if (ACTW(NT - 1)) { SBAR(); pv_tile<0>(o, vb0 + rp * SHM_V, pa0, pa1, pa2, pa3); }
    if (grpA) BAR_L();
#undef BAR_VN
#undef ACTW
#undef DMA_K
#undef DMA_V
    if (hi == 0) li_l[r32] = l_reg; asm volatile("s_waitcnt lgkmcnt(0)" ::: "memory");
    bf16* stg = (bf16*)(lds + wid * 8192);
    const int lane_e = launder(lane);
#pragma unroll
    for (int r = 0; r < 16; ++r) { const int orow = crow(r, hi); const float rl = __builtin_amdgcn_rcpf(li_l[orow]);
#pragma unroll
        for (int d0 = 0; d0 < 4; ++d0) stg[orow * 128 + d0 * 32 + r32] = (bf16)f2bf(o[d0][r] * rl); }
    asm volatile("s_waitcnt lgkmcnt(0)" ::: "memory");
#pragma unroll
    for (int i = 0; i < 8; ++i) { const int row = i * 4 + (lane_e >> 4), ch = lane_e & 15;
        const u32x4 v = *(const u32x4*)(stg + row * 128 + ch * 8);
        const size_t go = (size_t)(q0 + wid * QBLK + row) * 2048 + ch * 8;
        const u32x4 g = *(const u32x4*)(Gp + go); u32x4 w;
        w.x = cvtpk(bflo(v.x) * bflo(g.x), bfhi(v.x) * bfhi(g.x)); w.y = cvtpk(bflo(v.y) * bflo(g.y), bfhi(v.y) * bfhi(g.y));
        w.z = cvtpk(bflo(v.z) * bflo(g.z), bfhi(v.z) * bfhi(g.z)); w.w = cvtpk(bflo(v.w) * bflo(g.w), bfhi(v.w) * bfhi(g.w));
        *(u32x4*)(Op + go) = w; }
    BAR_VL();
#undef BAR_L
#undef BAR_VL
}
#undef KSWZ
#undef SBAR
}

__device__ __forceinline__ void transpose_item(const float* W, int ldw, int K, const float* g, bf16* WT, int dst_row0, int src_col0, int nvalid, int k0, LAS float* scr, int lane) {
    const int n = lane & 31; const bool ok = (src_col0 >= 0) && (n < nvalid);
    float tv[32];
#pragma unroll
    for (int i = 0; i < 32; ++i) { const int kk = 2 * i + (lane >> 5); tv[i] = ok ? W[(size_t)(k0 + kk) * ldw + src_col0 + n] : 0.f; }
    if (g) {
#pragma unroll
        for (int i = 0; i < 32; ++i) tv[i] *= g[k0 + 2 * i + (lane >> 5)]; }
#pragma unroll
    for (int i = 0; i < 32; ++i) scr[(2 * i + (lane >> 5)) * 33 + n] = tv[i];
    asm volatile("s_waitcnt lgkmcnt(0)" ::: "memory");
    const int c = lane & 7;
#pragma unroll
    for (int j = 0; j < 4; ++j) { const int nn = (lane >> 3) + 8 * j; const LAS float* s = scr + (8 * c) * 33 + nn;
        u32x4 o; o.x = pk2(s[0 * 33], s[1 * 33]); o.y = pk2(s[2 * 33], s[3 * 33]); o.z = pk2(s[4 * 33], s[5 * 33]); o.w = pk2(s[6 * 33], s[7 * 33]);
        *(u32x4*)(WT + (size_t)(dst_row0 + nn) * K + k0 + 8 * c) = o; }
    asm volatile("s_waitcnt lgkmcnt(0)" ::: "memory");
}
__device__ __forceinline__ void win_src(int r0, int& src, int& nv) {
    nv = 32;
    if (r0 < 1280) src = r0;
    else if (r0 < 2304) src = 1344 + (r0 - 1280);
    else if (r0 < 3328) src = 2368 + (r0 - 2304);
    else if (r0 < 4352) src = 3392 + (r0 - 3328);
    else if (r0 < 5376) src = 4416 + (r0 - 4352);
    else if (r0 < 6400) src = 5448 + (r0 - 5376);
    else if (r0 == 6400) src = 1280;
    else if (r0 == 6432) { src = 5440; nv = 8; }
    else if (r0 == 6528) src = 1312;
    else src = -1;
}
__device__ __forceinline__ int wuq_src(int r0) {
    if (r0 < 1024) return (r0 >> 7) * 192 + (r0 & 127);
    const int q = r0 - 1024, t = q >> 8, bj = (q >> 7) & 1, wc = (q >> 5) & 3;
    return (4 * t + wc) * 192 + 128 + 32 * bj;
}


#define XB_TMO      128
#define XB_XCNT(j)  (256  + 64 * (j))
#define XB_XSUB(j)  (1280 + 64 * (j))
#define XB_XGEN(j)  (2304 + 64 * (j))
#define XB_TOP      3328
#define XB_TOPGEN   3392
#define XCD_BAR_WORDS 3456
#define XB_SPIN_CAP (1u << 18)
__device__ __forceinline__ unsigned xb_ld(unsigned* p)              { return __hip_atomic_load(p, __ATOMIC_RELAXED, __HIP_MEMORY_SCOPE_AGENT); }
__device__ __forceinline__ unsigned xb_add(unsigned* p, unsigned v) { return __hip_atomic_fetch_add(p, v, __ATOMIC_RELAXED, __HIP_MEMORY_SCOPE_AGENT); }
__device__ __forceinline__ unsigned xb_xcc_id() { return (unsigned)__builtin_amdgcn_s_getreg((3 << 11) | 20) & 0xFu; }
#define XB_SPIN(cond, bar) do { unsigned _sp = 0; while (cond) { __builtin_amdgcn_s_sleep(1); \
    if ((++_sp & 255u) == 0u) { if (xb_ld(&(bar)[XB_TMO])) break; if (_sp > XB_SPIN_CAP) { atomicAdd(&(bar)[XB_TMO], 1u); break; } } } } while (0)
struct XcdBarrier { unsigned* bar; unsigned x; volatile LAS unsigned* st; };
__device__ __forceinline__ XcdBarrier xcd_barrier_post(unsigned* bar, volatile LAS unsigned* st) {
    XcdBarrier b; b.bar = bar; b.x = xb_xcc_id(); b.st = st;
    if (threadIdx.x == 0) (void)xb_add(&bar[XB_XCNT(b.x)], 1u);
    return b;
}
__device__ __forceinline__ void xcd_barrier_complete(unsigned* bar, unsigned x, unsigned& nloc, unsigned& nx) {
    const unsigned G = gridDim.x * gridDim.y * gridDim.z;
    unsigned sum, cnt, mine, sp = 0u;
    for (;;) {
        sum = 0u; cnt = 0u; mine = 0u;
#pragma unroll
        for (unsigned j = 0; j < 16; ++j) { const unsigned c = xb_ld(&bar[XB_XCNT(j)]); sum += c; cnt += (c > 0u) ? 1u : 0u; mine = (j == x) ? c : mine; }
        if (sum == G) break;
        __builtin_amdgcn_s_sleep(1);
        if ((++sp & 255u) == 0u) { if (xb_ld(&bar[XB_TMO])) break; if (sp > XB_SPIN_CAP) { atomicAdd(&bar[XB_TMO], 1u); break; } }
    }
    nloc = mine > 0u ? mine : 1u; nx = cnt > 0u ? cnt : 1u;
}
__device__ __forceinline__ void xcd_barrier(const XcdBarrier& b) {
    asm volatile("s_waitcnt vmcnt(0)" ::: "memory");
    __syncthreads();
    if (threadIdx.x == 0) {
        unsigned* bar = b.bar;
        __builtin_amdgcn_s_waitcnt(0);
        unsigned nloc = b.st[0], nx = b.st[1];
        if (nloc == 0u) { xcd_barrier_complete(bar, b.x, nloc, nx); b.st[0] = nloc; b.st[1] = nx; }
        const unsigned old = xb_add(&bar[XB_XSUB(b.x)], 1u);
        const unsigned gen = old / nloc;
        if (old + 1u == (gen + 1u) * nloc) {
            __builtin_amdgcn_fence(__ATOMIC_RELEASE, "agent");
            asm volatile("s_waitcnt vmcnt(0)" ::: "memory");
            const unsigned og = xb_add(&bar[XB_TOP], 1u);
            const unsigned tg = og / nx;
            if (og + 1u == (tg + 1u) * nx) xb_add(&bar[XB_TOPGEN], 1u);
            else XB_SPIN(xb_ld(&bar[XB_TOPGEN]) == tg, bar);
            __builtin_amdgcn_fence(__ATOMIC_ACQUIRE, "agent");
            xb_add(&bar[XB_XGEN(b.x)], 1u);
            asm volatile("s_waitcnt vmcnt(0)" ::: "memory");
        } else {
            XB_SPIN(xb_ld(&bar[XB_XGEN(b.x)]) == gen, bar);
            __builtin_amdgcn_fence(__ATOMIC_ACQUIRE, "agent");
            asm volatile("s_waitcnt vmcnt(0)" ::: "memory");
        }
    }
    __syncthreads();
}

struct Args { const float* x; const int* pos; const float* g_pre; const float* w_in; const float* g_q; const float* w_uq; const float* g_kv; const float* w_ukv;
              const float* b_forget; const float* w_out; const float* g_post; float* out; unsigned char* ws; int ph_lo, ph_hi; };

__global__ void __launch_bounds__(512, 2) hybrid_fwd(Args a) {
    extern __shared__ __attribute__((aligned(16))) unsigned char lds[];
    cg::grid_group grid = cg::this_grid();
    const int tid_k = threadIdx.x, lane_k = tid_k & 63, wave = __builtin_amdgcn_readfirstlane(tid_k >> 6);
    const int G = gridDim.x, bx = blockIdx.x; const int vcu = (G % 8 == 0) ? (bx % 8) * (G / 8) + bx / 8 : bx;
    unsigned char* ws = a.ws;
    float* rstd_x = (float*)(ws + WS_RSTDX); float* partq = (float*)(ws + WS_PARTQ); float* partkv = (float*)(ws + WS_PARTKV); float* party = (float*)(ws + WS_PARTY);
    float* flog = (float*)(ws + WS_FLOG); float* cf = (float*)(ws + WS_CF); float* cosT = (float*)(ws + WS_COS); float* sinT = (float*)(ws + WS_SIN);
    bf16* Win_t = (bf16*)(ws + WS_WIN); bf16* Wuq_t = (bf16*)(ws + WS_WUQ); bf16* Wukv_t = (bf16*)(ws + WS_WUKV); bf16* Wout_t = (bf16*)(ws + WS_WOUT);
    bf16* Xb = (bf16*)(ws + WS_XB); bf16* Ob = (bf16*)(ws + WS_O); bf16* qlat = (bf16*)(ws + WS_QLAT); bf16* kvlat = (bf16*)(ws + WS_KVLAT); bf16* Gb = (bf16*)(ws + WS_G);
    bf16* Qf = (bf16*)(ws + WS_QF); bf16* Kf = (bf16*)(ws + WS_KF); bf16* Vf = (bf16*)(ws + WS_VF); bf16* Yb = (bf16*)(ws + WS_Y);
    bf16* Qm = (bf16*)(ws + WS_QM); bf16* Km = (bf16*)(ws + WS_KM); bf16* Vm = (bf16*)(ws + WS_VM);
    const int lo = a.ph_lo, hi = a.ph_hi;
#ifndef PH_MASK
#define PH_MASK 63
#endif
#define IN(k) (((PH_MASK >> (k)) & 1) && lo <= (k) && (k) < hi)
#define BOTH(k) (IN(k) && IN((k) + 1))
    LAS unsigned char* ldsl = (LAS unsigned char*)lds;
    volatile LAS unsigned* bst = (volatile LAS unsigned*)(ldsl + LDS_BYTES - 64);
    if (tid_k < 2) bst[tid_k] = 0u;
    __syncthreads();
    XcdBarrier xbar = xcd_barrier_post((unsigned*)(ws + WS_CTL), bst);

    if (IN(0)) for (int rep_ = 0; rep_ < PROBE_REP0; ++rep_) {
        const int lane = launder(lane_k), tid = launder(tid_k);
        LAS float* scr = (LAS float*)(ldsl + wave * 16384);
        const int gw = vcu * 8 + wave, NGW = G * 8;
        constexpr int I_IN = 32 * 208, I_UQ = 12 * 48, I_UKV = 8 * 64, I_OUT = 32 * 64, NITEMS = I_IN + I_UQ + I_UKV + I_OUT;
        for (int it = gw; it < NITEMS; it += NGW) {
            int r = it;
            if (r < I_IN) { const int kb = r / 208, nb = r % 208; int src, nv; win_src(nb * 32, src, nv); transpose_item(a.w_in, DIN, 2048, a.g_pre, Win_t, nb * 32, src, nv, kb * 64, scr, lane); continue; } r -= I_IN;
            if (r < I_UQ) { const int kb = r / 48, nb = r % 48; transpose_item(a.w_uq, 1536, 768, a.g_q, Wuq_t, nb * 32, wuq_src(nb * 32), 32, kb * 64, scr, lane); continue; } r -= I_UQ;
            if (r < I_UKV) { const int kb = r / 64, nb = r % 64; transpose_item(a.w_ukv, 2048, 512, a.g_kv, Wukv_t, nb * 32, nb * 32, 32, kb * 64, scr, lane); continue; } r -= I_UKV;
            { const int kb = r / 64, nb = r % 64; transpose_item(a.w_out, 2048, 2048, nullptr, Wout_t, nb * 32, nb * 32, 32, kb * 64, scr, lane); }
        }
        for (int m = gw; m < M; m += 2 * NGW) {
            const int m2 = m + NGW;
            const f32x4* xr = (const f32x4*)(a.x + (size_t)m * DM) + lane; const f32x4* xr2 = (const f32x4*)(a.x + (size_t)m2 * DM) + lane; f32x4 v[8], v2[8]; float s = 0.f, s2 = 0.f;
#pragma unroll
            for (int j = 0; j < 8; ++j) { v[j] = __builtin_nontemporal_load(xr + 64 * j); v2[j] = __builtin_nontemporal_load(xr2 + 64 * j); }
#pragma unroll
            for (int j = 0; j < 8; ++j) { s += (v[j][0] * v[j][0] + v[j][1] * v[j][1]) + (v[j][2] * v[j][2] + v[j][3] * v[j][3]); s2 += (v2[j][0] * v2[j][0] + v2[j][1] * v2[j][1]) + (v2[j][2] * v2[j][2] + v2[j][3] * v2[j][3]); }
            s = wave_sum(s); s2 = wave_sum(s2);
            if (lane == 0) { rstd_x[m] = 1.f / sqrtf(s * (1.f / DM) + EPS); rstd_x[m2] = 1.f / sqrtf(s2 * (1.f / DM) + EPS); }
            u32x2* o8 = (u32x2*)(Xb + (size_t)m * DM) + lane; u32x2* o82 = (u32x2*)(Xb + (size_t)m2 * DM) + lane;
#pragma unroll
            for (int j = 0; j < 8; ++j) { u32x2 w; w.x = pk2(v[j][0], v[j][1]); w.y = pk2(v[j][2], v[j][3]); o8[64 * j] = w; u32x2 w2; w2.x = pk2(v2[j][0], v2[j][1]); w2.y = pk2(v2[j][2], v2[j][3]); o82[64 * j] = w2; }
        }
        for (int e = (vcu * 512 + tid); e < M * 32; e += G * 512) { const int row = e >> 5, i = e & 31;
            const float inv = exp2f(-(float)i * (13.287712379549449f / 32.f)); const float ang = (float)a.pos[row] * inv;
            const float n = rintf(ang * 0.15915494309189535f); float r = fmaf(-n, 6.28318548202514648f, ang); r = fmaf(-n, -1.7484555e-7f, r);
            cosT[e] = __cosf(r); sinT[e] = __sinf(r); }
    }
    if (BOTH(0)) xcd_barrier(xbar);
    if (a.ph_hi > 64) grid.sync();

    if (IN(1)) for (int rep_ = 0; rep_ < PROBE_REP1; ++rep_) {
        pg8::Gemm g{Xb, Win_t, M, NIN_PAD, 2048}; pg8::StaticOrder S; S.init(M, NIN_PAD, G, bx);
        EpiIn E{rstd_x, qlat, kvlat, Gb, Qf, Kf, Vf, Km, flog, partq, partkv, cosT, sinT};
        pg8::gemm_phase<EpiIn, pg8::StaticOrder, true, true>(ldsl, g, S, E);
    }
    if (BOTH(1)) xcd_barrier(xbar);

    if (IN(2)) for (int rep_ = 0; rep_ < PROBE_REP2; ++rep_) {
        const int lane = launder(lane_k), tid = launder(tid_k);
        if (bx >= G - BATCH * NH) { const int sq_ = bx - (G - BATCH * NH);
            const int b = sq_ >> 3, h = sq_ & 7; const float bf = a.b_forget[h];
            const float* fl = flog + ((size_t)b * SEQ + 8 * tid) * 8 + h; float lf[8];
#pragma unroll
            for (int j = 0; j < 8; ++j) lf[j] = fl[j * 8] + bf;
#pragma unroll
            for (int j = 0; j < 8; ++j) { const float z = lf[j]; lf[j] = fminf(z, 0.f) - log1pf(expf(-fabsf(z))); }
#pragma unroll
            for (int j = 1; j < 8; ++j) lf[j] += lf[j - 1];
            float incl = lf[7];
#pragma unroll
            for (int o = 1; o < 64; o <<= 1) { const float t = __shfl_up(incl, o); if (lane >= o) incl += t; }
            volatile LAS float* wtot = (volatile LAS float*)(ldsl + LDS_BYTES - 128);
            if (lane == 63) wtot[wave] = incl;
            __syncthreads();
            float off = incl - lf[7];
            for (int w2 = 0; w2 < wave; ++w2) off += wtot[w2];
            float* cp = cf + (size_t)sq_ * SEQ + 8 * tid;
            f32x4 o0, o1;
#pragma unroll
            for (int j = 0; j < 4; ++j) { o0[j] = (off + lf[j]) * LOG2E; o1[j] = (off + lf[4 + j]) * LOG2E; }
            *(f32x4*)cp = o0; *(f32x4*)(cp + 4) = o1;
            __syncthreads();
        }
        { pg8::Gemm g{qlat, Wuq_t, M, 1536, QRANK}; pg8::StaticOrder S; S.init(M, 1536, G, bx);
          EpiQ E{partq, Qm, cosT, sinT};
          pg8::gemm_phase<EpiQ, pg8::StaticOrder, true, true>(ldsl, g, S, E); }
        { pg8::Gemm g{kvlat, Wukv_t, M, 2048, KVRANK}; pg8::StaticOrder S; S.init(M, 2048, G, bx);
          EpiKV E{partkv, Km, Vm};
          pg8::gemm_phase<EpiKV, pg8::StaticOrder, true, true>(ldsl, g, S, E); }
    }
    if (BOTH(2)) xcd_barrier(xbar);

    if (IN(3)) for (int rep_ = 0; rep_ < PROBE_REP3; ++rep_) {
        for (int v = vcu; v < 256; v += G) {
            const int s = v & 3, w = v >> 2, b = w >> 4, hh = w & 15, hd = hh & 7, swp = hh >> 3;
            const size_t rb = (size_t)b * SEQ;
#pragma unroll 1
            for (int i = 0; i < 2; ++i) {
                const int qb = __builtin_amdgcn_readfirstlane(swp ? (i == 0 ? 8 + s : 7 - s) : (i == 0 ? 15 - s : s));
                att::attn_unit<192, false>((char*)lds, Qm + rb * 1536 + hd * 192, 1536, Km + rb * 1536 + hd * 192, 1536, Vm + rb * 1024 + hd * 128, 1024, nullptr,
                                           Gb + rb * 2048 + hd * 128, Ob + rb * 2048 + hd * 128, qb);
            }
#pragma unroll 1
            for (int i = 0; i < 2; ++i) {
                const int qb = __builtin_amdgcn_readfirstlane(swp ? (i == 0 ? 15 - s : s) : (i == 0 ? 8 + s : 7 - s));
                att::attn_unit<128, true>((char*)lds, Qf + rb * 1024 + hd * 128, 1024, Kf + rb * 1024 + hd * 128, 1024, Vf + rb * 1024 + hd * 128, 1024, cf + (size_t)(b * 8 + hd) * SEQ,
                                          Gb + rb * 2048 + 1024 + hd * 128, Ob + rb * 2048 + 1024 + hd * 128, qb);
            }
        }
    }
#if PROBE_ABL >= 0
    if (IN(3)) {
        for (int v = vcu; v < 256; v += G) {
            const int s = v & 3, w = v >> 2, b = w >> 4, hh = w & 15, hd = hh & 7, swp = hh >> 3;
            const size_t rb = (size_t)b * SEQ;
#pragma unroll 1
            for (int i = 0; i < 2; ++i) {
                const int qb = __builtin_amdgcn_readfirstlane(swp ? (i == 0 ? 8 + s : 7 - s) : (i == 0 ? 15 - s : s));
                att::attn_unit<192, false, PROBE_ABL>((char*)lds, Qm + rb * 1536 + hd * 192, 1536, Km + rb * 1536 + hd * 192, 1536, Vm + rb * 1024 + hd * 128, 1024, nullptr,
                                           Gb + rb * 2048 + hd * 128, qlat, qb);
            }
#pragma unroll 1
            for (int i = 0; i < 2; ++i) {
                const int qb = __builtin_amdgcn_readfirstlane(swp ? (i == 0 ? 15 - s : s) : (i == 0 ? 8 + s : 7 - s));
                att::attn_unit<128, true, PROBE_ABL>((char*)lds, Qf + rb * 1024 + hd * 128, 1024, Kf + rb * 1024 + hd * 128, 1024, Vf + rb * 1024 + hd * 128, 1024, cf + (size_t)(b * 8 + hd) * SEQ,
                                          Gb + rb * 2048 + 1024 + hd * 128, qlat, qb);
            }
        }
    }
#endif
    if (BOTH(3)) xcd_barrier(xbar);

    if (IN(4)) for (int rep_ = 0; rep_ < PROBE_REP4; ++rep_) {
        pg8::Gemm g{Ob, Wout_t, M, 2048, 2048}; pg8::StaticOrder S; S.init(M, 2048, G, bx);
        EpiOut E{Yb, party};
        pg8::gemm_phase<EpiOut, pg8::StaticOrder, true, true>(ldsl, g, S, E);
    }
    if (BOTH(4)) xcd_barrier(xbar);

    if (IN(5)) for (int rep_ = 0; rep_ < PROBE_REP5; ++rep_) {
        const int lane = launder(lane_k);
        const int gw = vcu * 8 + wave, NGW = G * 8;
        const f32x4* gp = (const f32x4*)a.g_post + lane; f32x4 gv[8];
#pragma unroll
        for (int j = 0; j < 8; ++j) gv[j] = gp[64 * j];
        for (int m = gw; m < M; m += 2 * NGW) {
            const int m2 = m + NGW;
            float s = (lane < 32) ? party[(size_t)m * 32 + lane] : 0.f, s2 = (lane < 32) ? party[(size_t)m2 * 32 + lane] : 0.f;
            const f32x4* xr = (const f32x4*)(a.x + (size_t)m * DM) + lane; const f32x4* xr2 = (const f32x4*)(a.x + (size_t)m2 * DM) + lane;
            const u32x2* yr = (const u32x2*)(Yb + (size_t)m * DM) + lane; const u32x2* yr2 = (const u32x2*)(Yb + (size_t)m2 * DM) + lane;
            f32x4 xv[8], xv2[8]; u32x2 y[8], y2[8];
#pragma unroll
            for (int j = 0; j < 8; ++j) { xv[j] = __builtin_nontemporal_load(xr + 64 * j); xv2[j] = __builtin_nontemporal_load(xr2 + 64 * j); y[j] = __builtin_nontemporal_load(yr + 64 * j); y2[j] = __builtin_nontemporal_load(yr2 + 64 * j); }
            s = wave_sum(s); s2 = wave_sum(s2);
            const float rs = 1.f / sqrtf(s * (1.f / DM) + EPS), rs2 = 1.f / sqrtf(s2 * (1.f / DM) + EPS);
            f32x4* orow = (f32x4*)(a.out + (size_t)m * DM) + lane; f32x4* orow2 = (f32x4*)(a.out + (size_t)m2 * DM) + lane;
#pragma unroll
            for (int j = 0; j < 8; ++j) {
                f32x4 o; o[0] = xv[j][0] + bflo(y[j].x) * rs * gv[j][0]; o[1] = xv[j][1] + bfhi(y[j].x) * rs * gv[j][1]; o[2] = xv[j][2] + bflo(y[j].y) * rs * gv[j][2]; o[3] = xv[j][3] + bfhi(y[j].y) * rs * gv[j][3];
                __builtin_nontemporal_store(o, orow + 64 * j);
                f32x4 o2; o2[0] = xv2[j][0] + bflo(y2[j].x) * rs2 * gv[j][0]; o2[1] = xv2[j][1] + bfhi(y2[j].x) * rs2 * gv[j][1]; o2[2] = xv2[j][2] + bflo(y2[j].y) * rs2 * gv[j][2]; o2[3] = xv2[j][3] + bfhi(y2[j].y) * rs2 * gv[j][3];
                __builtin_nontemporal_store(o2, orow2 + 64 * j); }
        }
    }
#undef IN
#undef BOTH
}

extern "C" void kernel_launch(void* const* d_in, const int* in_sizes, int n_in, void* d_out, int out_size, void* d_ws, size_t ws_size, hipStream_t stream) {
    static int grid = 0;
    if (grid == 0) {
        if (n_in != 11 || in_sizes[0] != M * DM || out_size != M * DM || ws_size < WS_END) { fprintf(stderr, "kernel_launch: shape mismatch n_in %d in0 %d out %d ws %zu\n", n_in, n_in > 0 ? in_sizes[0] : -1, out_size, ws_size); grid = -1; return; }
        int dev = 0, cus = 0, per_cu = 0;
        if (hipGetDevice(&dev) != hipSuccess || hipDeviceGetAttribute(&cus, hipDeviceAttributeMultiprocessorCount, dev) != hipSuccess) { grid = -1; return; }
        if (hipFuncSetAttribute((const void*)hybrid_fwd, hipFuncAttributeMaxDynamicSharedMemorySize, LDS_BYTES) != hipSuccess) { fprintf(stderr, "kernel_launch: hipFuncSetAttribute failed\n"); grid = -1; return; }
        if (hipOccupancyMaxActiveBlocksPerMultiprocessor(&per_cu, (const void*)hybrid_fwd, 512, LDS_BYTES) != hipSuccess || per_cu < 1) { fprintf(stderr, "kernel_launch: occupancy query says %d\n", per_cu); per_cu = 1; }
        (void)hipGetLastError();
        grid = cus;
    }
    if (grid < 0) return;
    if (hipMemsetAsync((char*)d_ws + WS_CTL, 0, CTL_BYTES, stream) != hipSuccess) { fprintf(stderr, "kernel_launch: memset failed\n"); return; }
    Args a{};
    a.x = (const float*)d_in[0]; a.pos = (const int*)d_in[1]; a.g_pre = (const float*)d_in[2]; a.w_in = (const float*)d_in[3]; a.g_q = (const float*)d_in[4]; a.w_uq = (const float*)d_in[5];
    a.g_kv = (const float*)d_in[6]; a.w_ukv = (const float*)d_in[7]; a.b_forget = (const float*)d_in[8]; a.w_out = (const float*)d_in[9]; a.g_post = (const float*)d_in[10];
    a.out = (float*)d_out; a.ws = (unsigned char*)d_ws;
#if MK_N_LAUNCHES == 1
    a.ph_lo = 0; a.ph_hi = 6;
    void* args[] = {&a};
    hipError_t e = hipLaunchCooperativeKernel((const void*)hybrid_fwd, dim3(grid), dim3(512), args, LDS_BYTES, stream);
    if (e != hipSuccess) fprintf(stderr, "cooperative launch failed: %s (grid %d)\n", hipGetErrorString(e), grid);
#else
    for (int p = 0; p < 6; ++p) { a.ph_lo = p; a.ph_hi = p + 1; for (int r = 0; r < (p == PROBE_DUP ? 2 : 1); ++r) hipLaunchKernelGGL(hybrid_fwd, dim3(grid), dim3(512), LDS_BYTES, stream, a); }
#endif
}
```

```cpp
#include <hip/hip_runtime.h>
#include <hip/hip_cooperative_groups.h>
#include <cstdio>
#include <cstdint>
namespace cg = cooperative_groups;

#ifndef PROBE_REP0
#define PROBE_REP0 1
#endif
#ifndef PROBE_REP1
#define PROBE_REP1 1
#endif
#ifndef PROBE_REP2
#define PROBE_REP2 1
#endif
#ifndef PROBE_REP3
#define PROBE_REP3 1
#endif
#ifndef PROBE_REP4
#define PROBE_REP4 1
#endif
#ifndef PROBE_REP5
#define PROBE_REP5 1
#endif
#ifndef PROBE_ABL
#define PROBE_ABL -1
#endif
#ifndef PROBE_DUP
#define PROBE_DUP -1
#endif
#ifndef MK_N_LAUNCHES
#define MK_N_LAUNCHES 1
#endif

namespace pg8 {
#define PG8_LAS __attribute__((address_space(3)))
typedef unsigned short bf16_t;
typedef short bf16x8 __attribute__((ext_vector_type(8)));
typedef float f32x4 __attribute__((ext_vector_type(4)));
typedef unsigned u32x4 __attribute__((ext_vector_type(4)));
constexpr int BM = 256, BK = 64, HALF = 128, HTB = HALF * BK * 2, STAGE_BYTES = 8 * HTB, NXCD = 8, WGM = 8;

__host__ __device__ __forceinline__ int lds_byte(int r, int c) { const int st = (r >> 4) * 2 + (c >> 5), rr = r & 15, cc = c & 31, ob = rr * 64 + cc * 2; return st * 1024 + (ob ^ (((ob >> 9) & 1) << 5)); }
__host__ __device__ __forceinline__ void stage_rc(int b, int& R, int& C) { const int st = b / 1024, sb = b % 1024, swz = sb ^ (((sb >> 9) & 1) << 5); R = (st >> 1) * 16 + swz / 64; C = (st & 1) * 32 + (swz % 64) / 2; }
__host__ __device__ __forceinline__ int perm32(int rho) { const int n = rho >> 4, i = rho & 15; return 8 * (i >> 2) + 4 * n + (i & 3); }

struct Unit { int pm, pn; };
struct Gemm { const bf16_t* A; const bf16_t* Bt; int M, N, K; };

struct StaticOrder {
    int nM, nN, nwg, G, c;
    __host__ __device__ void init(int M, int N, int G_, int c_) { nM = M / BM; nN = N / BM; nwg = nM * nN; G = G_; c = c_; }
    __host__ __device__ bool next(int i, Unit& u) const {
        const long L = (long)i * G + c; if (L >= nwg) return false;
        int wgid = (int)L; { const int q = nwg / NXCD, r = nwg % NXCD, xcd = wgid % NXCD, off = wgid / NXCD; wgid = (xcd < r ? xcd * (q + 1) : r * (q + 1) + (xcd - r) * q) + off; }
        const int nig = WGM * nN, gid = wgid / nig, fm = gid * WGM, gsz = (nM - fm) < WGM ? (nM - fm) : WGM;
        u.pm = fm + ((wgid % nig) % gsz); u.pn = (wgid % nig) / gsz; return true;
    }
    __device__ __forceinline__ void a_ready(const Unit&) const {}
    __device__ __forceinline__ void done(const Unit&) const {}
};

__device__ __forceinline__ unsigned cvt_pk_bf16(float lo, float hi) { unsigned r; asm volatile("v_cvt_pk_bf16_f32 %0, %1, %2" : "=v"(r) : "v"(lo), "v"(hi)); return r; }

template <class Epi, class Sched, bool ALIGN_EPI = false, bool SP2 = false>
__device__ __forceinline__ void gemm_phase(PG8_LAS unsigned char* lds, const Gemm g, const Sched& S, const Epi& E) {
    const int tid = threadIdx.x, wid = __builtin_amdgcn_readfirstlane(tid >> 6), lane = tid & 63, wr = wid >> 2, wc = wid & 3, fr = lane & 15, fq = lane >> 4;
    const int K = g.K, nt = K / BK;
    unsigned voffA[2], voffB[2];
#pragma unroll
    for (int i = 0; i < 2; ++i) { int R, C; stage_rc(tid * 16 + i * 8192, R, C); const int Rb = Epi::PERM ? ((R & ~31) + perm32(R & 31)) : R;
        voffA[i] = (unsigned)(R * K + C) * 2u; voffB[i] = (unsigned)(Rb * K + C) * 2u; }
    const size_t kstep = (size_t)(BK * 2);
    const size_t hstep = (size_t)HALF * K * 2;
    const size_t tstep = 2 * hstep;
    const unsigned ldsw = (unsigned)wid * 1024u;
    const int aoff = lds_byte(wr * 64 + fr, fq * 8), boff = lds_byte(wc * 32 + fr, fq * 8);
#define PG8_SA(b, h) (((b) * 2 + (h)) * HTB)
#define PG8_SB(b, h) ((4 + (b) * 2 + (h)) * HTB)
#define PG8_STAGE(bufoff, gbase, voff) do { _Pragma("unroll") for (int _i = 0; _i < 2; ++_i) \
        __builtin_amdgcn_global_load_lds((const unsigned*)((const char*)(gbase) + (voff)[_i]), (PG8_LAS unsigned*)(lds + (bufoff) + ldsw + _i * 8192), 16, 0, 0); } while (0)
#define PG8_LDA(dst, b, h) do { _Pragma("unroll") for (int m = 0; m < 4; ++m) _Pragma("unroll") for (int k = 0; k < 2; ++k) dst[m][k] = *(const PG8_LAS bf16x8*)(lds + PG8_SA(b, h) + aoff + m * 2048 + k * 1024); } while (0)
#define PG8_LDB(dst, b, h) do { _Pragma("unroll") for (int n = 0; n < 2; ++n) _Pragma("unroll") for (int k = 0; k < 2; ++k) dst[n][k] = *(const PG8_LAS bf16x8*)(lds + PG8_SB(b, h) + boff + n * 2048 + k * 1024); } while (0)
#define PG8_MMA(ai, bj, At, Bt) do { __builtin_amdgcn_s_setprio(1); _Pragma("unroll") for (int m = 0; m < 4; ++m) _Pragma("unroll") for (int n = 0; n < 2; ++n) _Pragma("unroll") for (int k = 0; k < 2; ++k) \
        acc[ai][bj][m][n] = __builtin_amdgcn_mfma_f32_16x16x32_bf16(Bt[n][k], At[m][k], acc[ai][bj][m][n], 0, 0, 0); __builtin_amdgcn_s_setprio(0); } while (0)
#define PG8_WAIT_V(n) asm volatile("s_waitcnt vmcnt(" #n ")" ::: "memory")
#define PG8_WAIT_L(n) asm volatile("s_waitcnt lgkmcnt(" #n ")" ::: "memory")
#define PG8_BAR __builtin_amdgcn_s_barrier()
#define PG8_SCHED __builtin_amdgcn_sched_barrier(0)
    Unit cur, nxt; int ui = 0;
    if (!S.next(0, cur)) return;
    f32x4 acc[2][2][4][2];
#pragma unroll
    for (int a = 0; a < 2; ++a)
#pragma unroll
        for (int b = 0; b < 2; ++b)
#pragma unroll
            for (int m = 0; m < 4; ++m)
#pragma unroll
                for (int n = 0; n < 2; ++n) acc[a][b][m][n] = (f32x4){0.f, 0.f, 0.f, 0.f};
    bf16x8 At[4][2], B0[2][2], B1[2][2];
    const char* cA = (const char*)g.A + (size_t)cur.pm * tstep; const char* cB = (const char*)g.Bt + (size_t)cur.pn * tstep;
    S.a_ready(cur);
    if constexpr (SP2) {
        PG8_STAGE(PG8_SB(0, 0), cB, voffB); PG8_STAGE(PG8_SB(0, 1), cB + hstep, voffB); PG8_STAGE(PG8_SA(0, 0), cA, voffA); PG8_STAGE(PG8_SA(0, 1), cA + hstep, voffA);
        if (wr == 1) PG8_BAR;
        PG8_WAIT_V(2); PG8_BAR;
        PG8_STAGE(PG8_SB(1, 0), cB + kstep, voffB); PG8_STAGE(PG8_SA(1, 0), cA + kstep, voffA); PG8_STAGE(PG8_SB(1, 1), cB + hstep + kstep, voffB);
        PG8_WAIT_V(6); PG8_BAR;
    } else {
        PG8_STAGE(PG8_SB(0, 0), cB, voffB); PG8_STAGE(PG8_SA(0, 0), cA, voffA); PG8_STAGE(PG8_SB(0, 1), cB + hstep, voffB); PG8_STAGE(PG8_SA(0, 1), cA + hstep, voffA);
        if (wr == 1) PG8_BAR;
        PG8_WAIT_V(4); PG8_BAR;
        PG8_STAGE(PG8_SB(1, 0), cB + kstep, voffB); PG8_STAGE(PG8_SA(1, 0), cA + kstep, voffA); PG8_STAGE(PG8_SB(1, 1), cB + hstep + kstep, voffB);
        PG8_WAIT_V(6); PG8_BAR;
    }
    for (;;) {
        const bool has_next = S.next(ui + 1, nxt);
        const char* nA = has_next ? (const char*)g.A + (size_t)nxt.pm * tstep : cA; const char* nB = has_next ? (const char*)g.Bt + (size_t)nxt.pn * tstep : cB;
        for (int t = 0; t < nt; t += 2) {
            const bool last = (t == nt - 2);
            const char* a1 = cA + (size_t)(t + 1) * kstep;
            const char* a2 = last ? nA : cA + (size_t)(t + 2) * kstep; const char* b2 = last ? nB : cB + (size_t)(t + 2) * kstep;
            const char* a3 = a2 + kstep; const char* b3 = b2 + kstep;
            if (last && has_next) S.a_ready(nxt);
            if constexpr (SP2) {
            PG8_LDB(B0, 0, 0); PG8_LDB(B1, 0, 1); PG8_SCHED; PG8_LDA(At, 0, 0); PG8_STAGE(PG8_SA(1, 1), a1 + hstep, voffA);
            PG8_WAIT_V(8); PG8_WAIT_L(0); PG8_BAR; PG8_MMA(0, 0, At, B0); PG8_MMA(0, 1, At, B1); PG8_BAR; PG8_SCHED;
            PG8_LDA(At, 0, 1); PG8_STAGE(PG8_SB(0, 0), b2, voffB); PG8_STAGE(PG8_SB(0, 1), b2 + hstep, voffB); PG8_STAGE(PG8_SA(0, 0), a2, voffA);
            PG8_WAIT_V(8); PG8_WAIT_L(0); PG8_BAR; PG8_MMA(1, 0, At, B0); PG8_MMA(1, 1, At, B1); PG8_BAR; PG8_SCHED;
            PG8_LDB(B0, 1, 0); PG8_LDB(B1, 1, 1); PG8_SCHED; PG8_LDA(At, 1, 0); PG8_STAGE(PG8_SA(0, 1), a2 + hstep, voffA);
            PG8_WAIT_V(8); PG8_WAIT_L(0); PG8_BAR; PG8_MMA(0, 0, At, B0); PG8_MMA(0, 1, At, B1); PG8_BAR; PG8_SCHED;
            PG8_LDA(At, 1, 1); PG8_STAGE(PG8_SB(1, 0), b3, voffB); PG8_STAGE(PG8_SB(1, 1), b3 + hstep, voffB); PG8_STAGE(PG8_SA(1, 0), a3, voffA);
            PG8_WAIT_V(8); PG8_WAIT_L(0); PG8_BAR; PG8_MMA(1, 0, At, B0); PG8_MMA(1, 1, At, B1); PG8_BAR; PG8_SCHED;
            } else {
            PG8_LDB(B0, 0, 0); PG8_SCHED; PG8_LDA(At, 0, 0); PG8_STAGE(PG8_SA(1, 1), a1 + hstep, voffA);
            PG8_WAIT_L(8); PG8_BAR; PG8_WAIT_L(0); PG8_MMA(0, 0, At, B0); PG8_BAR; PG8_SCHED;
            PG8_LDB(B1, 0, 1); PG8_STAGE(PG8_SB(0, 0), b2, voffB);
            PG8_BAR; PG8_WAIT_L(0); PG8_MMA(0, 1, At, B1); PG8_BAR;
            PG8_LDA(At, 0, 1); PG8_STAGE(PG8_SA(0, 0), a2, voffA);
            PG8_BAR; PG8_WAIT_L(0); PG8_MMA(1, 0, At, B0); PG8_BAR; PG8_SCHED;
            PG8_STAGE(PG8_SB(0, 1), b2 + hstep, voffB);
            PG8_WAIT_V(6); PG8_BAR; PG8_MMA(1, 1, At, B1); PG8_BAR;
            PG8_LDB(B0, 1, 0); PG8_SCHED; PG8_LDA(At, 1, 0); PG8_STAGE(PG8_SA(0, 1), a2 + hstep, voffA);
            PG8_WAIT_L(8); PG8_BAR; PG8_WAIT_L(0); PG8_MMA(0, 0, At, B0); PG8_BAR; PG8_SCHED;
            PG8_LDB(B1, 1, 1); PG8_STAGE(PG8_SB(1, 0), b3, voffB);
            PG8_BAR; PG8_WAIT_L(0); PG8_MMA(0, 1, At, B1); PG8_BAR;
            PG8_LDA(At, 1, 1); PG8_STAGE(PG8_SA(1, 0), a3, voffA);
            PG8_BAR; PG8_WAIT_L(0); PG8_MMA(1, 0, At, B0); PG8_BAR; PG8_SCHED;
            PG8_STAGE(PG8_SB(1, 1), b3 + hstep, voffB);
            PG8_WAIT_V(6); PG8_BAR; PG8_MMA(1, 1, At, B1); PG8_BAR;
            }
        }
        if constexpr (ALIGN_EPI) { if (wr == 0) PG8_BAR; }
        if constexpr (!Epi::AFTER_DRAIN) { E(acc, cur, wr, wc, fr, fq); S.done(cur); }
        if (!has_next) break;
#pragma unroll
        for (int a = 0; a < 2; ++a)
#pragma unroll
            for (int b = 0; b < 2; ++b)
#pragma unroll
                for (int m = 0; m < 4; ++m)
#pragma unroll
                    for (int n = 0; n < 2; ++n) acc[a][b][m][n] = (f32x4){0.f, 0.f, 0.f, 0.f};
        cur = nxt; cA = nA; cB = nB; ++ui;
        if constexpr (ALIGN_EPI) { if (wr == 1) PG8_BAR; }
    }
    PG8_WAIT_V(0);
    if constexpr (!ALIGN_EPI) { if (wr == 0) PG8_BAR; }
    PG8_BAR;
#undef PG8_SA
#undef PG8_SB
#undef PG8_STAGE
#undef PG8_LDA
#undef PG8_LDB
#undef PG8_MMA
#undef PG8_WAIT_V
#undef PG8_WAIT_L
#undef PG8_BAR
#undef PG8_SCHED
}
}

typedef unsigned short bf16;
typedef float f32x4 __attribute__((ext_vector_type(4)));
typedef unsigned u32x4 __attribute__((ext_vector_type(4)));
typedef unsigned u32x2 __attribute__((ext_vector_type(2)));
typedef short bf16x8 __attribute__((ext_vector_type(8)));
typedef short s16x4 __attribute__((ext_vector_type(4)));
typedef float f32x16 __attribute__((ext_vector_type(16)));
#define LAS __attribute__((address_space(3)))

constexpr int BATCH = 4, SEQ = 4096, DM = 2048, M = BATCH * SEQ;
constexpr int NH = 8, QKD = 192, QRANK = 768, KVRANK = 512, DIN = 6472;
constexpr int NIN_PAD = 6656;
constexpr float EPS = 1e-6f;
constexpr float LOG2E = 1.4426950408889634f;
constexpr float C2M = 0.07216878364870322f * LOG2E;
constexpr float C2F = 0.08838834764831845f * LOG2E;

constexpr size_t MiB = 1u << 20;
constexpr size_t WS_RSTDX = 0, WS_PARTQ = 1 * MiB, WS_PARTKV = 2 * MiB, WS_PARTY = 3 * MiB, WS_FLOG = 5 * MiB, WS_CF = 6 * MiB, WS_COS = 7 * MiB, WS_SIN = 9 * MiB;
constexpr size_t WS_CTL = 11 * MiB, CTL_BYTES = 16384;
constexpr size_t WS_WIN = 16 * MiB, WS_WUQ = 42 * MiB, WS_WUKV = 45 * MiB, WS_WOUT = 47 * MiB;
constexpr size_t WS_XB = 56 * MiB, WS_O = 56 * MiB;
constexpr size_t WS_QLAT = 120 * MiB, WS_KVLAT = 144 * MiB, WS_G = 160 * MiB;
constexpr size_t WS_QF = 224 * MiB, WS_Y = 224 * MiB, WS_KF = 256 * MiB, WS_VF = 288 * MiB;
constexpr size_t WS_QM = 320 * MiB, WS_KM = 368 * MiB, WS_VM = 416 * MiB, WS_END = 448 * MiB;

constexpr int LDS_BYTES = 163840;

__device__ __forceinline__ unsigned f2bf(float f) { unsigned u = __builtin_bit_cast(unsigned, f); return (u + 0x7fffu + ((u >> 16) & 1u)) >> 16; }
__device__ __forceinline__ unsigned pk2(float lo, float hi) { return pg8::cvt_pk_bf16(lo, hi); }
__device__ __forceinline__ float bflo(unsigned w) { return __builtin_bit_cast(float, w << 16); }
__device__ __forceinline__ float bfhi(unsigned w) { return __builtin_bit_cast(float, w & 0xffff0000u); }
__device__ __forceinline__ int launder(int v) { asm volatile("" : "+v"(v)); return v; }
__device__ __forceinline__ float wave_sum(float v) {
#pragma unroll
    for (int o = 1; o < 64; o <<= 1) v += __shfl_xor(v, o);
    return v;
}
__device__ __forceinline__ float silu_f(float v) { return v * __builtin_amdgcn_rcpf(1.f + __builtin_amdgcn_exp2f(-v * LOG2E)); }
__device__ __forceinline__ u32x4 pack8f(f32x4 a, f32x4 b) { u32x4 w; w.x = pk2(a[0], a[1]); w.y = pk2(a[2], a[3]); w.z = pk2(b[0], b[1]); w.w = pk2(b[2], b[3]); return w; }

typedef pg8::f32x4 af4;
struct EpiIn {
    static constexpr bool PERM = true, AFTER_DRAIN = false;
    const float* rstd_x; bf16 *qlat, *kvlat, *G, *Qf, *Kf, *Vf, *Km; float *flog, *partq, *partkv; const float *cosT, *sinT;
    __device__ __forceinline__ void operator()(const af4 (&acc)[2][2][4][2], const pg8::Unit& u, int wr, int wc, int fr, int fq) const {
        const int pn = u.pn; const int row0 = u.pm * 256 + wr * 64 + fr;
        if (pn == 25) {
            if (wc == 0) {
#pragma unroll
                for (int ai = 0; ai < 2; ++ai)
#pragma unroll
                    for (int m = 0; m < 4; ++m) { const int row = row0 + ai * 128 + m * 16; const float rs = rstd_x[row];
                        f32x4 o1[2], o2[2];
#pragma unroll
                        for (int n = 0; n < 2; ++n) { const f32x4 c = *(const f32x4*)(cosT + (size_t)row * 32 + 8 * fq + 4 * n), s = *(const f32x4*)(sinT + (size_t)row * 32 + 8 * fq + 4 * n);
                            const f32x4 x1 = acc[ai][0][m][n] * rs, x2 = acc[ai][1][m][n] * rs; o1[n] = x1 * c - x2 * s; o2[n] = x2 * c + x1 * s; }
                        const u32x4 w1 = pack8f(o1[0], o1[1]), w2 = pack8f(o2[0], o2[1]);
                        bf16* kp = Km + (size_t)row * 1536 + 128 + 8 * fq;
#pragma unroll
                        for (int h = 0; h < 8; ++h) { *(u32x4*)(kp + h * 192) = w1; *(u32x4*)(kp + h * 192 + 32) = w2; } }
            } else if (wc == 1 && fq == 0) {
#pragma unroll
                for (int ai = 0; ai < 2; ++ai)
#pragma unroll
                    for (int m = 0; m < 4; ++m) { const int row = row0 + ai * 128 + m * 16; const float rs = rstd_x[row];
                        *(f32x4*)(flog + (size_t)row * 8) = acc[ai][0][m][0] * rs; *(f32x4*)(flog + (size_t)row * 8 + 4) = acc[ai][0][m][1] * rs; }
            }
            return;
        }
        bf16* base; int ld, colt, mode = 0; float* part = nullptr; int nslot = 0, slot0 = 0;
        if (pn < 3) { base = qlat; ld = 768; colt = pn * 256; part = partq; nslot = 12; slot0 = pn * 4; }
        else if (pn < 5) { base = kvlat; ld = 512; colt = (pn - 3) * 256; part = partkv; nslot = 8; slot0 = (pn - 3) * 4; }
        else if (pn < 9) { base = G; ld = 2048; colt = (pn - 5) * 256; mode = 1; }
        else if (pn < 13) { base = Qf; ld = 1024; colt = (pn - 9) * 256; mode = 2; }
        else if (pn < 17) { base = Kf; ld = 1024; colt = (pn - 13) * 256; }
        else if (pn < 21) { base = Vf; ld = 1024; colt = (pn - 17) * 256; }
        else { base = G; ld = 2048; colt = 1024 + (pn - 21) * 256; mode = 1; }
        const int col0 = colt + wc * 32 + 8 * fq;
#pragma unroll
        for (int ai = 0; ai < 2; ++ai)
#pragma unroll
            for (int m = 0; m < 4; ++m) { const int row = row0 + ai * 128 + m * 16; float rs = rstd_x[row]; if (mode == 2) rs *= C2F;
                bf16* rowp = base + (size_t)row * ld + col0; float ss = 0.f;
#pragma unroll
                for (int bj = 0; bj < 2; ++bj) { f32x4 v0 = acc[ai][bj][m][0] * rs, v1 = acc[ai][bj][m][1] * rs;
                    ss += (v0[0] * v0[0] + v0[1] * v0[1]) + (v0[2] * v0[2] + v0[3] * v0[3]) + (v1[0] * v1[0] + v1[1] * v1[1]) + (v1[2] * v1[2] + v1[3] * v1[3]);
                    if (mode == 1) {
#pragma unroll
                        for (int e = 0; e < 4; ++e) { v0[e] = silu_f(v0[e]); v1[e] = silu_f(v1[e]); } }
                    *(u32x4*)(rowp + bj * 128) = pack8f(v0, v1); }
                if (part) { ss += __shfl_xor(ss, 16); ss += __shfl_xor(ss, 32); if (fq == 0) part[(size_t)row * nslot + slot0 + wc] = ss; } }
    }
};
struct EpiQ {
    static constexpr bool PERM = true, AFTER_DRAIN = false;
    const float* partq; bf16* Qm; const float *cosT, *sinT;
    __device__ __forceinline__ void operator()(const af4 (&acc)[2][2][4][2], const pg8::Unit& u, int wr, int wc, int fr, int fq) const {
        const int pn = u.pn; const int row0 = u.pm * 256 + wr * 64 + fr;
#pragma unroll
        for (int ai = 0; ai < 2; ++ai)
#pragma unroll
            for (int m = 0; m < 4; ++m) { const int row = row0 + ai * 128 + m * 16;
                const f32x4 pa = *(const f32x4*)(partq + (size_t)row * 12), pb = *(const f32x4*)(partq + (size_t)row * 12 + 4), pc = *(const f32x4*)(partq + (size_t)row * 12 + 8);
                const float ssq = ((pa[0] + pa[1]) + (pa[2] + pa[3])) + ((pb[0] + pb[1]) + (pb[2] + pb[3])) + ((pc[0] + pc[1]) + (pc[2] + pc[3]));
                const float rs = C2M / sqrtf(ssq * (1.f / 768.f) + EPS);
                if (pn < 4) {
#pragma unroll
                    for (int bj = 0; bj < 2; ++bj) *(u32x4*)(Qm + (size_t)row * 1536 + (2 * pn + bj) * 192 + wc * 32 + 8 * fq) = pack8f(acc[ai][bj][m][0] * rs, acc[ai][bj][m][1] * rs);
                } else { const int head = 4 * (pn - 4) + wc; f32x4 o1[2], o2[2];
#pragma unroll
                    for (int n = 0; n < 2; ++n) { const f32x4 c = *(const f32x4*)(cosT + (size_t)row * 32 + 8 * fq + 4 * n), s = *(const f32x4*)(sinT + (size_t)row * 32 + 8 * fq + 4 * n);
                        const f32x4 x1 = acc[ai][0][m][n] * rs, x2 = acc[ai][1][m][n] * rs; o1[n] = x1 * c - x2 * s; o2[n] = x2 * c + x1 * s; }
                    bf16* qp = Qm + (size_t)row * 1536 + head * 192 + 128 + 8 * fq;
                    *(u32x4*)qp = pack8f(o1[0], o1[1]); *(u32x4*)(qp + 32) = pack8f(o2[0], o2[1]); } }
    }
};
struct EpiKV {
    static constexpr bool PERM = true, AFTER_DRAIN = false;
    const float* partkv; bf16 *Km, *Vm;
    __device__ __forceinline__ void operator()(const af4 (&acc)[2][2][4][2], const pg8::Unit& u, int wr, int wc, int fr, int fq) const {
        const int pn = u.pn; const int row0 = u.pm * 256 + wr * 64 + fr;
#pragma unroll
        for (int ai = 0; ai < 2; ++ai)
#pragma unroll
            for (int m = 0; m < 4; ++m) { const int row = row0 + ai * 128 + m * 16;
                const f32x4 pa = *(const f32x4*)(partkv + (size_t)row * 8), pb = *(const f32x4*)(partkv + (size_t)row * 8 + 4);
                const float ssq = ((pa[0] + pa[1]) + (pa[2] + pa[3])) + ((pb[0] + pb[1]) + (pb[2] + pb[3]));
                const float rs = 1.f / sqrtf(ssq * (1.f / 512.f) + EPS);
                *(u32x4*)(Km + (size_t)row * 1536 + pn * 192 + wc * 32 + 8 * fq) = pack8f(acc[ai][0][m][0] * rs, acc[ai][0][m][1] * rs);
                *(u32x4*)(Vm + (size_t)row * 1024 + pn * 128 + wc * 32 + 8 * fq) = pack8f(acc[ai][1][m][0] * rs, acc[ai][1][m][1] * rs); }
    }
};
struct EpiOut {
    static constexpr bool PERM = true, AFTER_DRAIN = false;
    bf16* Y; float* party;
    __device__ __forceinline__ void operator()(const af4 (&acc)[2][2][4][2], const pg8::Unit& u, int wr, int wc, int fr, int fq) const {
        const int pn = u.pn; const int row0 = u.pm * 256 + wr * 64 + fr; const int col0 = pn * 256 + wc * 32 + 8 * fq;
#pragma unroll
        for (int ai = 0; ai < 2; ++ai)
#pragma unroll
            for (int m = 0; m < 4; ++m) { const int row = row0 + ai * 128 + m * 16; float ss = 0.f;
#pragma unroll
                for (int bj = 0; bj < 2; ++bj) { const f32x4 v0 = acc[ai][bj][m][0], v1 = acc[ai][bj][m][1];
                    ss += (v0[0] * v0[0] + v0[1] * v0[1]) + (v0[2] * v0[2] + v0[3] * v0[3]) + (v1[0] * v1[0] + v1[1] * v1[1]) + (v1[2] * v1[2] + v1[3] * v1[3]);
                    *(u32x4*)(Y + (size_t)row * 2048 + col0 + bj * 128) = pack8f(v0, v1); }
                ss += __shfl_xor(ss, 16); ss += __shfl_xor(ss, 32); if (fq == 0) party[(size_t)row * 32 + pn * 4 + wc] = ss; }
    }
};

namespace att {
constexpr int KVBLK = 64, QBLK = 32, QB = 256;
constexpr int SHM_K = 24576, SHM_V = 16384;
constexpr int NRING = 3;
constexpr int OFF_K = 0, OFF_V = NRING * SHM_K, OFF_CK = OFF_V + NRING * SHM_V, OFF_WS = OFF_CK + 1024, OFF_QP = OFF_WS + 2048;
constexpr float THR = 20.f;
#define KSWZ(row, colB) ((row) * 256 + ((colB) ^ (((row) & 7) << 4)))
#define SBAR() __builtin_amdgcn_sched_barrier(0)
__device__ __forceinline__ int v_st(int k, int c) { const int kk = (k & ~0xC) | ((k & 4) << 1) | ((k & 8) >> 1); return ((kk >> 3) * 4 + (c >> 5)) * 512 + ((kk & 7) * 32 + (c & 31)) * 2; }
__device__ __forceinline__ int v_rd_base(int lane) { return ((lane & 3) << 3) | (((lane >> 2) & 3) << 6) | (((lane >> 4) & 1) << 5) | (((lane >> 5) & 1) << 8); }
constexpr int v_rd_off(int d0, int ks, int half) { return d0 * 512 + ks * 4096 + half * 2048; }
__device__ __forceinline__ int crow(int r, int hi) { return (r & 3) + 8 * (r >> 2) + 4 * hi; }
__device__ __forceinline__ unsigned cvtpk(float lo, float hi) { unsigned r; asm volatile("v_cvt_pk_bf16_f32 %0, %1, %2" : "=v"(r) : "v"(lo), "v"(hi)); return r; }

__device__ __forceinline__ void mask_tile(f32x16& p0, f32x16& p1, int dq) {
    const float NEG = -__builtin_inff();
#pragma unroll
    for (int r = 0; r < 16; ++r) { const int c = (r & 3) + 8 * (r >> 2);
        if (dq - c < 0) p0[r] = NEG;
        if (dq - c - 32 < 0) p1[r] = NEG; }
}
__device__ __forceinline__ void softmax_tile(f32x16& p0, f32x16& p1, float cq, float& m_reg, float& l_reg, float& alpha, bf16x8& pa0, bf16x8& pa1, bf16x8& pa2, bf16x8& pa3) {
    float ma = __builtin_fmaxf(__builtin_fmaxf(p0[0], p0[1]), p0[2]), mb = __builtin_fmaxf(__builtin_fmaxf(p1[0], p1[1]), p1[2]);
#pragma unroll
    for (int r = 3; r < 15; r += 2) { ma = __builtin_fmaxf(__builtin_fmaxf(ma, p0[r]), p0[r + 1]); mb = __builtin_fmaxf(__builtin_fmaxf(mb, p1[r]), p1[r + 1]); }
    float pmax = __builtin_fmaxf(__builtin_fmaxf(ma, mb), __builtin_fmaxf(p0[15], p1[15]));
    { auto rr = __builtin_amdgcn_permlane32_swap(__float_as_uint(pmax), __float_as_uint(pmax), false, false);
      pmax = fmaxf(__uint_as_float(rr[0]), __uint_as_float(rr[1])); }
    pmax += cq;
    float mn;
    if (__builtin_expect(__all(pmax - m_reg <= THR), 1)) { mn = m_reg; alpha = 1.f; }
    else { mn = fmaxf(m_reg, pmax); alpha = __builtin_amdgcn_exp2f(m_reg - mn); m_reg = mn; }
    const float sh = mn - cq;
#pragma unroll
    for (int r = 0; r < 16; ++r) { p0[r] = __builtin_amdgcn_exp2f(p0[r] - sh); p1[r] = __builtin_amdgcn_exp2f(p1[r] - sh); }
    float ps = 0.f;
#pragma unroll
    for (int r = 0; r < 16; ++r) ps += p0[r];
#pragma unroll
    for (int r = 0; r < 16; ++r) ps += p1[r];
    { auto rr = __builtin_amdgcn_permlane32_swap(__float_as_uint(ps), __float_as_uint(ps), false, false);
      ps = __uint_as_float(rr[0]) + __uint_as_float(rr[1]); }
    l_reg = l_reg * alpha + ps;
#define PK4(P, B_, OUT) do { unsigned a0 = cvtpk(P[B_+0], P[B_+1]), a1 = cvtpk(P[B_+2], P[B_+3]);                          \
        unsigned b0 = cvtpk(P[B_+4], P[B_+5]), b1 = cvtpk(P[B_+6], P[B_+7]);                                             \
        auto r0 = __builtin_amdgcn_permlane32_swap(a0, b0, false, false); auto r1 = __builtin_amdgcn_permlane32_swap(a1, b1, false, false); \
        u32x4 w = {r0[0], r1[0], r0[1], r1[1]}; OUT = *reinterpret_cast<bf16x8*>(&w); } while (0)
    PK4(p0, 0, pa0); PK4(p0, 8, pa1); PK4(p1, 0, pa2); PK4(p1, 8, pa3);
#undef PK4
}
template <int DQK, int NPARK>
__device__ __forceinline__ void qkt(f32x16& p0, f32x16& p1, const char* Kb, int r32, int hi, const bf16x8* qr, const char* qpk) {
    constexpr int ND = DQK / 16, NQR = ND - NPARK;
    p0 = f32x16{}; p1 = f32x16{};
    const char* kb[4];
#pragma unroll
    for (int dd = 0; dd < 4; ++dd) kb[dd] = Kb + KSWZ(r32, (dd * 16 + hi * 8) * 2);
    const char* kr = Kb + 16384 + r32 * 128;
    const int rx = (r32 & 7) << 4;
    bf16x8 kf[3][2], qf[3];
#define QK_LD(set, d_) do { \
            if ((d_) < 8) { const char* a_ = kb[(d_) & 3] + ((d_) >> 2) * 128; kf[set][0] = *reinterpret_cast<const bf16x8*>(a_); kf[set][1] = *reinterpret_cast<const bf16x8*>(a_ + 32 * 256); } \
            else { const char* a_ = kr + (((((d_) - 8) * 16 + hi * 8) * 2) ^ rx); kf[set][0] = *reinterpret_cast<const bf16x8*>(a_); kf[set][1] = *reinterpret_cast<const bf16x8*>(a_ + 32 * 128); } \
            if ((d_) >= NQR) qf[set] = *reinterpret_cast<const bf16x8*>(qpk + ((d_) - NQR) * 1024); } while (0)
    QK_LD(0, 0); QK_LD(1, 1); SBAR();
#pragma unroll
    for (int d = 0; d < ND; ++d) {
        const int cs = d % 3;
        if (d + 2 < ND) { const int ns = (d + 2) % 3; if (ns == 0) QK_LD(0, d + 2); else if (ns == 1) QK_LD(1, d + 2); else QK_LD(2, d + 2); SBAR(); }
        const bf16x8 q = (d < NQR) ? qr[d < NQR ? d : 0] : qf[cs];
        p0 = __builtin_amdgcn_mfma_f32_32x32x16_bf16(kf[cs][0], q, p0, 0, 0, 0);
        p1 = __builtin_amdgcn_mfma_f32_32x32x16_bf16(kf[cs][1], q, p1, 0, 0, 0);
        SBAR();
    }
#undef QK_LD
}
template <int VOFF>
__device__ __forceinline__ void pv_tile(f32x16* o, int vb0, bf16x8 pa0, bf16x8 pa1, bf16x8 pa2, bf16x8 pa3) {
#define TRRD(dst, off) asm volatile("ds_read_b64_tr_b16 %0, %1 offset:%2" : "=&v"(dst) : "v"(vb0), "i"(off) : "memory")
#define PV_D0(d0) do { s16x4 l0, l1, l2, l3, h0, h1, h2, h3; constexpr int b_ = VOFF + v_rd_off(d0, 0, 0); \
        TRRD(l0, b_); TRRD(h0, b_ + 2048); TRRD(l1, b_ + 4096); TRRD(h1, b_ + 6144); TRRD(l2, b_ + 8192); TRRD(h2, b_ + 10240); TRRD(l3, b_ + 12288); TRRD(h3, b_ + 14336); \
        asm volatile("s_waitcnt lgkmcnt(0)" ::: "memory"); SBAR(); \
        o[d0] = __builtin_amdgcn_mfma_f32_32x32x16_bf16((bf16x8){l0[0], l0[1], l0[2], l0[3], h0[0], h0[1], h0[2], h0[3]}, pa0, o[d0], 0, 0, 0);   \
        o[d0] = __builtin_amdgcn_mfma_f32_32x32x16_bf16((bf16x8){l1[0], l1[1], l1[2], l1[3], h1[0], h1[1], h1[2], h1[3]}, pa1, o[d0], 0, 0, 0);   \
        o[d0] = __builtin_amdgcn_mfma_f32_32x32x16_bf16((bf16x8){l2[0], l2[1], l2[2], l2[3], h2[0], h2[1], h2[2], h2[3]}, pa2, o[d0], 0, 0, 0);   \
        o[d0] = __builtin_amdgcn_mfma_f32_32x32x16_bf16((bf16x8){l3[0], l3[1], l3[2], l3[3], h3[0], h3[1], h3[2], h3[3]}, pa3, o[d0], 0, 0, 0); } while (0)
    PV_D0(0); PV_D0(1); PV_D0(2); PV_D0(3);
#undef PV_D0
#undef TRRD
}

#define RD128(dst, addr, off) asm volatile("ds_read_b128 %0, %1 offset:%2" : "=&v"(dst) : "v"(addr), "i"(off) : "memory")
#define RDTR(dst, addr, off) asm volatile("ds_read_b64_tr_b16 %0, %1 offset:%2" : "=&v"(dst) : "v"(addr), "i"(off) : "memory")
#define WAITK(n, x) asm volatile("s_waitcnt lgkmcnt(%1)" : "+v"(x) : "n"(n) : "memory")
#define WAITKQ(n, x, q) asm volatile("s_waitcnt lgkmcnt(%2)" : "+v"(x), "+v"(q) : "n"(n) : "memory")
#define WAITV(n, x, y) asm volatile("s_waitcnt lgkmcnt(%2)" : "+v"(x), "+v"(y) : "n"(n) : "memory")

__device__ __forceinline__ void mblock_mla_q(f32x16& p0, f32x16& p1, f32x16* o, const bf16x8* qr, bf16x8 pa0, bf16x8 pa1, bf16x8 pa2, bf16x8 pa3, const unsigned* kbv, const unsigned* krv, unsigned qpkv, unsigned vbv) {
    bf16x8 ksl[5], qsl[3]; s16x4 vlo[5], vhi[5];
    p0 = f32x16{}; p1 = f32x16{};
    RD128(ksl[0], kbv[0], 0);
    RD128(ksl[1], kbv[0], 8192);
    RD128(ksl[2], kbv[1], 0);
    RD128(ksl[3], kbv[1], 8192);
    RD128(ksl[4], kbv[2], 0);
    WAITK(4, ksl[0]); p0 = __builtin_amdgcn_mfma_f32_32x32x16_bf16(ksl[0], qr[0], p0, 0, 0, 0);
    RD128(ksl[0], kbv[2], 8192);
    WAITK(4, ksl[1]); p1 = __builtin_amdgcn_mfma_f32_32x32x16_bf16(ksl[1], qr[0], p1, 0, 0, 0);
    RD128(ksl[1], kbv[3], 0);
    WAITK(4, ksl[2]); p0 = __builtin_amdgcn_mfma_f32_32x32x16_bf16(ksl[2], qr[1], p0, 0, 0, 0);
    RD128(ksl[2], kbv[3], 8192);
    WAITK(4, ksl[3]); p1 = __builtin_amdgcn_mfma_f32_32x32x16_bf16(ksl[3], qr[1], p1, 0, 0, 0);
    RD128(ksl[3], kbv[0], 128);
    WAITK(4, ksl[4]); p0 = __builtin_amdgcn_mfma_f32_32x32x16_bf16(ksl[4], qr[2], p0, 0, 0, 0);
    RD128(ksl[4], kbv[0], 8320);
    WAITK(4, ksl[0]); p1 = __builtin_amdgcn_mfma_f32_32x32x16_bf16(ksl[0], qr[2], p1, 0, 0, 0);
    RD128(ksl[0], kbv[1], 128);
    WAITK(4, ksl[1]); p0 = __builtin_amdgcn_mfma_f32_32x32x16_bf16(ksl[1], qr[3], p0, 0, 0, 0);
    RD128(ksl[1], kbv[1], 8320);
    WAITK(4, ksl[2]); p1 = __builtin_amdgcn_mfma_f32_32x32x16_bf16(ksl[2], qr[3], p1, 0, 0, 0);
    RD128(ksl[2], kbv[2], 128);
    WAITK(4, ksl[3]); p0 = __builtin_amdgcn_mfma_f32_32x32x16_bf16(ksl[3], qr[4], p0, 0, 0, 0);
    RD128(ksl[3], kbv[2], 8320);
    WAITK(4, ksl[4]); p1 = __builtin_amdgcn_mfma_f32_32x32x16_bf16(ksl[4], qr[4], p1, 0, 0, 0);
    RD128(ksl[4], kbv[3], 128);
    WAITK(4, ksl[0]); p0 = __builtin_amdgcn_mfma_f32_32x32x16_bf16(ksl[0], qr[5], p0, 0, 0, 0);
    RD128(ksl[0], kbv[3], 8320);
    WAITK(4, ksl[1]); p1 = __builtin_amdgcn_mfma_f32_32x32x16_bf16(ksl[1], qr[5], p1, 0, 0, 0);
    RD128(ksl[1], krv[0], 0); RD128(qsl[2], qpkv, 0);
    WAITK(5, ksl[2]); p0 = __builtin_amdgcn_mfma_f32_32x32x16_bf16(ksl[2], qr[6], p0, 0, 0, 0);
    RD128(ksl[2], krv[0], 4096);
    WAITK(5, ksl[3]); p1 = __builtin_amdgcn_mfma_f32_32x32x16_bf16(ksl[3], qr[6], p1, 0, 0, 0);
    RD128(ksl[3], krv[1], 0); RD128(qsl[0], qpkv, 1024);
    WAITK(6, ksl[4]); p0 = __builtin_amdgcn_mfma_f32_32x32x16_bf16(ksl[4], qr[7], p0, 0, 0, 0);
    RD128(ksl[4], krv[1], 4096);
    WAITK(6, ksl[0]); p1 = __builtin_amdgcn_mfma_f32_32x32x16_bf16(ksl[0], qr[7], p1, 0, 0, 0);
    RD128(ksl[0], krv[2], 0); RD128(qsl[1], qpkv, 2048);
    WAITKQ(6, ksl[1], qsl[2]); p0 = __builtin_amdgcn_mfma_f32_32x32x16_bf16(ksl[1], qsl[2], p0, 0, 0, 0);
    RD128(ksl[1], krv[2], 4096);
    WAITKQ(6, ksl[2], qsl[2]); p1 = __builtin_amdgcn_mfma_f32_32x32x16_bf16(ksl[2], qsl[2], p1, 0, 0, 0);
    RD128(ksl[2], krv[3], 0); RD128(qsl[2], qpkv, 3072);
    WAITKQ(6, ksl[3], qsl[0]); p0 = __builtin_amdgcn_mfma_f32_32x32x16_bf16(ksl[3], qsl[0], p0, 0, 0, 0);
    RD128(ksl[3], krv[3], 4096);
    WAITKQ(6, ksl[4], qsl[0]); p1 = __builtin_amdgcn_mfma_f32_32x32x16_bf16(ksl[4], qsl[0], p1, 0, 0, 0);
    WAITKQ(4, ksl[0], qsl[1]); p0 = __builtin_amdgcn_mfma_f32_32x32x16_bf16(ksl[0], qsl[1], p0, 0, 0, 0);
    WAITKQ(3, ksl[1], qsl[1]); p1 = __builtin_amdgcn_mfma_f32_32x32x16_bf16(ksl[1], qsl[1], p1, 0, 0, 0);
    WAITKQ(1, ksl[2], qsl[2]); p0 = __builtin_amdgcn_mfma_f32_32x32x16_bf16(ksl[2], qsl[2], p0, 0, 0, 0);
    WAITKQ(0, ksl[3], qsl[2]); p1 = __builtin_amdgcn_mfma_f32_32x32x16_bf16(ksl[3], qsl[2], p1, 0, 0, 0);
}
__device__ __forceinline__ void mblock_fox_q(f32x16& p0, f32x16& p1, f32x16* o, const bf16x8* qr, bf16x8 pa0, bf16x8 pa1, bf16x8 pa2, bf16x8 pa3, const unsigned* kbv, const unsigned* krv, unsigned qpkv, unsigned vbv) {
    bf16x8 ksl[5], qsl[3]; s16x4 vlo[5], vhi[5];
    p0 = f32x16{}; p1 = f32x16{};
    RD128(ksl[0], kbv[0], 0);
    RD128(ksl[1], kbv[0], 8192);
    RD128(ksl[2], kbv[1], 0);
    RD128(ksl[3], kbv[1], 8192);
    RD128(ksl[4], kbv[2], 0);
    WAITK(4, ksl[0]); p0 = __builtin_amdgcn_mfma_f32_32x32x16_bf16(ksl[0], qr[0], p0, 0, 0, 0);
    RD128(ksl[0], kbv[2], 8192);
    WAITK(4, ksl[1]); p1 = __builtin_amdgcn_mfma_f32_32x32x16_bf16(ksl[1], qr[0], p1, 0, 0, 0);
    RD128(ksl[1], kbv[3], 0);
    WAITK(4, ksl[2]); p0 = __builtin_amdgcn_mfma_f32_32x32x16_bf16(ksl[2], qr[1], p0, 0, 0, 0);
    RD128(ksl[2], kbv[3], 8192);
    WAITK(4, ksl[3]); p1 = __builtin_amdgcn_mfma_f32_32x32x16_bf16(ksl[3], qr[1], p1, 0, 0, 0);
    RD128(ksl[3], kbv[0], 128); RD128(qsl[1], qpkv, 0);
    WAITK(5, ksl[4]); p0 = __builtin_amdgcn_mfma_f32_32x32x16_bf16(ksl[4], qr[2], p0, 0, 0, 0);
    RD128(ksl[4], kbv[0], 8320);
    WAITK(5, ksl[0]); p1 = __builtin_amdgcn_mfma_f32_32x32x16_bf16(ksl[0], qr[2], p1, 0, 0, 0);
    RD128(ksl[0], kbv[1], 128); RD128(qsl[2], qpkv, 1024);
    WAITK(6, ksl[1]); p0 = __builtin_amdgcn_mfma_f32_32x32x16_bf16(ksl[1], qr[3], p0, 0, 0, 0);
    RD128(ksl[1], kbv[1], 8320);
    WAITK(6, ksl[2]); p1 = __builtin_amdgcn_mfma_f32_32x32x16_bf16(ksl[2], qr[3], p1, 0, 0, 0);
    RD128(ksl[2], kbv[2], 128); RD128(qsl[0], qpkv, 2048);
    WAITKQ(6, ksl[3], qsl[1]); p0 = __builtin_amdgcn_mfma_f32_32x32x16_bf16(ksl[3], qsl[1], p0, 0, 0, 0);
    RD128(ksl[3], kbv[2], 8320);
    WAITKQ(6, ksl[4], qsl[1]); p1 = __builtin_amdgcn_mfma_f32_32x32x16_bf16(ksl[4], qsl[1], p1, 0, 0, 0);
    RD128(ksl[4], kbv[3], 128); RD128(qsl[1], qpkv, 3072);
    WAITKQ(6, ksl[0], qsl[2]); p0 = __builtin_amdgcn_mfma_f32_32x32x16_bf16(ksl[0], qsl[2], p0, 0, 0, 0);
    RD128(ksl[0], kbv[3], 8320);
    WAITKQ(6, ksl[1], qsl[2]); p1 = __builtin_amdgcn_mfma_f32_32x32x16_bf16(ksl[1], qsl[2], p1, 0, 0, 0);
    WAITKQ(4, ksl[2], qsl[0]); p0 = __builtin_amdgcn_mfma_f32_32x32x16_bf16(ksl[2], qsl[0], p0, 0, 0, 0);
    WAITKQ(3, ksl[3], qsl[0]); p1 = __builtin_amdgcn_mfma_f32_32x32x16_bf16(ksl[3], qsl[0], p1, 0, 0, 0);
    WAITKQ(1, ksl[4], qsl[1]); p0 = __builtin_amdgcn_mfma_f32_32x32x16_bf16(ksl[4], qsl[1], p0, 0, 0, 0);
    WAITKQ(0, ksl[0], qsl[1]); p1 = __builtin_amdgcn_mfma_f32_32x32x16_bf16(ksl[0], qsl[1], p1, 0, 0, 0);
}
#undef RD128
#undef RDTR
#undef WAITK
#undef WAITKQ
#undef WAITV

template <int DQK, bool FOX, int ABL = 0>
__device__ __forceinline__ void attn_unit(char* lds, const bf16* Q, int ldq, const bf16* K, int ldk, const bf16* V, int ldv, const float* cfs, const bf16* Gp, bf16* Op, int qb) {
    const int tid = threadIdx.x, wid = __builtin_amdgcn_readfirstlane(tid >> 6), lane = tid & 63, r32 = lane & 31, hi = lane >> 5;
    const bool grpA = wid < 4; const int w4 = wid & 3;
    const int q0 = qb * QB, NT = 4 * (qb + 1);
    char* K_lds = lds + OFF_K; char* V_lds = lds + OFF_V; float* ck_l = (float*)(lds + OFF_CK);
    float* wsf = (float*)(lds + OFF_WS) + wid * 64; float* li_l = wsf; float* al_l = wsf + 32;
    constexpr int NPARK = 4, NQR = DQK / 16 - NPARK;
    bf16x8 qr[NQR];
    char* qpk = lds + OFF_QP + wid * 4096 + (hi * 32 + r32) * 16;
    unsigned koff, kroff = 0, voff;
    { const int row = 4 * w4 + (lane >> 4), c = (lane & 15) ^ (row & 7); koff = (unsigned)(row * ldk + c * 8) * 2u; }
    { const int s0 = 2 * w4 + (lane >> 5), kk = 8 * (s0 >> 2) + ((lane & 31) >> 2), k = (kk & ~0xC) | ((kk & 4) << 1) | ((kk & 8) >> 1); voff = (unsigned)(k * ldv + 32 * (s0 & 3) + 8 * (lane & 3)) * 2u; }
    if constexpr (DQK == 192) { const int row = 8 * w4 + (lane >> 3), c = (lane & 7) ^ (row & 7); kroff = (unsigned)(row * ldk + 128 + c * 8) * 2u; }
    const int vb0 = (int)(uintptr_t)V_lds + v_rd_base(lane);
    LAS unsigned char* ldsl = (LAS unsigned char*)(uintptr_t)(unsigned)(uintptr_t)lds;
    unsigned kb0[4], kr0[4];
#pragma unroll
    for (int i = 0; i < 4; ++i) { const unsigned xo = (unsigned)((i * 32 + hi * 16) ^ ((r32 & 7) << 4)); kb0[i] = (unsigned)(uintptr_t)K_lds + r32 * 256 + xo; kr0[i] = (unsigned)(uintptr_t)K_lds + 16384 + r32 * 128 + xo; }
    const unsigned qpkv = (unsigned)(uintptr_t)qpk;
#define DMA_K(t, bf) do { const char* kt_ = (const char*)K + (size_t)(t) * KVBLK * ldk * 2; \
        _Pragma("unroll") for (int j_ = 0; j_ < 4; ++j_) \
            __builtin_amdgcn_global_load_lds((const unsigned*)(kt_ + koff + (size_t)j_ * 16 * ldk * 2), (LAS unsigned*)(ldsl + OFF_K + (bf) * SHM_K + (w4 + 4 * j_) * 1024), 16, 0, 0); \
        if constexpr (DQK == 192) { _Pragma("unroll") for (int j_ = 0; j_ < 2; ++j_) \
            __builtin_amdgcn_global_load_lds((const unsigned*)(kt_ + kroff + (size_t)j_ * 32 * ldk * 2), (LAS unsigned*)(ldsl + OFF_K + (bf) * SHM_K + 16384 + (w4 + 4 * j_) * 1024), 16, 0, 0); } \
        if constexpr (FOX) { __builtin_amdgcn_global_load_lds((const unsigned*)(cfs + (t) * KVBLK + lane), (LAS unsigned*)(ldsl + OFF_CK + ((t) & 3) * 256), 4, 0, 0); } } while (0)
#define DMA_V(t, bf) do { const char* vt_ = (const char*)V + (size_t)(t) * KVBLK * ldv * 2; \
        _Pragma("unroll") for (int j_ = 0; j_ < 4; ++j_) \
            __builtin_amdgcn_global_load_lds((const unsigned*)(vt_ + voff + (size_t)j_ * 16 * ldv * 2), (LAS unsigned*)(ldsl + OFF_V + (bf) * SHM_V + (w4 + 4 * j_) * 1024), 16, 0, 0); } while (0)
#define BAR_L() asm volatile("s_waitcnt lgkmcnt(0)\n\ts_barrier" ::: "memory")
#define BAR_VL() asm volatile("s_waitcnt vmcnt(0) lgkmcnt(0)\n\ts_barrier" ::: "memory")
    constexpr int NDK = 4 + (DQK == 192 ? 2 : 0) + (FOX ? 1 : 0), NDV = 4;
#define BAR_VN(n) asm volatile("s_waitcnt vmcnt(%0) lgkmcnt(0)\n\ts_barrier" :: "n"(n) : "memory")
    if (grpA) DMA_K(0, 0);
    { const bf16* qp = Q + (size_t)(q0 + wid * QBLK + r32) * ldq + hi * 8;
#pragma unroll
      for (int d0 = 0; d0 < NQR; ++d0) qr[d0] = *(const bf16x8*)(qp + d0 * 16);
#pragma unroll
      for (int d0 = 0; d0 < NPARK; ++d0) *(bf16x8*)(qpk + d0 * 1024) = *(const bf16x8*)(qp + (NQR + d0) * 16); }
    float cq = 0.f; if constexpr (FOX) cq = cfs[q0 + wid * QBLK + r32];
    asm volatile("s_waitcnt vmcnt(0)" ::: "memory");
    if (grpA) { DMA_K(1, 1); DMA_V(0, 0); BAR_VN(NDK + NDV); } else BAR_VN(0);
    if (!grpA) BAR_L();
    float m_reg = -1e30f, l_reg = 0.f; f32x16 o[4] = {}; f32x16 p0 = {}, p1 = {}; bf16x8 pa0 = {}, pa1 = {}, pa2 = {}, pa3 = {};
#define ACTW(tt) ((tt) - (NT - 4) < 0 || 64 * ((tt) - (NT - 4)) <= 32 * wid + 31)
    int rc = 0, rp = 2, rn = 1;
#pragma unroll 1
    for (int t = 0; t < NT; ++t) {
        if (grpA && !(ABL & 1)) { if (t + 2 < NT) DMA_K(t + 2, rp); if (t + 1 < NT) DMA_V(t + 1, rn); }
        const int jb_ = t - (NT - 4); const bool act_ = ACTW(t);
        if (act_ && !(ABL & 4)) { unsigned kbv[4], krv[4];
#pragma unroll
            for (int i = 0; i < 4; ++i) { kbv[i] = kb0[i] + rc * SHM_K; krv[i] = kr0[i] + rc * SHM_K; }
            if constexpr (DQK == 192) mblock_mla_q(p0, p1, o, qr, pa0, pa1, pa2, pa3, kbv, krv, qpkv, 0u); else mblock_fox_q(p0, p1, o, qr, pa0, pa1, pa2, pa3, kbv, krv, qpkv, 0u); }
        if (t > 0 && ACTW(t - 1) && !(ABL & 4)) { SBAR(); pv_tile<0>(o, vb0 + rp * SHM_V, pa0, pa1, pa2, pa3); }
        BAR_L();
        if (act_ && (ABL & 8)) {
#define PK4(P, B_, OUT) do { unsigned a0 = cvtpk(P[B_+0], P[B_+1]), a1 = cvtpk(P[B_+2], P[B_+3]); unsigned b0 = cvtpk(P[B_+4], P[B_+5]), b1 = cvtpk(P[B_+6], P[B_+7]); \
        auto r0 = __builtin_amdgcn_permlane32_swap(a0, b0, false, false); auto r1 = __builtin_amdgcn_permlane32_swap(a1, b1, false, false); u32x4 w = {r0[0], r1[0], r0[1], r1[1]}; OUT = *reinterpret_cast<bf16x8*>(&w); } while (0)
            PK4(p0, 0, pa0); PK4(p0, 8, pa1); PK4(p1, 0, pa2); PK4(p1, 8, pa3);
#undef PK4
        }
        if (act_ && !(ABL & 2)) { float alpha;
            if constexpr (FOX) { const float* ckp = ck_l + (t & 3) * 64 + 4 * hi;
#pragma unroll
                for (int g_ = 0; g_ < 4; ++g_) { const f32x4 c0 = *(const f32x4*)(ckp + 8 * g_), c1 = *(const f32x4*)(ckp + 32 + 8 * g_);
#pragma unroll
                    for (int e_ = 0; e_ < 4; ++e_) { p0[4 * g_ + e_] -= c0[e_]; p1[4 * g_ + e_] -= c1[e_]; } } }
            if (jb_ >= 0 && 64 * jb_ + 63 > 32 * wid) mask_tile(p0, p1, 32 * wid + r32 - 64 * jb_ - 4 * hi);
            softmax_tile(p0, p1, cq, m_reg, l_reg, alpha, pa0, pa1, pa2, pa3);
            if (__any(alpha < 1.f)) {
#pragma unroll
                for (int d_ = 0; d_ < 4; ++d_)
#pragma unroll
                    for (int r = 0; r < 16; ++r) o[d_][r] *= alpha; }
        }
        if (ABL & 1) BAR_VN(0); else if (t + 2 < NT) BAR_VN(NDK + NDV); else if (t + 1 < NT) BAR_VN(NDV); else BAR_VN(0);
        rp = rc; rc = rn; rn = (rn == NRING - 1) ? 0 : rn + 1;
    }
    if (ACTW(NT - 1)) { SBAR(); pv_tile<0>(o, vb0 + rp * SHM_V, pa0, pa1, pa2, pa3); }
    if (grpA) BAR_L();
#undef BAR_VN
#undef ACTW
#undef DMA_K
#undef DMA_V
    { const float rl = __builtin_amdgcn_rcpf(l_reg);
      const size_t rowoff = (size_t)(q0 + wid * QBLK + r32) * 2048;
      const bf16* gp = Gp + rowoff + 4 * hi; bf16* op = Op + rowoff + 8 * hi;
#pragma unroll
      for (int k2 = 0; k2 < 8; ++k2) { const int ka = 2 * k2, kb = 2 * k2 + 1;
          const u32x2 ga = *(const u32x2*)(gp + 8 * ka), gb = *(const u32x2*)(gp + 8 * kb);
          const int ra = 4 * (ka & 3), rb = 4 * (kb & 3);
          unsigned ax = cvtpk(o[ka >> 2][ra] * rl * bflo(ga.x), o[ka >> 2][ra + 1] * rl * bfhi(ga.x)), ay = cvtpk(o[ka >> 2][ra + 2] * rl * bflo(ga.y), o[ka >> 2][ra + 3] * rl * bfhi(ga.y));
          unsigned bx = cvtpk(o[kb >> 2][rb] * rl * bflo(gb.x), o[kb >> 2][rb + 1] * rl * bfhi(gb.x)), by = cvtpk(o[kb >> 2][rb + 2] * rl * bflo(gb.y), o[kb >> 2][rb + 3] * rl * bfhi(gb.y));
          { auto sx = __builtin_amdgcn_permlane32_swap(ax, bx, false, false); ax = sx[0]; bx = sx[1]; }
          { auto sy = __builtin_amdgcn_permlane32_swap(ay, by, false, false); ay = sy[0]; by = sy[1]; }
          u32x4 w; w.x = ax; w.y = ay; w.z = bx; w.w = by;
          *(u32x4*)(op + 16 * k2) = w; } }
    BAR_VL();
#undef BAR_L
#undef BAR_VL
}
#undef KSWZ
#undef SBAR
}

__device__ __forceinline__ void transpose_item(const float* W, int ldw, int K, const float* g, bf16* WT, int dst_row0, int src_col0, int nvalid, int k0, LAS float* scr, int lane) {
    const int n = lane & 31; const bool ok = (src_col0 >= 0) && (n < nvalid);
    float tv[32];
#pragma unroll
    for (int i = 0; i < 32; ++i) { const int kk = 2 * i + (lane >> 5); tv[i] = ok ? W[(size_t)(k0 + kk) * ldw + src_col0 + n] : 0.f; }
    if (g) {
#pragma unroll
        for (int i = 0; i < 32; ++i) tv[i] *= g[k0 + 2 * i + (lane >> 5)]; }
#pragma unroll
    for (int i = 0; i < 32; ++i) scr[(2 * i + (lane >> 5)) * 33 + n] = tv[i];
    asm volatile("s_waitcnt lgkmcnt(0)" ::: "memory");
    const int c = lane & 7;
#pragma unroll
    for (int j = 0; j < 4; ++j) { const int nn = (lane >> 3) + 8 * j; const LAS float* s = scr + (8 * c) * 33 + nn;
        u32x4 o; o.x = pk2(s[0 * 33], s[1 * 33]); o.y = pk2(s[2 * 33], s[3 * 33]); o.z = pk2(s[4 * 33], s[5 * 33]); o.w = pk2(s[6 * 33], s[7 * 33]);
        *(u32x4*)(WT + (size_t)(dst_row0 + nn) * K + k0 + 8 * c) = o; }
    asm volatile("s_waitcnt lgkmcnt(0)" ::: "memory");
}
__device__ __forceinline__ void win_src(int r0, int& src, int& nv) {
    nv = 32;
    if (r0 < 1280) src = r0;
    else if (r0 < 2304) src = 1344 + (r0 - 1280);
    else if (r0 < 3328) src = 2368 + (r0 - 2304);
    else if (r0 < 4352) src = 3392 + (r0 - 3328);
    else if (r0 < 5376) src = 4416 + (r0 - 4352);
    else if (r0 < 6400) src = 5448 + (r0 - 5376);
    else if (r0 == 6400) src = 1280;
    else if (r0 == 6432) { src = 5440; nv = 8; }
    else if (r0 == 6528) src = 1312;
    else src = -1;
}
__device__ __forceinline__ int wuq_src(int r0) {
    if (r0 < 1024) return (r0 >> 7) * 192 + (r0 & 127);
    const int q = r0 - 1024, t = q >> 8, bj = (q >> 7) & 1, wc = (q >> 5) & 3;
    return (4 * t + wc) * 192 + 128 + 32 * bj;
}


#define XB_TMO      128
#define XB_XCNT(j)  (256  + 64 * (j))
#define XB_XSUB(j)  (1280 + 64 * (j))
#define XB_XGEN(j)  (2304 + 64 * (j))
#define XB_TOP      3328
#define XB_TOPGEN   3392
#define XCD_BAR_WORDS 3456
#define XB_SPIN_CAP (1u << 18)
__device__ __forceinline__ unsigned xb_ld(unsigned* p)              { return __hip_atomic_load(p, __ATOMIC_RELAXED, __HIP_MEMORY_SCOPE_AGENT); }
__device__ __forceinline__ unsigned xb_add(unsigned* p, unsigned v) { return __hip_atomic_fetch_add(p, v, __ATOMIC_RELAXED, __HIP_MEMORY_SCOPE_AGENT); }
__device__ __forceinline__ unsigned xb_xcc_id() { return (unsigned)__builtin_amdgcn_s_getreg((3 << 11) | 20) & 0xFu; }
#define XB_SPIN(cond, bar) do { unsigned _sp = 0; while (cond) { __builtin_amdgcn_s_sleep(1); \
    if ((++_sp & 255u) == 0u) { if (xb_ld(&(bar)[XB_TMO])) break; if (_sp > XB_SPIN_CAP) { atomicAdd(&(bar)[XB_TMO], 1u); break; } } } } while (0)
struct XcdBarrier { unsigned* bar; unsigned x; volatile LAS unsigned* st; };
__device__ __forceinline__ XcdBarrier xcd_barrier_post(unsigned* bar, volatile LAS unsigned* st) {
    XcdBarrier b; b.bar = bar; b.x = xb_xcc_id(); b.st = st;
    if (threadIdx.x == 0) (void)xb_add(&bar[XB_XCNT(b.x)], 1u);
    return b;
}
__device__ __forceinline__ void xcd_barrier_complete(unsigned* bar, unsigned x, unsigned& nloc, unsigned& nx) {
    const unsigned G = gridDim.x * gridDim.y * gridDim.z;
    unsigned sum, cnt, mine, sp = 0u;
    for (;;) {
        sum = 0u; cnt = 0u; mine = 0u;
#pragma unroll
        for (unsigned j = 0; j < 16; ++j) { const unsigned c = xb_ld(&bar[XB_XCNT(j)]); sum += c; cnt += (c > 0u) ? 1u : 0u; mine = (j == x) ? c : mine; }
        if (sum == G) break;
        __builtin_amdgcn_s_sleep(1);
        if ((++sp & 255u) == 0u) { if (xb_ld(&bar[XB_TMO])) break; if (sp > XB_SPIN_CAP) { atomicAdd(&bar[XB_TMO], 1u); break; } }
    }
    nloc = mine > 0u ? mine : 1u; nx = cnt > 0u ? cnt : 1u;
}
__device__ __forceinline__ void xcd_barrier(const XcdBarrier& b) {
    asm volatile("s_waitcnt vmcnt(0)" ::: "memory");
    __syncthreads();
    if (threadIdx.x == 0) {
        unsigned* bar = b.bar;
        __builtin_amdgcn_s_waitcnt(0);
        unsigned nloc = b.st[0], nx = b.st[1];
        if (nloc == 0u) { xcd_barrier_complete(bar, b.x, nloc, nx); b.st[0] = nloc; b.st[1] = nx; }
        const unsigned old = xb_add(&bar[XB_XSUB(b.x)], 1u);
        const unsigned gen = old / nloc;
        if (old + 1u == (gen + 1u) * nloc) {
            __builtin_amdgcn_fence(__ATOMIC_RELEASE, "agent");
            asm volatile("s_waitcnt vmcnt(0)" ::: "memory");
            const unsigned og = xb_add(&bar[XB_TOP], 1u);
            const unsigned tg = og / nx;
            if (og + 1u == (tg + 1u) * nx) xb_add(&bar[XB_TOPGEN], 1u);
            else XB_SPIN(xb_ld(&bar[XB_TOPGEN]) == tg, bar);
            __builtin_amdgcn_fence(__ATOMIC_ACQUIRE, "agent");
            xb_add(&bar[XB_XGEN(b.x)], 1u);
            asm volatile("s_waitcnt vmcnt(0)" ::: "memory");
        } else {
            XB_SPIN(xb_ld(&bar[XB_XGEN(b.x)]) == gen, bar);
            __builtin_amdgcn_fence(__ATOMIC_ACQUIRE, "agent");
            asm volatile("s_waitcnt vmcnt(0)" ::: "memory");
        }
    }
    __syncthreads();
}

struct Args { const float* x; const int* pos; const float* g_pre; const float* w_in; const float* g_q; const float* w_uq; const float* g_kv; const float* w_ukv;
              const float* b_forget; const float* w_out; const float* g_post; float* out; unsigned char* ws; int ph_lo, ph_hi; };

__global__ void __launch_bounds__(512, 2) hybrid_fwd(Args a) {
    extern __shared__ __attribute__((aligned(16))) unsigned char lds[];
    cg::grid_group grid = cg::this_grid();
    const int tid_k = threadIdx.x, lane_k = tid_k & 63, wave = __builtin_amdgcn_readfirstlane(tid_k >> 6);
    const int G = gridDim.x, bx = blockIdx.x; const int vcu = (G % 8 == 0) ? (bx % 8) * (G / 8) + bx / 8 : bx;
    unsigned char* ws = a.ws;
    float* rstd_x = (float*)(ws + WS_RSTDX); float* partq = (float*)(ws + WS_PARTQ); float* partkv = (float*)(ws + WS_PARTKV); float* party = (float*)(ws + WS_PARTY);
    float* flog = (float*)(ws + WS_FLOG); float* cf = (float*)(ws + WS_CF); float* cosT = (float*)(ws + WS_COS); float* sinT = (float*)(ws + WS_SIN);
    bf16* Win_t = (bf16*)(ws + WS_WIN); bf16* Wuq_t = (bf16*)(ws + WS_WUQ); bf16* Wukv_t = (bf16*)(ws + WS_WUKV); bf16* Wout_t = (bf16*)(ws + WS_WOUT);
    bf16* Xb = (bf16*)(ws + WS_XB); bf16* Ob = (bf16*)(ws + WS_O); bf16* qlat = (bf16*)(ws + WS_QLAT); bf16* kvlat = (bf16*)(ws + WS_KVLAT); bf16* Gb = (bf16*)(ws + WS_G);
    bf16* Qf = (bf16*)(ws + WS_QF); bf16* Kf = (bf16*)(ws + WS_KF); bf16* Vf = (bf16*)(ws + WS_VF); bf16* Yb = (bf16*)(ws + WS_Y);
    bf16* Qm = (bf16*)(ws + WS_QM); bf16* Km = (bf16*)(ws + WS_KM); bf16* Vm = (bf16*)(ws + WS_VM);
    const int lo = a.ph_lo, hi = a.ph_hi;
#ifndef PH_MASK
#define PH_MASK 63
#endif
#define IN(k) (((PH_MASK >> (k)) & 1) && lo <= (k) && (k) < hi)
#define BOTH(k) (IN(k) && IN((k) + 1))
    LAS unsigned char* ldsl = (LAS unsigned char*)lds;
    volatile LAS unsigned* bst = (volatile LAS unsigned*)(ldsl + LDS_BYTES - 64);
    if (tid_k < 2) bst[tid_k] = 0u;
    __syncthreads();
    XcdBarrier xbar = xcd_barrier_post((unsigned*)(ws + WS_CTL), bst);

    if (IN(0)) for (int rep_ = 0; rep_ < PROBE_REP0; ++rep_) {
        const int lane = launder(lane_k), tid = launder(tid_k);
        LAS float* scr = (LAS float*)(ldsl + wave * 16384);
        const int gw = vcu * 8 + wave, NGW = G * 8;
        constexpr int I_IN = 32 * 208, I_UQ = 12 * 48, I_UKV = 8 * 64, I_OUT = 32 * 64, NITEMS = I_IN + I_UQ + I_UKV + I_OUT;
        for (int it = gw; it < NITEMS; it += NGW) {
            int r = it;
            if (r < I_IN) { const int kb = r / 208, nb = r % 208; int src, nv; win_src(nb * 32, src, nv); transpose_item(a.w_in, DIN, 2048, a.g_pre, Win_t, nb * 32, src, nv, kb * 64, scr, lane); continue; } r -= I_IN;
            if (r < I_UQ) { const int kb = r / 48, nb = r % 48; transpose_item(a.w_uq, 1536, 768, a.g_q, Wuq_t, nb * 32, wuq_src(nb * 32), 32, kb * 64, scr, lane); continue; } r -= I_UQ;
            if (r < I_UKV) { const int kb = r / 64, nb = r % 64; transpose_item(a.w_ukv, 2048, 512, a.g_kv, Wukv_t, nb * 32, nb * 32, 32, kb * 64, scr, lane); continue; } r -= I_UKV;
            { const int kb = r / 64, nb = r % 64; transpose_item(a.w_out, 2048, 2048, nullptr, Wout_t, nb * 32, nb * 32, 32, kb * 64, scr, lane); }
        }
        for (int m = gw; m < M; m += 2 * NGW) {
            const int m2 = m + NGW;
            const f32x4* xr = (const f32x4*)(a.x + (size_t)m * DM) + lane; const f32x4* xr2 = (const f32x4*)(a.x + (size_t)m2 * DM) + lane; f32x4 v[8], v2[8]; float s = 0.f, s2 = 0.f;
#pragma unroll
            for (int j = 0; j < 8; ++j) { v[j] = __builtin_nontemporal_load(xr + 64 * j); v2[j] = __builtin_nontemporal_load(xr2 + 64 * j); }
#pragma unroll
            for (int j = 0; j < 8; ++j) { s += (v[j][0] * v[j][0] + v[j][1] * v[j][1]) + (v[j][2] * v[j][2] + v[j][3] * v[j][3]); s2 += (v2[j][0] * v2[j][0] + v2[j][1] * v2[j][1]) + (v2[j][2] * v2[j][2] + v2[j][3] * v2[j][3]); }
            s = wave_sum(s); s2 = wave_sum(s2);
            if (lane == 0) { rstd_x[m] = 1.f / sqrtf(s * (1.f / DM) + EPS); rstd_x[m2] = 1.f / sqrtf(s2 * (1.f / DM) + EPS); }
            u32x2* o8 = (u32x2*)(Xb + (size_t)m * DM) + lane; u32x2* o82 = (u32x2*)(Xb + (size_t)m2 * DM) + lane;
#pragma unroll
            for (int j = 0; j < 8; ++j) { u32x2 w; w.x = pk2(v[j][0], v[j][1]); w.y = pk2(v[j][2], v[j][3]); o8[64 * j] = w; u32x2 w2; w2.x = pk2(v2[j][0], v2[j][1]); w2.y = pk2(v2[j][2], v2[j][3]); o82[64 * j] = w2; }
        }
        for (int e = (vcu * 512 + tid); e < M * 32; e += G * 512) { const int row = e >> 5, i = e & 31;
            const float inv = exp2f(-(float)i * (13.287712379549449f / 32.f)); const float ang = (float)a.pos[row] * inv;
            const float n = rintf(ang * 0.15915494309189535f); float r = fmaf(-n, 6.28318548202514648f, ang); r = fmaf(-n, -1.7484555e-7f, r);
            cosT[e] = __cosf(r); sinT[e] = __sinf(r); }
    }
    if (BOTH(0)) xcd_barrier(xbar);
    if (a.ph_hi > 64) grid.sync();

    if (IN(1)) for (int rep_ = 0; rep_ < PROBE_REP1; ++rep_) {
        pg8::Gemm g{Xb, Win_t, M, NIN_PAD, 2048}; pg8::StaticOrder S; S.init(M, NIN_PAD, G, bx);
        EpiIn E{rstd_x, qlat, kvlat, Gb, Qf, Kf, Vf, Km, flog, partq, partkv, cosT, sinT};
        pg8::gemm_phase<EpiIn, pg8::StaticOrder, true, true>(ldsl, g, S, E);
    }
    if (BOTH(1)) xcd_barrier(xbar);

    if (IN(2)) for (int rep_ = 0; rep_ < PROBE_REP2; ++rep_) {
        const int lane = launder(lane_k), tid = launder(tid_k);
        if (bx >= G - BATCH * NH) { const int sq_ = bx - (G - BATCH * NH);
            const int b = sq_ >> 3, h = sq_ & 7; const float bf = a.b_forget[h];
            const float* fl = flog + ((size_t)b * SEQ + 8 * tid) * 8 + h; float lf[8];
#pragma unroll
            for (int j = 0; j < 8; ++j) lf[j] = fl[j * 8] + bf;
#pragma unroll
            for (int j = 0; j < 8; ++j) { const float z = lf[j]; lf[j] = fminf(z, 0.f) - log1pf(expf(-fabsf(z))); }
#pragma unroll
            for (int j = 1; j < 8; ++j) lf[j] += lf[j - 1];
            float incl = lf[7];
#pragma unroll
            for (int o = 1; o < 64; o <<= 1) { const float t = __shfl_up(incl, o); if (lane >= o) incl += t; }
            volatile LAS float* wtot = (volatile LAS float*)(ldsl + LDS_BYTES - 128);
            if (lane == 63) wtot[wave] = incl;
            __syncthreads();
            float off = incl - lf[7];
            for (int w2 = 0; w2 < wave; ++w2) off += wtot[w2];
            float* cp = cf + (size_t)sq_ * SEQ + 8 * tid;
            f32x4 o0, o1;
#pragma unroll
            for (int j = 0; j < 4; ++j) { o0[j] = (off + lf[j]) * LOG2E; o1[j] = (off + lf[4 + j]) * LOG2E; }
            *(f32x4*)cp = o0; *(f32x4*)(cp + 4) = o1;
            __syncthreads();
        }
        { pg8::Gemm g{qlat, Wuq_t, M, 1536, QRANK}; pg8::StaticOrder S; S.init(M, 1536, G, bx);
          EpiQ E{partq, Qm, cosT, sinT};
          pg8::gemm_phase<EpiQ, pg8::StaticOrder, true, true>(ldsl, g, S, E); }
        { pg8::Gemm g{kvlat, Wukv_t, M, 2048, KVRANK}; pg8::StaticOrder S; S.init(M, 2048, G, bx);
          EpiKV E{partkv, Km, Vm};
          pg8::gemm_phase<EpiKV, pg8::StaticOrder, true, true>(ldsl, g, S, E); }
    }
    if (BOTH(2)) xcd_barrier(xbar);

    if (IN(3)) for (int rep_ = 0; rep_ < PROBE_REP3; ++rep_) {
        for (int v = vcu; v < 256; v += G) {
            const int s = v & 3, w = v >> 2, b = w >> 4, hh = w & 15, hd = hh & 7, swp = hh >> 3;
            const size_t rb = (size_t)b * SEQ;
#pragma unroll 1
            for (int i = 0; i < 2; ++i) {
                const int qb = __builtin_amdgcn_readfirstlane(swp ? (i == 0 ? 8 + s : 7 - s) : (i == 0 ? 15 - s : s));
                att::attn_unit<192, false>((char*)lds, Qm + rb * 1536 + hd * 192, 1536, Km + rb * 1536 + hd * 192, 1536, Vm + rb * 1024 + hd * 128, 1024, nullptr,
                                           Gb + rb * 2048 + hd * 128, Ob + rb * 2048 + hd * 128, qb);
            }
#pragma unroll 1
            for (int i = 0; i < 2; ++i) {
                const int qb = __builtin_amdgcn_readfirstlane(swp ? (i == 0 ? 15 - s : s) : (i == 0 ? 8 + s : 7 - s));
                att::attn_unit<128, true>((char*)lds, Qf + rb * 1024 + hd * 128, 1024, Kf + rb * 1024 + hd * 128, 1024, Vf + rb * 1024 + hd * 128, 1024, cf + (size_t)(b * 8 + hd) * SEQ,
                                          Gb + rb * 2048 + 1024 + hd * 128, Ob + rb * 2048 + 1024 + hd * 128, qb);
            }
        }
    }
#if PROBE_ABL >= 0
    if (IN(3)) {
        for (int v = vcu; v < 256; v += G) {
            const int s = v & 3, w = v >> 2, b = w >> 4, hh = w & 15, hd = hh & 7, swp = hh >> 3;
            const size_t rb = (size_t)b * SEQ;
#pragma unroll 1
            for (int i = 0; i < 2; ++i) {
                const int qb = __builtin_amdgcn_readfirstlane(swp ? (i == 0 ? 8 + s : 7 - s) : (i == 0 ? 15 - s : s));
                att::attn_unit<192, false, PROBE_ABL>((char*)lds, Qm + rb * 1536 + hd * 192, 1536, Km + rb * 1536 + hd * 192, 1536, Vm + rb * 1024 + hd * 128, 1024, nullptr,
                                           Gb + rb * 2048 + hd * 128, qlat, qb);
            }
#pragma unroll 1
            for (int i = 0; i < 2; ++i) {
                const int qb = __builtin_amdgcn_readfirstlane(swp ? (i == 0 ? 15 - s : s) : (i == 0 ? 8 + s : 7 - s));
                att::attn_unit<128, true, PROBE_ABL>((char*)lds, Qf + rb * 1024 + hd * 128, 1024, Kf + rb * 1024 + hd * 128, 1024, Vf + rb * 1024 + hd * 128, 1024, cf + (size_t)(b * 8 + hd) * SEQ,
                                          Gb + rb * 2048 + 1024 + hd * 128, qlat, qb);
            }
        }
    }
#endif
    if (BOTH(3)) xcd_barrier(xbar);

    if (IN(4)) for (int rep_ = 0; rep_ < PROBE_REP4; ++rep_) {
        pg8::Gemm g{Ob, Wout_t, M, 2048, 2048}; pg8::StaticOrder S; S.init(M, 2048, G, bx);
        EpiOut E{Yb, party};
        pg8::gemm_phase<EpiOut, pg8::StaticOrder, true, true>(ldsl, g, S, E);
    }
    if (BOTH(4)) xcd_barrier(xbar);

    if (IN(5)) for (int rep_ = 0; rep_ < PROBE_REP5; ++rep_) {
        const int lane = launder(lane_k);
        const int gw = vcu * 8 + wave, NGW = G * 8;
        const f32x4* gp = (const f32x4*)a.g_post + lane; f32x4 gv[8];
#pragma unroll
        for (int j = 0; j < 8; ++j) gv[j] = gp[64 * j];
        for (int m = gw; m < M; m += 2 * NGW) {
            const int m2 = m + NGW;
            float s = (lane < 32) ? party[(size_t)m * 32 + lane] : 0.f, s2 = (lane < 32) ? party[(size_t)m2 * 32 + lane] : 0.f;
            const f32x4* xr = (const f32x4*)(a.x + (size_t)m * DM) + lane; const f32x4* xr2 = (const f32x4*)(a.x + (size_t)m2 * DM) + lane;
            const u32x2* yr = (const u32x2*)(Yb + (size_t)m * DM) + lane; const u32x2* yr2 = (const u32x2*)(Yb + (size_t)m2 * DM) + lane;
            f32x4 xv[8], xv2[8]; u32x2 y[8], y2[8];
#pragma unroll
            for (int j = 0; j < 8; ++j) { xv[j] = __builtin_nontemporal_load(xr + 64 * j); xv2[j] = __builtin_nontemporal_load(xr2 + 64 * j); y[j] = __builtin_nontemporal_load(yr + 64 * j); y2[j] = __builtin_nontemporal_load(yr2 + 64 * j); }
            s = wave_sum(s); s2 = wave_sum(s2);
            const float rs = 1.f / sqrtf(s * (1.f / DM) + EPS), rs2 = 1.f / sqrtf(s2 * (1.f / DM) + EPS);
            f32x4* orow = (f32x4*)(a.out + (size_t)m * DM) + lane; f32x4* orow2 = (f32x4*)(a.out + (size_t)m2 * DM) + lane;
#pragma unroll
            for (int j = 0; j < 8; ++j) {
                f32x4 o; o[0] = xv[j][0] + bflo(y[j].x) * rs * gv[j][0]; o[1] = xv[j][1] + bfhi(y[j].x) * rs * gv[j][1]; o[2] = xv[j][2] + bflo(y[j].y) * rs * gv[j][2]; o[3] = xv[j][3] + bfhi(y[j].y) * rs * gv[j][3];
                __builtin_nontemporal_store(o, orow + 64 * j);
                f32x4 o2; o2[0] = xv2[j][0] + bflo(y2[j].x) * rs2 * gv[j][0]; o2[1] = xv2[j][1] + bfhi(y2[j].x) * rs2 * gv[j][1]; o2[2] = xv2[j][2] + bflo(y2[j].y) * rs2 * gv[j][2]; o2[3] = xv2[j][3] + bfhi(y2[j].y) * rs2 * gv[j][3];
                __builtin_nontemporal_store(o2, orow2 + 64 * j); }
        }
    }
#undef IN
#undef BOTH
}

extern "C" void kernel_launch(void* const* d_in, const int* in_sizes, int n_in, void* d_out, int out_size, void* d_ws, size_t ws_size, hipStream_t stream) {
    static int grid = 0;
    if (grid == 0) {
        if (n_in != 11 || in_sizes[0] != M * DM || out_size != M * DM || ws_size < WS_END) { fprintf(stderr, "kernel_launch: shape mismatch n_in %d in0 %d out %d ws %zu\n", n_in, n_in > 0 ? in_sizes[0] : -1, out_size, ws_size); grid = -1; return; }
        int dev = 0, cus = 0, per_cu = 0;
        if (hipGetDevice(&dev) != hipSuccess || hipDeviceGetAttribute(&cus, hipDeviceAttributeMultiprocessorCount, dev) != hipSuccess) { grid = -1; return; }
        if (hipFuncSetAttribute((const void*)hybrid_fwd, hipFuncAttributeMaxDynamicSharedMemorySize, LDS_BYTES) != hipSuccess) { fprintf(stderr, "kernel_launch: hipFuncSetAttribute failed\n"); grid = -1; return; }
        if (hipOccupancyMaxActiveBlocksPerMultiprocessor(&per_cu, (const void*)hybrid_fwd, 512, LDS_BYTES) != hipSuccess || per_cu < 1) { fprintf(stderr, "kernel_launch: occupancy query says %d\n", per_cu); per_cu = 1; }
        (void)hipGetLastError();
        grid = cus;
    }
    if (grid < 0) return;
    if (hipMemsetAsync((char*)d_ws + WS_CTL, 0, CTL_BYTES, stream) != hipSuccess) { fprintf(stderr, "kernel_launch: memset failed\n"); return; }
    Args a{};
    a.x = (const float*)d_in[0]; a.pos = (const int*)d_in[1]; a.g_pre = (const float*)d_in[2]; a.w_in = (const float*)d_in[3]; a.g_q = (const float*)d_in[4]; a.w_uq = (const float*)d_in[5];
    a.g_kv = (const float*)d_in[6]; a.w_ukv = (const float*)d_in[7]; a.b_forget = (const float*)d_in[8]; a.w_out = (const float*)d_in[9]; a.g_post = (const float*)d_in[10];
    a.out = (float*)d_out; a.ws = (unsigned char*)d_ws;
#if MK_N_LAUNCHES == 1
    a.ph_lo = 0; a.ph_hi = 6;
    void* args[] = {&a};
    hipError_t e = hipLaunchCooperativeKernel((const void*)hybrid_fwd, dim3(grid), dim3(512), args, LDS_BYTES, stream);
    if (e != hipSuccess) fprintf(stderr, "cooperative launch failed: %s (grid %d)\n", hipGetErrorString(e), grid);
#else
    for (int p = 0; p < 6; ++p) { a.ph_lo = p; a.ph_hi = p + 1; for (int r = 0; r < (p == PROBE_DUP ? 2 : 1); ++r) hipLaunchKernelGGL(hybrid_fwd, dim3(grid), dim3(512), LDS_BYTES, stream, a); }
#endif
}
```

```cpp
#include <hip/hip_runtime.h>
#include <hip/hip_cooperative_groups.h>
#include <cstdio>
#include <cstdint>
namespace cg = cooperative_groups;

#ifndef PROBE_REP0
#define PROBE_REP0 1
#endif
#ifndef PROBE_REP1
#define PROBE_REP1 1
#endif
#ifndef PROBE_REP2
#define PROBE_REP2 1
#endif
#ifndef PROBE_REP3
#define PROBE_REP3 1
#endif
#ifndef PROBE_REP4
#define PROBE_REP4 1
#endif
#ifndef PROBE_REP5
#define PROBE_REP5 1
#endif
#ifndef PROBE_ABL
#define PROBE_ABL -1
#endif
#ifndef PROBE_DUP
#define PROBE_DUP -1
#endif
#ifndef MK_N_LAUNCHES
#define MK_N_LAUNCHES 1
#endif

namespace pg8 {
#define PG8_LAS __attribute__((address_space(3)))
typedef unsigned short bf16_t;
typedef short bf16x8 __attribute__((ext_vector_type(8)));
typedef float f32x4 __attribute__((ext_vector_type(4)));
typedef unsigned u32x4 __attribute__((ext_vector_type(4)));
constexpr int BM = 256, BK = 64, HALF = 128, HTB = HALF * BK * 2, STAGE_BYTES = 8 * HTB, NXCD = 8, WGM = 8;

__host__ __device__ __forceinline__ int lds_byte(int r, int c) { const int st = (r >> 4) * 2 + (c >> 5), rr = r & 15, cc = c & 31, ob = rr * 64 + cc * 2; return st * 1024 + (ob ^ (((ob >> 9) & 1) << 5)); }
__host__ __device__ __forceinline__ void stage_rc(int b, int& R, int& C) { const int st = b / 1024, sb = b % 1024, swz = sb ^ (((sb >> 9) & 1) << 5); R = (st >> 1) * 16 + swz / 64; C = (st & 1) * 32 + (swz % 64) / 2; }
__host__ __device__ __forceinline__ int perm32(int rho) { const int n = rho >> 4, i = rho & 15; return 8 * (i >> 2) + 4 * n + (i & 3); }

struct Unit { int pm, pn; };
struct Gemm { const bf16_t* A; const bf16_t* Bt; int M, N, K; };

struct StaticOrder {
    int nM, nN, nwg, G, c;
    __host__ __device__ void init(int M, int N, int G_, int c_) { nM = M / BM; nN = N / BM; nwg = nM * nN; G = G_; c = c_; }
    __host__ __device__ bool next(int i, Unit& u) const {
        const long L = (long)i * G + c; if (L >= nwg) return false;
        int wgid = (int)L; { const int q = nwg / NXCD, r = nwg % NXCD, xcd = wgid % NXCD, off = wgid / NXCD; wgid = (xcd < r ? xcd * (q + 1) : r * (q + 1) + (xcd - r) * q) + off; }
        const int nig = WGM * nN, gid = wgid / nig, fm = gid * WGM, gsz = (nM - fm) < WGM ? (nM - fm) : WGM;
        u.pm = fm + ((wgid % nig) % gsz); u.pn = (wgid % nig) / gsz; return true;
    }
    __device__ __forceinline__ void a_ready(const Unit&) const {}
    __device__ __forceinline__ void done(const Unit&) const {}
};

__device__ __forceinline__ unsigned cvt_pk_bf16(float lo, float hi) { unsigned r; asm volatile("v_cvt_pk_bf16_f32 %0, %1, %2" : "=v"(r) : "v"(lo), "v"(hi)); return r; }

template <class Epi, class Sched, bool ALIGN_EPI = false, bool SP2 = false>
__device__ __forceinline__ void gemm_phase(PG8_LAS unsigned char* lds, const Gemm g, const Sched& S, const Epi& E) {
    const int tid = threadIdx.x, wid = __builtin_amdgcn_readfirstlane(tid >> 6), lane = tid & 63, wr = wid >> 2, wc = wid & 3, fr = lane & 15, fq = lane >> 4;
    const int K = g.K, nt = K / BK;
    unsigned voffA[2], voffB[2];
#pragma unroll
    for (int i = 0; i < 2; ++i) { int R, C; stage_rc(tid * 16 + i * 8192, R, C); const int Rb = Epi::PERM ? ((R & ~31) + perm32(R & 31)) : R;
        voffA[i] = (unsigned)(R * K + C) * 2u; voffB[i] = (unsigned)(Rb * K + C) * 2u; }
    const size_t kstep = (size_t)(BK * 2);
    const size_t hstep = (size_t)HALF * K * 2;
    const size_t tstep = 2 * hstep;
    const unsigned ldsw = (unsigned)wid * 1024u;
    const int aoff = lds_byte(wr * 64 + fr, fq * 8), boff = lds_byte(wc * 32 + fr, fq * 8);
#define PG8_SA(b, h) (((b) * 2 + (h)) * HTB)
#define PG8_SB(b, h) ((4 + (b) * 2 + (h)) * HTB)
#define PG8_STAGE(bufoff, gbase, voff) do { _Pragma("unroll") for (int _i = 0; _i < 2; ++_i) \
        __builtin_amdgcn_global_load_lds((const unsigned*)((const char*)(gbase) + (voff)[_i]), (PG8_LAS unsigned*)(lds + (bufoff) + ldsw + _i * 8192), 16, 0, 0); } while (0)
#define PG8_LDA(dst, b, h) do { _Pragma("unroll") for (int m = 0; m < 4; ++m) _Pragma("unroll") for (int k = 0; k < 2; ++k) dst[m][k] = *(const PG8_LAS bf16x8*)(lds + PG8_SA(b, h) + aoff + m * 2048 + k * 1024); } while (0)
#define PG8_LDB(dst, b, h) do { _Pragma("unroll") for (int n = 0; n < 2; ++n) _Pragma("unroll") for (int k = 0; k < 2; ++k) dst[n][k] = *(const PG8_LAS bf16x8*)(lds + PG8_SB(b, h) + boff + n * 2048 + k * 1024); } while (0)
#define PG8_MMA(ai, bj, At, Bt) do { __builtin_amdgcn_s_setprio(1); _Pragma("unroll") for (int m = 0; m < 4; ++m) _Pragma("unroll") for (int n = 0; n < 2; ++n) _Pragma("unroll") for (int k = 0; k < 2; ++k) \
        acc[ai][bj][m][n] = __builtin_amdgcn_mfma_f32_16x16x32_bf16(Bt[n][k], At[m][k], acc[ai][bj][m][n], 0, 0, 0); __builtin_amdgcn_s_setprio(0); } while (0)
#define PG8_WAIT_V(n) asm volatile("s_waitcnt vmcnt(" #n ")" ::: "memory")
#define PG8_WAIT_L(n) asm volatile("s_waitcnt lgkmcnt(" #n ")" ::: "memory")
#define PG8_BAR __builtin_amdgcn_s_barrier()
#define PG8_SCHED __builtin_amdgcn_sched_barrier(0)
    Unit cur, nxt; int ui = 0;
    if (!S.next(0, cur)) return;
    f32x4 acc[2][2][4][2];
#pragma unroll
    for (int a = 0; a < 2; ++a)
#pragma unroll
        for (int b = 0; b < 2; ++b)
#pragma unroll
            for (int m = 0; m < 4; ++m)
#pragma unroll
                for (int n = 0; n < 2; ++n) acc[a][b][m][n] = (f32x4){0.f, 0.f, 0.f, 0.f};
    bf16x8 At[4][2], B0[2][2], B1[2][2];
    const char* cA = (const char*)g.A + (size_t)cur.pm * tstep; const char* cB = (const char*)g.Bt + (size_t)cur.pn * tstep;
    S.a_ready(cur);
    if constexpr (SP2) {
        PG8_STAGE(PG8_SB(0, 0), cB, voffB); PG8_STAGE(PG8_SB(0, 1), cB + hstep, voffB); PG8_STAGE(PG8_SA(0, 0), cA, voffA); PG8_STAGE(PG8_SA(0, 1), cA + hstep, voffA);
        if (wr == 1) PG8_BAR;
        PG8_WAIT_V(2); PG8_BAR;
        PG8_STAGE(PG8_SB(1, 0), cB + kstep, voffB); PG8_STAGE(PG8_SA(1, 0), cA + kstep, voffA); PG8_STAGE(PG8_SB(1, 1), cB + hstep + kstep, voffB);
        PG8_WAIT_V(6); PG8_BAR;
    } else {
        PG8_STAGE(PG8_SB(0, 0), cB, voffB); PG8_STAGE(PG8_SA(0, 0), cA, voffA); PG8_STAGE(PG8_SB(0, 1), cB + hstep, voffB); PG8_STAGE(PG8_SA(0, 1), cA + hstep, voffA);
        if (wr == 1) PG8_BAR;
        PG8_WAIT_V(4); PG8_BAR;
        PG8_STAGE(PG8_SB(1, 0), cB + kstep, voffB); PG8_STAGE(PG8_SA(1, 0), cA + kstep, voffA); PG8_STAGE(PG8_SB(1, 1), cB + hstep + kstep, voffB);
        PG8_WAIT_V(6); PG8_BAR;
    }
    for (;;) {
        const bool has_next = S.next(ui + 1, nxt);
        const char* nA = has_next ? (const char*)g.A + (size_t)nxt.pm * tstep : cA; const char* nB = has_next ? (const char*)g.Bt + (size_t)nxt.pn * tstep : cB;
        for (int t = 0; t < nt; t += 2) {
            const bool last = (t == nt - 2);
            const char* a1 = cA + (size_t)(t + 1) * kstep;
            const char* a2 = last ? nA : cA + (size_t)(t + 2) * kstep; const char* b2 = last ? nB : cB + (size_t)(t + 2) * kstep;
            const char* a3 = a2 + kstep; const char* b3 = b2 + kstep;
            if (last && has_next) S.a_ready(nxt);
            if constexpr (SP2) {
            PG8_LDB(B0, 0, 0); PG8_LDB(B1, 0, 1); PG8_SCHED; PG8_LDA(At, 0, 0); PG8_STAGE(PG8_SA(1, 1), a1 + hstep, voffA);
            PG8_WAIT_V(8); PG8_WAIT_L(0); PG8_BAR; PG8_MMA(0, 0, At, B0); PG8_MMA(0, 1, At, B1); PG8_BAR; PG8_SCHED;
            PG8_LDA(At, 0, 1); PG8_STAGE(PG8_SB(0, 0), b2, voffB); PG8_STAGE(PG8_SB(0, 1), b2 + hstep, voffB); PG8_STAGE(PG8_SA(0, 0), a2, voffA);
            PG8_WAIT_V(8); PG8_WAIT_L(0); PG8_BAR; PG8_MMA(1, 0, At, B0); PG8_MMA(1, 1, At, B1); PG8_BAR; PG8_SCHED;
            PG8_LDB(B0, 1, 0); PG8_LDB(B1, 1, 1); PG8_SCHED; PG8_LDA(At, 1, 0); PG8_STAGE(PG8_SA(0, 1), a2 + hstep, voffA);
            PG8_WAIT_V(8); PG8_WAIT_L(0); PG8_BAR; PG8_MMA(0, 0, At, B0); PG8_MMA(0, 1, At, B1); PG8_BAR; PG8_SCHED;
            PG8_LDA(At, 1, 1); PG8_STAGE(PG8_SB(1, 0), b3, voffB); PG8_STAGE(PG8_SB(1, 1), b3 + hstep, voffB); PG8_STAGE(PG8_SA(1, 0), a3, voffA);
            PG8_WAIT_V(8); PG8_WAIT_L(0); PG8_BAR; PG8_MMA(1, 0, At, B0); PG8_MMA(1, 1, At, B1); PG8_BAR; PG8_SCHED;
            } else {
            PG8_LDB(B0, 0, 0); PG8_SCHED; PG8_LDA(At, 0, 0); PG8_STAGE(PG8_SA(1, 1), a1 + hstep, voffA);
            PG8_WAIT_L(8); PG8_BAR; PG8_WAIT_L(0); PG8_MMA(0, 0, At, B0); PG8_BAR; PG8_SCHED;
            PG8_LDB(B1, 0, 1); PG8_STAGE(PG8_SB(0, 0), b2, voffB);
            PG8_BAR; PG8_WAIT_L(0); PG8_MMA(0, 1, At, B1); PG8_BAR;
            PG8_LDA(At, 0, 1); PG8_STAGE(PG8_SA(0, 0), a2, voffA);
            PG8_BAR; PG8_WAIT_L(0); PG8_MMA(1, 0, At, B0); PG8_BAR; PG8_SCHED;
            PG8_STAGE(PG8_SB(0, 1), b2 + hstep, voffB);
            PG8_WAIT_V(6); PG8_BAR; PG8_MMA(1, 1, At, B1); PG8_BAR;
            PG8_LDB(B0, 1, 0); PG8_SCHED; PG8_LDA(At, 1, 0); PG8_STAGE(PG8_SA(0, 1), a2 + hstep, voffA);
            PG8_WAIT_L(8); PG8_BAR; PG8_WAIT_L(0); PG8_MMA(0, 0, At, B0); PG8_BAR; PG8_SCHED;
            PG8_LDB(B1, 1, 1); PG8_STAGE(PG8_SB(1, 0), b3, voffB);
            PG8_BAR; PG8_WAIT_L(0); PG8_MMA(0, 1, At, B1); PG8_BAR;
            PG8_LDA(At, 1, 1); PG8_STAGE(PG8_SA(1, 0), a3, voffA);
            PG8_BAR; PG8_WAIT_L(0); PG8_MMA(1, 0, At, B0); PG8_BAR; PG8_SCHED;
            PG8_STAGE(PG8_SB(1, 1), b3 + hstep, voffB);
            PG8_WAIT_V(6); PG8_BAR; PG8_MMA(1, 1, At, B1); PG8_BAR;
            }
        }
        if constexpr (ALIGN_EPI) { if (wr == 0) PG8_BAR; }
        if constexpr (!Epi::AFTER_DRAIN) { E(acc, cur, wr, wc, fr, fq); S.done(cur); }
        if (!has_next) break;
#pragma unroll
        for (int a = 0; a < 2; ++a)
#pragma unroll
            for (int b = 0; b < 2; ++b)
#pragma unroll
                for (int m = 0; m < 4; ++m)
#pragma unroll
                    for (int n = 0; n < 2; ++n) acc[a][b][m][n] = (f32x4){0.f, 0.f, 0.f, 0.f};
        cur = nxt; cA = nA; cB = nB; ++ui;
        if constexpr (ALIGN_EPI) { if (wr == 1) PG8_BAR; }
    }
    PG8_WAIT_V(0);
    if constexpr (!ALIGN_EPI) { if (wr == 0) PG8_BAR; }
    PG8_BAR;
#undef PG8_SA
#undef PG8_SB
#undef PG8_STAGE
#undef PG8_LDA
#undef PG8_LDB
#undef PG8_MMA
#undef PG8_WAIT_V
#undef PG8_WAIT_L
#undef PG8_BAR
#undef PG8_SCHED
}
}

typedef unsigned short bf16;
typedef float f32x4 __attribute__((ext_vector_type(4)));
typedef unsigned u32x4 __attribute__((ext_vector_type(4)));
typedef unsigned u32x2 __attribute__((ext_vector_type(2)));
typedef short bf16x8 __attribute__((ext_vector_type(8)));
typedef short s16x4 __attribute__((ext_vector_type(4)));
typedef float f32x16 __attribute__((ext_vector_type(16)));
#define LAS __attribute__((address_space(3)))

constexpr int BATCH = 4, SEQ = 4096, DM = 2048, M = BATCH * SEQ;
constexpr int NH = 8, QKD = 192, QRANK = 768, KVRANK = 512, DIN = 6472;
constexpr int NIN_PAD = 6656;
constexpr float EPS = 1e-6f;
constexpr float LOG2E = 1.4426950408889634f;
constexpr float C2M = 0.07216878364870322f * LOG2E;
constexpr float C2F = 0.08838834764831845f * LOG2E;

constexpr size_t MiB = 1u << 20;
constexpr size_t WS_RSTDX = 0, WS_PARTQ = 1 * MiB, WS_PARTKV = 2 * MiB, WS_PARTY = 3 * MiB, WS_FLOG = 5 * MiB, WS_CF = 6 * MiB, WS_COS = 7 * MiB, WS_SIN = 9 * MiB;
constexpr size_t WS_CTL = 11 * MiB, CTL_BYTES = 16384;
constexpr size_t WS_WIN = 16 * MiB, WS_WUQ = 42 * MiB, WS_WUKV = 45 * MiB, WS_WOUT = 47 * MiB;
constexpr size_t WS_XB = 56 * MiB, WS_O = 56 * MiB;
constexpr size_t WS_QLAT = 120 * MiB, WS_KVLAT = 144 * MiB, WS_G = 160 * MiB;
constexpr size_t WS_QF = 224 * MiB, WS_Y = 224 * MiB, WS_KF = 256 * MiB, WS_VF = 288 * MiB;
constexpr size_t WS_QM = 320 * MiB, WS_KM = 368 * MiB, WS_VM = 416 * MiB, WS_END = 448 * MiB;

constexpr int LDS_BYTES = 163840;

__device__ __forceinline__ unsigned f2bf(float f) { unsigned u = __builtin_bit_cast(unsigned, f); return (u + 0x7fffu + ((u >> 16) & 1u)) >> 16; }
__device__ __forceinline__ unsigned pk2(float lo, float hi) { return pg8::cvt_pk_bf16(lo, hi); }
__device__ __forceinline__ float bflo(unsigned w) { return __builtin_bit_cast(float, w << 16); }
__device__ __forceinline__ float bfhi(unsigned w) { return __builtin_bit_cast(float, w & 0xffff0000u); }
__device__ __forceinline__ int launder(int v) { asm volatile("" : "+v"(v)); return v; }
__device__ __forceinline__ float wave_sum(float v) {
#pragma unroll
    for (int o = 1; o < 64; o <<= 1) v += __shfl_xor(v, o);
    return v;
}
__device__ __forceinline__ float silu_f(float v) { return v * __builtin_amdgcn_rcpf(1.f + __builtin_amdgcn_exp2f(-v * LOG2E)); }
__device__ __forceinline__ u32x4 pack8f(f32x4 a, f32x4 b) { u32x4 w; w.x = pk2(a[0], a[1]); w.y = pk2(a[2], a[3]); w.z = pk2(b[0], b[1]); w.w = pk2(b[2], b[3]); return w; }

typedef pg8::f32x4 af4;
struct EpiIn {
    static constexpr bool PERM = true, AFTER_DRAIN = false;
    const float* rstd_x; bf16 *qlat, *kvlat, *G, *Qf, *Kf, *Vf, *Km; float *flog, *partq, *partkv; const float *cosT, *sinT;
    __device__ __forceinline__ void operator()(const af4 (&acc)[2][2][4][2], const pg8::Unit& u, int wr, int wc, int fr, int fq) const {
        const int pn = u.pn; const int row0 = u.pm * 256 + wr * 64 + fr;
        if (pn == 25) {
            if (wc == 0) {
#pragma unroll
                for (int ai = 0; ai < 2; ++ai)
#pragma unroll
                    for (int m = 0; m < 4; ++m) { const int row = row0 + ai * 128 + m * 16; const float rs = rstd_x[row];
                        f32x4 o1[2], o2[2];
#pragma unroll
                        for (int n = 0; n < 2; ++n) { const f32x4 c = *(const f32x4*)(cosT + (size_t)row * 32 + 8 * fq + 4 * n), s = *(const f32x4*)(sinT + (size_t)row * 32 + 8 * fq + 4 * n);
                            const f32x4 x1 = acc[ai][0][m][n] * rs, x2 = acc[ai][1][m][n] * rs; o1[n] = x1 * c - x2 * s; o2[n] = x2 * c + x1 * s; }
                        const u32x4 w1 = pack8f(o1[0], o1[1]), w2 = pack8f(o2[0], o2[1]);
                        bf16* kp = Km + (size_t)row * 1536 + 128 + 8 * fq;
#pragma unroll
                        for (int h = 0; h < 8; ++h) { *(u32x4*)(kp + h * 192) = w1; *(u32x4*)(kp + h * 192 + 32) = w2; } }
            } else if (wc == 1 && fq == 0) {
#pragma unroll
                for (int ai = 0; ai < 2; ++ai)
#pragma unroll
                    for (int m = 0; m < 4; ++m) { const int row = row0 + ai * 128 + m * 16; const float rs = rstd_x[row];
                        *(f32x4*)(flog + (size_t)row * 8) = acc[ai][0][m][0] * rs; *(f32x4*)(flog + (size_t)row * 8 + 4) = acc[ai][0][m][1] * rs; }
            }
            return;
        }
        bf16* base; int ld, colt, mode = 0; float* part = nullptr; int nslot = 0, slot0 = 0;
        if (pn < 3) { base = qlat; ld = 768; colt = pn * 256; part = partq; nslot = 12; slot0 = pn * 4; }
        else if (pn < 5) { base = kvlat; ld = 512; colt = (pn - 3) * 256; part = partkv; nslot = 8; slot0 = (pn - 3) * 4; }
        else if (pn < 9) { base = G; ld = 2048; colt = (pn - 5) * 256; mode = 1; }
        else if (pn < 13) { base = Qf; ld = 1024; colt = (pn - 9) * 256; mode = 2; }
        else if (pn < 17) { base = Kf; ld = 1024; colt = (pn - 13) * 256; }
        else if (pn < 21) { base = Vf; ld = 1024; colt = (pn - 17) * 256; }
        else { base = G; ld = 2048; colt = 1024 + (pn - 21) * 256; mode = 1; }
        const int col0 = colt + wc * 32 + 8 * fq;
#pragma unroll
        for (int ai = 0; ai < 2; ++ai)
#pragma unroll
            for (int m = 0; m < 4; ++m) { const int row = row0 + ai * 128 + m * 16; float rs = rstd_x[row]; if (mode == 2) rs *= C2F;
                bf16* rowp = base + (size_t)row * ld + col0; float ss = 0.f;
#pragma unroll
                for (int bj = 0; bj < 2; ++bj) { f32x4 v0 = acc[ai][bj][m][0] * rs, v1 = acc[ai][bj][m][1] * rs;
                    ss += (v0[0] * v0[0] + v0[1] * v0[1]) + (v0[2] * v0[2] + v0[3] * v0[3]) + (v1[0] * v1[0] + v1[1] * v1[1]) + (v1[2] * v1[2] + v1[3] * v1[3]);
                    if (mode == 1) {
#pragma unroll
                        for (int e = 0; e < 4; ++e) { v0[e] = silu_f(v0[e]); v1[e] = silu_f(v1[e]); } }
                    *(u32x4*)(rowp + bj * 128) = pack8f(v0, v1); }
                if (part) { ss += __shfl_xor(ss, 16); ss += __shfl_xor(ss, 32); if (fq == 0) part[(size_t)row * nslot + slot0 + wc] = ss; } }
    }
};
struct EpiQ {
    static constexpr bool PERM = true, AFTER_DRAIN = false;
    const float* partq; bf16* Qm; const float *cosT, *sinT;
    __device__ __forceinline__ void operator()(const af4 (&acc)[2][2][4][2], const pg8::Unit& u, int wr, int wc, int fr, int fq) const {
        const int pn = u.pn; const int row0 = u.pm * 256 + wr * 64 + fr;
#pragma unroll
        for (int ai = 0; ai < 2; ++ai)
#pragma unroll
            for (int m = 0; m < 4; ++m) { const int row = row0 + ai * 128 + m * 16;
                const f32x4 pa = *(const f32x4*)(partq + (size_t)row * 12), pb = *(const f32x4*)(partq + (size_t)row * 12 + 4), pc = *(const f32x4*)(partq + (size_t)row * 12 + 8);
                const float ssq = ((pa[0] + pa[1]) + (pa[2] + pa[3])) + ((pb[0] + pb[1]) + (pb[2] + pb[3])) + ((pc[0] + pc[1]) + (pc[2] + pc[3]));
                const float rs = C2M / sqrtf(ssq * (1.f / 768.f) + EPS);
                if (pn < 4) {
#pragma unroll
                    for (int bj = 0; bj < 2; ++bj) *(u32x4*)(Qm + (size_t)row * 1536 + (2 * pn + bj) * 192 + wc * 32 + 8 * fq) = pack8f(acc[ai][bj][m][0] * rs, acc[ai][bj][m][1] * rs);
                } else { const int head = 4 * (pn - 4) + wc; f32x4 o1[2], o2[2];
#pragma unroll
                    for (int n = 0; n < 2; ++n) { const f32x4 c = *(const f32x4*)(cosT + (size_t)row * 32 + 8 * fq + 4 * n), s = *(const f32x4*)(sinT + (size_t)row * 32 + 8 * fq + 4 * n);
                        const f32x4 x1 = acc[ai][0][m][n] * rs, x2 = acc[ai][1][m][n] * rs; o1[n] = x1 * c - x2 * s; o2[n] = x2 * c + x1 * s; }
                    bf16* qp = Qm + (size_t)row * 1536 + head * 192 + 128 + 8 * fq;
                    *(u32x4*)qp = pack8f(o1[0], o1[1]); *(u32x4*)(qp + 32) = pack8f(o2[0], o2[1]); } }
    }
};
struct EpiKV {
    static constexpr bool PERM = true, AFTER_DRAIN = false;
    const float* partkv; bf16 *Km, *Vm;
    __device__ __forceinline__ void operator()(const af4 (&acc)[2][2][4][2], const pg8::Unit& u, int wr, int wc, int fr, int fq) const {
        const int pn = u.pn; const int row0 = u.pm * 256 + wr * 64 + fr;
#pragma unroll
        for (int ai = 0; ai < 2; ++ai)
#pragma unroll
            for (int m = 0; m < 4; ++m) { const int row = row0 + ai * 128 + m * 16;
                const f32x4 pa = *(const f32x4*)(partkv + (size_t)row * 8), pb = *(const f32x4*)(partkv + (size_t)row * 8 + 4);
                const float ssq = ((pa[0] + pa[1]) + (pa[2] + pa[3])) + ((pb[0] + pb[1]) + (pb[2] + pb[3]));
                const float rs = 1.f / sqrtf(ssq * (1.f / 512.f) + EPS);
                *(u32x4*)(Km + (size_t)row * 1536 + pn * 192 + wc * 32 + 8 * fq) = pack8f(acc[ai][0][m][0] * rs, acc[ai][0][m][1] * rs);
                *(u32x4*)(Vm + (size_t)row * 1024 + pn * 128 + wc * 32 + 8 * fq) = pack8f(acc[ai][1][m][0] * rs, acc[ai][1][m][1] * rs); }
    }
};
struct EpiOut {
    static constexpr bool PERM = true, AFTER_DRAIN = false;
    bf16* Y; float* party;
    __device__ __forceinline__ void operator()(const af4 (&acc)[2][2][4][2], const pg8::Unit& u, int wr, int wc, int fr, int fq) const {
        const int pn = u.pn; const int row0 = u.pm * 256 + wr * 64 + fr; const int col0 = pn * 256 + wc * 32 + 8 * fq;
#pragma unroll
        for (int ai = 0; ai < 2; ++ai)
#pragma unroll
            for (int m = 0; m < 4; ++m) { const int row = row0 + ai * 128 + m * 16; float ss = 0.f;
#pragma unroll
                for (int bj = 0; bj < 2; ++bj) { const f32x4 v0 = acc[ai][bj][m][0], v1 = acc[ai][bj][m][1];
                    ss += (v0[0] * v0[0] + v0[1] * v0[1]) + (v0[2] * v0[2] + v0[3] * v0[3]) + (v1[0] * v1[0] + v1[1] * v1[1]) + (v1[2] * v1[2] + v1[3] * v1[3]);
                    *(u32x4*)(Y + (size_t)row * 2048 + col0 + bj * 128) = pack8f(v0, v1); }
                ss += __shfl_xor(ss, 16); ss += __shfl_xor(ss, 32); if (fq == 0) party[(size_t)row * 32 + pn * 4 + wc] = ss; }
    }
};

namespace att {
constexpr int KVBLK = 64, QBLK = 32, QB = 256;
constexpr int SHM_K = 24576, SHM_V = 16384;
constexpr int NRING = 3;
constexpr int OFF_K = 0, OFF_V = NRING * SHM_K, OFF_CK = OFF_V + NRING * SHM_V, OFF_WS = OFF_CK + 1024, OFF_QP = OFF_WS + 2048;
constexpr float THR = 20.f;
#define KSWZ(row, colB) ((row) * 256 + ((colB) ^ (((row) & 7) << 4)))
#define SBAR() __builtin_amdgcn_sched_barrier(0)
__device__ __forceinline__ int v_st(int k, int c) { const int kk = (k & ~0xC) | ((k & 4) << 1) | ((k & 8) >> 1); return ((kk >> 3) * 4 + (c >> 5)) * 512 + ((kk & 7) * 32 + (c & 31)) * 2; }
__device__ __forceinline__ int v_rd_base(int lane) { return ((lane & 3) << 3) | (((lane >> 2) & 3) << 6) | (((lane >> 4) & 1) << 5) | (((lane >> 5) & 1) << 8); }
constexpr int v_rd_off(int d0, int ks, int half) { return d0 * 512 + ks * 4096 + half * 2048; }
__device__ __forceinline__ int crow(int r, int hi) { return (r & 3) + 8 * (r >> 2) + 4 * hi; }
__device__ __forceinline__ unsigned cvtpk(float lo, float hi) { unsigned r; asm volatile("v_cvt_pk_bf16_f32 %0, %1, %2" : "=v"(r) : "v"(lo), "v"(hi)); return r; }

__device__ __forceinline__ void mask_tile(f32x16& p0, f32x16& p1, int dq) {
    const float NEG = -__builtin_inff();
#pragma unroll
    for (int r = 0; r < 16; ++r) { const int c = (r & 3) + 8 * (r >> 2);
        if (dq - c < 0) p0[r] = NEG;
        if (dq - c - 32 < 0) p1[r] = NEG; }
}
__device__ __forceinline__ void softmax_tile(f32x16& p0, f32x16& p1, float cq, float& m_reg, float& l_reg, float& alpha, bf16x8& pa0, bf16x8& pa1, bf16x8& pa2, bf16x8& pa3) {
    float ma = __builtin_fmaxf(__builtin_fmaxf(p0[0], p0[1]), p0[2]), mb = __builtin_fmaxf(__builtin_fmaxf(p1[0], p1[1]), p1[2]);
#pragma unroll
    for (int r = 3; r < 15; r += 2) { ma = __builtin_fmaxf(__builtin_fmaxf(ma, p0[r]), p0[r + 1]); mb = __builtin_fmaxf(__builtin_fmaxf(mb, p1[r]), p1[r + 1]); }
    float pmax = __builtin_fmaxf(__builtin_fmaxf(ma, mb), __builtin_fmaxf(p0[15], p1[15]));
    { auto rr = __builtin_amdgcn_permlane32_swap(__float_as_uint(pmax), __float_as_uint(pmax), false, false);
      pmax = fmaxf(__uint_as_float(rr[0]), __uint_as_float(rr[1])); }
    pmax += cq;
    float mn;
    if (__builtin_expect(__all(pmax - m_reg <= THR), 1)) { mn = m_reg; alpha = 1.f; }
    else { mn = fmaxf(m_reg, pmax); alpha = __builtin_amdgcn_exp2f(m_reg - mn); m_reg = mn; }
    const float sh = mn - cq;
#pragma unroll
    for (int r = 0; r < 16; ++r) { p0[r] = __builtin_amdgcn_exp2f(p0[r] - sh); p1[r] = __builtin_amdgcn_exp2f(p1[r] - sh); }
    float ps = 0.f;
#pragma unroll
    for (int r = 0; r < 16; ++r) ps += p0[r];
#pragma unroll
    for (int r = 0; r < 16; ++r) ps += p1[r];
    { auto rr = __builtin_amdgcn_permlane32_swap(__float_as_uint(ps), __float_as_uint(ps), false, false);
      ps = __uint_as_float(rr[0]) + __uint_as_float(rr[1]); }
    l_reg = l_reg * alpha + ps;
#define PK4(P, B_, OUT) do { unsigned a0 = cvtpk(P[B_+0], P[B_+1]), a1 = cvtpk(P[B_+2], P[B_+3]);                          \
        unsigned b0 = cvtpk(P[B_+4], P[B_+5]), b1 = cvtpk(P[B_+6], P[B_+7]);                                             \
        auto r0 = __builtin_amdgcn_permlane32_swap(a0, b0, false, false); auto r1 = __builtin_amdgcn_permlane32_swap(a1, b1, false, false); \
        u32x4 w = {r0[0], r1[0], r0[1], r1[1]}; OUT = *reinterpret_cast<bf16x8*>(&w); } while (0)
    PK4(p0, 0, pa0); PK4(p0, 8, pa1); PK4(p1, 0, pa2); PK4(p1, 8, pa3);
#undef PK4
}
template <int DQK, int NPARK>
__device__ __forceinline__ void qkt(f32x16& p0, f32x16& p1, const char* Kb, int r32, int hi, const bf16x8* qr, const char* qpk) {
    constexpr int ND = DQK / 16, NQR = ND - NPARK;
    p0 = f32x16{}; p1 = f32x16{};
    const char* kb[4];
#pragma unroll
    for (int dd = 0; dd < 4; ++dd) kb[dd] = Kb + KSWZ(r32, (dd * 16 + hi * 8) * 2);
    const char* kr = Kb + 16384 + r32 * 128;
    const int rx = (r32 & 7) << 4;
    bf16x8 kf[3][2], qf[3];
#define QK_LD(set, d_) do { \
            if ((d_) < 8) { const char* a_ = kb[(d_) & 3] + ((d_) >> 2) * 128; kf[set][0] = *reinterpret_cast<const bf16x8*>(a_); kf[set][1] = *reinterpret_cast<const bf16x8*>(a_ + 32 * 256); } \
            else { const char* a_ = kr + (((((d_) - 8) * 16 + hi * 8) * 2) ^ rx); kf[set][0] = *reinterpret_cast<const bf16x8*>(a_); kf[set][1] = *reinterpret_cast<const bf16x8*>(a_ + 32 * 128); } \
            if ((d_) >= NQR) qf[set] = *reinterpret_cast<const bf16x8*>(qpk + ((d_) - NQR) * 1024); } while (0)
    QK_LD(0, 0); QK_LD(1, 1); SBAR();
#pragma unroll
    for (int d = 0; d < ND; ++d) {
        const int cs = d % 3;
        if (d + 2 < ND) { const int ns = (d + 2) % 3; if (ns == 0) QK_LD(0, d + 2); else if (ns == 1) QK_LD(1, d + 2); else QK_LD(2, d + 2); SBAR(); }
        const bf16x8 q = (d < NQR) ? qr[d < NQR ? d : 0] : qf[cs];
        p0 = __builtin_amdgcn_mfma_f32_32x32x16_bf16(kf[cs][0], q, p0, 0, 0, 0);
        p1 = __builtin_amdgcn_mfma_f32_32x32x16_bf16(kf[cs][1], q, p1, 0, 0, 0);
        SBAR();
    }
#undef QK_LD
}
template <int VOFF>
__device__ __forceinline__ void pv_tile(f32x16* o, int vb0, bf16x8 pa0, bf16x8 pa1, bf16x8 pa2, bf16x8 pa3) {
#define TRRD(dst, off) asm volatile("ds_read_b64_tr_b16 %0, %1 offset:%2" : "=&v"(dst) : "v"(vb0), "i"(off) : "memory")
#define PV_D0(d0) do { s16x4 l0, l1, l2, l3, h0, h1, h2, h3; constexpr int b_ = VOFF + v_rd_off(d0, 0, 0); \
        TRRD(l0, b_); TRRD(h0, b_ + 2048); TRRD(l1, b_ + 4096); TRRD(h1, b_ + 6144); TRRD(l2, b_ + 8192); TRRD(h2, b_ + 10240); TRRD(l3, b_ + 12288); TRRD(h3, b_ + 14336); \
        asm volatile("s_waitcnt lgkmcnt(0)" ::: "memory"); SBAR(); \
        o[d0] = __builtin_amdgcn_mfma_f32_32x32x16_bf16((bf16x8){l0[0], l0[1], l0[2], l0[3], h0[0], h0[1], h0[2], h0[3]}, pa0, o[d0], 0, 0, 0);   \
        o[d0] = __builtin_amdgcn_mfma_f32_32x32x16_bf16((bf16x8){l1[0], l1[1], l1[2], l1[3], h1[0], h1[1], h1[2], h1[3]}, pa1, o[d0], 0, 0, 0);   \
        o[d0] = __builtin_amdgcn_mfma_f32_32x32x16_bf16((bf16x8){l2[0], l2[1], l2[2], l2[3], h2[0], h2[1], h2[2], h2[3]}, pa2, o[d0], 0, 0, 0);   \
        o[d0] = __builtin_amdgcn_mfma_f32_32x32x16_bf16((bf16x8){l3[0], l3[1], l3[2], l3[3], h3[0], h3[1], h3[2], h3[3]}, pa3, o[d0], 0, 0, 0); } while (0)
    PV_D0(0); PV_D0(1); PV_D0(2); PV_D0(3);
#undef PV_D0
#undef TRRD
}

#define RD128(dst, addr, off) asm volatile("ds_read_b128 %0, %1 offset:%2" : "=&v"(dst) : "v"(addr), "i"(off) : "memory")
#define RDTR(dst, addr, off) asm volatile("ds_read_b64_tr_b16 %0, %1 offset:%2" : "=&v"(dst) : "v"(addr), "i"(off) : "memory")
#define WAITK(n, x) asm volatile("s_waitcnt lgkmcnt(%1)" : "+v"(x) : "n"(n) : "memory")
#define WAITKQ(n, x, q) asm volatile("s_waitcnt lgkmcnt(%2)" : "+v"(x), "+v"(q) : "n"(n) : "memory")
#define WAITV(n, x, y) asm volatile("s_waitcnt lgkmcnt(%2)" : "+v"(x), "+v"(y) : "n"(n) : "memory")

__device__ __forceinline__ void mblock_mla_q(f32x16& p0, f32x16& p1, f32x16* o, const bf16x8* qr, bf16x8 pa0, bf16x8 pa1, bf16x8 pa2, bf16x8 pa3, const unsigned* kbv, const unsigned* krv, unsigned qpkv, unsigned vbv) {
    bf16x8 ksl[5], qsl[3]; s16x4 vlo[5], vhi[5];
    p0 = f32x16{}; p1 = f32x16{};
    RD128(ksl[0], kbv[0], 0);
    RD128(ksl[1], kbv[0], 8192);
    RD128(ksl[2], kbv[1], 0);
    RD128(ksl[3], kbv[1], 8192);
    RD128(ksl[4], kbv[2], 0);
    WAITK(4, ksl[0]); p0 = __builtin_amdgcn_mfma_f32_32x32x16_bf16(ksl[0], qr[0], p0, 0, 0, 0);
    RD128(ksl[0], kbv[2], 8192);
    WAITK(4, ksl[1]); p1 = __builtin_amdgcn_mfma_f32_32x32x16_bf16(ksl[1], qr[0], p1, 0, 0, 0);
    RD128(ksl[1], kbv[3], 0);
    WAITK(4, ksl[2]); p0 = __builtin_amdgcn_mfma_f32_32x32x16_bf16(ksl[2], qr[1], p0, 0, 0, 0);
    RD128(ksl[2], kbv[3], 8192);
    WAITK(4, ksl[3]); p1 = __builtin_amdgcn_mfma_f32_32x32x16_bf16(ksl[3], qr[1], p1, 0, 0, 0);
    RD128(ksl[3], kbv[0], 128);
    WAITK(4, ksl[4]); p0 = __builtin_amdgcn_mfma_f32_32x32x16_bf16(ksl[4], qr[2], p0, 0, 0, 0);
    RD128(ksl[4], kbv[0], 8320);
    WAITK(4, ksl[0]); p1 = __builtin_amdgcn_mfma_f32_32x32x16_bf16(ksl[0], qr[2], p1, 0, 0, 0);
    RD128(ksl[0], kbv[1], 128);
    WAITK(4, ksl[1]); p0 = __builtin_amdgcn_mfma_f32_32x32x16_bf16(ksl[1], qr[3], p0, 0, 0, 0);
    RD128(ksl[1], kbv[1], 8320);
    WAITK(4, ksl[2]); p1 = __builtin_amdgcn_mfma_f32_32x32x16_bf16(ksl[2], qr[3], p1, 0, 0, 0);
    RD128(ksl[2], kbv[2], 128);
    WAITK(4, ksl[3]); p0 = __builtin_amdgcn_mfma_f32_32x32x16_bf16(ksl[3], qr[4], p0, 0, 0, 0);
    RD128(ksl[3], kbv[2], 8320);
    WAITK(4, ksl[4]); p1 = __builtin_amdgcn_mfma_f32_32x32x16_bf16(ksl[4], qr[4], p1, 0, 0, 0);
    RD128(ksl[4], kbv[3], 128);
    WAITK(4, ksl[0]); p0 = __builtin_amdgcn_mfma_f32_32x32x16_bf16(ksl[0], qr[5], p0, 0, 0, 0);
    RD128(ksl[0], kbv[3], 8320);
    WAITK(4, ksl[1]); p1 = __builtin_amdgcn_mfma_f32_32x32x16_bf16(ksl[1], qr[5], p1, 0, 0, 0);
    RD128(ksl[1], krv[0], 0); RD128(qsl[2], qpkv, 0);
    WAITK(5, ksl[2]); p0 = __builtin_amdgcn_mfma_f32_32x32x16_bf16(ksl[2], qr[6], p0, 0, 0, 0);
    RD128(ksl[2], krv[0], 4096);
    WAITK(5, ksl[3]); p1 = __builtin_amdgcn_mfma_f32_32x32x16_bf16(ksl[3], qr[6], p1, 0, 0, 0);
    RD128(ksl[3], krv[1], 0); RD128(qsl[0], qpkv, 1024);
    WAITK(6, ksl[4]); p0 = __builtin_amdgcn_mfma_f32_32x32x16_bf16(ksl[4], qr[7], p0, 0, 0, 0);
    RD128(ksl[4], krv[1], 4096);
    WAITK(6, ksl[0]); p1 = __builtin_amdgcn_mfma_f32_32x32x16_bf16(ksl[0], qr[7], p1, 0, 0, 0);
    RD128(ksl[0], krv[2], 0); RD128(qsl[1], qpkv, 2048);
    WAITKQ(6, ksl[1], qsl[2]); p0 = __builtin_amdgcn_mfma_f32_32x32x16_bf16(ksl[1], qsl[2], p0, 0, 0, 0);
    RD128(ksl[1], krv[2], 4096);
    WAITKQ(6, ksl[2], qsl[2]); p1 = __builtin_amdgcn_mfma_f32_32x32x16_bf16(ksl[2], qsl[2], p1, 0, 0, 0);
    RD128(ksl[2], krv[3], 0); RD128(qsl[2], qpkv, 3072);
    WAITKQ(6, ksl[3], qsl[0]); p0 = __builtin_amdgcn_mfma_f32_32x32x16_bf16(ksl[3], qsl[0], p0, 0, 0, 0);
    RD128(ksl[3], krv[3], 4096);
    WAITKQ(6, ksl[4], qsl[0]); p1 = __builtin_amdgcn_mfma_f32_32x32x16_bf16(ksl[4], qsl[0], p1, 0, 0, 0);
    WAITKQ(4, ksl[0], qsl[1]); p0 = __builtin_amdgcn_mfma_f32_32x32x16_bf16(ksl[0], qsl[1], p0, 0, 0, 0);
    WAITKQ(3, ksl[1], qsl[1]); p1 = __builtin_amdgcn_mfma_f32_32x32x16_bf16(ksl[1], qsl[1], p1, 0, 0, 0);
    WAITKQ(1, ksl[2], qsl[2]); p0 = __builtin_amdgcn_mfma_f32_32x32x16_bf16(ksl[2], qsl[2], p0, 0, 0, 0);
    WAITKQ(0, ksl[3], qsl[2]); p1 = __builtin_amdgcn_mfma_f32_32x32x16_bf16(ksl[3], qsl[2], p1, 0, 0, 0);
}
__device__ __forceinline__ void mblock_fox_q(f32x16& p0, f32x16& p1, f32x16* o, const bf16x8* qr, bf16x8 pa0, bf16x8 pa1, bf16x8 pa2, bf16x8 pa3, const unsigned* kbv, const unsigned* krv, unsigned qpkv, unsigned vbv) {
    bf16x8 ksl[5], qsl[3]; s16x4 vlo[5], vhi[5];
    p0 = f32x16{}; p1 = f32x16{};
    RD128(ksl[0], kbv[0], 0);
    RD128(ksl[1], kbv[0], 8192);
    RD128(ksl[2], kbv[1], 0);
    RD128(ksl[3], kbv[1], 8192);
    RD128(ksl[4], kbv[2], 0);
    WAITK(4, ksl[0]); p0 = __builtin_amdgcn_mfma_f32_32x32x16_bf16(ksl[0], qr[0], p0, 0, 0, 0);
    RD128(ksl[0], kbv[2], 8192);
    WAITK(4, ksl[1]); p1 = __builtin_amdgcn_mfma_f32_32x32x16_bf16(ksl[1], qr[0], p1, 0, 0, 0);
    RD128(ksl[1], kbv[3], 0);
    WAITK(4, ksl[2]); p0 = __builtin_amdgcn_mfma_f32_32x32x16_bf16(ksl[2], qr[1], p0, 0, 0, 0);
    RD128(ksl[2], kbv[3], 8192);
    WAITK(4, ksl[3]); p1 = __builtin_amdgcn_mfma_f32_32x32x16_bf16(ksl[3], qr[1], p1, 0, 0, 0);
    RD128(ksl[3], kbv[0], 128); RD128(qsl[1], qpkv, 0);
    WAITK(5, ksl[4]); p0 = __builtin_amdgcn_mfma_f32_32x32x16_bf16(ksl[4], qr[2], p0, 0, 0, 0);
    RD128(ksl[4], kbv[0], 8320);
    WAITK(5, ksl[0]); p1 = __builtin_amdgcn_mfma_f32_32x32x16_bf16(ksl[0], qr[2], p1, 0, 0, 0);
    RD128(ksl[0], kbv[1], 128); RD128(qsl[2], qpkv, 1024);
    WAITK(6, ksl[1]); p0 = __builtin_amdgcn_mfma_f32_32x32x16_bf16(ksl[1], qr[3], p0, 0, 0, 0);
    RD128(ksl[1], kbv[1], 8320);
    WAITK(6, ksl[2]); p1 = __builtin_amdgcn_mfma_f32_32x32x16_bf16(ksl[2], qr[3], p1, 0, 0, 0);
    RD128(ksl[2], kbv[2], 128); RD128(qsl[0], qpkv, 2048);
    WAITKQ(6, ksl[3], qsl[1]); p0 = __builtin_amdgcn_mfma_f32_32x32x16_bf16(ksl[3], qsl[1], p0, 0, 0, 0);
    RD128(ksl[3], kbv[2], 8320);
    WAITKQ(6, ksl[4], qsl[1]); p1 = __builtin_amdgcn_mfma_f32_32x32x16_bf16(ksl[4], qsl[1], p1, 0, 0, 0);
    RD128(ksl[4], kbv[3], 128); RD128(qsl[1], qpkv, 3072);
    WAITKQ(6, ksl[0], qsl[2]); p0 = __builtin_amdgcn_mfma_f32_32x32x16_bf16(ksl[0], qsl[2], p0, 0, 0, 0);
    RD128(ksl[0], kbv[3], 8320);
    WAITKQ(6, ksl[1], qsl[2]); p1 = __builtin_amdgcn_mfma_f32_32x32x16_bf16(ksl[1], qsl[2], p1, 0, 0, 0);
    WAITKQ(4, ksl[2], qsl[0]); p0 = __builtin_amdgcn_mfma_f32_32x32x16_bf16(ksl[2], qsl[0], p0, 0, 0, 0);
    WAITKQ(3, ksl[3], qsl[0]); p1 = __builtin_amdgcn_mfma_f32_32x32x16_bf16(ksl[3], qsl[0], p1, 0, 0, 0);
    WAITKQ(1, ksl[4], qsl[1]); p0 = __builtin_amdgcn_mfma_f32_32x32x16_bf16(ksl[4], qsl[1], p0, 0, 0, 0);
    WAITKQ(0, ksl[0], qsl[1]); p1 = __builtin_amdgcn_mfma_f32_32x32x16_bf16(ksl[0], qsl[1], p1, 0, 0, 0);
}
#undef RD128
#undef RDTR
#undef WAITK
#undef WAITKQ
#undef WAITV

template <int DQK, bool FOX, int ABL = 0>
__device__ __forceinline__ void attn_unit(char* lds, const bf16* Q, int ldq, const bf16* K, int ldk, const bf16* V, int ldv, const float* cfs, const bf16* Gp, bf16* Op, int qb) {
    const int tid = threadIdx.x, wid = __builtin_amdgcn_readfirstlane(tid >> 6), lane = tid & 63, r32 = lane & 31, hi = lane >> 5;
    const bool grpA = wid < 4; const int w4 = wid & 3;
    const int q0 = qb * QB, NT = 4 * (qb + 1);
    char* K_lds = lds + OFF_K; char* V_lds = lds + OFF_V; float* ck_l = (float*)(lds + OFF_CK);
    float* wsf = (float*)(lds + OFF_WS) + wid * 64; float* li_l = wsf; float* al_l = wsf + 32;
    constexpr int NPARK = 4, NQR = DQK / 16 - NPARK;
    bf16x8 qr[NQR];
    char* qpk = lds + OFF_QP + wid * 4096 + (hi * 32 + r32) * 16;
    unsigned koff, kroff = 0, voff;
    { const int row = 4 * w4 + (lane >> 4), c = (lane & 15) ^ (row & 7); koff = (unsigned)(row * ldk + c * 8) * 2u; }
    { const int s0 = 2 * w4 + (lane >> 5), kk = 8 * (s0 >> 2) + ((lane & 31) >> 2), k = (kk & ~0xC) | ((kk & 4) << 1) | ((kk & 8) >> 1); voff = (unsigned)(k * ldv + 32 * (s0 & 3) + 8 * (lane & 3)) * 2u; }
    if constexpr (DQK == 192) { const int row = 8 * w4 + (lane >> 3), c = (lane & 7) ^ (row & 7); kroff = (unsigned)(row * ldk + 128 + c * 8) * 2u; }
    const int vb0 = (int)(uintptr_t)V_lds + v_rd_base(lane);
    LAS unsigned char* ldsl = (LAS unsigned char*)(uintptr_t)(unsigned)(uintptr_t)lds;
    unsigned kb0[4], kr0[4];
#pragma unroll
    for (int i = 0; i < 4; ++i) { const unsigned xo = (unsigned)((i * 32 + hi * 16) ^ ((r32 & 7) << 4)); kb0[i] = (unsigned)(uintptr_t)K_lds + r32 * 256 + xo; kr0[i] = (unsigned)(uintptr_t)K_lds + 16384 + r32 * 128 + xo; }
    const unsigned qpkv = (unsigned)(uintptr_t)qpk;
#define DMA_K(t, bf) do { const char* kt_ = (const char*)K + (size_t)(t) * KVBLK * ldk * 2; \
        _Pragma("unroll") for (int j_ = 0; j_ < 4; ++j_) \
            __builtin_amdgcn_global_load_lds((const unsigned*)(kt_ + koff + (size_t)j_ * 16 * ldk * 2), (LAS unsigned*)(ldsl + OFF_K + (bf) * SHM_K + (w4 + 4 * j_) * 1024), 16, 0, 0); \
        if constexpr (DQK == 192) { _Pragma("unroll") for (int j_ = 0; j_ < 2; ++j_) \
            __builtin_amdgcn_global_load_lds((const unsigned*)(kt_ + kroff + (size_t)j_ * 32 * ldk * 2), (LAS unsigned*)(ldsl + OFF_K + (bf) * SHM_K + 16384 + (w4 + 4 * j_) * 1024), 16, 0, 0); } \
        if constexpr (FOX) { __builtin_amdgcn_global_load_lds((const unsigned*)(cfs + (t) * KVBLK + lane), (LAS unsigned*)(ldsl + OFF_CK + ((t) & 3) * 256), 4, 0, 0); } } while (0)
#define DMA_V(t, bf) do { const char* vt_ = (const char*)V + (size_t)(t) * KVBLK * ldv * 2; \
        _Pragma("unroll") for (int j_ = 0; j_ < 4; ++j_) \
            __builtin_amdgcn_global_load_lds((const unsigned*)(vt_ + voff + (size_t)j_ * 16 * ldv * 2), (LAS unsigned*)(ldsl + OFF_V + (bf) * SHM_V + (w4 + 4 * j_) * 1024), 16, 0, 0); } while (0)
#define BAR_L() asm volatile("s_waitcnt lgkmcnt(0)\n\ts_barrier" ::: "memory")
#define BAR_VL() asm volatile("s_waitcnt vmcnt(0) lgkmcnt(0)\n\ts_barrier" ::: "memory")
    constexpr int NDK = 4 + (DQK == 192 ? 2 : 0) + (FOX ? 1 : 0), NDV = 4;
#define BAR_VN(n) asm volatile("s_waitcnt vmcnt(%0) lgkmcnt(0)\n\ts_barrier" :: "n"(n) : "memory")
    if (grpA) DMA_K(0, 0);
    { const bf16* qp = Q + (size_t)(q0 + wid * QBLK + r32) * ldq + hi * 8;
#pragma unroll
      for (int d0 = 0; d0 < NQR; ++d0) qr[d0] = *(const bf16x8*)(qp + d0 * 16);
#pragma unroll
      for (int d0 = 0; d0 < NPARK; ++d0) *(bf16x8*)(qpk + d0 * 1024) = *(const bf16x8*)(qp + (NQR + d0) * 16); }
    float cq = 0.f; if constexpr (FOX) cq = cfs[q0 + wid * QBLK + r32];
    asm volatile("s_waitcnt vmcnt(0)" ::: "memory");
    if (grpA) { DMA_K(1, 1); DMA_V(0, 0); BAR_VN(NDK + NDV); } else BAR_VN(0);
    if (!grpA) BAR_L();
    float m_reg = -1e30f, l_reg = 0.f; f32x16 o[4] = {}; f32x16 p0 = {}, p1 = {}; bf16x8 pa0 = {}, pa1 = {}, pa2 = {}, pa3 = {};
#define ACTW(tt) ((tt) - (NT - 4) < 0 || 64 * ((tt) - (NT - 4)) <= 32 * wid + 31)
    int rc = 0, rp = 2, rn = 1;
#pragma unroll 1
    for (int t = 0; t < NT; ++t) {
        if (grpA && !(ABL & 1)) { if (t + 2 < NT) DMA_K(t + 2, rp); if (DQK != 192 && t + 1 < NT) DMA_V(t + 1, rn); }
        const int jb_ = t - (NT - 4); const bool act_ = ACTW(t);
        if (act_ && !(ABL & 4)) { unsigned kbv[4], krv[4];
#pragma unroll
            for (int i = 0; i < 4; ++i) { kbv[i] = kb0[i] + rc * SHM_K; krv[i] = kr0[i] + rc * SHM_K; }
            if constexpr (DQK == 192) mblock_mla_q(p0, p1, o, qr, pa0, pa1, pa2, pa3, kbv, krv, qpkv, 0u); else mblock_fox_q(p0, p1, o, qr, pa0, pa1, pa2, pa3, kbv, krv, qpkv, 0u); }
        if (t > 0 && ACTW(t - 1) && !(ABL & 4)) { SBAR(); pv_tile<0>(o, vb0 + rp * SHM_V, pa0, pa1, pa2, pa3); }
        BAR_L();
        if (DQK == 192 && grpA && !(ABL & 1)) { if (t + 1 < NT) DMA_V(t + 1, rn); }
        if (act_ && (ABL & 8)) {
#define PK4(P, B_, OUT) do { unsigned a0 = cvtpk(P[B_+0], P[B_+1]), a1 = cvtpk(P[B_+2], P[B_+3]); unsigned b0 = cvtpk(P[B_+4], P[B_+5]), b1 = cvtpk(P[B_+6], P[B_+7]); \
        auto r0 = __builtin_amdgcn_permlane32_swap(a0, b0, false, false); auto r1 = __builtin_amdgcn_permlane32_swap(a1, b1, false, false); u32x4 w = {r0[0], r1[0], r0[1], r1[1]}; OUT = *reinterpret_cast<bf16x8*>(&w); } while (0)
            PK4(p0, 0, pa0); PK4(p0, 8, pa1); PK4(p1, 0, pa2); PK4(p1, 8, pa3);
#undef PK4
        }
        if (act_ && !(ABL & 2)) { float alpha;
            if constexpr (FOX) { const float* ckp = ck_l + (t & 3) * 64 + 4 * hi;
#pragma unroll
                for (int g_ = 0; g_ < 4; ++g_) { const f32x4 c0 = *(const f32x4*)(ckp + 8 * g_), c1 = *(const f32x4*)(ckp + 32 + 8 * g_);
#pragma unroll
                    for (int e_ = 0; e_ < 4; ++e_) { p0[4 * g_ + e_] -= c0[e_]; p1[4 * g_ + e_] -= c1[e_]; } } }
            if (jb_ >= 0 && 64 * jb_ + 63 > 32 * wid) mask_tile(p0, p1, 32 * wid + r32 - 64 * jb_ - 4 * hi);
            softmax_tile(p0, p1, cq, m_reg, l_reg, alpha, pa0, pa1, pa2, pa3);
            if (__any(alpha < 1.f)) {
#pragma unroll
                for (int d_ = 0; d_ < 4; ++d_)
#pragma unroll
                    for (int r = 0; r < 16; ++r) o[d_][r] *= alpha; }
        }
        if (ABL & 1) BAR_VN(0); else if (t + 2 < NT) BAR_VN(NDK + NDV); else if (t + 1 < NT) BAR_VN(NDV); else BAR_VN(0);
        rp = rc; rc = rn; rn = (rn == NRING - 1) ? 0 : rn + 1;
    }
    if (ACTW(NT - 1)) { SBAR(); pv_tile<0>(o, vb0 + rp * SHM_V, pa0, pa1, pa2, pa3); }
    if (grpA) BAR_L();
#undef BAR_VN
#undef ACTW
#undef DMA_K
#undef DMA_V
    { const float rl = __builtin_amdgcn_rcpf(l_reg);
      const size_t rowoff = (size_t)(q0 + wid * QBLK + r32) * 2048;
      const bf16* gp = Gp + rowoff + 4 * hi; bf16* op = Op + rowoff + 8 * hi;
#pragma unroll
      for (int k2 = 0; k2 < 8; ++k2) { const int ka = 2 * k2, kb = 2 * k2 + 1;
          const u32x2 ga = *(const u32x2*)(gp + 8 * ka), gb = *(const u32x2*)(gp + 8 * kb);
          const int ra = 4 * (ka & 3), rb = 4 * (kb & 3);
          unsigned ax = cvtpk(o[ka >> 2][ra] * rl * bflo(ga.x), o[ka >> 2][ra + 1] * rl * bfhi(ga.x)), ay = cvtpk(o[ka >> 2][ra + 2] * rl * bflo(ga.y), o[ka >> 2][ra + 3] * rl * bfhi(ga.y));
          unsigned bx = cvtpk(o[kb >> 2][rb] * rl * bflo(gb.x), o[kb >> 2][rb + 1] * rl * bfhi(gb.x)), by = cvtpk(o[kb >> 2][rb + 2] * rl * bflo(gb.y), o[kb >> 2][rb + 3] * rl * bfhi(gb.y));
          { auto sx = __builtin_amdgcn_permlane32_swap(ax, bx, false, false); ax = sx[0]; bx = sx[1]; }
          { auto sy = __builtin_amdgcn_permlane32_swap(ay, by, false, false); ay = sy[0]; by = sy[1]; }
          u32x4 w; w.x = ax; w.y = ay; w.z = bx; w.w = by;
          *(u32x4*)(op + 16 * k2) = w; } }
    BAR_VL();
#undef BAR_L
#undef BAR_VL
}
#undef KSWZ
#undef SBAR
}

__device__ __forceinline__ void transpose_item(const float* W, int ldw, int K, const float* g, bf16* WT, int dst_row0, int src_col0, int nvalid, int k0, LAS float* scr, int lane) {
    const int n = lane & 31; const bool ok = (src_col0 >= 0) && (n < nvalid);
    float tv[32];
#pragma unroll
    for (int i = 0; i < 32; ++i) { const int kk = 2 * i + (lane >> 5); tv[i] = ok ? W[(size_t)(k0 + kk) * ldw + src_col0 + n] : 0.f; }
    if (g) {
#pragma unroll
        for (int i = 0; i < 32; ++i) tv[i] *= g[k0 + 2 * i + (lane >> 5)]; }
#pragma unroll
    for (int i = 0; i < 32; ++i) scr[(2 * i + (lane >> 5)) * 33 + n] = tv[i];
    asm volatile("s_waitcnt lgkmcnt(0)" ::: "memory");
    const int c = lane & 7;
#pragma unroll
    for (int j = 0; j < 4; ++j) { const int nn = (lane >> 3) + 8 * j; const LAS float* s = scr + (8 * c) * 33 + nn;
        u32x4 o; o.x = pk2(s[0 * 33], s[1 * 33]); o.y = pk2(s[2 * 33], s[3 * 33]); o.z = pk2(s[4 * 33], s[5 * 33]); o.w = pk2(s[6 * 33], s[7 * 33]);
        *(u32x4*)(WT + (size_t)(dst_row0 + nn) * K + k0 + 8 * c) = o; }
    asm volatile("s_waitcnt lgkmcnt(0)" ::: "memory");
}
__device__ __forceinline__ void win_src(int r0, int& src, int& nv) {
    nv = 32;
    if (r0 < 1280) src = r0;
    else if (r0 < 2304) src = 1344 + (r0 - 1280);
    else if (r0 < 3328) src = 2368 + (r0 - 2304);
    else if (r0 < 4352) src = 3392 + (r0 - 3328);
    else if (r0 < 5376) src = 4416 + (r0 - 4352);
    else if (r0 < 6400) src = 5448 + (r0 - 5376);
    else if (r0 == 6400) src = 1280;
    else if (r0 == 6432) { src = 5440; nv = 8; }
    else if (r0 == 6528) src = 1312;
    else src = -1;
}
__device__ __forceinline__ int wuq_src(int r0) {
    if (r0 < 1024) return (r0 >> 7) * 192 + (r0 & 127);
    const int q = r0 - 1024, t = q >> 8, bj = (q >> 7) & 1, wc = (q >> 5) & 3;
    return (4 * t + wc) * 192 + 128 + 32 * bj;
}


#define XB_TMO      128
#define XB_XCNT(j)  (256  + 64 * (j))
#define XB_XSUB(j)  (1280 + 64 * (j))
#define XB_XGEN(j)  (2304 + 64 * (j))
#define XB_TOP      3328
#define XB_TOPGEN   3392
#define XCD_BAR_WORDS 3456
#define XB_SPIN_CAP (1u << 18)
__device__ __forceinline__ unsigned xb_ld(unsigned* p)              { return __hip_atomic_load(p, __ATOMIC_RELAXED, __HIP_MEMORY_SCOPE_AGENT); }
__device__ __forceinline__ unsigned xb_add(unsigned* p, unsigned v) { return __hip_atomic_fetch_add(p, v, __ATOMIC_RELAXED, __HIP_MEMORY_SCOPE_AGENT); }
__device__ __forceinline__ unsigned xb_xcc_id() { return (unsigned)__builtin_amdgcn_s_getreg((3 << 11) | 20) & 0xFu; }
#define XB_SPIN(cond, bar) do { unsigned _sp = 0; while (cond) { __builtin_amdgcn_s_sleep(1); \
    if ((++_sp & 255u) == 0u) { if (xb_ld(&(bar)[XB_TMO])) break; if (_sp > XB_SPIN_CAP) { atomicAdd(&(bar)[XB_TMO], 1u); break; } } } } while (0)
struct XcdBarrier { unsigned* bar; unsigned x; volatile LAS unsigned* st; };
__device__ __forceinline__ XcdBarrier xcd_barrier_post(unsigned* bar, volatile LAS unsigned* st) {
    XcdBarrier b; b.bar = bar; b.x = xb_xcc_id(); b.st = st;
    if (threadIdx.x == 0) (void)xb_add(&bar[XB_XCNT(b.x)], 1u);
    return b;
}
__device__ __forceinline__ void xcd_barrier_complete(unsigned* bar, unsigned x, unsigned& nloc, unsigned& nx) {
    const unsigned G = gridDim.x * gridDim.y * gridDim.z;
    unsigned sum, cnt, mine, sp = 0u;
    for (;;) {
        sum = 0u; cnt = 0u; mine = 0u;
#pragma unroll
        for (unsigned j = 0; j < 16; ++j) { const unsigned c = xb_ld(&bar[XB_XCNT(j)]); sum += c; cnt += (c > 0u) ? 1u : 0u; mine = (j == x) ? c : mine; }
        if (sum == G) break;
        __builtin_amdgcn_s_sleep(1);
        if ((++sp & 255u) == 0u) { if (xb_ld(&bar[XB_TMO])) break; if (sp > XB_SPIN_CAP) { atomicAdd(&bar[XB_TMO], 1u); break; } }
    }
    nloc = mine > 0u ? mine : 1u; nx = cnt > 0u ? cnt : 1u;
}
__device__ __forceinline__ void xcd_barrier(const XcdBarrier& b) {
    asm volatile("s_waitcnt vmcnt(0)" ::: "memory");
    __syncthreads();
    if (threadIdx.x == 0) {
        unsigned* bar = b.bar;
        __builtin_amdgcn_s_waitcnt(0);
        unsigned nloc = b.st[0], nx = b.st[1];
        if (nloc == 0u) { xcd_barrier_complete(bar, b.x, nloc, nx); b.st[0] = nloc; b.st[1] = nx; }
        const unsigned old = xb_add(&bar[XB_XSUB(b.x)], 1u);
        const unsigned gen = old / nloc;
        if (old + 1u == (gen + 1u) * nloc) {
            __builtin_amdgcn_fence(__ATOMIC_RELEASE, "agent");
            asm volatile("s_waitcnt vmcnt(0)" ::: "memory");
            const unsigned og = xb_add(&bar[XB_TOP], 1u);
            const unsigned tg = og / nx;
            if (og + 1u == (tg + 1u) * nx) xb_add(&bar[XB_TOPGEN], 1u);
            else XB_SPIN(xb_ld(&bar[XB_TOPGEN]) == tg, bar);
            __builtin_amdgcn_fence(__ATOMIC_ACQUIRE, "agent");
            xb_add(&bar[XB_XGEN(b.x)], 1u);
            asm volatile("s_waitcnt vmcnt(0)" ::: "memory");
        } else {
            XB_SPIN(xb_ld(&bar[XB_XGEN(b.x)]) == gen, bar);
            __builtin_amdgcn_fence(__ATOMIC_ACQUIRE, "agent");
            asm volatile("s_waitcnt vmcnt(0)" ::: "memory");
        }
    }
    __syncthreads();
}

struct Args { const float* x; const int* pos; const float* g_pre; const float* w_in; const float* g_q; const float* w_uq; const float* g_kv; const float* w_ukv;
              const float* b_forget; const float* w_out; const float* g_post; float* out; unsigned char* ws; int ph_lo, ph_hi; };

__global__ void __launch_bounds__(512, 2) hybrid_fwd(Args a) {
    extern __shared__ __attribute__((aligned(16))) unsigned char lds[];
    cg::grid_group grid = cg::this_grid();
    const int tid_k = threadIdx.x, lane_k = tid_k & 63, wave = __builtin_amdgcn_readfirstlane(tid_k >> 6);
    const int G = gridDim.x, bx = blockIdx.x; const int vcu = (G % 8 == 0) ? (bx % 8) * (G / 8) + bx / 8 : bx;
    unsigned char* ws = a.ws;
    float* rstd_x = (float*)(ws + WS_RSTDX); float* partq = (float*)(ws + WS_PARTQ); float* partkv = (float*)(ws + WS_PARTKV); float* party = (float*)(ws + WS_PARTY);
    float* flog = (float*)(ws + WS_FLOG); float* cf = (float*)(ws + WS_CF); float* cosT = (float*)(ws + WS_COS); float* sinT = (float*)(ws + WS_SIN);
    bf16* Win_t = (bf16*)(ws + WS_WIN); bf16* Wuq_t = (bf16*)(ws + WS_WUQ); bf16* Wukv_t = (bf16*)(ws + WS_WUKV); bf16* Wout_t = (bf16*)(ws + WS_WOUT);
    bf16* Xb = (bf16*)(ws + WS_XB); bf16* Ob = (bf16*)(ws + WS_O); bf16* qlat = (bf16*)(ws + WS_QLAT); bf16* kvlat = (bf16*)(ws + WS_KVLAT); bf16* Gb = (bf16*)(ws + WS_G);
    bf16* Qf = (bf16*)(ws + WS_QF); bf16* Kf = (bf16*)(ws + WS_KF); bf16* Vf = (bf16*)(ws + WS_VF); bf16* Yb = (bf16*)(ws + WS_Y);
    bf16* Qm = (bf16*)(ws + WS_QM); bf16* Km = (bf16*)(ws + WS_KM); bf16* Vm = (bf16*)(ws + WS_VM);
    const int lo = a.ph_lo, hi = a.ph_hi;
#ifndef PH_MASK
#define PH_MASK 63
#endif
#define IN(k) (((PH_MASK >> (k)) & 1) && lo <= (k) && (k) < hi)
#define BOTH(k) (IN(k) && IN((k) + 1))
    LAS unsigned char* ldsl = (LAS unsigned char*)lds;
    volatile LAS unsigned* bst = (volatile LAS unsigned*)(ldsl + LDS_BYTES - 64);
    if (tid_k < 2) bst[tid_k] = 0u;
    __syncthreads();
    XcdBarrier xbar = xcd_barrier_post((unsigned*)(ws + WS_CTL), bst);

    if (IN(0)) for (int rep_ = 0; rep_ < PROBE_REP0; ++rep_) {
        const int lane = launder(lane_k), tid = launder(tid_k);
        LAS float* scr = (LAS float*)(ldsl + wave * 16384);
        const int gw = vcu * 8 + wave, NGW = G * 8;
        constexpr int I_IN = 32 * 208, I_UQ = 12 * 48, I_UKV = 8 * 64, I_OUT = 32 * 64, NITEMS = I_IN + I_UQ + I_UKV + I_OUT;
        for (int it = gw; it < NITEMS; it += NGW) {
            int r = it;
            if (r < I_IN) { const int kb = r / 208, nb = r % 208; int src, nv; win_src(nb * 32, src, nv); transpose_item(a.w_in, DIN, 2048, a.g_pre, Win_t, nb * 32, src, nv, kb * 64, scr, lane); continue; } r -= I_IN;
            if (r < I_UQ) { const int kb = r / 48, nb = r % 48; transpose_item(a.w_uq, 1536, 768, a.g_q, Wuq_t, nb * 32, wuq_src(nb * 32), 32, kb * 64, scr, lane); continue; } r -= I_UQ;
            if (r < I_UKV) { const int kb = r / 64, nb = r % 64; transpose_item(a.w_ukv, 2048, 512, a.g_kv, Wukv_t, nb * 32, nb * 32, 32, kb * 64, scr, lane); continue; } r -= I_UKV;
            { const int kb = r / 64, nb = r % 64; transpose_item(a.w_out, 2048, 2048, nullptr, Wout_t, nb * 32, nb * 32, 32, kb * 64, scr, lane); }
        }
        for (int m = gw; m < M; m += 2 * NGW) {
            const int m2 = m + NGW;
            const f32x4* xr = (const f32x4*)(a.x + (size_t)m * DM) + lane; const f32x4* xr2 = (const f32x4*)(a.x + (size_t)m2 * DM) + lane; f32x4 v[8], v2[8]; float s = 0.f, s2 = 0.f;
#pragma unroll
            for (int j = 0; j < 8; ++j) { v[j] = __builtin_nontemporal_load(xr + 64 * j); v2[j] = __builtin_nontemporal_load(xr2 + 64 * j); }
#pragma unroll
            for (int j = 0; j < 8; ++j) { s += (v[j][0] * v[j][0] + v[j][1] * v[j][1]) + (v[j][2] * v[j][2] + v[j][3] * v[j][3]); s2 += (v2[j][0] * v2[j][0] + v2[j][1] * v2[j][1]) + (v2[j][2] * v2[j][2] + v2[j][3] * v2[j][3]); }
            s = wave_sum(s); s2 = wave_sum(s2);
            if (lane == 0) { rstd_x[m] = 1.f / sqrtf(s * (1.f / DM) + EPS); rstd_x[m2] = 1.f / sqrtf(s2 * (1.f / DM) + EPS); }
            u32x2* o8 = (u32x2*)(Xb + (size_t)m * DM) + lane; u32x2* o82 = (u32x2*)(Xb + (size_t)m2 * DM) + lane;
#pragma unroll
            for (int j = 0; j < 8; ++j) { u32x2 w; w.x = pk2(v[j][0], v[j][1]); w.y = pk2(v[j][2], v[j][3]); o8[64 * j] = w; u32x2 w2; w2.x = pk2(v2[j][0], v2[j][1]); w2.y = pk2(v2[j][2], v2[j][3]); o82[64 * j] = w2; }
        }
        for (int e = (vcu * 512 + tid); e < M * 32; e += G * 512) { const int row = e >> 5, i = e & 31;
            const float inv = exp2f(-(float)i * (13.287712379549449f / 32.f)); const float ang = (float)a.pos[row] * inv;
            const float n = rintf(ang * 0.15915494309189535f); float r = fmaf(-n, 6.28318548202514648f, ang); r = fmaf(-n, -1.7484555e-7f, r);
            cosT[e] = __cosf(r); sinT[e] = __sinf(r); }
    }
    if (BOTH(0)) xcd_barrier(xbar);
    if (a.ph_hi > 64) grid.sync();

    if (IN(1)) for (int rep_ = 0; rep_ < PROBE_REP1; ++rep_) {
        pg8::Gemm g{Xb, Win_t, M, NIN_PAD, 2048}; pg8::StaticOrder S; S.init(M, NIN_PAD, G, bx);
        EpiIn E{rstd_x, qlat, kvlat, Gb, Qf, Kf, Vf, Km, flog, partq, partkv, cosT, sinT};
        pg8::gemm_phase<EpiIn, pg8::StaticOrder, true, true>(ldsl, g, S, E);
    }
    if (BOTH(1)) xcd_barrier(xbar);

    if (IN(2)) for (int rep_ = 0; rep_ < PROBE_REP2; ++rep_) {
        const int lane = launder(lane_k), tid = launder(tid_k);
        if (bx >= G - BATCH * NH) { const int sq_ = bx - (G - BATCH * NH);
            const int b = sq_ >> 3, h = sq_ & 7; const float bf = a.b_forget[h];
            const float* fl = flog + ((size_t)b * SEQ + 8 * tid) * 8 + h; float lf[8];
#pragma unroll
            for (int j = 0; j < 8; ++j) lf[j] = fl[j * 8] + bf;
#pragma unroll
            for (int j = 0; j < 8; ++j) { const float z = lf[j]; lf[j] = fminf(z, 0.f) - log1pf(expf(-fabsf(z))); }
#pragma unroll
            for (int j = 1; j < 8; ++j) lf[j] += lf[j - 1];
            float incl = lf[7];
#pragma unroll
            for (int o = 1; o < 64; o <<= 1) { const float t = __shfl_up(incl, o); if (lane >= o) incl += t; }
            volatile LAS float* wtot = (volatile LAS float*)(ldsl + LDS_BYTES - 128);
            if (lane == 63) wtot[wave] = incl;
            __syncthreads();
            float off = incl - lf[7];
            for (int w2 = 0; w2 < wave; ++w2) off += wtot[w2];
            float* cp = cf + (size_t)sq_ * SEQ + 8 * tid;
            f32x4 o0, o1;
#pragma unroll
            for (int j = 0; j < 4; ++j) { o0[j] = (off + lf[j]) * LOG2E; o1[j] = (off + lf[4 + j]) * LOG2E; }
            *(f32x4*)cp = o0; *(f32x4*)(cp + 4) = o1;
            __syncthreads();
        }
        { pg8::Gemm g{qlat, Wuq_t, M, 1536, QRANK}; pg8::StaticOrder S; S.init(M, 1536, G, bx);
          EpiQ E{partq, Qm, cosT, sinT};
          pg8::gemm_phase<EpiQ, pg8::StaticOrder, true, true>(ldsl, g, S, E); }
        { pg8::Gemm g{kvlat, Wukv_t, M, 2048, KVRANK}; pg8::StaticOrder S; S.init(M, 2048, G, bx);
          EpiKV E{partkv, Km, Vm};
          pg8::gemm_phase<EpiKV, pg8::StaticOrder, true, true>(ldsl, g, S, E); }
    }
    if (BOTH(2)) xcd_barrier(xbar);

    if (IN(3)) for (int rep_ = 0; rep_ < PROBE_REP3; ++rep_) {
        for (int v = vcu; v < 256; v += G) {
            const int s = v & 3, w = v >> 2, b = w >> 4, hh = w & 15, hd = hh & 7, swp = hh >> 3;
            const size_t rb = (size_t)b * SEQ;
#pragma unroll 1
            for (int i = 0; i < 2; ++i) {
                const int qb = __builtin_amdgcn_readfirstlane(swp ? (i == 0 ? 8 + s : 7 - s) : (i == 0 ? 15 - s : s));
                att::attn_unit<192, false>((char*)lds, Qm + rb * 1536 + hd * 192, 1536, Km + rb * 1536 + hd * 192, 1536, Vm + rb * 1024 + hd * 128, 1024, nullptr,
                                           Gb + rb * 2048 + hd * 128, Ob + rb * 2048 + hd * 128, qb);
            }
#pragma unroll 1
            for (int i = 0; i < 2; ++i) {
                const int qb = __builtin_amdgcn_readfirstlane(swp ? (i == 0 ? 15 - s : s) : (i == 0 ? 8 + s : 7 - s));
                att::attn_unit<128, true>((char*)lds, Qf + rb * 1024 + hd * 128, 1024, Kf + rb * 1024 + hd * 128, 1024, Vf + rb * 1024 + hd * 128, 1024, cf + (size_t)(b * 8 + hd) * SEQ,
                                          Gb + rb * 2048 + 1024 + hd * 128, Ob + rb * 2048 + 1024 + hd * 128, qb);
            }
        }
    }
#if PROBE_ABL >= 0
    if (IN(3)) {
        for (int v = vcu; v < 256; v += G) {
            const int s = v & 3, w = v >> 2, b = w >> 4, hh = w & 15, hd = hh & 7, swp = hh >> 3;
            const size_t rb = (size_t)b * SEQ;
#pragma unroll 1
            for (int i = 0; i < 2; ++i) {
                const int qb = __builtin_amdgcn_readfirstlane(swp ? (i == 0 ? 8 + s : 7 - s) : (i == 0 ? 15 - s : s));
                att::attn_unit<192, false, PROBE_ABL>((char*)lds, Qm + rb * 1536 + hd * 192, 1536, Km + rb * 1536 + hd * 192, 1536, Vm + rb * 1024 + hd * 128, 1024, nullptr,
                                           Gb + rb * 2048 + hd * 128, qlat, qb);
            }
#pragma unroll 1
            for (int i = 0; i < 2; ++i) {
                const int qb = __builtin_amdgcn_readfirstlane(swp ? (i == 0 ? 15 - s : s) : (i == 0 ? 8 + s : 7 - s));
                att::attn_unit<128, true, PROBE_ABL>((char*)lds, Qf + rb * 1024 + hd * 128, 1024, Kf + rb * 1024 + hd * 128, 1024, Vf + rb * 1024 + hd * 128, 1024, cf + (size_t)(b * 8 + hd) * SEQ,
                                          Gb + rb * 2048 + 1024 + hd * 128, qlat, qb);
            }
        }
    }
#endif
    if (BOTH(3)) xcd_barrier(xbar);

    if (IN(4)) for (int rep_ = 0; rep_ < PROBE_REP4; ++rep_) {
        pg8::Gemm g{Ob, Wout_t, M, 2048, 2048}; pg8::StaticOrder S; S.init(M, 2048, G, bx);
        EpiOut E{Yb, party};
        pg8::gemm_phase<EpiOut, pg8::StaticOrder, true, true>(ldsl, g, S, E);
    }
    if (BOTH(4)) xcd_barrier(xbar);

    if (IN(5)) for (int rep_ = 0; rep_ < PROBE_REP5; ++rep_) {
        const int lane = launder(lane_k);
        const int gw = vcu * 8 + wave, NGW = G * 8;
        const f32x4* gp = (const f32x4*)a.g_post + lane; f32x4 gv[8];
#pragma unroll
        for (int j = 0; j < 8; ++j) gv[j] = gp[64 * j];
        for (int m = gw; m < M; m += 2 * NGW) {
            const int m2 = m + NGW;
            float s = (lane < 32) ? party[(size_t)m * 32 + lane] : 0.f, s2 = (lane < 32) ? party[(size_t)m2 * 32 + lane] : 0.f;
            const f32x4* xr = (const f32x4*)(a.x + (size_t)m * DM) + lane; const f32x4* xr2 = (const f32x4*)(a.x + (size_t)m2 * DM) + lane;
            const u32x2* yr = (const u32x2*)(Yb + (size_t)m * DM) + lane; const u32x2* yr2 = (const u32x2*)(Yb + (size_t)m2 * DM) + lane;
            f32x4 xv[8], xv2[8]; u32x2 y[8], y2[8];
#pragma unroll
            for (int j = 0; j < 8; ++j) { xv[j] = __builtin_nontemporal_load(xr + 64 * j); xv2[j] = __builtin_nontemporal_load(xr2 + 64 * j); y[j] = __builtin_nontemporal_load(yr + 64 * j); y2[j] = __builtin_nontemporal_load(yr2 + 64 * j); }
            s = wave_sum(s); s2 = wave_sum(s2);
            const float rs = 1.f / sqrtf(s * (1.f / DM) + EPS), rs2 = 1.f / sqrtf(s2 * (1.f / DM) + EPS);
            f32x4* orow = (f32x4*)(a.out + (size_t)m * DM) + lane; f32x4* orow2 = (f32x4*)(a.out + (size_t)m2 * DM) + lane;
#pragma unroll
            for (int j = 0; j < 8; ++j) {
                f32x4 o; o[0] = xv[j][0] + bflo(y[j].x) * rs * gv[j][0]; o[1] = xv[j][1] + bfhi(y[j].x) * rs * gv[j][1]; o[2] = xv[j][2] + bflo(y[j].y) * rs * gv[j][2]; o[3] = xv[j][3] + bfhi(y[j].y) * rs * gv[j][3];
                __builtin_nontemporal_store(o, orow + 64 * j);
                f32x4 o2; o2[0] = xv2[j][0] + bflo(y2[j].x) * rs2 * gv[j][0]; o2[1] = xv2[j][1] + bfhi(y2[j].x) * rs2 * gv[j][1]; o2[2] = xv2[j][2] + bflo(y2[j].y) * rs2 * gv[j][2]; o2[3] = xv2[j][3] + bfhi(y2[j].y) * rs2 * gv[j][3];
                __builtin_nontemporal_store(o2, orow2 + 64 * j); }
        }
    }
#undef IN
#undef BOTH
}

extern "C" void kernel_launch(void* const* d_in, const int* in_sizes, int n_in, void* d_out, int out_size, void* d_ws, size_t ws_size, hipStream_t stream) {
    static int grid = 0;
    if (grid == 0) {
        if (n_in != 11 || in_sizes[0] != M * DM || out_size != M * DM || ws_size < WS_END) { fprintf(stderr, "kernel_launch: shape mismatch n_in %d in0 %d out %d ws %zu\n", n_in, n_in > 0 ? in_sizes[0] : -1, out_size, ws_size); grid = -1; return; }
        int dev = 0, cus = 0, per_cu = 0;
        if (hipGetDevice(&dev) != hipSuccess || hipDeviceGetAttribute(&cus, hipDeviceAttributeMultiprocessorCount, dev) != hipSuccess) { grid = -1; return; }
        if (hipFuncSetAttribute((const void*)hybrid_fwd, hipFuncAttributeMaxDynamicSharedMemorySize, LDS_BYTES) != hipSuccess) { fprintf(stderr, "kernel_launch: hipFuncSetAttribute failed\n"); grid = -1; return; }
        if (hipOccupancyMaxActiveBlocksPerMultiprocessor(&per_cu, (const void*)hybrid_fwd, 512, LDS_BYTES) != hipSuccess || per_cu < 1) { fprintf(stderr, "kernel_launch: occupancy query says %d\n", per_cu); per_cu = 1; }
        (void)hipGetLastError();
        grid = cus;
    }
    if (grid < 0) return;
    if (hipMemsetAsync((char*)d_ws + WS_CTL, 0, CTL_BYTES, stream) != hipSuccess) { fprintf(stderr, "kernel_launch: memset failed\n"); return; }
    Args a{};
    a.x = (const float*)d_in[0]; a.pos = (const int*)d_in[1]; a.g_pre = (const float*)d_in[2]; a.w_in = (const float*)d_in[3]; a.g_q = (const float*)d_in[4]; a.w_uq = (const float*)d_in[5];
    a.g_kv = (const float*)d_in[6]; a.w_ukv = (const float*)d_in[7]; a.b_forget = (const float*)d_in[8]; a.w_out = (const float*)d_in[9]; a.g_post = (const float*)d_in[10];
    a.out = (float*)d_out; a.ws = (unsigned char*)d_ws;
#if MK_N_LAUNCHES == 1
    a.ph_lo = 0; a.ph_hi = 6;
    void* args[] = {&a};
    hipError_t e = hipLaunchCooperativeKernel((const void*)hybrid_fwd, dim3(grid), dim3(512), args, LDS_BYTES, stream);
    if (e != hipSuccess) fprintf(stderr, "cooperative launch failed: %s (grid %d)\n", hipGetErrorString(e), grid);
#else
    for (int p = 0; p < 6; ++p) { a.ph_lo = p; a.ph_hi = p + 1; for (int r = 0; r < (p == PROBE_DUP ? 2 : 1); ++r) hipLaunchKernelGGL(hybrid_fwd, dim3(grid), dim3(512), LDS_BYTES, stream, a); }
#endif
}
```

```cpp
#include <hip/hip_runtime.h>
#include <hip/hip_cooperative_groups.h>
#include <cstdio>
#include <cstdint>
namespace cg = cooperative_groups;

#ifndef PROBE_REP0
#define PROBE_REP0 1
#endif
#ifndef PROBE_REP1
#define PROBE_REP1 1
#endif
#ifndef PROBE_REP2
#define PROBE_REP2 1
#endif
#ifndef PROBE_REP3
#define PROBE_REP3 1
#endif
#ifndef PROBE_REP4
#define PROBE_REP4 1
#endif
#ifndef PROBE_REP5
#define PROBE_REP5 1
#endif
#ifndef PROBE_ABL
#define PROBE_ABL -1
#endif
#ifndef PROBE_DUP
#define PROBE_DUP -1
#endif
#ifndef MK_N_LAUNCHES
#define MK_N_LAUNCHES 1
#endif

namespace pg8 {
#define PG8_LAS __attribute__((address_space(3)))
typedef unsigned short bf16_t;
typedef short bf16x8 __attribute__((ext_vector_type(8)));
typedef float f32x4 __attribute__((ext_vector_type(4)));
typedef unsigned u32x4 __attribute__((ext_vector_type(4)));
constexpr int BM = 256, BK = 64, HALF = 128, HTB = HALF * BK * 2, STAGE_BYTES = 8 * HTB, NXCD = 8, WGM = 8;

__host__ __device__ __forceinline__ int lds_byte(int r, int c) { const int st = (r >> 4) * 2 + (c >> 5), rr = r & 15, cc = c & 31, ob = rr * 64 + cc * 2; return st * 1024 + (ob ^ (((ob >> 9) & 1) << 5)); }
__host__ __device__ __forceinline__ void stage_rc(int b, int& R, int& C) { const int st = b / 1024, sb = b % 1024, swz = sb ^ (((sb >> 9) & 1) << 5); R = (st >> 1) * 16 + swz / 64; C = (st & 1) * 32 + (swz % 64) / 2; }
__host__ __device__ __forceinline__ int perm32(int rho) { const int n = rho >> 4, i = rho & 15; return 8 * (i >> 2) + 4 * n + (i & 3); }

struct Unit { int pm, pn; };
struct Gemm { const bf16_t* A; const bf16_t* Bt; int M, N, K; };

struct StaticOrder {
    int nM, nN, nwg, G, c;
    __host__ __device__ void init(int M, int N, int G_, int c_) { nM = M / BM; nN = N / BM; nwg = nM * nN; G = G_; c = c_; }
    __host__ __device__ bool next(int i, Unit& u) const {
        const long L = (long)i * G + c; if (L >= nwg) return false;
        int wgid = (int)L; { const int q = nwg / NXCD, r = nwg % NXCD, xcd = wgid % NXCD, off = wgid / NXCD; wgid = (xcd < r ? xcd * (q + 1) : r * (q + 1) + (xcd - r) * q) + off; }
        const int nig = WGM * nN, gid = wgid / nig, fm = gid * WGM, gsz = (nM - fm) < WGM ? (nM - fm) : WGM;
        u.pm = fm + ((wgid % nig) % gsz); u.pn = (wgid % nig) / gsz; return true;
    }
    __device__ __forceinline__ void a_ready(const Unit&) const {}
    __device__ __forceinline__ void done(const Unit&) const {}
};

__device__ __forceinline__ unsigned cvt_pk_bf16(float lo, float hi) { unsigned r; asm volatile("v_cvt_pk_bf16_f32 %0, %1, %2" : "=v"(r) : "v"(lo), "v"(hi)); return r; }

template <class Epi, class Sched, bool ALIGN_EPI = false, bool SP2 = false>
__device__ __forceinline__ void gemm_phase(PG8_LAS unsigned char* lds, const Gemm g, const Sched& S, const Epi& E) {
    const int tid = threadIdx.x, wid = __builtin_amdgcn_readfirstlane(tid >> 6), lane = tid & 63, wr = wid >> 2, wc = wid & 3, fr = lane & 15, fq = lane >> 4;
    const int K = g.K, nt = K / BK;
    unsigned voffA[2], voffB[2];
#pragma unroll
    for (int i = 0; i < 2; ++i) { int R, C; stage_rc(tid * 16 + i * 8192, R, C); const int Rb = Epi::PERM ? ((R & ~31) + perm32(R & 31)) : R;
        voffA[i] = (unsigned)(R * K + C) * 2u; voffB[i] = (unsigned)(Rb * K + C) * 2u; }
    const size_t kstep = (size_t)(BK * 2);
    const size_t hstep = (size_t)HALF * K * 2;
    const size_t tstep = 2 * hstep;
    const unsigned ldsw = (unsigned)wid * 1024u;
    const int aoff = lds_byte(wr * 64 + fr, fq * 8), boff = lds_byte(wc * 32 + fr, fq * 8);
#define PG8_SA(b, h) (((b) * 2 + (h)) * HTB)
#define PG8_SB(b, h) ((4 + (b) * 2 + (h)) * HTB)
#define PG8_STAGE(bufoff, gbase, voff) do { _Pragma("unroll") for (int _i = 0; _i < 2; ++_i) \
        __builtin_amdgcn_global_load_lds((const unsigned*)((const char*)(gbase) + (voff)[_i]), (PG8_LAS unsigned*)(lds + (bufoff) + ldsw + _i * 8192), 16, 0, 0); } while (0)
#define PG8_LDA(dst, b, h) do { _Pragma("unroll") for (int m = 0; m < 4; ++m) _Pragma("unroll") for (int k = 0; k < 2; ++k) dst[m][k] = *(const PG8_LAS bf16x8*)(lds + PG8_SA(b, h) + aoff + m * 2048 + k * 1024); } while (0)
#define PG8_LDB(dst, b, h) do { _Pragma("unroll") for (int n = 0; n < 2; ++n) _Pragma("unroll") for (int k = 0; k < 2; ++k) dst[n][k] = *(const PG8_LAS bf16x8*)(lds + PG8_SB(b, h) + boff + n * 2048 + k * 1024); } while (0)
#define PG8_MMA(ai, bj, At, Bt) do { __builtin_amdgcn_s_setprio(1); _Pragma("unroll") for (int m = 0; m < 4; ++m) _Pragma("unroll") for (int n = 0; n < 2; ++n) _Pragma("unroll") for (int k = 0; k < 2; ++k) \
        acc[ai][bj][m][n] = __builtin_amdgcn_mfma_f32_16x16x32_bf16(Bt[n][k], At[m][k], acc[ai][bj][m][n], 0, 0, 0); __builtin_amdgcn_s_setprio(0); } while (0)
#define PG8_WAIT_V(n) asm volatile("s_waitcnt vmcnt(" #n ")" ::: "memory")
#define PG8_WAIT_L(n) asm volatile("s_waitcnt lgkmcnt(" #n ")" ::: "memory")
#define PG8_BAR __builtin_amdgcn_s_barrier()
#define PG8_SCHED __builtin_amdgcn_sched_barrier(0)
    Unit cur, nxt; int ui = 0;
    if (!S.next(0, cur)) return;
    f32x4 acc[2][2][4][2];
#pragma unroll
    for (int a = 0; a < 2; ++a)
#pragma unroll
        for (int b = 0; b < 2; ++b)
#pragma unroll
            for (int m = 0; m < 4; ++m)
#pragma unroll
                for (int n = 0; n < 2; ++n) acc[a][b][m][n] = (f32x4){0.f, 0.f, 0.f, 0.f};
    bf16x8 At[4][2], B0[2][2], B1[2][2];
    const char* cA = (const char*)g.A + (size_t)cur.pm * tstep; const char* cB = (const char*)g.Bt + (size_t)cur.pn * tstep;
    S.a_ready(cur);
    if constexpr (SP2) {
        PG8_STAGE(PG8_SB(0, 0), cB, voffB); PG8_STAGE(PG8_SB(0, 1), cB + hstep, voffB); PG8_STAGE(PG8_SA(0, 0), cA, voffA); PG8_STAGE(PG8_SA(0, 1), cA + hstep, voffA);
        if (wr == 1) PG8_BAR;
        PG8_WAIT_V(2); PG8_BAR;
        PG8_STAGE(PG8_SB(1, 0), cB + kstep, voffB); PG8_STAGE(PG8_SA(1, 0), cA + kstep, voffA); PG8_STAGE(PG8_SB(1, 1), cB + hstep + kstep, voffB);
        PG8_WAIT_V(6); PG8_BAR;
    } else {
        PG8_STAGE(PG8_SB(0, 0), cB, voffB); PG8_STAGE(PG8_SA(0, 0), cA, voffA); PG8_STAGE(PG8_SB(0, 1), cB + hstep, voffB); PG8_STAGE(PG8_SA(0, 1), cA + hstep, voffA);
        if (wr == 1) PG8_BAR;
        PG8_WAIT_V(4); PG8_BAR;
        PG8_STAGE(PG8_SB(1, 0), cB + kstep, voffB); PG8_STAGE(PG8_SA(1, 0), cA + kstep, voffA); PG8_STAGE(PG8_SB(1, 1), cB + hstep + kstep, voffB);
        PG8_WAIT_V(6); PG8_BAR;
    }
    for (;;) {
        const bool has_next = S.next(ui + 1, nxt);
        const char* nA = has_next ? (const char*)g.A + (size_t)nxt.pm * tstep : cA; const char* nB = has_next ? (const char*)g.Bt + (size_t)nxt.pn * tstep : cB;
        for (int t = 0; t < nt; t += 2) {
            const bool last = (t == nt - 2);
            const char* a1 = cA + (size_t)(t + 1) * kstep;
            const char* a2 = last ? nA : cA + (size_t)(t + 2) * kstep; const char* b2 = last ? nB : cB + (size_t)(t + 2) * kstep;
            const char* a3 = a2 + kstep; const char* b3 = b2 + kstep;
            if (last && has_next) S.a_ready(nxt);
            if constexpr (SP2) {
            PG8_LDB(B0, 0, 0); PG8_LDB(B1, 0, 1); PG8_SCHED; PG8_LDA(At, 0, 0); PG8_STAGE(PG8_SA(1, 1), a1 + hstep, voffA);
            PG8_WAIT_V(8); PG8_WAIT_L(0); PG8_BAR; PG8_MMA(0, 0, At, B0); PG8_MMA(0, 1, At, B1); PG8_BAR; PG8_SCHED;
            PG8_LDA(At, 0, 1); PG8_STAGE(PG8_SB(0, 0), b2, voffB); PG8_STAGE(PG8_SB(0, 1), b2 + hstep, voffB); PG8_STAGE(PG8_SA(0, 0), a2, voffA);
            PG8_WAIT_V(8); PG8_WAIT_L(0); PG8_BAR; PG8_MMA(1, 0, At, B0); PG8_MMA(1, 1, At, B1); PG8_BAR; PG8_SCHED;
            PG8_LDB(B0, 1, 0); PG8_LDB(B1, 1, 1); PG8_SCHED; PG8_LDA(At, 1, 0); PG8_STAGE(PG8_SA(0, 1), a2 + hstep, voffA);
            PG8_WAIT_V(8); PG8_WAIT_L(0); PG8_BAR; PG8_MMA(0, 0, At, B0); PG8_MMA(0, 1, At, B1); PG8_BAR; PG8_SCHED;
            PG8_LDA(At, 1, 1); PG8_STAGE(PG8_SB(1, 0), b3, voffB); PG8_STAGE(PG8_SB(1, 1), b3 + hstep, voffB); PG8_STAGE(PG8_SA(1, 0), a3, voffA);
            PG8_WAIT_V(8); PG8_WAIT_L(0); PG8_BAR; PG8_MMA(1, 0, At, B0); PG8_MMA(1, 1, At, B1); PG8_BAR; PG8_SCHED;
            } else {
            PG8_LDB(B0, 0, 0); PG8_SCHED; PG8_LDA(At, 0, 0); PG8_STAGE(PG8_SA(1, 1), a1 + hstep, voffA);
            PG8_WAIT_L(8); PG8_BAR; PG8_WAIT_L(0); PG8_MMA(0, 0, At, B0); PG8_BAR; PG8_SCHED;
            PG8_LDB(B1, 0, 1); PG8_STAGE(PG8_SB(0, 0), b2, voffB);
            PG8_BAR; PG8_WAIT_L(0); PG8_MMA(0, 1, At, B1); PG8_BAR;
            PG8_LDA(At, 0, 1); PG8_STAGE(PG8_SA(0, 0), a2, voffA);
            PG8_BAR; PG8_WAIT_L(0); PG8_MMA(1, 0, At, B0); PG8_BAR; PG8_SCHED;
            PG8_STAGE(PG8_SB(0, 1), b2 + hstep, voffB);
            PG8_WAIT_V(6); PG8_BAR; PG8_MMA(1, 1, At, B1); PG8_BAR;
            PG8_LDB(B0, 1, 0); PG8_SCHED; PG8_LDA(At, 1, 0); PG8_STAGE(PG8_SA(0, 1), a2 + hstep, voffA);
            PG8_WAIT_L(8); PG8_BAR; PG8_WAIT_L(0); PG8_MMA(0, 0, At, B0); PG8_BAR; PG8_SCHED;
            PG8_LDB(B1, 1, 1); PG8_STAGE(PG8_SB(1, 0), b3, voffB);
            PG8_BAR; PG8_WAIT_L(0); PG8_MMA(0, 1, At, B1); PG8_BAR;
            PG8_LDA(At, 1, 1); PG8_STAGE(PG8_SA(1, 0), a3, voffA);
            PG8_BAR; PG8_WAIT_L(0); PG8_MMA(1, 0, At, B0); PG8_BAR; PG8_SCHED;
            PG8_STAGE(PG8_SB(1, 1), b3 + hstep, voffB);
            PG8_WAIT_V(6); PG8_BAR; PG8_MMA(1, 1, At, B1); PG8_BAR;
            }
        }
        if constexpr (ALIGN_EPI) { if (wr == 0) PG8_BAR; }
        if constexpr (!Epi::AFTER_DRAIN) { E(acc, cur, wr, wc, fr, fq); S.done(cur); }
        if (!has_next) break;
#pragma unroll
        for (int a = 0; a < 2; ++a)
#pragma unroll
            for (int b = 0; b < 2; ++b)
#pragma unroll
                for (int m = 0; m < 4; ++m)
#pragma unroll
                    for (int n = 0; n < 2; ++n) acc[a][b][m][n] = (f32x4){0.f, 0.f, 0.f, 0.f};
        cur = nxt; cA = nA; cB = nB; ++ui;
        if constexpr (ALIGN_EPI) { if (wr == 1) PG8_BAR; }
    }
    PG8_WAIT_V(0);
    if constexpr (!ALIGN_EPI) { if (wr == 0) PG8_BAR; }
    PG8_BAR;
#undef PG8_SA
#undef PG8_SB
#undef PG8_STAGE
#undef PG8_LDA
#undef PG8_LDB
#undef PG8_MMA
#undef PG8_WAIT_V
#undef PG8_WAIT_L
#undef PG8_BAR
#undef PG8_SCHED
}
}

typedef unsigned short bf16;
typedef float f32x4 __attribute__((ext_vector_type(4)));
typedef unsigned u32x4 __attribute__((ext_vector_type(4)));
typedef unsigned u32x2 __attribute__((ext_vector_type(2)));
typedef short bf16x8 __attribute__((ext_vector_type(8)));
typedef short s16x4 __attribute__((ext_vector_type(4)));
typedef float f32x16 __attribute__((ext_vector_type(16)));
#define LAS __attribute__((address_space(3)))

constexpr int BATCH = 4, SEQ = 4096, DM = 2048, M = BATCH * SEQ;
constexpr int NH = 8, QKD = 192, QRANK = 768, KVRANK = 512, DIN = 6472;
constexpr int NIN_PAD = 6656;
constexpr float EPS = 1e-6f;
constexpr float LOG2E = 1.4426950408889634f;
constexpr float C2M = 0.07216878364870322f * LOG2E;
constexpr float C2F = 0.08838834764831845f * LOG2E;

constexpr size_t MiB = 1u << 20;
constexpr size_t WS_RSTDX = 0, WS_PARTQ = 1 * MiB, WS_PARTKV = 2 * MiB, WS_PARTY = 3 * MiB, WS_FLOG = 5 * MiB, WS_CF = 6 * MiB, WS_COS = 7 * MiB, WS_SIN = 9 * MiB;
constexpr size_t WS_CTL = 11 * MiB, CTL_BYTES = 16384;
constexpr size_t WS_WIN = 16 * MiB, WS_WUQ = 42 * MiB, WS_WUKV = 45 * MiB, WS_WOUT = 47 * MiB;
constexpr size_t WS_XB = 56 * MiB, WS_O = 56 * MiB;
constexpr size_t WS_QLAT = 120 * MiB, WS_KVLAT = 144 * MiB, WS_G = 160 * MiB;
constexpr size_t WS_QF = 224 * MiB, WS_Y = 224 * MiB, WS_KF = 256 * MiB, WS_VF = 288 * MiB;
constexpr size_t WS_QM = 320 * MiB, WS_KM = 368 * MiB, WS_VM = 416 * MiB, WS_END = 448 * MiB;

constexpr int LDS_BYTES = 163840;

__device__ __forceinline__ unsigned f2bf(float f) { unsigned u = __builtin_bit_cast(unsigned, f); return (u + 0x7fffu + ((u >> 16) & 1u)) >> 16; }
__device__ __forceinline__ unsigned pk2(float lo, float hi) { return pg8::cvt_pk_bf16(lo, hi); }
__device__ __forceinline__ float bflo(unsigned w) { return __builtin_bit_cast(float, w << 16); }
__device__ __forceinline__ float bfhi(unsigned w) { return __builtin_bit_cast(float, w & 0xffff0000u); }
__device__ __forceinline__ int launder(int v) { asm volatile("" : "+v"(v)); return v; }
__device__ __forceinline__ float wave_sum(float v) {
#pragma unroll
    for (int o = 1; o < 64; o <<= 1) v += __shfl_xor(v, o);
    return v;
}
__device__ __forceinline__ float silu_f(float v) { return v * __builtin_amdgcn_rcpf(1.f + __builtin_amdgcn_exp2f(-v * LOG2E)); }
__device__ __forceinline__ u32x4 pack8f(f32x4 a, f32x4 b) { u32x4 w; w.x = pk2(a[0], a[1]); w.y = pk2(a[2], a[3]); w.z = pk2(b[0], b[1]); w.w = pk2(b[2], b[3]); return w; }

typedef pg8::f32x4 af4;
struct EpiIn {
    static constexpr bool PERM = true, AFTER_DRAIN = false;
    const float* rstd_x; bf16 *qlat, *kvlat, *G, *Qf, *Kf, *Vf, *Km; float *flog, *partq, *partkv; const float *cosT, *sinT;
    __device__ __forceinline__ void operator()(const af4 (&acc)[2][2][4][2], const pg8::Unit& u, int wr, int wc, int fr, int fq) const {
        const int pn = u.pn; const int row0 = u.pm * 256 + wr * 64 + fr;
        if (pn == 25) {
            if (wc == 0) {
#pragma unroll
                for (int ai = 0; ai < 2; ++ai)
#pragma unroll
                    for (int m = 0; m < 4; ++m) { const int row = row0 + ai * 128 + m * 16; const float rs = rstd_x[row];
                        f32x4 o1[2], o2[2];
#pragma unroll
                        for (int n = 0; n < 2; ++n) { const f32x4 c = *(const f32x4*)(cosT + (size_t)row * 32 + 8 * fq + 4 * n), s = *(const f32x4*)(sinT + (size_t)row * 32 + 8 * fq + 4 * n);
                            const f32x4 x1 = acc[ai][0][m][n] * rs, x2 = acc[ai][1][m][n] * rs; o1[n] = x1 * c - x2 * s; o2[n] = x2 * c + x1 * s; }
                        const u32x4 w1 = pack8f(o1[0], o1[1]), w2 = pack8f(o2[0], o2[1]);
                        bf16* kp = Km + (size_t)row * 1536 + 128 + 8 * fq;
#pragma unroll
                        for (int h = 0; h < 8; ++h) { *(u32x4*)(kp + h * 192) = w1; *(u32x4*)(kp + h * 192 + 32) = w2; } }
            } else if (wc == 1 && fq == 0) {
#pragma unroll
                for (int ai = 0; ai < 2; ++ai)
#pragma unroll
                    for (int m = 0; m < 4; ++m) { const int row = row0 + ai * 128 + m * 16; const float rs = rstd_x[row];
                        *(f32x4*)(flog + (size_t)row * 8) = acc[ai][0][m][0] * rs; *(f32x4*)(flog + (size_t)row * 8 + 4) = acc[ai][0][m][1] * rs; }
            }
            return;
        }
        bf16* base; int ld, colt, mode = 0; float* part = nullptr; int nslot = 0, slot0 = 0;
        if (pn < 3) { base = qlat; ld = 768; colt = pn * 256; part = partq; nslot = 12; slot0 = pn * 4; }
        else if (pn < 5) { base = kvlat; ld = 512; colt = (pn - 3) * 256; part = partkv; nslot = 8; slot0 = (pn - 3) * 4; }
        else if (pn < 9) { base = G; ld = 2048; colt = (pn - 5) * 256; mode = 1; }
        else if (pn < 13) { base = Qf; ld = 1024; colt = (pn - 9) * 256; mode = 2; }
        else if (pn < 17) { base = Kf; ld = 1024; colt = (pn - 13) * 256; }
        else if (pn < 21) { base = Vf; ld = 1024; colt = (pn - 17) * 256; }
        else { base = G; ld = 2048; colt = 1024 + (pn - 21) * 256; mode = 1; }
        const int col0 = colt + wc * 32 + 8 * fq;
#pragma unroll
        for (int ai = 0; ai < 2; ++ai)
#pragma unroll
            for (int m = 0; m < 4; ++m) { const int row = row0 + ai * 128 + m * 16; float rs = rstd_x[row]; if (mode == 2) rs *= C2F;
                bf16* rowp = base + (size_t)row * ld + col0; float ss = 0.f;
#pragma unroll
                for (int bj = 0; bj < 2; ++bj) { f32x4 v0 = acc[ai][bj][m][0] * rs, v1 = acc[ai][bj][m][1] * rs;
                    ss += (v0[0] * v0[0] + v0[1] * v0[1]) + (v0[2] * v0[2] + v0[3] * v0[3]) + (v1[0] * v1[0] + v1[1] * v1[1]) + (v1[2] * v1[2] + v1[3] * v1[3]);
                    if (mode == 1) {
#pragma unroll
                        for (int e = 0; e < 4; ++e) { v0[e] = silu_f(v0[e]); v1[e] = silu_f(v1[e]); } }
                    *(u32x4*)(rowp + bj * 128) = pack8f(v0, v1); }
                if (part) { ss += __shfl_xor(ss, 16); ss += __shfl_xor(ss, 32); if (fq == 0) part[(size_t)row * nslot + slot0 + wc] = ss; } }
    }
};
struct EpiQ {
    static constexpr bool PERM = true, AFTER_DRAIN = false;
    const float* partq; bf16* Qm; const float *cosT, *sinT;
    __device__ __forceinline__ void operator()(const af4 (&acc)[2][2][4][2], const pg8::Unit& u, int wr, int wc, int fr, int fq) const {
        const int pn = u.pn; const int row0 = u.pm * 256 + wr * 64 + fr;
#pragma unroll
        for (int ai = 0; ai < 2; ++ai)
#pragma unroll
            for (int m = 0; m < 4; ++m) { const int row = row0 + ai * 128 + m * 16;
                const f32x4 pa = *(const f32x4*)(partq + (size_t)row * 12), pb = *(const f32x4*)(partq + (size_t)row * 12 + 4), pc = *(const f32x4*)(partq + (size_t)row * 12 + 8);
                const float ssq = ((pa[0] + pa[1]) + (pa[2] + pa[3])) + ((pb[0] + pb[1]) + (pb[2] + pb[3])) + ((pc[0] + pc[1]) + (pc[2] + pc[3]));
                const float rs = C2M / sqrtf(ssq * (1.f / 768.f) + EPS);
                if (pn < 4) {
#pragma unroll
                    for (int bj = 0; bj < 2; ++bj) *(u32x4*)(Qm + (size_t)row * 1536 + (2 * pn + bj) * 192 + wc * 32 + 8 * fq) = pack8f(acc[ai][bj][m][0] * rs, acc[ai][bj][m][1] * rs);
                } else { const int head = 4 * (pn - 4) + wc; f32x4 o1[2], o2[2];
#pragma unroll
                    for (int n = 0; n < 2; ++n) { const f32x4 c = *(const f32x4*)(cosT + (size_t)row * 32 + 8 * fq + 4 * n), s = *(const f32x4*)(sinT + (size_t)row * 32 + 8 * fq + 4 * n);
                        const f32x4 x1 = acc[ai][0][m][n] * rs, x2 = acc[ai][1][m][n] * rs; o1[n] = x1 * c - x2 * s; o2[n] = x2 * c + x1 * s; }
                    bf16* qp = Qm + (size_t)row * 1536 + head * 192 + 128 + 8 * fq;
                    *(u32x4*)qp = pack8f(o1[0], o1[1]); *(u32x4*)(qp + 32) = pack8f(o2[0], o2[1]); } }
    }
};
struct EpiKV {
    static constexpr bool PERM = true, AFTER_DRAIN = false;
    const float* partkv; bf16 *Km, *Vm;
    __device__ __forceinline__ void operator()(const af4 (&acc)[2][2][4][2], const pg8::Unit& u, int wr, int wc, int fr, int fq) const {
        const int pn = u.pn; const int row0 = u.pm * 256 + wr * 64 + fr;
#pragma unroll
        for (int ai = 0; ai < 2; ++ai)
#pragma unroll
            for (int m = 0; m < 4; ++m) { const int row = row0 + ai * 128 + m * 16;
                const f32x4 pa = *(const f32x4*)(partkv + (size_t)row * 8), pb = *(const f32x4*)(partkv + (size_t)row * 8 + 4);
                const float ssq = ((pa[0] + pa[1]) + (pa[2] + pa[3])) + ((pb[0] + pb[1]) + (pb[2] + pb[3]));
                const float rs = 1.f / sqrtf(ssq * (1.f / 512.f) + EPS);
                *(u32x4*)(Km + (size_t)row * 1536 + pn * 192 + wc * 32 + 8 * fq) = pack8f(acc[ai][0][m][0] * rs, acc[ai][0][m][1] * rs);
                *(u32x4*)(Vm + (size_t)row * 1024 + pn * 128 + wc * 32 + 8 * fq) = pack8f(acc[ai][1][m][0] * rs, acc[ai][1][m][1] * rs); }
    }
};
struct EpiOut {
    static constexpr bool PERM = true, AFTER_DRAIN = false;
    bf16* Y; float* party;
    __device__ __forceinline__ void operator()(const af4 (&acc)[2][2][4][2], const pg8::Unit& u, int wr, int wc, int fr, int fq) const {
        const int pn = u.pn; const int row0 = u.pm * 256 + wr * 64 + fr; const int col0 = pn * 256 + wc * 32 + 8 * fq;
#pragma unroll
        for (int ai = 0; ai < 2; ++ai)
#pragma unroll
            for (int m = 0; m < 4; ++m) { const int row = row0 + ai * 128 + m * 16; float ss = 0.f;
#pragma unroll
                for (int bj = 0; bj < 2; ++bj) { const f32x4 v0 = acc[ai][bj][m][0], v1 = acc[ai][bj][m][1];
                    ss += (v0[0] * v0[0] + v0[1] * v0[1]) + (v0[2] * v0[2] + v0[3] * v0[3]) + (v1[0] * v1[0] + v1[1] * v1[1]) + (v1[2] * v1[2] + v1[3] * v1[3]);
                    *(u32x4*)(Y + (size_t)row * 2048 + col0 + bj * 128) = pack8f(v0, v1); }
                ss += __shfl_xor(ss, 16); ss += __shfl_xor(ss, 32); if (fq == 0) party[(size_t)row * 32 + pn * 4 + wc] = ss; }
    }
};

namespace att {
constexpr int KVBLK = 64, QBLK = 32, QB = 256;
constexpr int SHM_K = 24576, SHM_V = 16384;
constexpr int NRING = 3;
constexpr int OFF_K = 0, OFF_V = NRING * SHM_K, OFF_CK = OFF_V + NRING * SHM_V, OFF_WS = OFF_CK + 1024, OFF_QP = OFF_WS + 2048;
constexpr float THR = 20.f;
#define KSWZ(row, colB) ((row) * 256 + ((colB) ^ (((row) & 7) << 4)))
#define SBAR() __builtin_amdgcn_sched_barrier(0)
__device__ __forceinline__ int v_st(int k, int c) { const int kk = (k & ~0xC) | ((k & 4) << 1) | ((k & 8) >> 1); return ((kk >> 3) * 4 + (c >> 5)) * 512 + ((kk & 7) * 32 + (c & 31)) * 2; }
__device__ __forceinline__ int v_rd_base(int lane) { return ((lane & 3) << 3) | (((lane >> 2) & 3) << 6) | (((lane >> 4) & 1) << 5) | (((lane >> 5) & 1) << 8); }
constexpr int v_rd_off(int d0, int ks, int half) { return d0 * 512 + ks * 4096 + half * 2048; }
__device__ __forceinline__ int crow(int r, int hi) { return (r & 3) + 8 * (r >> 2) + 4 * hi; }
__device__ __forceinline__ unsigned cvtpk(float lo, float hi) { unsigned r; asm volatile("v_cvt_pk_bf16_f32 %0, %1, %2" : "=v"(r) : "v"(lo), "v"(hi)); return r; }

__device__ __forceinline__ void mask_tile(f32x16& p0, f32x16& p1, int dq) {
    const float NEG = -__builtin_inff();
#pragma unroll
    for (int r = 0; r < 16; ++r) { const int c = (r & 3) + 8 * (r >> 2);
        if (dq - c < 0) p0[r] = NEG;
        if (dq - c - 32 < 0) p1[r] = NEG; }
}
__device__ __forceinline__ void softmax_tile(f32x16& p0, f32x16& p1, float cq, float& m_reg, float& l_reg, float& alpha, bf16x8& pa0, bf16x8& pa1, bf16x8& pa2, bf16x8& pa3) {
    float ma = __builtin_fmaxf(__builtin_fmaxf(p0[0], p0[1]), p0[2]), mb = __builtin_fmaxf(__builtin_fmaxf(p1[0], p1[1]), p1[2]);
#pragma unroll
    for (int r = 3; r < 15; r += 2) { ma = __builtin_fmaxf(__builtin_fmaxf(ma, p0[r]), p0[r + 1]); mb = __builtin_fmaxf(__builtin_fmaxf(mb, p1[r]), p1[r + 1]); }
    float pmax = __builtin_fmaxf(__builtin_fmaxf(ma, mb), __builtin_fmaxf(p0[15], p1[15]));
    { auto rr = __builtin_amdgcn_permlane32_swap(__float_as_uint(pmax), __float_as_uint(pmax), false, false);
      pmax = fmaxf(__uint_as_float(rr[0]), __uint_as_float(rr[1])); }
    pmax += cq;
    float mn;
    if (__builtin_expect(__all(pmax - m_reg <= THR), 1)) { mn = m_reg; alpha = 1.f; }
    else { mn = fmaxf(m_reg, pmax); alpha = __builtin_amdgcn_exp2f(m_reg - mn); m_reg = mn; }
    const float sh = mn - cq;
#pragma unroll
    for (int r = 0; r < 16; ++r) { p0[r] = __builtin_amdgcn_exp2f(p0[r] - sh); p1[r] = __builtin_amdgcn_exp2f(p1[r] - sh); }
    float ps = 0.f;
#pragma unroll
    for (int r = 0; r < 16; ++r) ps += p0[r];
#pragma unroll
    for (int r = 0; r < 16; ++r) ps += p1[r];
    { auto rr = __builtin_amdgcn_permlane32_swap(__float_as_uint(ps), __float_as_uint(ps), false, false);
      ps = __uint_as_float(rr[0]) + __uint_as_float(rr[1]); }
    l_reg = l_reg * alpha + ps;
#define PK4(P, B_, OUT) do { unsigned a0 = cvtpk(P[B_+0], P[B_+1]), a1 = cvtpk(P[B_+2], P[B_+3]);                          \
        unsigned b0 = cvtpk(P[B_+4], P[B_+5]), b1 = cvtpk(P[B_+6], P[B_+7]);                                             \
        auto r0 = __builtin_amdgcn_permlane32_swap(a0, b0, false, false); auto r1 = __builtin_amdgcn_permlane32_swap(a1, b1, false, false); \
        u32x4 w = {r0[0], r1[0], r0[1], r1[1]}; OUT = *reinterpret_cast<bf16x8*>(&w); } while (0)
    PK4(p0, 0, pa0); PK4(p0, 8, pa1); PK4(p1, 0, pa2); PK4(p1, 8, pa3);
#undef PK4
}
template <int DQK, int NPARK>
__device__ __forceinline__ void qkt(f32x16& p0, f32x16& p1, const char* Kb, int r32, int hi, const bf16x8* qr, const char* qpk) {
    constexpr int ND = DQK / 16, NQR = ND - NPARK;
    p0 = f32x16{}; p1 = f32x16{};
    const char* kb[4];
#pragma unroll
    for (int dd = 0; dd < 4; ++dd) kb[dd] = Kb + KSWZ(r32, (dd * 16 + hi * 8) * 2);
    const char* kr = Kb + 16384 + r32 * 128;
    const int rx = (r32 & 7) << 4;
    bf16x8 kf[3][2], qf[3];
#define QK_LD(set, d_) do { \
            if ((d_) < 8) { const char* a_ = kb[(d_) & 3] + ((d_) >> 2) * 128; kf[set][0] = *reinterpret_cast<const bf16x8*>(a_); kf[set][1] = *reinterpret_cast<const bf16x8*>(a_ + 32 * 256); } \
            else { const char* a_ = kr + (((((d_) - 8) * 16 + hi * 8) * 2) ^ rx); kf[set][0] = *reinterpret_cast<const bf16x8*>(a_); kf[set][1] = *reinterpret_cast<const bf16x8*>(a_ + 32 * 128); } \
            if ((d_) >= NQR) qf[set] = *reinterpret_cast<const bf16x8*>(qpk + ((d_) - NQR) * 1024); } while (0)
    QK_LD(0, 0); QK_LD(1, 1); SBAR();
#pragma unroll
    for (int d = 0; d < ND; ++d) {
        const int cs = d % 3;
        if (d + 2 < ND) { const int ns = (d + 2) % 3; if (ns == 0) QK_LD(0, d + 2); else if (ns == 1) QK_LD(1, d + 2); else QK_LD(2, d + 2); SBAR(); }
        const bf16x8 q = (d < NQR) ? qr[d < NQR ? d : 0] : qf[cs];
        p0 = __builtin_amdgcn_mfma_f32_32x32x16_bf16(kf[cs][0], q, p0, 0, 0, 0);
        p1 = __builtin_amdgcn_mfma_f32_32x32x16_bf16(kf[cs][1], q, p1, 0, 0, 0);
        SBAR();
    }
#undef QK_LD
}
template <int VOFF>
__device__ __forceinline__ void pv_tile(f32x16* o, int vb0, bf16x8 pa0, bf16x8 pa1, bf16x8 pa2, bf16x8 pa3) {
#define TRRD(dst, off) asm volatile("ds_read_b64_tr_b16 %0, %1 offset:%2" : "=&v"(dst) : "v"(vb0), "i"(off) : "memory")
#define PV_D0(d0) do { s16x4 l0, l1, l2, l3, h0, h1, h2, h3; constexpr int b_ = VOFF + v_rd_off(d0, 0, 0); \
        TRRD(l0, b_); TRRD(h0, b_ + 2048); TRRD(l1, b_ + 4096); TRRD(h1, b_ + 6144); TRRD(l2, b_ + 8192); TRRD(h2, b_ + 10240); TRRD(l3, b_ + 12288); TRRD(h3, b_ + 14336); \
        asm volatile("s_waitcnt lgkmcnt(0)" ::: "memory"); SBAR(); \
        o[d0] = __builtin_amdgcn_mfma_f32_32x32x16_bf16((bf16x8){l0[0], l0[1], l0[2], l0[3], h0[0], h0[1], h0[2], h0[3]}, pa0, o[d0], 0, 0, 0);   \
        o[d0] = __builtin_amdgcn_mfma_f32_32x32x16_bf16((bf16x8){l1[0], l1[1], l1[2], l1[3], h1[0], h1[1], h1[2], h1[3]}, pa1, o[d0], 0, 0, 0);   \
        o[d0] = __builtin_amdgcn_mfma_f32_32x32x16_bf16((bf16x8){l2[0], l2[1], l2[2], l2[3], h2[0], h2[1], h2[2], h2[3]}, pa2, o[d0], 0, 0, 0);   \
        o[d0] = __builtin_amdgcn_mfma_f32_32x32x16_bf16((bf16x8){l3[0], l3[1], l3[2], l3[3], h3[0], h3[1], h3[2], h3[3]}, pa3, o[d0], 0, 0, 0); } while (0)
    PV_D0(0); PV_D0(1); PV_D0(2); PV_D0(3);
#undef PV_D0
#undef TRRD
}

#define RD128(dst, addr, off) asm volatile("ds_read_b128 %0, %1 offset:%2" : "=&v"(dst) : "v"(addr), "i"(off) : "memory")
#define RDTR(dst, addr, off) asm volatile("ds_read_b64_tr_b16 %0, %1 offset:%2" : "=&v"(dst) : "v"(addr), "i"(off) : "memory")
#define WAITK(n, x) asm volatile("s_waitcnt lgkmcnt(%1)" : "+v"(x) : "n"(n) : "memory")
#define WAITKQ(n, x, q) asm volatile("s_waitcnt lgkmcnt(%2)" : "+v"(x), "+v"(q) : "n"(n) : "memory")
#define WAITV(n, x, y) asm volatile("s_waitcnt lgkmcnt(%2)" : "+v"(x), "+v"(y) : "n"(n) : "memory")

__device__ __forceinline__ void mblock_mla_q(f32x16& p0, f32x16& p1, f32x16* o, const bf16x8* qr, bf16x8 pa0, bf16x8 pa1, bf16x8 pa2, bf16x8 pa3, const unsigned* kbv, const unsigned* krv, unsigned qpkv, unsigned vbv) {
    bf16x8 ksl[5], qsl[3]; s16x4 vlo[5], vhi[5];
    p0 = f32x16{}; p1 = f32x16{};
    RD128(ksl[0], kbv[0], 0);
    RD128(ksl[1], kbv[0], 8192);
    RD128(ksl[2], kbv[1], 0);
    RD128(ksl[3], kbv[1], 8192);
    RD128(ksl[4], kbv[2], 0);
    WAITK(4, ksl[0]); p0 = __builtin_amdgcn_mfma_f32_32x32x16_bf16(ksl[0], qr[0], p0, 0, 0, 0);
    RD128(ksl[0], kbv[2], 8192);
    WAITK(4, ksl[1]); p1 = __builtin_amdgcn_mfma_f32_32x32x16_bf16(ksl[1], qr[0], p1, 0, 0, 0);
    RD128(ksl[1], kbv[3], 0);
    WAITK(4, ksl[2]); p0 = __builtin_amdgcn_mfma_f32_32x32x16_bf16(ksl[2], qr[1], p0, 0, 0, 0);
    RD128(ksl[2], kbv[3], 8192);
    WAITK(4, ksl[3]); p1 = __builtin_amdgcn_mfma_f32_32x32x16_bf16(ksl[3], qr[1], p1, 0, 0, 0);
    RD128(ksl[3], kbv[0], 128);
    WAITK(4, ksl[4]); p0 = __builtin_amdgcn_mfma_f32_32x32x16_bf16(ksl[4], qr[2], p0, 0, 0, 0);
    RD128(ksl[4], kbv[0], 8320);
    WAITK(4, ksl[0]); p1 = __builtin_amdgcn_mfma_f32_32x32x16_bf16(ksl[0], qr[2], p1, 0, 0, 0);
    RD128(ksl[0], kbv[1], 128);
    WAITK(4, ksl[1]); p0 = __builtin_amdgcn_mfma_f32_32x32x16_bf16(ksl[1], qr[3], p0, 0, 0, 0);
    RD128(ksl[1], kbv[1], 8320);
    WAITK(4, ksl[2]); p1 = __builtin_amdgcn_mfma_f32_32x32x16_bf16(ksl[2], qr[3], p1, 0, 0, 0);
    RD128(ksl[2], kbv[2], 128);
    WAITK(4, ksl[3]); p0 = __builtin_amdgcn_mfma_f32_32x32x16_bf16(ksl[3], qr[4], p0, 0, 0, 0);
    RD128(ksl[3], kbv[2], 8320);
    WAITK(4, ksl[4]); p1 = __builtin_amdgcn_mfma_f32_32x32x16_bf16(ksl[4], qr[4], p1, 0, 0, 0);
    RD128(ksl[4], kbv[3], 128);
    WAITK(4, ksl[0]); p0 = __builtin_amdgcn_mfma_f32_32x32x16_bf16(ksl[0], qr[5], p0, 0, 0, 0);
    RD128(ksl[0], kbv[3], 8320);
    WAITK(4, ksl[1]); p1 = __builtin_amdgcn_mfma_f32_32x32x16_bf16(ksl[1], qr[5], p1, 0, 0, 0);
    RD128(ksl[1], krv[0], 0); RD128(qsl[2], qpkv, 0);
    WAITK(5, ksl[2]); p0 = __builtin_amdgcn_mfma_f32_32x32x16_bf16(ksl[2], qr[6], p0, 0, 0, 0);
    RD128(ksl[2], krv[0], 4096);
    WAITK(5, ksl[3]); p1 = __builtin_amdgcn_mfma_f32_32x32x16_bf16(ksl[3], qr[6], p1, 0, 0, 0);
    RD128(ksl[3], krv[1], 0); RD128(qsl[0], qpkv, 1024);
    WAITK(6, ksl[4]); p0 = __builtin_amdgcn_mfma_f32_32x32x16_bf16(ksl[4], qr[7], p0, 0, 0, 0);
    RD128(ksl[4], krv[1], 4096);
    WAITK(6, ksl[0]); p1 = __builtin_amdgcn_mfma_f32_32x32x16_bf16(ksl[0], qr[7], p1, 0, 0, 0);
    RD128(ksl[0], krv[2], 0); RD128(qsl[1], qpkv, 2048);
    WAITKQ(6, ksl[1], qsl[2]); p0 = __builtin_amdgcn_mfma_f32_32x32x16_bf16(ksl[1], qsl[2], p0, 0, 0, 0);
    RD128(ksl[1], krv[2], 4096);
    WAITKQ(6, ksl[2], qsl[2]); p1 = __builtin_amdgcn_mfma_f32_32x32x16_bf16(ksl[2], qsl[2], p1, 0, 0, 0);
    RD128(ksl[2], krv[3], 0); RD128(qsl[2], qpkv, 3072);
    WAITKQ(6, ksl[3], qsl[0]); p0 = __builtin_amdgcn_mfma_f32_32x32x16_bf16(ksl[3], qsl[0], p0, 0, 0, 0);
    RD128(ksl[3], krv[3], 4096);
    WAITKQ(6, ksl[4], qsl[0]); p1 = __builtin_amdgcn_mfma_f32_32x32x16_bf16(ksl[4], qsl[0], p1, 0, 0, 0);
    WAITKQ(4, ksl[0], qsl[1]); p0 = __builtin_amdgcn_mfma_f32_32x32x16_bf16(ksl[0], qsl[1], p0, 0, 0, 0);
    WAITKQ(3, ksl[1], qsl[1]); p1 = __builtin_amdgcn_mfma_f32_32x32x16_bf16(ksl[1], qsl[1], p1, 0, 0, 0);
    WAITKQ(1, ksl[2], qsl[2]); p0 = __builtin_amdgcn_mfma_f32_32x32x16_bf16(ksl[2], qsl[2], p0, 0, 0, 0);
    WAITKQ(0, ksl[3], qsl[2]); p1 = __builtin_amdgcn_mfma_f32_32x32x16_bf16(ksl[3], qsl[2], p1, 0, 0, 0);
}
__device__ __forceinline__ void mblock_fox_q(f32x16& p0, f32x16& p1, f32x16* o, const bf16x8* qr, bf16x8 pa0, bf16x8 pa1, bf16x8 pa2, bf16x8 pa3, const unsigned* kbv, const unsigned* krv, unsigned qpkv, unsigned vbv) {
    bf16x8 ksl[5], qsl[3]; s16x4 vlo[5], vhi[5];
    p0 = f32x16{}; p1 = f32x16{};
    RD128(ksl[0], kbv[0], 0);
    RD128(ksl[1], kbv[0], 8192);
    RD128(ksl[2], kbv[1], 0);
    RD128(ksl[3], kbv[1], 8192);
    RD128(ksl[4], kbv[2], 0);
    WAITK(4, ksl[0]); p0 = __builtin_amdgcn_mfma_f32_32x32x16_bf16(ksl[0], qr[0], p0, 0, 0, 0);
    RD128(ksl[0], kbv[2], 8192);
    WAITK(4, ksl[1]); p1 = __builtin_amdgcn_mfma_f32_32x32x16_bf16(ksl[1], qr[0], p1, 0, 0, 0);
    RD128(ksl[1], kbv[3], 0);
    WAITK(4, ksl[2]); p0 = __builtin_amdgcn_mfma_f32_32x32x16_bf16(ksl[2], qr[1], p0, 0, 0, 0);
    RD128(ksl[2], kbv[3], 8192);
    WAITK(4, ksl[3]); p1 = __builtin_amdgcn_mfma_f32_32x32x16_bf16(ksl[3], qr[1], p1, 0, 0, 0);
    RD128(ksl[3], kbv[0], 128); RD128(qsl[1], qpkv, 0);
    WAITK(5, ksl[4]); p0 = __builtin_amdgcn_mfma_f32_32x32x16_bf16(ksl[4], qr[2], p0, 0, 0, 0);
    RD128(ksl[4], kbv[0], 8320);
    WAITK(5, ksl[0]); p1 = __builtin_amdgcn_mfma_f32_32x32x16_bf16(ksl[0], qr[2], p1, 0, 0, 0);
    RD128(ksl[0], kbv[1], 128); RD128(qsl[2], qpkv, 1024);
    WAITK(6, ksl[1]); p0 = __builtin_amdgcn_mfma_f32_32x32x16_bf16(ksl[1], qr[3], p0, 0, 0, 0);
    RD128(ksl[1], kbv[1], 8320);
    WAITK(6, ksl[2]); p1 = __builtin_amdgcn_mfma_f32_32x32x16_bf16(ksl[2], qr[3], p1, 0, 0, 0);
    RD128(ksl[2], kbv[2], 128); RD128(qsl[0], qpkv, 2048);
    WAITKQ(6, ksl[3], qsl[1]); p0 = __builtin_amdgcn_mfma_f32_32x32x16_bf16(ksl[3], qsl[1], p0, 0, 0, 0);
    RD128(ksl[3], kbv[2], 8320);
    WAITKQ(6, ksl[4], qsl[1]); p1 = __builtin_amdgcn_mfma_f32_32x32x16_bf16(ksl[4], qsl[1], p1, 0, 0, 0);
    RD128(ksl[4], kbv[3], 128); RD128(qsl[1], qpkv, 3072);
    WAITKQ(6, ksl[0], qsl[2]); p0 = __builtin_amdgcn_mfma_f32_32x32x16_bf16(ksl[0], qsl[2], p0, 0, 0, 0);
    RD128(ksl[0], kbv[3], 8320);
    WAITKQ(6, ksl[1], qsl[2]); p1 = __builtin_amdgcn_mfma_f32_32x32x16_bf16(ksl[1], qsl[2], p1, 0, 0, 0);
    WAITKQ(4, ksl[2], qsl[0]); p0 = __builtin_amdgcn_mfma_f32_32x32x16_bf16(ksl[2], qsl[0], p0, 0, 0, 0);
    WAITKQ(3, ksl[3], qsl[0]); p1 = __builtin_amdgcn_mfma_f32_32x32x16_bf16(ksl[3], qsl[0], p1, 0, 0, 0);
    WAITKQ(1, ksl[4], qsl[1]); p0 = __builtin_amdgcn_mfma_f32_32x32x16_bf16(ksl[4], qsl[1], p0, 0, 0, 0);
    WAITKQ(0, ksl[0], qsl[1]); p1 = __builtin_amdgcn_mfma_f32_32x32x16_bf16(ksl[0], qsl[1], p1, 0, 0, 0);
}
#undef RD128
#undef RDTR
#undef WAITK
#undef WAITKQ
#undef WAITV

template <int DQK, bool FOX, int ABL = 0>
__device__ __forceinline__ void attn_unit(char* lds, const bf16* Q, int ldq, const bf16* K, int ldk, const bf16* V, int ldv, const float* cfs, const bf16* Gp, bf16* Op, int qb) {
    const int tid = threadIdx.x, wid = __builtin_amdgcn_readfirstlane(tid >> 6), lane = tid & 63, r32 = lane & 31, hi = lane >> 5;
    const bool grpA = wid < 4; const int w4 = wid & 3;
    const int q0 = qb * QB, NT = 4 * (qb + 1);
    char* K_lds = lds + OFF_K; char* V_lds = lds + OFF_V; float* ck_l = (float*)(lds + OFF_CK);
    float* wsf = (float*)(lds + OFF_WS) + wid * 64; float* li_l = wsf; float* al_l = wsf + 32;
    constexpr int NPARK = 4, NQR = DQK / 16 - NPARK;
    bf16x8 qr[NQR];
    char* qpk = lds + OFF_QP + wid * 4096 + (hi * 32 + r32) * 16;
    unsigned koff, kroff = 0, voff;
    { const int row = 4 * w4 + (lane >> 4), c = (lane & 15) ^ (row & 7); koff = (unsigned)(row * ldk + c * 8) * 2u; }
    { const int s0 = 2 * w4 + (lane >> 5), kk = 8 * (s0 >> 2) + ((lane & 31) >> 2), k = (kk & ~0xC) | ((kk & 4) << 1) | ((kk & 8) >> 1); voff = (unsigned)(k * ldv + 32 * (s0 & 3) + 8 * (lane & 3)) * 2u; }
    if constexpr (DQK == 192) { const int row = 8 * w4 + (lane >> 3), c = (lane & 7) ^ (row & 7); kroff = (unsigned)(row * ldk + 128 + c * 8) * 2u; }
    const int vb0 = (int)(uintptr_t)V_lds + v_rd_base(lane);
    LAS unsigned char* ldsl = (LAS unsigned char*)(uintptr_t)(unsigned)(uintptr_t)lds;
    unsigned kb0[4], kr0[4];
#pragma unroll
    for (int i = 0; i < 4; ++i) { const unsigned xo = (unsigned)((i * 32 + hi * 16) ^ ((r32 & 7) << 4)); kb0[i] = (unsigned)(uintptr_t)K_lds + r32 * 256 + xo; kr0[i] = (unsigned)(uintptr_t)K_lds + 16384 + r32 * 128 + xo; }
    const unsigned qpkv = (unsigned)(uintptr_t)qpk;
#define DMA_K(t, bf) do { const char* kt_ = (const char*)K + (size_t)(t) * KVBLK * ldk * 2; \
        _Pragma("unroll") for (int j_ = 0; j_ < 4; ++j_) \
            __builtin_amdgcn_global_load_lds((const unsigned*)(kt_ + koff + (size_t)j_ * 16 * ldk * 2), (LAS unsigned*)(ldsl + OFF_K + (bf) * SHM_K + (w4 + 4 * j_) * 1024), 16, 0, 0); \
        if constexpr (DQK == 192) { _Pragma("unroll") for (int j_ = 0; j_ < 2; ++j_) \
            __builtin_amdgcn_global_load_lds((const unsigned*)(kt_ + kroff + (size_t)j_ * 32 * ldk * 2), (LAS unsigned*)(ldsl + OFF_K + (bf) * SHM_K + 16384 + (w4 + 4 * j_) * 1024), 16, 0, 0); } \
        if constexpr (FOX) { __builtin_amdgcn_global_load_lds((const unsigned*)(cfs + (t) * KVBLK + lane), (LAS unsigned*)(ldsl + OFF_CK + ((t) & 3) * 256), 4, 0, 0); } } while (0)
#define DMA_V(t, bf) do { const char* vt_ = (const char*)V + (size_t)(t) * KVBLK * ldv * 2; \
        _Pragma("unroll") for (int j_ = 0; j_ < 4; ++j_) \
            __builtin_amdgcn_global_load_lds((const unsigned*)(vt_ + voff + (size_t)j_ * 16 * ldv * 2), (LAS unsigned*)(ldsl + OFF_V + (bf) * SHM_V + (w4 + 4 * j_) * 1024), 16, 0, 0); } while (0)
#define BAR_L() asm volatile("s_waitcnt lgkmcnt(0)\n\ts_barrier" ::: "memory")
#define BAR_VL() asm volatile("s_waitcnt vmcnt(0) lgkmcnt(0)\n\ts_barrier" ::: "memory")
    constexpr int NDK = 4 + (DQK == 192 ? 2 : 0) + (FOX ? 1 : 0), NDV = 4;
#define BAR_VN(n) asm volatile("s_waitcnt vmcnt(%0) lgkmcnt(0)\n\ts_barrier" :: "n"(n) : "memory")
    if (grpA) DMA_K(0, 0);
    { const bf16* qp = Q + (size_t)(q0 + wid * QBLK + r32) * ldq + hi * 8;
#pragma unroll
      for (int d0 = 0; d0 < NQR; ++d0) qr[d0] = *(const bf16x8*)(qp + d0 * 16);
#pragma unroll
      for (int d0 = 0; d0 < NPARK; ++d0) *(bf16x8*)(qpk + d0 * 1024) = *(const bf16x8*)(qp + (NQR + d0) * 16); }
    float cq = 0.f; if constexpr (FOX) cq = cfs[q0 + wid * QBLK + r32];
    asm volatile("s_waitcnt vmcnt(0)" ::: "memory");
    if (grpA) { DMA_K(1, 1); DMA_V(0, 0); BAR_VN(NDK + NDV); } else BAR_VN(0);
    if (!grpA) BAR_L();
    float m_reg = -1e30f, l_reg = 0.f; f32x16 o[4] = {}; f32x16 p0 = {}, p1 = {}; bf16x8 pa0 = {}, pa1 = {}, pa2 = {}, pa3 = {};
#define ACTW(tt) ((tt) - (NT - 4) < 0 || 64 * ((tt) - (NT - 4)) <= 32 * wid + 31)
    int rc = 0, rp = 2, rn = 1;
#pragma unroll 1
    for (int t = 0; t < NT; ++t) {
        if (DQK != 192 && grpA && !(ABL & 1)) { if (t + 2 < NT) DMA_K(t + 2, rp); if (t + 1 < NT) DMA_V(t + 1, rn); }
        const int jb_ = t - (NT - 4); const bool act_ = ACTW(t);
        if (act_ && !(ABL & 4)) { unsigned kbv[4], krv[4];
#pragma unroll
            for (int i = 0; i < 4; ++i) { kbv[i] = kb0[i] + rc * SHM_K; krv[i] = kr0[i] + rc * SHM_K; }
            if constexpr (DQK == 192) mblock_mla_q(p0, p1, o, qr, pa0, pa1, pa2, pa3, kbv, krv, qpkv, 0u); else mblock_fox_q(p0, p1, o, qr, pa0, pa1, pa2, pa3, kbv, krv, qpkv, 0u); }
        if (t > 0 && ACTW(t - 1) && !(ABL & 4)) { SBAR(); pv_tile<0>(o, vb0 + rp * SHM_V, pa0, pa1, pa2, pa3); }
        BAR_L();
        if (DQK == 192 && grpA && !(ABL & 1)) { if (t + 2 < NT) DMA_K(t + 2, rp); if (t + 1 < NT) DMA_V(t + 1, rn); }
        if (act_ && (ABL & 8)) {
#define PK4(P, B_, OUT) do { unsigned a0 = cvtpk(P[B_+0], P[B_+1]), a1 = cvtpk(P[B_+2], P[B_+3]); unsigned b0 = cvtpk(P[B_+4], P[B_+5]), b1 = cvtpk(P[B_+6], P[B_+7]); \
        auto r0 = __builtin_amdgcn_permlane32_swap(a0, b0, false, false); auto r1 = __builtin_amdgcn_permlane32_swap(a1, b1, false, false); u32x4 w = {r0[0], r1[0], r0[1], r1[1]}; OUT = *reinterpret_cast<bf16x8*>(&w); } while (0)
            PK4(p0, 0, pa0); PK4(p0, 8, pa1); PK4(p1, 0, pa2); PK4(p1, 8, pa3);
#undef PK4
        }
        if (act_ && !(ABL & 2)) { float alpha;
            if constexpr (FOX) { const float* ckp = ck_l + (t & 3) * 64 + 4 * hi;
#pragma unroll
                for (int g_ = 0; g_ < 4; ++g_) { const f32x4 c0 = *(const f32x4*)(ckp + 8 * g_), c1 = *(const f32x4*)(ckp + 32 + 8 * g_);
#pragma unroll
                    for (int e_ = 0; e_ < 4; ++e_) { p0[4 * g_ + e_] -= c0[e_]; p1[4 * g_ + e_] -= c1[e_]; } } }
            if (jb_ >= 0 && 64 * jb_ + 63 > 32 * wid) mask_tile(p0, p1, 32 * wid + r32 - 64 * jb_ - 4 * hi);
            softmax_tile(p0, p1, cq, m_reg, l_reg, alpha, pa0, pa1, pa2, pa3);
            if (__any(alpha < 1.f)) {
#pragma unroll
                for (int d_ = 0; d_ < 4; ++d_)
#pragma unroll
                    for (int r = 0; r < 16; ++r) o[d_][r] *= alpha; }
        }
        if (ABL & 1) BAR_VN(0); else if (t + 2 < NT) BAR_VN(NDK + NDV); else if (t + 1 < NT) BAR_VN(NDV); else BAR_VN(0);
        rp = rc; rc = rn; rn = (rn == NRING - 1) ? 0 : rn + 1;
    }
    if (ACTW(NT - 1)) { SBAR(); pv_tile<0>(o, vb0 + rp * SHM_V, pa0, pa1, pa2, pa3); }
    if (grpA) BAR_L();
#undef BAR_VN
#undef ACTW
#undef DMA_K
#undef DMA_V
    { const float rl = __builtin_amdgcn_rcpf(l_reg);
      const size_t rowoff = (size_t)(q0 + wid * QBLK + r32) * 2048;
      const bf16* gp = Gp + rowoff + 4 * hi; bf16* op = Op + rowoff + 8 * hi;
#pragma unroll
      for (int k2 = 0; k2 < 8; ++k2) { const int ka = 2 * k2, kb = 2 * k2 + 1;
          const u32x2 ga = *(const u32x2*)(gp + 8 * ka), gb = *(const u32x2*)(gp + 8 * kb);
          const int ra = 4 * (ka & 3), rb = 4 * (kb & 3);
          unsigned ax = cvtpk(o[ka >> 2][ra] * rl * bflo(ga.x), o[ka >> 2][ra + 1] * rl * bfhi(ga.x)), ay = cvtpk(o[ka >> 2][ra + 2] * rl * bflo(ga.y), o[ka >> 2][ra + 3] * rl * bfhi(ga.y));
          unsigned bx = cvtpk(o[kb >> 2][rb] * rl * bflo(gb.x), o[kb >> 2][rb + 1] * rl * bfhi(gb.x)), by = cvtpk(o[kb >> 2][rb + 2] * rl * bflo(gb.y), o[kb >> 2][rb + 3] * rl * bfhi(gb.y));
          { auto sx = __builtin_amdgcn_permlane32_swap(ax, bx, false, false); ax = sx[0]; bx = sx[1]; }
          { auto sy = __builtin_amdgcn_permlane32_swap(ay, by, false, false); ay = sy[0]; by = sy[1]; }
          u32x4 w; w.x = ax; w.y = ay; w.z = bx; w.w = by;
          *(u32x4*)(op + 16 * k2) = w; } }
    BAR_VL();
#undef BAR_L
#undef BAR_VL
}
#undef KSWZ
#undef SBAR
}

__device__ __forceinline__ void transpose_item(const float* W, int ldw, int K, const float* g, bf16* WT, int dst_row0, int src_col0, int nvalid, int k0, LAS float* scr, int lane) {
    const int n = lane & 31; const bool ok = (src_col0 >= 0) && (n < nvalid);
    float tv[32];
#pragma unroll
    for (int i = 0; i < 32; ++i) { const int kk = 2 * i + (lane >> 5); tv[i] = ok ? W[(size_t)(k0 + kk) * ldw + src_col0 + n] : 0.f; }
    if (g) {
#pragma unroll
        for (int i = 0; i < 32; ++i) tv[i] *= g[k0 + 2 * i + (lane >> 5)]; }
#pragma unroll
    for (int i = 0; i < 32; ++i) scr[(2 * i + (lane >> 5)) * 33 + n] = tv[i];
    asm volatile("s_waitcnt lgkmcnt(0)" ::: "memory");
    const int c = lane & 7;
#pragma unroll
    for (int j = 0; j < 4; ++j) { const int nn = (lane >> 3) + 8 * j; const LAS float* s = scr + (8 * c) * 33 + nn;
        u32x4 o; o.x = pk2(s[0 * 33], s[1 * 33]); o.y = pk2(s[2 * 33], s[3 * 33]); o.z = pk2(s[4 * 33], s[5 * 33]); o.w = pk2(s[6 * 33], s[7 * 33]);
        *(u32x4*)(WT + (size_t)(dst_row0 + nn) * K + k0 + 8 * c) = o; }
    asm volatile("s_waitcnt lgkmcnt(0)" ::: "memory");
}
__device__ __forceinline__ void win_src(int r0, int& src, int& nv) {
    nv = 32;
    if (r0 < 1280) src = r0;
    else if (r0 < 2304) src = 1344 + (r0 - 1280);
    else if (r0 < 3328) src = 2368 + (r0 - 2304);
    else if (r0 < 4352) src = 3392 + (r0 - 3328);
    else if (r0 < 5376) src = 4416 + (r0 - 4352);
    else if (r0 < 6400) src = 5448 + (r0 - 5376);
    else if (r0 == 6400) src = 1280;
    else if (r0 == 6432) { src = 5440; nv = 8; }
    else if (r0 == 6528) src = 1312;
    else src = -1;
}
__device__ __forceinline__ int wuq_src(int r0) {
    if (r0 < 1024) return (r0 >> 7) * 192 + (r0 & 127);
    const int q = r0 - 1024, t = q >> 8, bj = (q >> 7) & 1, wc = (q >> 5) & 3;
    return (4 * t + wc) * 192 + 128 + 32 * bj;
}


#define XB_TMO      128
#define XB_XCNT(j)  (256  + 64 * (j))
#define XB_XSUB(j)  (1280 + 64 * (j))
#define XB_XGEN(j)  (2304 + 64 * (j))
#define XB_TOP      3328
#define XB_TOPGEN   3392
#define XCD_BAR_WORDS 3456
#define XB_SPIN_CAP (1u << 18)
__device__ __forceinline__ unsigned xb_ld(unsigned* p)              { return __hip_atomic_load(p, __ATOMIC_RELAXED, __HIP_MEMORY_SCOPE_AGENT); }
__device__ __forceinline__ unsigned xb_add(unsigned* p, unsigned v) { return __hip_atomic_fetch_add(p, v, __ATOMIC_RELAXED, __HIP_MEMORY_SCOPE_AGENT); }
__device__ __forceinline__ unsigned xb_xcc_id() { return (unsigned)__builtin_amdgcn_s_getreg((3 << 11) | 20) & 0xFu; }
#define XB_SPIN(cond, bar) do { unsigned _sp = 0; while (cond) { __builtin_amdgcn_s_sleep(1); \
    if ((++_sp & 255u) == 0u) { if (xb_ld(&(bar)[XB_TMO])) break; if (_sp > XB_SPIN_CAP) { atomicAdd(&(bar)[XB_TMO], 1u); break; } } } } while (0)
struct XcdBarrier { unsigned* bar; unsigned x; volatile LAS unsigned* st; };
__device__ __forceinline__ XcdBarrier xcd_barrier_post(unsigned* bar, volatile LAS unsigned* st) {
    XcdBarrier b; b.bar = bar; b.x = xb_xcc_id(); b.st = st;
    if (threadIdx.x == 0) (void)xb_add(&bar[XB_XCNT(b.x)], 1u);
    return b;
}
__device__ __forceinline__ void xcd_barrier_complete(unsigned* bar, unsigned x, unsigned& nloc, unsigned& nx) {
    const unsigned G = gridDim.x * gridDim.y * gridDim.z;
    unsigned sum, cnt, mine, sp = 0u;
    for (;;) {
        sum = 0u; cnt = 0u; mine = 0u;
#pragma unroll
        for (unsigned j = 0; j < 16; ++j) { const unsigned c = xb_ld(&bar[XB_XCNT(j)]); sum += c; cnt += (c > 0u) ? 1u : 0u; mine = (j == x) ? c : mine; }
        if (sum == G) break;
        __builtin_amdgcn_s_sleep(1);
        if ((++sp & 255u) == 0u) { if (xb_ld(&bar[XB_TMO])) break; if (sp > XB_SPIN_CAP) { atomicAdd(&bar[XB_TMO], 1u); break; } }
    }
    nloc = mine > 0u ? mine : 1u; nx = cnt > 0u ? cnt : 1u;
}
__device__ __forceinline__ void xcd_barrier(const XcdBarrier& b) {
    asm volatile("s_waitcnt vmcnt(0)" ::: "memory");
    __syncthreads();
    if (threadIdx.x == 0) {
        unsigned* bar = b.bar;
        __builtin_amdgcn_s_waitcnt(0);
        unsigned nloc = b.st[0], nx = b.st[1];
        if (nloc == 0u) { xcd_barrier_complete(bar, b.x, nloc, nx); b.st[0] = nloc; b.st[1] = nx; }
        const unsigned old = xb_add(&bar[XB_XSUB(b.x)], 1u);
        const unsigned gen = old / nloc;
        if (old + 1u == (gen + 1u) * nloc) {
            __builtin_amdgcn_fence(__ATOMIC_RELEASE, "agent");
            asm volatile("s_waitcnt vmcnt(0)" ::: "memory");
            const unsigned og = xb_add(&bar[XB_TOP], 1u);
            const unsigned tg = og / nx;
            if (og + 1u == (tg + 1u) * nx) xb_add(&bar[XB_TOPGEN], 1u);
            else XB_SPIN(xb_ld(&bar[XB_TOPGEN]) == tg, bar);
            __builtin_amdgcn_fence(__ATOMIC_ACQUIRE, "agent");
            xb_add(&bar[XB_XGEN(b.x)], 1u);
            asm volatile("s_waitcnt vmcnt(0)" ::: "memory");
        } else {
            XB_SPIN(xb_ld(&bar[XB_XGEN(b.x)]) == gen, bar);
            __builtin_amdgcn_fence(__ATOMIC_ACQUIRE, "agent");
            asm volatile("s_waitcnt vmcnt(0)" ::: "memory");
        }
    }
    __syncthreads();
}

struct Args { const float* x; const int* pos; const float* g_pre; const float* w_in; const float* g_q; const float* w_uq; const float* g_kv; const float* w_ukv;
              const float* b_forget; const float* w_out; const float* g_post; float* out; unsigned char* ws; int ph_lo, ph_hi; };

__global__ void __launch_bounds__(512, 2) hybrid_fwd(Args a) {
    extern __shared__ __attribute__((aligned(16))) unsigned char lds[];
    cg::grid_group grid = cg::this_grid();
    const int tid_k = threadIdx.x, lane_k = tid_k & 63, wave = __builtin_amdgcn_readfirstlane(tid_k >> 6);
    const int G = gridDim.x, bx = blockIdx.x; const int vcu = (G % 8 == 0) ? (bx % 8) * (G / 8) + bx / 8 : bx;
    unsigned char* ws = a.ws;
    float* rstd_x = (float*)(ws + WS_RSTDX); float* partq = (float*)(ws + WS_PARTQ); float* partkv = (float*)(ws + WS_PARTKV); float* party = (float*)(ws + WS_PARTY);
    float* flog = (float*)(ws + WS_FLOG); float* cf = (float*)(ws + WS_CF); float* cosT = (float*)(ws + WS_COS); float* sinT = (float*)(ws + WS_SIN);
    bf16* Win_t = (bf16*)(ws + WS_WIN); bf16* Wuq_t = (bf16*)(ws + WS_WUQ); bf16* Wukv_t = (bf16*)(ws + WS_WUKV); bf16* Wout_t = (bf16*)(ws + WS_WOUT);
    bf16* Xb = (bf16*)(ws + WS_XB); bf16* Ob = (bf16*)(ws + WS_O); bf16* qlat = (bf16*)(ws + WS_QLAT); bf16* kvlat = (bf16*)(ws + WS_KVLAT); bf16* Gb = (bf16*)(ws + WS_G);
    bf16* Qf = (bf16*)(ws + WS_QF); bf16* Kf = (bf16*)(ws + WS_KF); bf16* Vf = (bf16*)(ws + WS_VF); bf16* Yb = (bf16*)(ws + WS_Y);
    bf16* Qm = (bf16*)(ws + WS_QM); bf16* Km = (bf16*)(ws + WS_KM); bf16* Vm = (bf16*)(ws + WS_VM);
    const int lo = a.ph_lo, hi = a.ph_hi;
#ifndef PH_MASK
#define PH_MASK 63
#endif
#define IN(k) (((PH_MASK >> (k)) & 1) && lo <= (k) && (k) < hi)
#define BOTH(k) (IN(k) && IN((k) + 1))
    LAS unsigned char* ldsl = (LAS unsigned char*)lds;
    volatile LAS unsigned* bst = (volatile LAS unsigned*)(ldsl + LDS_BYTES - 64);
    if (tid_k < 2) bst[tid_k] = 0u;
    __syncthreads();
    XcdBarrier xbar = xcd_barrier_post((unsigned*)(ws + WS_CTL), bst);

    if (IN(0)) for (int rep_ = 0; rep_ < PROBE_REP0; ++rep_) {
        const int lane = launder(lane_k), tid = launder(tid_k);
        LAS float* scr = (LAS float*)(ldsl + wave * 16384);
        const int gw = vcu * 8 + wave, NGW = G * 8;
        constexpr int I_IN = 32 * 208, I_UQ = 12 * 48, I_UKV = 8 * 64, I_OUT = 32 * 64, NITEMS = I_IN + I_UQ + I_UKV + I_OUT;
        for (int it = gw; it < NITEMS; it += NGW) {
            int r = it;
            if (r < I_IN) { const int kb = r / 208, nb = r % 208; int src, nv; win_src(nb * 32, src, nv); transpose_item(a.w_in, DIN, 2048, a.g_pre, Win_t, nb * 32, src, nv, kb * 64, scr, lane); continue; } r -= I_IN;
            if (r < I_UQ) { const int kb = r / 48, nb = r % 48; transpose_item(a.w_uq, 1536, 768, a.g_q, Wuq_t, nb * 32, wuq_src(nb * 32), 32, kb * 64, scr, lane); continue; } r -= I_UQ;
            if (r < I_UKV) { const int kb = r / 64, nb = r % 64; transpose_item(a.w_ukv, 2048, 512, a.g_kv, Wukv_t, nb * 32, nb * 32, 32, kb * 64, scr, lane); continue; } r -= I_UKV;
            { const int kb = r / 64, nb = r % 64; transpose_item(a.w_out, 2048, 2048, nullptr, Wout_t, nb * 32, nb * 32, 32, kb * 64, scr, lane); }
        }
        for (int m = gw; m < M; m += 2 * NGW) {
            const int m2 = m + NGW;
            const f32x4* xr = (const f32x4*)(a.x + (size_t)m * DM) + lane; const f32x4* xr2 = (const f32x4*)(a.x + (size_t)m2 * DM) + lane; f32x4 v[8], v2[8]; float s = 0.f, s2 = 0.f;
#pragma unroll
            for (int j = 0; j < 8; ++j) { v[j] = __builtin_nontemporal_load(xr + 64 * j); v2[j] = __builtin_nontemporal_load(xr2 + 64 * j); }
#pragma unroll
            for (int j = 0; j < 8; ++j) { s += (v[j][0] * v[j][0] + v[j][1] * v[j][1]) + (v[j][2] * v[j][2] + v[j][3] * v[j][3]); s2 += (v2[j][0] * v2[j][0] + v2[j][1] * v2[j][1]) + (v2[j][2] * v2[j][2] + v2[j][3] * v2[j][3]); }
            s = wave_sum(s); s2 = wave_sum(s2);
            if (lane == 0) { rstd_x[m] = 1.f / sqrtf(s * (1.f / DM) + EPS); rstd_x[m2] = 1.f / sqrtf(s2 * (1.f / DM) + EPS); }
            u32x2* o8 = (u32x2*)(Xb + (size_t)m * DM) + lane; u32x2* o82 = (u32x2*)(Xb + (size_t)m2 * DM) + lane;
#pragma unroll
            for (int j = 0; j < 8; ++j) { u32x2 w; w.x = pk2(v[j][0], v[j][1]); w.y = pk2(v[j][2], v[j][3]); o8[64 * j] = w; u32x2 w2; w2.x = pk2(v2[j][0], v2[j][1]); w2.y = pk2(v2[j][2], v2[j][3]); o82[64 * j] = w2; }
        }
        for (int e = (vcu * 512 + tid); e < M * 32; e += G * 512) { const int row = e >> 5, i = e & 31;
            const float inv = exp2f(-(float)i * (13.287712379549449f / 32.f)); const float ang = (float)a.pos[row] * inv;
            const float n = rintf(ang * 0.15915494309189535f); float r = fmaf(-n, 6.28318548202514648f, ang); r = fmaf(-n, -1.7484555e-7f, r);
            cosT[e] = __cosf(r); sinT[e] = __sinf(r); }
    }
    if (BOTH(0)) xcd_barrier(xbar);
    if (a.ph_hi > 64) grid.sync();

    if (IN(1)) for (int rep_ = 0; rep_ < PROBE_REP1; ++rep_) {
        pg8::Gemm g{Xb, Win_t, M, NIN_PAD, 2048}; pg8::StaticOrder S; S.init(M, NIN_PAD, G, bx);
        EpiIn E{rstd_x, qlat, kvlat, Gb, Qf, Kf, Vf, Km, flog, partq, partkv, cosT, sinT};
        pg8::gemm_phase<EpiIn, pg8::StaticOrder, true, true>(ldsl, g, S, E);
    }
    if (BOTH(1)) xcd_barrier(xbar);

    if (IN(2)) for (int rep_ = 0; rep_ < PROBE_REP2; ++rep_) {
        const int lane = launder(lane_k), tid = launder(tid_k);
        if (bx >= G - BATCH * NH) { const int sq_ = bx - (G - BATCH * NH);
            const int b = sq_ >> 3, h = sq_ & 7; const float bf = a.b_forget[h];
            const float* fl = flog + ((size_t)b * SEQ + 8 * tid) * 8 + h; float lf[8];
#pragma unroll
            for (int j = 0; j < 8; ++j) lf[j] = fl[j * 8] + bf;
#pragma unroll
            for (int j = 0; j < 8; ++j) { const float z = lf[j]; lf[j] = fminf(z, 0.f) - log1pf(expf(-fabsf(z))); }
#pragma unroll
            for (int j = 1; j < 8; ++j) lf[j] += lf[j - 1];
            float incl = lf[7];
#pragma unroll
            for (int o = 1; o < 64; o <<= 1) { const float t = __shfl_up(incl, o); if (lane >= o) incl += t; }
            volatile LAS float* wtot = (volatile LAS float*)(ldsl + LDS_BYTES - 128);
            if (lane == 63) wtot[wave] = incl;
            __syncthreads();
            float off = incl - lf[7];
            for (int w2 = 0; w2 < wave; ++w2) off += wtot[w2];
            float* cp = cf + (size_t)sq_ * SEQ + 8 * tid;
            f32x4 o0, o1;
#pragma unroll
            for (int j = 0; j < 4; ++j) { o0[j] = (off + lf[j]) * LOG2E; o1[j] = (off + lf[4 + j]) * LOG2E; }
            *(f32x4*)cp = o0; *(f32x4*)(cp + 4) = o1;
            __syncthreads();
        }
        { pg8::Gemm g{qlat, Wuq_t, M, 1536, QRANK}; pg8::StaticOrder S; S.init(M, 1536, G, bx);
          EpiQ E{partq, Qm, cosT, sinT};
          pg8::gemm_phase<EpiQ, pg8::StaticOrder, true, true>(ldsl, g, S, E); }
        { pg8::Gemm g{kvlat, Wukv_t, M, 2048, KVRANK}; pg8::StaticOrder S; S.init(M, 2048, G, bx);
          EpiKV E{partkv, Km, Vm};
          pg8::gemm_phase<EpiKV, pg8::StaticOrder, true, true>(ldsl, g, S, E); }
    }
    if (BOTH(2)) xcd_barrier(xbar);

    if (IN(3)) for (int rep_ = 0; rep_ < PROBE_REP3; ++rep_) {
        for (int v = vcu; v < 256; v += G) {
            const int s = v & 3, w = v >> 2, b = w >> 4, hh = w & 15, hd = hh & 7, swp = hh >> 3;
            const size_t rb = (size_t)b * SEQ;
#pragma unroll 1
            for (int i = 0; i < 2; ++i) {
                const int qb = __builtin_amdgcn_readfirstlane(swp ? (i == 0 ? 8 + s : 7 - s) : (i == 0 ? 15 - s : s));
                att::attn_unit<192, false>((char*)lds, Qm + rb * 1536 + hd * 192, 1536, Km + rb * 1536 + hd * 192, 1536, Vm + rb * 1024 + hd * 128, 1024, nullptr,
                                           Gb + rb * 2048 + hd * 128, Ob + rb * 2048 + hd * 128, qb);
            }
#pragma unroll 1
            for (int i = 0; i < 2; ++i) {
                const int qb = __builtin_amdgcn_readfirstlane(swp ? (i == 0 ? 15 - s : s) : (i == 0 ? 8 + s : 7 - s));
                att::attn_unit<128, true>((char*)lds, Qf + rb * 1024 + hd * 128, 1024, Kf + rb * 1024 + hd * 128, 1024, Vf + rb * 1024 + hd * 128, 1024, cf + (size_t)(b * 8 + hd) * SEQ,
                                          Gb + rb * 2048 + 1024 + hd * 128, Ob + rb * 2048 + 1024 + hd * 128, qb);
            }
        }
    }
#if PROBE_ABL >= 0
    if (IN(3)) {
        for (int v = vcu; v < 256; v += G) {
            const int s = v & 3, w = v >> 2, b = w >> 4, hh = w & 15, hd = hh & 7, swp = hh >> 3;
            const size_t rb = (size_t)b * SEQ;
#pragma unroll 1
            for (int i = 0; i < 2; ++i) {
                const int qb = __builtin_amdgcn_readfirstlane(swp ? (i == 0 ? 8 + s : 7 - s) : (i == 0 ? 15 - s : s));
                att::attn_unit<192, false, PROBE_ABL>((char*)lds, Qm + rb * 1536 + hd * 192, 1536, Km + rb * 1536 + hd * 192, 1536, Vm + rb * 1024 + hd * 128, 1024, nullptr,
                                           Gb + rb * 2048 + hd * 128, qlat, qb);
            }
#pragma unroll 1
            for (int i = 0; i < 2; ++i) {
                const int qb = __builtin_amdgcn_readfirstlane(swp ? (i == 0 ? 15 - s : s) : (i == 0 ? 8 + s : 7 - s));
                att::attn_unit<128, true, PROBE_ABL>((char*)lds, Qf + rb * 1024 + hd * 128, 1024, Kf + rb * 1024 + hd * 128, 1024, Vf + rb * 1024 + hd * 128, 1024, cf + (size_t)(b * 8 + hd) * SEQ,
                                          Gb + rb * 2048 + 1024 + hd * 128, qlat, qb);
            }
        }
    }
#endif
    if (BOTH(3)) xcd_barrier(xbar);

    if (IN(4)) for (int rep_ = 0; rep_ < PROBE_REP4; ++rep_) {
        pg8::Gemm g{Ob, Wout_t, M, 2048, 2048}; pg8::StaticOrder S; S.init(M, 2048, G, bx);
        EpiOut E{Yb, party};
        pg8::gemm_phase<EpiOut, pg8::StaticOrder, true, true>(ldsl, g, S, E);
    }
    if (BOTH(4)) xcd_barrier(xbar);

    if (IN(5)) for (int rep_ = 0; rep_ < PROBE_REP5; ++rep_) {
        const int lane = launder(lane_k);
        const int gw = vcu * 8 + wave, NGW = G * 8;
        const f32x4* gp = (const f32x4*)a.g_post + lane; f32x4 gv[8];
#pragma unroll
        for (int j = 0; j < 8; ++j) gv[j] = gp[64 * j];
        for (int m = gw; m < M; m += 2 * NGW) {
            const int m2 = m + NGW;
            float s = (lane < 32) ? party[(size_t)m * 32 + lane] : 0.f, s2 = (lane < 32) ? party[(size_t)m2 * 32 + lane] : 0.f;
            const f32x4* xr = (const f32x4*)(a.x + (size_t)m * DM) + lane; const f32x4* xr2 = (const f32x4*)(a.x + (size_t)m2 * DM) + lane;
            const u32x2* yr = (const u32x2*)(Yb + (size_t)m * DM) + lane; const u32x2* yr2 = (const u32x2*)(Yb + (size_t)m2 * DM) + lane;
            f32x4 xv[8], xv2[8]; u32x2 y[8], y2[8];
#pragma unroll
            for (int j = 0; j < 8; ++j) { xv[j] = __builtin_nontemporal_load(xr + 64 * j); xv2[j] = __builtin_nontemporal_load(xr2 + 64 * j); y[j] = __builtin_nontemporal_load(yr + 64 * j); y2[j] = __builtin_nontemporal_load(yr2 + 64 * j); }
            s = wave_sum(s); s2 = wave_sum(s2);
            const float rs = 1.f / sqrtf(s * (1.f / DM) + EPS), rs2 = 1.f / sqrtf(s2 * (1.f / DM) + EPS);
            f32x4* orow = (f32x4*)(a.out + (size_t)m * DM) + lane; f32x4* orow2 = (f32x4*)(a.out + (size_t)m2 * DM) + lane;
#pragma unroll
            for (int j = 0; j < 8; ++j) {
                f32x4 o; o[0] = xv[j][0] + bflo(y[j].x) * rs * gv[j][0]; o[1] = xv[j][1] + bfhi(y[j].x) * rs * gv[j][1]; o[2] = xv[j][2] + bflo(y[j].y) * rs * gv[j][2]; o[3] = xv[j][3] + bfhi(y[j].y) * rs * gv[j][3];
                __builtin_nontemporal_store(o, orow + 64 * j);
                f32x4 o2; o2[0] = xv2[j][0] + bflo(y2[j].x) * rs2 * gv[j][0]; o2[1] = xv2[j][1] + bfhi(y2[j].x) * rs2 * gv[j][1]; o2[2] = xv2[j][2] + bflo(y2[j].y) * rs2 * gv[j][2]; o2[3] = xv2[j][3] + bfhi(y2[j].y) * rs2 * gv[j][3];
                __builtin_nontemporal_store(o2, orow2 + 64 * j); }
        }
    }
#undef IN
#undef BOTH
}

extern "C" void kernel_launch(void* const* d_in, const int* in_sizes, int n_in, void* d_out, int out_size, void* d_ws, size_t ws_size, hipStream_t stream) {
    static int grid = 0;
    if (grid == 0) {
        if (n_in != 11 || in_sizes[0] != M * DM || out_size != M * DM || ws_size < WS_END) { fprintf(stderr, "kernel_launch: shape mismatch n_in %d in0 %d out %d ws %zu\n", n_in, n_in > 0 ? in_sizes[0] : -1, out_size, ws_size); grid = -1; return; }
        int dev = 0, cus = 0, per_cu = 0;
        if (hipGetDevice(&dev) != hipSuccess || hipDeviceGetAttribute(&cus, hipDeviceAttributeMultiprocessorCount, dev) != hipSuccess) { grid = -1; return; }
        if (hipFuncSetAttribute((const void*)hybrid_fwd, hipFuncAttributeMaxDynamicSharedMemorySize, LDS_BYTES) != hipSuccess) { fprintf(stderr, "kernel_launch: hipFuncSetAttribute failed\n"); grid = -1; return; }
        if (hipOccupancyMaxActiveBlocksPerMultiprocessor(&per_cu, (const void*)hybrid_fwd, 512, LDS_BYTES) != hipSuccess || per_cu < 1) { fprintf(stderr, "kernel_launch: occupancy query says %d\n", per_cu); per_cu = 1; }
        (void)hipGetLastError();
        grid = cus;
    }
    if (grid < 0) return;
    if (hipMemsetAsync((char*)d_ws + WS_CTL, 0, CTL_BYTES, stream) != hipSuccess) { fprintf(stderr, "kernel_launch: memset failed\n"); return; }
    Args a{};
    a.x = (const float*)d_in[0]; a.pos = (const int*)d_in[1]; a.g_pre = (const float*)d_in[2]; a.w_in = (const float*)d_in[3]; a.g_q = (const float*)d_in[4]; a.w_uq = (const float*)d_in[5];
    a.g_kv = (const float*)d_in[6]; a.w_ukv = (const float*)d_in[7]; a.b_forget = (const float*)d_in[8]; a.w_out = (const float*)d_in[9]; a.g_post = (const float*)d_in[10];
    a.out = (float*)d_out; a.ws = (unsigned char*)d_ws;
#if MK_N_LAUNCHES == 1
    a.ph_lo = 0; a.ph_hi = 6;
    void* args[] = {&a};
    hipError_t e = hipLaunchCooperativeKernel((const void*)hybrid_fwd, dim3(grid), dim3(512), args, LDS_BYTES, stream);
    if (e != hipSuccess) fprintf(stderr, "cooperative launch failed: %s (grid %d)\n", hipGetErrorString(e), grid);
#else
    for (int p = 0; p < 6; ++p) { a.ph_lo = p; a.ph_hi = p + 1; for (int r = 0; r < (p == PROBE_DUP ? 2 : 1); ++r) hipLaunchKernelGGL(hybrid_fwd, dim3(grid), dim3(512), LDS_BYTES, stream, a); }
#endif
}
```
